# Optimizing an MI355X kernel written in HIP

```python
import jax, jax.numpy as jnp
from jax import lax
import numpy as np

D_MODEL = 1024
BATCH = 2
SEQ = 8192
DEPTH = 4

N_MEM = 256
FOX_HEADS = 8
FOX_HEAD_DIM = D_MODEL // 16
FOX_WIDTH = FOX_HEADS * FOX_HEAD_DIM
Q_BLOCK = 128
HGRN_HEADS = 4
HGRN_KEY_DIM = D_MODEL // 16
HGRN_VAL_DIM = D_MODEL // 16
HGRN_KEY_WIDTH = HGRN_HEADS * HGRN_KEY_DIM
HGRN_WIDTH = HGRN_HEADS * HGRN_VAL_DIM
HGRN_CHUNK = 16
CONV_CH = D_MODEL // 4
CONV_GROUPS = 4
CONV_WIDTH = 31
MIX_WIDTH = FOX_WIDTH + HGRN_WIDTH + CONV_CH
IN_SIZES = (FOX_WIDTH, FOX_WIDTH, FOX_WIDTH, FOX_HEADS,
            HGRN_KEY_WIDTH, HGRN_KEY_WIDTH, HGRN_WIDTH, HGRN_WIDTH,
            CONV_CH, CONV_CH)
IN_WIDTH = 3 * FOX_WIDTH + FOX_HEADS + 2 * HGRN_KEY_WIDTH + 2 * HGRN_WIDTH + 2 * CONV_CH
XATT_HEADS = 4
XATT_HEAD_DIM = D_MODEL // XATT_HEADS
N_GROUPS = 4
EXPERTS_PER_GROUP = 4
EXPERT_TOPK = 2
EXPERT_FF = D_MODEL // 4
EPS = 1e-6

kernel_name = "hybrid_fox_hgrn2_conformer_hmoe"


def rmsnorm(x, g):
    xf = x.astype(jnp.float32)
    y = xf * lax.rsqrt(jnp.mean(xf * xf, axis=-1, keepdims=True) + EPS)
    return (y * g.astype(jnp.float32)).astype(x.dtype)


def split_columns(y, sizes):
    out, start = [], 0
    for n in sizes:
        out.append(y[..., start:start + n])
        start += n
    return out


def forgetting_attention(q, k, v, log_f):
    B, H, S, d = q.shape
    c = jnp.cumsum(log_f, axis=-1)
    nb = S // Q_BLOCK
    qb = q.reshape(B, H, nb, Q_BLOCK, d).transpose(2, 0, 1, 3, 4)
    cb = c.reshape(B, H, nb, Q_BLOCK).transpose(2, 0, 1, 3)
    qpos = jnp.arange(S, dtype=jnp.int32).reshape(nb, Q_BLOCK)
    kpos = jnp.arange(S, dtype=jnp.int32)
    scale = d ** -0.5

    def block(args):
        qi, ci, pi = args
        s = jnp.einsum('bhqd,bhkd->bhqk', qi, k).astype(jnp.float32) * scale
        s = s + (ci[..., None] - c[:, :, None, :])
        s = jnp.where(pi[:, None] >= kpos[None, :], s, -jnp.inf)
        p = jax.nn.softmax(s, axis=-1)
        return jnp.einsum('bhqk,bhkd->bhqd', p.astype(v.dtype), v)

    out = lax.map(block, (qb, cb, qpos))
    return out.transpose(1, 2, 0, 3, 4).reshape(B, H, S, d)


def hgrn2_recurrence(q, f_pre, v, lb):
    B, S, H, K = q.shape
    V = v.shape[-1]
    C = HGRN_CHUNK
    N = S // C
    f = lb + (1.0 - lb) * jax.nn.sigmoid(f_pre.astype(jnp.float32))
    g = jnp.log(f)
    k = 1.0 - f

    def chunks(t):
        return t.reshape(B, N, C, H, t.shape[-1]).transpose(0, 3, 1, 2, 4)

    qc = chunks(q.astype(jnp.float32))
    kc = chunks(k)
    vc = chunks(v.astype(jnp.float32))
    b = jnp.cumsum(chunks(g), axis=3)
    b_last = b[:, :, :, -1:, :]
    b_mid = b[:, :, :, C // 2:C // 2 + 1, :]
    attn = jnp.einsum('bhncK,bhnsK->bhncs', qc * jnp.exp(b - b_mid), kc * jnp.exp(b_mid - b))
    causal = jnp.tril(jnp.ones((C, C), dtype=bool))
    attn = jnp.where(causal, attn, 0.0)
    o_intra = jnp.einsum('bhncs,bhnsv->bhncv', attn, vc)
    u = jnp.einsum('bhncK,bhncv->bhnKv', kc * jnp.exp(b_last - b), vc)
    decay = jnp.exp(b_last[:, :, :, 0, :])

    def step(state, inp):
        dec, uu = inp
        return state * dec[..., None] + uu, state

    _, s_prev = lax.scan(step, jnp.zeros((B, H, K, V), jnp.float32),
                         (decay.transpose(2, 0, 1, 3), u.transpose(2, 0, 1, 3, 4)))
    s_prev = s_prev.transpose(1, 2, 0, 3, 4)
    o_inter = jnp.einsum('bhncK,bhnKv->bhncv', qc * jnp.exp(b), s_prev)
    o = (o_intra + o_inter).transpose(0, 2, 3, 1, 4).reshape(B, S, H, V)
    return o.astype(q.dtype)


def causal_depthwise_conv(a, w, bias):
    y = lax.conv_general_dilated(a, w[:, None, :].astype(a.dtype), window_strides=(1,),
                                 padding=[(CONV_WIDTH - 1, 0)],
                                 dimension_numbers=('NWC', 'WIO', 'NWC'),
                                 feature_group_count=a.shape[-1])
    return y + bias.astype(a.dtype)


def channel_group_norm(a, g, bias):
    B, S, C = a.shape
    af = a.astype(jnp.float32).reshape(B, S, CONV_GROUPS, C // CONV_GROUPS)
    mu = jnp.mean(af, axis=-1, keepdims=True)
    var = jnp.mean(jnp.square(af - mu), axis=-1, keepdims=True)
    y = ((af - mu) * lax.rsqrt(var + EPS)).reshape(B, S, C)
    return (y * g + bias).astype(a.dtype)


def hybrid_mixer(h, w_in, fox_f_bias, fox_norm_g, lb, hgrn_norm_g,
                 conv_w, conv_b, conv_norm_g, conv_norm_b, w_out):
    B, S, _ = h.shape
    y = h @ w_in
    fq, fk, fv, ff, hq, hf, hi, hg, cu, cg = split_columns(y, IN_SIZES)
    to_heads = lambda t: t.reshape(B, S, FOX_HEADS, FOX_HEAD_DIM).transpose(0, 2, 1, 3)
    log_f = jax.nn.log_sigmoid((ff + fox_f_bias).astype(jnp.float32)).transpose(0, 2, 1)
    fo = forgetting_attention(to_heads(fq), to_heads(fk), to_heads(fv), log_f).transpose(0, 2, 1, 3)
    fo = rmsnorm(fo, fox_norm_g.reshape(FOX_HEADS, FOX_HEAD_DIM)).reshape(B, S, FOX_WIDTH)
    ho = hgrn2_recurrence(hq.reshape(B, S, HGRN_HEADS, HGRN_KEY_DIM),
                          hf.reshape(B, S, HGRN_HEADS, HGRN_KEY_DIM),
                          hi.reshape(B, S, HGRN_HEADS, HGRN_VAL_DIM),
                          lb.reshape(HGRN_HEADS, HGRN_KEY_DIM))
    ho = rmsnorm(ho, hgrn_norm_g.reshape(HGRN_HEADS, HGRN_VAL_DIM)).reshape(B, S, HGRN_WIDTH) * jax.nn.silu(hg)
    a = cu * jax.nn.sigmoid(cg)
    a = causal_depthwise_conv(a, conv_w, conv_b)
    co = jax.nn.silu(channel_group_norm(a, conv_norm_g, conv_norm_b))
    return jnp.concatenate([fo, ho, co], axis=-1) @ w_out


def cross_attention(h, mem_n, w_xq, w_xkv, w_xo):
    B, S, D = h.shape
    M = mem_n.shape[1]
    q = (h @ w_xq).reshape(B, S, XATT_HEADS, XATT_HEAD_DIM)
    k, v = jnp.split(mem_n @ w_xkv, 2, axis=-1)
    k = k.reshape(B, M, XATT_HEADS, XATT_HEAD_DIM)
    v = v.reshape(B, M, XATT_HEADS, XATT_HEAD_DIM)
    s = jnp.einsum('bshd,bmhd->bhsm', q, k).astype(jnp.float32) * (XATT_HEAD_DIM ** -0.5)
    p = jax.nn.softmax(s, axis=-1)
    o = jnp.einsum('bhsm,bmhd->bshd', p.astype(v.dtype), v).reshape(B, S, D)
    return o @ w_xo


def hierarchical_moe(h, w_group, b_group, w_router, b_router, w_gate, w_up, w_down):
    B, S, D = h.shape
    t = h.reshape(-1, D)
    n = t.shape[0]
    g_logits = (t @ w_group).astype(jnp.float32) + b_group
    p_group = jax.nn.softmax(g_logits, axis=-1)
    g_idx = jnp.argmax(g_logits, axis=-1)
    p_gsel = jnp.take_along_axis(p_group, g_idx[:, None], axis=1)[:, 0]
    e_logits = ((t @ w_router).astype(jnp.float32) + b_router).reshape(n, N_GROUPS, EXPERTS_PER_GROUP)
    e_sel = jnp.take_along_axis(e_logits, g_idx[:, None, None], axis=1)[:, 0]
    p_exp = jax.nn.softmax(e_sel, axis=-1)
    top_v, top_i = lax.top_k(p_exp, EXPERT_TOPK)
    top_v = top_v / jnp.sum(top_v, axis=-1, keepdims=True)
    e_w = jnp.sum(jax.nn.one_hot(top_i, EXPERTS_PER_GROUP, dtype=jnp.float32) * top_v[..., None], axis=1)
    combine = (p_gsel[:, None, None] * jax.nn.one_hot(g_idx, N_GROUPS, dtype=jnp.float32)[:, :, None]
               * e_w[:, None, :]).astype(t.dtype)
    out = jnp.zeros_like(t)
    for grp in range(N_GROUPS):
        hid = jax.nn.silu(jnp.einsum('nd,edf->nef', t, w_gate[grp])) * jnp.einsum('nd,edf->nef', t, w_up[grp])
        out = out + jnp.einsum('nef,efd->nd', hid * combine[:, grp, :, None], w_down[grp])
    return out.reshape(B, S, D)


def setup_inputs(seed: int = 0) -> dict:
    key = jax.random.key(seed)
    ks = jax.random.split(key, 32)
    nrm = lambda k, shape, scale: jax.random.normal(k, shape, jnp.float32) * scale
    gain = lambda k, shape: 1.0 + 0.02 * jax.random.normal(k, shape, jnp.float32)
    G, E, F = N_GROUPS, EXPERTS_PER_GROUP, EXPERT_FF
    return {
        "x": nrm(ks[0], (BATCH, SEQ, D_MODEL), 1.0),
        "mem": nrm(ks[1], (BATCH, N_MEM, D_MODEL), 1.0),
        "mix_norm_g": gain(ks[2], (DEPTH, D_MODEL)),
        "w_in": nrm(ks[3], (DEPTH, D_MODEL, IN_WIDTH), D_MODEL ** -0.5),
        "fox_f_bias": 2.0 + 0.5 * jax.random.normal(ks[4], (DEPTH, FOX_HEADS), jnp.float32),
        "fox_norm_g": gain(ks[5], (DEPTH, FOX_WIDTH)),
        "hgrn_lb_logits": nrm(ks[6], (DEPTH, HGRN_KEY_WIDTH), 0.5),
        "hgrn_norm_g": gain(ks[7], (DEPTH, HGRN_WIDTH)),
        "conv_w": nrm(ks[8], (DEPTH, CONV_WIDTH, CONV_CH), CONV_WIDTH ** -0.5),
        "conv_b": nrm(ks[9], (DEPTH, CONV_CH), 0.02),
        "conv_norm_g": gain(ks[10], (DEPTH, CONV_CH)),
        "conv_norm_b": nrm(ks[11], (DEPTH, CONV_CH), 0.02),
        "w_out": nrm(ks[12], (DEPTH, MIX_WIDTH, D_MODEL), MIX_WIDTH ** -0.5),
        "xatt_norm_g": gain(ks[13], (DEPTH, D_MODEL)),
        "mem_norm_g": gain(ks[14], (D_MODEL,)),
        "w_xq": nrm(ks[15], (DEPTH, D_MODEL, D_MODEL), D_MODEL ** -0.5),
        "w_xkv": nrm(ks[16], (DEPTH, D_MODEL, 2 * D_MODEL), D_MODEL ** -0.5),
        "w_xo": nrm(ks[17], (DEPTH, D_MODEL, D_MODEL), D_MODEL ** -0.5),
        "ffn_norm_g": gain(ks[18], (DEPTH, D_MODEL)),
        "w_group": nrm(ks[19], (DEPTH, D_MODEL, G), D_MODEL ** -0.5),
        "b_group": nrm(ks[20], (DEPTH, G), 0.01),
        "w_router": nrm(ks[21], (DEPTH, D_MODEL, G * E), D_MODEL ** -0.5),
        "b_router": nrm(ks[22], (DEPTH, G * E), 0.01),
        "w_gate": nrm(ks[23], (DEPTH, G, E, D_MODEL, F), D_MODEL ** -0.5),
        "w_up": nrm(ks[24], (DEPTH, G, E, D_MODEL, F), D_MODEL ** -0.5),
        "w_down": nrm(ks[25], (DEPTH, G, E, F, D_MODEL), F ** -0.5),
        "final_norm_g": gain(ks[26], (D_MODEL,)),
    }


def reference(x, mem, mix_norm_g, w_in, fox_f_bias, fox_norm_g, hgrn_lb_logits, hgrn_norm_g,
              conv_w, conv_b, conv_norm_g, conv_norm_b, w_out, xatt_norm_g, mem_norm_g,
              w_xq, w_xkv, w_xo, ffn_norm_g, w_group, b_group, w_router, b_router,
              w_gate, w_up, w_down, final_norm_g):
    mem_n = rmsnorm(mem, mem_norm_g)
    lb_all = jnp.cumsum(jax.nn.softmax(hgrn_lb_logits.astype(jnp.float32), axis=0), axis=0)
    lb_all = lb_all - lb_all[0:1]
    for l in range(DEPTH):
        x = x + hybrid_mixer(rmsnorm(x, mix_norm_g[l]), w_in[l], fox_f_bias[l], fox_norm_g[l],
                             lb_all[l], hgrn_norm_g[l], conv_w[l], conv_b[l],
                             conv_norm_g[l], conv_norm_b[l], w_out[l])
        x = x + cross_attention(rmsnorm(x, xatt_norm_g[l]), mem_n, w_xq[l], w_xkv[l], w_xo[l])
        x = x + hierarchical_moe(rmsnorm(x, ffn_norm_g[l]), w_group[l], b_group[l], w_router[l],
                                 b_router[l], w_gate[l], w_up[l], w_down[l])
    return rmsnorm(x, final_norm_g)
```

```cpp
#include <hip/hip_runtime.h>
#include <cstdio>
#include <cstdint>

#ifndef USE_MFMA
#define USE_MFMA 1
#endif
#ifndef ONE_LAUNCH
#define ONE_LAUNCH 1
#endif
#ifndef DIS
#define DIS 0
#endif
#define PHON(k) (!(((DIS) >> (k)) & 1))
#ifndef FOX_PRUNE
#define FOX_PRUNE 0
#endif

#define LAS __attribute__((address_space(3)))
#define GAS __attribute__((address_space(1)))
typedef unsigned short bf16_t;
typedef short bf16x8 __attribute__((ext_vector_type(8)));
typedef float f32x4 __attribute__((ext_vector_type(4)));
typedef float f32x2 __attribute__((ext_vector_type(2)));
typedef unsigned u32x4 __attribute__((ext_vector_type(4)));
typedef unsigned u32x2 __attribute__((ext_vector_type(2)));

constexpr int NTOK = 16384, DM = 1024, SEQ = 8192, NLAYER = 4, NY = 3072;
constexpr float EPS = 1e-6f, LOG2E = 1.4426950408889634f;
constexpr float C2 = 0.125f * LOG2E;
constexpr int NWAVES = 8, NTHR = 512;

constexpr size_t MiB = 1u << 20;
constexpr size_t WS_CTL = 0, CTL_ZERO_BYTES = 64 * 1024;
constexpr size_t WS_WFF = 1 * MiB;
constexpr size_t WS_WR = 1 * MiB + 256 * 1024;
constexpr size_t WS_LOGF = 2 * MiB;
constexpr size_t WS_CFOX = 2 * MiB + 512 * 1024;
constexpr size_t WS_SSQ = 3 * MiB;
constexpr size_t WS_HU = 4 * MiB;
constexpr size_t WS_HD = 8 * MiB;
constexpr size_t WS_TOKC = 9 * MiB;
constexpr size_t WS_WTS = 10 * MiB + 512 * 1024;
constexpr size_t WS_MEMN = 11 * MiB;
constexpr size_t WS_KV = 12 * MiB;
constexpr size_t WS_WIN = 20 * MiB;
constexpr size_t WS_WOUT = 44 * MiB;
constexpr size_t WS_WQK = 52 * MiB;
constexpr size_t WS_WVO = 68 * MiB;
constexpr size_t WS_WGU = 84 * MiB;
constexpr size_t WS_WD = 148 * MiB;
constexpr size_t WS_XB = 180 * MiB;
constexpr size_t WS_CAT = 212 * MiB;
constexpr size_t WS_R1 = 244 * MiB;
constexpr size_t WS_PBUF = WS_R1;
constexpr size_t WS_HID = WS_R1 + 32 * MiB;
constexpr size_t WS_WQS = WS_R1;
constexpr size_t WS_WKVT = WS_R1 + 8 * MiB;
constexpr size_t WS_WOT = WS_R1 + 24 * MiB;
constexpr size_t WS_END = 340 * MiB;

constexpr int CW_TMO = 0, CW_KQMAX = 256, CW_MOECNT = 512, CW_BAR = 4096;

constexpr int LDS_STAGE = 0, LDS_STAGE_BYTES = 131072;
constexpr int LDS_EPI = 131072;
constexpr int LDS_MISC = 131072 + 8192;
constexpr int LDS_BYTES = 131072 + 8192 + 1024;

__device__ __forceinline__ float bf2f(unsigned b) { return __uint_as_float(b << 16); }
__device__ __forceinline__ unsigned cvt_pk_bf16(float lo, float hi) { unsigned r; asm volatile("v_cvt_pk_bf16_f32 %0, %1, %2" : "=v"(r) : "v"(lo), "v"(hi)); return r; }
__device__ __forceinline__ unsigned short f2bf1(float f) { return (unsigned short)(cvt_pk_bf16(f, 0.f) & 0xffffu); }
template <int K> __device__ __forceinline__ float swz_xor(float v) { return __int_as_float(__builtin_amdgcn_ds_swizzle(__float_as_int(v), (K << 10) | 0x1f)); }
__device__ __forceinline__ float x32_sum(float v) { auto r = __builtin_amdgcn_permlane32_swap(__float_as_uint(v), __float_as_uint(v), false, false); return __uint_as_float(r[0]) + __uint_as_float(r[1]); }
__device__ __forceinline__ float x32_max(float v) { auto r = __builtin_amdgcn_permlane32_swap(__float_as_uint(v), __float_as_uint(v), false, false); return fmaxf(__uint_as_float(r[0]), __uint_as_float(r[1])); }
__device__ __forceinline__ float wave_sum(float v) {
    v += swz_xor<1>(v); v += swz_xor<2>(v); v += swz_xor<4>(v); v += swz_xor<8>(v); v += swz_xor<16>(v);
    return x32_sum(v);
}
__device__ __forceinline__ float sigmoidf_(float x) { return 1.f / (1.f + __expf(-x)); }
#define LDS_WAIT() asm volatile("s_waitcnt lgkmcnt(0)" ::: "memory")
#define VM_WAIT() asm volatile("s_waitcnt vmcnt(0)" ::: "memory")

#define XB_TMO      128
#define XB_XCNT(j)  (256  + 64 * (j))
#define XB_XSUB(j)  (1280 + 64 * (j))
#define XB_XGEN(j)  (2304 + 64 * (j))
#define XB_TOP      3328
#define XB_TOPGEN   3392
#define XCD_BAR_WORDS 3456
#define XB_SPIN_CAP (1u << 22)
__device__ __forceinline__ unsigned xb_ld(unsigned* p)              { return __hip_atomic_load(p, __ATOMIC_RELAXED, __HIP_MEMORY_SCOPE_AGENT); }
__device__ __forceinline__ unsigned xb_add(unsigned* p, unsigned v) { return __hip_atomic_fetch_add(p, v, __ATOMIC_RELAXED, __HIP_MEMORY_SCOPE_AGENT); }
__device__ __forceinline__ unsigned xb_xcc_id() { return (unsigned)__builtin_amdgcn_s_getreg((3 << 11) | 20) & 0xFu; }
#define XB_SPIN(cond, bar) do { unsigned _sp = 0; while (cond) { __builtin_amdgcn_s_sleep(1); \
    if ((++_sp & 255u) == 0u) { if (xb_ld(&(bar)[XB_TMO])) break; if (_sp > XB_SPIN_CAP) { atomicAdd(&(bar)[XB_TMO], 1u); break; } } } } while (0)
struct XcdBarrier { unsigned* bar; unsigned x; volatile LAS unsigned* st; };
__device__ __forceinline__ XcdBarrier xcd_barrier_post(unsigned* bar, volatile LAS unsigned* st) {
    XcdBarrier b; b.bar = bar; b.x = xb_xcc_id(); b.st = st;
    if (threadIdx.x == 0) (void)xb_add(&bar[XB_XCNT(b.x)], 1u);
    return b;
}
__device__ __forceinline__ void xcd_barrier_complete(unsigned* bar, unsigned x, unsigned& nloc, unsigned& nx) {
    const unsigned G = gridDim.x * gridDim.y * gridDim.z;
    unsigned sum, cnt, mine, sp = 0u;
    for (;;) {
        sum = 0u; cnt = 0u; mine = 0u;
#pragma unroll
        for (unsigned j = 0; j < 16; ++j) { const unsigned c = xb_ld(&bar[XB_XCNT(j)]); sum += c; cnt += (c > 0u) ? 1u : 0u; mine = (j == x) ? c : mine; }
        if (sum == G) break;
        __builtin_amdgcn_s_sleep(1);
        if ((++sp & 255u) == 0u) { if (xb_ld(&bar[XB_TMO])) break; if (sp > XB_SPIN_CAP) { atomicAdd(&bar[XB_TMO], 1u); break; } }
    }
    nloc = mine > 0u ? mine : 1u; nx = cnt > 0u ? cnt : 1u;
}
__device__ __forceinline__ void xcd_barrier(const XcdBarrier& b) {
    asm volatile("s_waitcnt vmcnt(0)" ::: "memory");
    __syncthreads();
    if (threadIdx.x == 0) {
        unsigned* bar = b.bar;
        __builtin_amdgcn_s_waitcnt(0);
        unsigned nloc = b.st[0], nx = b.st[1];
        if (nloc == 0u) { xcd_barrier_complete(bar, b.x, nloc, nx); b.st[0] = nloc; b.st[1] = nx; }
        const unsigned old = xb_add(&bar[XB_XSUB(b.x)], 1u);
        const unsigned gen = old / nloc;
        if (old + 1u == (gen + 1u) * nloc) {
            __builtin_amdgcn_fence(__ATOMIC_RELEASE, "agent");
            asm volatile("s_waitcnt vmcnt(0)" ::: "memory");
            const unsigned og = xb_add(&bar[XB_TOP], 1u);
            const unsigned tg = og / nx;
            if (og + 1u == (tg + 1u) * nx) xb_add(&bar[XB_TOPGEN], 1u);
            else XB_SPIN(xb_ld(&bar[XB_TOPGEN]) == tg, bar);
            __builtin_amdgcn_fence(__ATOMIC_ACQUIRE, "agent");
            xb_add(&bar[XB_XGEN(b.x)], 1u);
            asm volatile("s_waitcnt vmcnt(0)" ::: "memory");
        } else {
            XB_SPIN(xb_ld(&bar[XB_XGEN(b.x)]) == gen, bar);
            __builtin_amdgcn_fence(__ATOMIC_ACQUIRE, "agent");
            asm volatile("s_waitcnt vmcnt(0)" ::: "memory");
        }
    }
    __syncthreads();
}

namespace pg8 {
constexpr int BM = 256, BK = 64, HALF = 128, HTB = HALF * BK * 2;
__host__ __device__ __forceinline__ int lds_byte(int r, int c) { const int st = (r >> 4) * 2 + (c >> 5), rr = r & 15, cc = c & 31, ob = rr * 64 + cc * 2; return st * 1024 + (ob ^ (((ob >> 9) & 1) << 5)); }
__host__ __device__ __forceinline__ void stage_rc(int b, int& R, int& C) { const int st = b / 1024, sb = b % 1024, swz = sb ^ (((sb >> 9) & 1) << 5); R = (st >> 1) * 16 + swz / 64; C = (st & 1) * 32 + (swz % 64) / 2; }
__host__ __device__ __forceinline__ int perm32(int rho) { const int n = rho >> 4, i = rho & 15; return 8 * (i >> 2) + 4 * n + (i & 3); }

struct Unit { int pm, pn, a0, a1, a2, a3; };
struct GemmDesc { int K; unsigned lda, ldb; int ksplit; };


#if USE_MFMA
template <class Epi, class Sched, bool ALIGN_EPI, bool GATHER, bool BSPLIT>
__device__ __forceinline__ void gemm_phase(LAS unsigned char* lds, const GemmDesc g, const Sched& S, const Epi& E) {
    int tid = threadIdx.x; asm volatile("" : "+v"(tid));
    const int wid = __builtin_amdgcn_readfirstlane(tid >> 6), lane = tid & 63, wr = wid >> 2, wc = wid & 3, fr = lane & 15, fq = lane >> 4;
    const int nt = g.K / BK;
    int R0, C0; stage_rc(tid * 16, R0, C0);
    const unsigned voffB = (unsigned)((R0 & ~31) + perm32(R0 & 31)) * g.ldb + (unsigned)C0 * 2u, voffA = (unsigned)R0 * g.lda + (unsigned)C0 * 2u;
    const size_t qstepA = (size_t)64 * g.lda, qstepB = (size_t)64 * g.ldb;
    const size_t kstep = (size_t)(BK * 2);
    const size_t hstepB = (size_t)HALF * g.ldb, hstepA = GATHER ? (size_t)0 : (size_t)HALF * g.lda;
    const unsigned ldsw = (unsigned)wid * 1024u;
    const int aoff = lds_byte(wr * 64 + fr, fq * 8), boff = lds_byte(wc * 32 + fr, fq * 8);
#define PG8_SA(b, h) (((b) * 2 + (h)) * HTB)
#define PG8_SB(b, h) ((4 + (b) * 2 + (h)) * HTB)
#define PG8_STAGE(bufoff, gbase, voff) do { _Pragma("unroll") for (int _i = 0; _i < 2; ++_i) \
        __builtin_amdgcn_global_load_lds((const unsigned*)((const char*)(gbase) + (voff)[_i]), (LAS unsigned*)(lds + (bufoff) + ldsw + _i * 8192), 16, 0, 0); } while (0)
#define PG8_STAGE1(bufoff, gbase, voff, qstep) do { _Pragma("unroll") for (int _i = 0; _i < 2; ++_i) \
        __builtin_amdgcn_global_load_lds((const unsigned*)((const char*)(gbase) + _i * (qstep) + (voff)), (LAS unsigned*)(lds + (bufoff) + ldsw + _i * 8192), 16, 0, 0); } while (0)
#define PG8_STAGE_B(bufoff, gbase) PG8_STAGE1(bufoff, gbase, voffB, qstepB)
#define PG8_LDA(dst, b, h) do { _Pragma("unroll") for (int m = 0; m < 4; ++m) _Pragma("unroll") for (int k = 0; k < 2; ++k) dst[m][k] = *(const LAS bf16x8*)(lds + PG8_SA(b, h) + aoff + m * 2048 + k * 1024); } while (0)
#define PG8_LDB(dst, b, h) do { _Pragma("unroll") for (int n = 0; n < 2; ++n) _Pragma("unroll") for (int k = 0; k < 2; ++k) dst[n][k] = *(const LAS bf16x8*)(lds + PG8_SB(b, h) + boff + n * 2048 + k * 1024); } while (0)
#define PG8_MMA(ai, bj, At, Bt) do { __builtin_amdgcn_s_setprio(1); _Pragma("unroll") for (int m = 0; m < 4; ++m) _Pragma("unroll") for (int n = 0; n < 2; ++n) _Pragma("unroll") for (int k = 0; k < 2; ++k) \
        acc[ai][bj][m][n] = __builtin_amdgcn_mfma_f32_16x16x32_bf16(Bt[n][k], At[m][k], acc[ai][bj][m][n], 0, 0, 0); __builtin_amdgcn_s_setprio(0); } while (0)
#define PG8_WAIT_V(n) asm volatile("s_waitcnt vmcnt(" #n ")" ::: "memory")
#define PG8_WAIT_L(n) asm volatile("s_waitcnt lgkmcnt(" #n ")" ::: "memory")
#define PG8_BAR __builtin_amdgcn_s_barrier()
#define PG8_SCHED __builtin_amdgcn_sched_barrier(0)
#define PG8_OFFS(u, o) do { if constexpr (GATHER) { _Pragma("unroll") for (int _h = 0; _h < 2; ++_h) _Pragma("unroll") for (int _i = 0; _i < 2; ++_i) \
        o[_h][_i] = S.arow(u, _h * 128 + _i * 64 + R0) + (unsigned)C0 * 2u; } } while (0)
#define PG8_STAGE_A(bufoff, gbase, h, OFF) do { if constexpr (GATHER) { PG8_STAGE(bufoff, gbase, OFF[h]); } else { PG8_STAGE1(bufoff, (gbase) + (h) * hstepA, voffA, qstepA); } } while (0)
#define PG8_BP(base, base2, tt) (((BSPLIT && (tt) >= g.ksplit) ? (base2) : (base)) + (size_t)(tt) * kstep)
    Unit cur, nxt; int ui = 0;
    if (!S.next(0, cur)) return;
    f32x4 acc[2][2][4][2];
#pragma unroll
    for (int a = 0; a < 2; ++a)
#pragma unroll
        for (int b = 0; b < 2; ++b)
#pragma unroll
            for (int m = 0; m < 4; ++m)
#pragma unroll
                for (int n = 0; n < 2; ++n) acc[a][b][m][n] = (f32x4){0.f, 0.f, 0.f, 0.f};
    bf16x8 At[4][2], B0[2][2], B1[2][2];
    unsigned coff[2][2], noff[2][2];
#pragma unroll
    for (int h = 0; h < 2; ++h)
#pragma unroll
        for (int i = 0; i < 2; ++i) { coff[h][i] = 0u; noff[h][i] = 0u; }
    PG8_OFFS(cur, coff);
    const char* cA = S.A(cur); const char* cB = S.B(cur); const char* cB2 = BSPLIT ? S.B2(cur) : cB;
    PG8_STAGE_B(PG8_SB(0, 0), cB); PG8_STAGE_B(PG8_SB(0, 1), cB + hstepB); PG8_STAGE_A(PG8_SA(0, 0), cA, 0, coff); PG8_STAGE_A(PG8_SA(0, 1), cA, 1, coff);
    if (wr == 1) PG8_BAR;
    PG8_WAIT_V(2); PG8_BAR;
    PG8_STAGE_B(PG8_SB(1, 0), cB + kstep); PG8_STAGE_A(PG8_SA(1, 0), cA + kstep, 0, coff); PG8_STAGE_B(PG8_SB(1, 1), cB + hstepB + kstep);
    PG8_WAIT_V(6); PG8_BAR;
    for (;;) {
        const bool has_next = S.next(ui + 1, nxt);
        const char* nA = has_next ? S.A(nxt) : cA; const char* nB = has_next ? S.B(nxt) : cB; const char* nB2 = (BSPLIT && has_next) ? S.B2(nxt) : cB2;
        if constexpr (GATHER) { if (has_next) { PG8_OFFS(nxt, noff); } else {
#pragma unroll
            for (int h = 0; h < 2; ++h)
#pragma unroll
                for (int i = 0; i < 2; ++i) noff[h][i] = coff[h][i]; } }
        for (int t = 0; t < nt; t += 2) {
            const bool last = (t == nt - 2);
            const char* a1 = cA + (size_t)(t + 1) * kstep;
            const char* a2 = last ? nA : cA + (size_t)(t + 2) * kstep;
            const char* b2 = last ? nB : PG8_BP(cB, cB2, t + 2);
            const char* a3 = a2 + kstep;
            const char* b3 = last ? nB + kstep : PG8_BP(cB, cB2, t + 3);
            unsigned o2[2][2];
#pragma unroll
            for (int h = 0; h < 2; ++h)
#pragma unroll
                for (int i = 0; i < 2; ++i) o2[h][i] = GATHER ? (last ? noff[h][i] : coff[h][i]) : 0u;
            PG8_LDB(B0, 0, 0); PG8_LDB(B1, 0, 1); PG8_SCHED; PG8_LDA(At, 0, 0); PG8_STAGE_A(PG8_SA(1, 1), a1, 1, coff);
            PG8_WAIT_V(8); PG8_WAIT_L(0); PG8_BAR; PG8_MMA(0, 0, At, B0); PG8_MMA(0, 1, At, B1); PG8_BAR; PG8_SCHED;
            PG8_LDA(At, 0, 1); PG8_STAGE_B(PG8_SB(0, 0), b2); PG8_STAGE_B(PG8_SB(0, 1), b2 + hstepB); PG8_STAGE_A(PG8_SA(0, 0), a2, 0, o2);
            PG8_WAIT_V(8); PG8_WAIT_L(0); PG8_BAR; PG8_MMA(1, 0, At, B0); PG8_MMA(1, 1, At, B1); PG8_BAR; PG8_SCHED;
            PG8_LDB(B0, 1, 0); PG8_LDB(B1, 1, 1); PG8_SCHED; PG8_LDA(At, 1, 0); PG8_STAGE_A(PG8_SA(0, 1), a2, 1, o2);
            PG8_WAIT_V(8); PG8_WAIT_L(0); PG8_BAR; PG8_MMA(0, 0, At, B0); PG8_MMA(0, 1, At, B1); PG8_BAR; PG8_SCHED;
            PG8_LDA(At, 1, 1); PG8_STAGE_B(PG8_SB(1, 0), b3); PG8_STAGE_B(PG8_SB(1, 1), b3 + hstepB); PG8_STAGE_A(PG8_SA(1, 0), a3, 0, o2);
            PG8_WAIT_V(8); PG8_WAIT_L(0); PG8_BAR; PG8_MMA(1, 0, At, B0); PG8_MMA(1, 1, At, B1); PG8_BAR; PG8_SCHED;
        }
        if constexpr (ALIGN_EPI) { if (wr == 0) PG8_BAR; }
        { int t2 = threadIdx.x; asm volatile("" : "+v"(t2)); const int l2 = t2 & 63; E(acc, cur, wr, wc, l2 & 15, l2 >> 4); }
        if (!has_next) break;
#pragma unroll
        for (int a = 0; a < 2; ++a)
#pragma unroll
            for (int b = 0; b < 2; ++b)
#pragma unroll
                for (int m = 0; m < 4; ++m)
#pragma unroll
                    for (int n = 0; n < 2; ++n) acc[a][b][m][n] = (f32x4){0.f, 0.f, 0.f, 0.f};
        cur = nxt; cA = nA; cB = nB; cB2 = nB2; ++ui;
#pragma unroll
        for (int h = 0; h < 2; ++h)
#pragma unroll
            for (int i = 0; i < 2; ++i) coff[h][i] = noff[h][i];
        if constexpr (ALIGN_EPI) { if (wr == 1) PG8_BAR; }
    }
    PG8_WAIT_V(0);
    if constexpr (!ALIGN_EPI) { if (wr == 0) PG8_BAR; }
    PG8_BAR;
#undef PG8_SA
#undef PG8_SB
#undef PG8_STAGE
#undef PG8_LDA
#undef PG8_LDB
#undef PG8_MMA
#undef PG8_WAIT_V
#undef PG8_WAIT_L
#undef PG8_BAR
#undef PG8_SCHED
#undef PG8_OFFS
#undef PG8_STAGE_A
#undef PG8_STAGE1
#undef PG8_STAGE_B
#undef PG8_BP
}
#else
template <class Epi, class Sched, bool ALIGN_EPI, bool GATHER, bool BSPLIT>
__device__ __forceinline__ void gemm_phase(LAS unsigned char* lds, const GemmDesc g, const Sched& S, const Epi& E) {
    const int tid = threadIdx.x, wid = __builtin_amdgcn_readfirstlane(tid >> 6), lane = tid & 63, wr = wid >> 2, wc = wid & 3, fr = lane & 15, fq = lane >> 4;
    Unit cur;
    for (int ui = 0; S.next(ui, cur); ++ui) {
        f32x4 acc[2][2][4][2];
#pragma unroll
        for (int a = 0; a < 2; ++a)
#pragma unroll
            for (int b = 0; b < 2; ++b)
#pragma unroll
                for (int m = 0; m < 4; ++m)
#pragma unroll
                    for (int n = 0; n < 2; ++n) acc[a][b][m][n] = (f32x4){0.f, 0.f, 0.f, 0.f};
        const char* cA = S.A(cur); const char* cB = S.B(cur); const char* cB2 = BSPLIT ? S.B2(cur) : cB;
        unsigned aro[2][4];
#pragma unroll
        for (int ai = 0; ai < 2; ++ai)
#pragma unroll
            for (int m = 0; m < 4; ++m) { const int r = ai * 128 + wr * 64 + m * 16 + fr; aro[ai][m] = GATHER ? S.arow(cur, r) : (unsigned)r * g.lda; }
        for (int k0 = 0; k0 < g.K; k0 += 4) {
            u32x2 av[2][4];
#pragma unroll
            for (int ai = 0; ai < 2; ++ai)
#pragma unroll
                for (int m = 0; m < 4; ++m) av[ai][m] = *(const u32x2*)(cA + aro[ai][m] + (size_t)k0 * 2);
            const char* bb = (BSPLIT && k0 >= g.ksplit * 64) ? cB2 : cB;
#pragma unroll
            for (int bj = 0; bj < 2; ++bj)
#pragma unroll
                for (int n = 0; n < 2; ++n)
#pragma unroll
                    for (int j = 0; j < 4; ++j) {
                        const int c = bj * 128 + wc * 32 + fq * 8 + n * 4 + j;
                        const u32x2 bv = *(const u32x2*)(bb + (size_t)c * g.ldb + (size_t)k0 * 2);
                        const float b0 = bf2f(bv.x & 0xffffu), b1 = bf2f(bv.x >> 16), b2 = bf2f(bv.y & 0xffffu), b3 = bf2f(bv.y >> 16);
#pragma unroll
                        for (int ai = 0; ai < 2; ++ai)
#pragma unroll
                            for (int m = 0; m < 4; ++m) {
                                const u32x2 a = av[ai][m];
                                acc[ai][bj][m][n][j] += bf2f(a.x & 0xffffu) * b0 + bf2f(a.x >> 16) * b1 + bf2f(a.y & 0xffffu) * b2 + bf2f(a.y >> 16) * b3;
                            }
                    }
        }
        E(acc, cur, wr, wc, fr, fq);
    }
    __syncthreads();
}
#endif
}
using pg8::Unit; using pg8::GemmDesc;

__device__ __forceinline__ float row_rstd(const float* ssq, int row) {
    const f32x4* p = (const f32x4*)(ssq + (size_t)row * 16);
    const f32x4 a = p[0], b = p[1], c = p[2], d = p[3];
    const float s = ((a.x + a.y) + (a.z + a.w)) + ((b.x + b.y) + (b.z + b.w)) + ((c.x + c.y) + (c.z + c.w)) + ((d.x + d.y) + (d.z + d.w));
    return rsqrtf(s * (1.f / 1024.f) + EPS);
}
__device__ __forceinline__ u32x4 pack8(f32x4 v0, f32x4 v1) { u32x4 w; w.x = cvt_pk_bf16(v0[0], v0[1]); w.y = cvt_pk_bf16(v0[2], v0[3]); w.z = cvt_pk_bf16(v1[0], v1[1]); w.w = cvt_pk_bf16(v1[2], v1[3]); return w; }

struct EpiBf16 {
    bf16_t* O; int ldc; const float* ssq;
    __device__ __forceinline__ void operator()(const f32x4 (&acc)[2][2][4][2], const Unit& u, int wr, int wc, int fr, int fq) const {
#pragma unroll
        for (int ai = 0; ai < 2; ++ai)
#pragma unroll
            for (int m = 0; m < 4; ++m) {
                const int r = ai * 128 + wr * 64 + m * 16 + fr;
                const float rs = ssq ? row_rstd(ssq, u.a1 + r) : 1.f;
                bf16_t* rowp = O + (size_t)u.a0 + (size_t)r * ldc + wc * 32 + fq * 8;
#pragma unroll
                for (int bj = 0; bj < 2; ++bj) *(u32x4*)(rowp + bj * 128) = pack8(acc[ai][bj][m][0] * rs, acc[ai][bj][m][1] * rs);
                __builtin_amdgcn_sched_barrier(0);
            }
    }
};
struct EpiResidual {
    const float* xin; float* xout; bf16_t* xb; float* ssq;
    __device__ __forceinline__ void operator()(const f32x4 (&acc)[2][2][4][2], const Unit& u, int wr, int wc, int fr, int fq) const {
#pragma unroll
        for (int ai = 0; ai < 2; ++ai)
#pragma unroll
            for (int m = 0; m < 4; ++m) {
                const int row = u.pm * 256 + ai * 128 + wr * 64 + m * 16 + fr;
                float ss = 0.f;
#pragma unroll
                for (int bj = 0; bj < 2; ++bj) {
                    const size_t o = (size_t)row * DM + u.pn * 256 + bj * 128 + wc * 32 + fq * 8;
                    const f32x4 v0 = acc[ai][bj][m][0] + *(const f32x4*)(xin + o), v1 = acc[ai][bj][m][1] + *(const f32x4*)(xin + o + 4);
                    *(f32x4*)(xout + o) = v0; *(f32x4*)(xout + o + 4) = v1;
                    *(u32x4*)(xb + o) = pack8(v0, v1);
                    ss += (v0[0] * v0[0] + v0[1] * v0[1]) + (v0[2] * v0[2] + v0[3] * v0[3]) + (v1[0] * v1[0] + v1[1] * v1[1]) + (v1[2] * v1[2] + v1[3] * v1[3]);
                }
                ss += swz_xor<16>(ss); ss = x32_sum(ss);
                if (fq == 0) ssq[(size_t)row * 16 + u.pn * 4 + wc] = ss;
                __builtin_amdgcn_sched_barrier(0);
            }
    }
};
struct EpiSoftmax {
    bf16_t* P; const float* ssq; LAS float* scr;
    __device__ __forceinline__ void operator()(const f32x4 (&acc)[2][2][4][2], const Unit& u, int wr, int wc, int fr, int fq) const {
#pragma unroll
        for (int ai = 0; ai < 2; ++ai)
#pragma unroll
            for (int m = 0; m < 4; ++m) {
                const int rl = ai * 128 + wr * 64 + m * 16 + fr;
                const float rs = row_rstd(ssq, u.pm * 256 + rl) * (LOG2E / 16.f);
                float mm = -INFINITY;
#pragma unroll
                for (int bj = 0; bj < 2; ++bj)
#pragma unroll
                    for (int n = 0; n < 2; ++n)
#pragma unroll
                        for (int j = 0; j < 4; ++j) mm = fmaxf(mm, acc[ai][bj][m][n][j] * rs);
                mm = fmaxf(mm, swz_xor<16>(mm)); mm = x32_max(mm);
                if (fq == 0) scr[rl * 4 + wc] = mm;
            }
        LDS_WAIT(); __builtin_amdgcn_s_barrier();
#pragma unroll
        for (int ai = 0; ai < 2; ++ai)
#pragma unroll
            for (int m = 0; m < 4; ++m) {
                const int rl = ai * 128 + wr * 64 + m * 16 + fr;
                const float rs = row_rstd(ssq, u.pm * 256 + rl) * (LOG2E / 16.f);
                const f32x4 q = *(const LAS f32x4*)(scr + rl * 4);
                const float M = fmaxf(fmaxf(q.x, q.y), fmaxf(q.z, q.w));
                float s = 0.f;
#pragma unroll
                for (int bj = 0; bj < 2; ++bj)
#pragma unroll
                    for (int n = 0; n < 2; ++n)
#pragma unroll
                        for (int j = 0; j < 4; ++j) s += __builtin_amdgcn_exp2f(acc[ai][bj][m][n][j] * rs - M);
                s += swz_xor<16>(s); s = x32_sum(s);
                if (fq == 0) scr[1024 + rl * 4 + wc] = s;
            }
        LDS_WAIT(); __builtin_amdgcn_s_barrier();
#pragma unroll
        for (int ai = 0; ai < 2; ++ai)
#pragma unroll
            for (int m = 0; m < 4; ++m) {
                const int rl = ai * 128 + wr * 64 + m * 16 + fr;
                const float r = row_rstd(ssq, u.pm * 256 + rl) * (LOG2E / 16.f);
                const f32x4 qm = *(const LAS f32x4*)(scr + rl * 4);
                const float M = fmaxf(fmaxf(qm.x, qm.y), fmaxf(qm.z, qm.w));
                const f32x4 q = *(const LAS f32x4*)(scr + 1024 + rl * 4);
                const float inv = 1.f / ((q.x + q.y) + (q.z + q.w));
                bf16_t* rowp = P + (size_t)(u.pm * 256 + rl) * DM + u.pn * 256 + wc * 32 + fq * 8;
#pragma unroll
                for (int bj = 0; bj < 2; ++bj) {
                    f32x4 v0, v1;
#pragma unroll
                    for (int j = 0; j < 4; ++j) { v0[j] = __builtin_amdgcn_exp2f(acc[ai][bj][m][0][j] * r - M) * inv; v1[j] = __builtin_amdgcn_exp2f(acc[ai][bj][m][1][j] * r - M) * inv; }
                    *(u32x4*)(rowp + bj * 128) = pack8(v0, v1);
                }
            }
        LDS_WAIT(); __builtin_amdgcn_s_barrier();
    }
};
struct EpiMoeUp {
    bf16_t* hid; const int* tokc; const float* ssq; const f32x2* wts;
    __device__ __forceinline__ void operator()(const f32x4 (&acc)[2][2][4][2], const Unit& u, int wr, int wc, int fr, int fq) const {
#pragma unroll
        for (int ai = 0; ai < 2; ++ai)
#pragma unroll
            for (int m = 0; m < 4; ++m) {
                const int rl = ai * 128 + wr * 64 + m * 16 + fr;
                const bool valid = rl < u.a2;
                const int tok = valid ? tokc[u.a1 + rl] : 0;
                const float rs = row_rstd(ssq, tok);
                const f32x2 w2 = wts[tok];
                const float w = valid ? (u.a3 ? w2.y : w2.x) : 0.f;
                f32x4 h[2];
#pragma unroll
                for (int n = 0; n < 2; ++n)
#pragma unroll
                    for (int j = 0; j < 4; ++j) { const float gt = acc[ai][0][m][n][j] * rs, up = acc[ai][1][m][n][j] * rs; h[n][j] = gt / (1.f + __expf(-gt)) * up * w; }
                *(u32x4*)(hid + (size_t)(u.a0 + rl) * 512 + u.a3 * 256 + u.pn * 128 + wc * 32 + fq * 8) = pack8(h[0], h[1]);
            }
    }
};
struct EpiMoeDown {
    float* x; bf16_t* xb; float* ssq; const int* tokc;
    __device__ __forceinline__ void operator()(const f32x4 (&acc)[2][2][4][2], const Unit& u, int wr, int wc, int fr, int fq) const {
#pragma unroll
        for (int ai = 0; ai < 2; ++ai)
#pragma unroll
            for (int m = 0; m < 4; ++m) {
                const int rl = ai * 128 + wr * 64 + m * 16 + fr;
                const bool valid = rl < u.a2;
                const int tok = valid ? tokc[u.a1 + rl] : 0;
                float ss = 0.f;
                if (valid) {
#pragma unroll
                    for (int bj = 0; bj < 2; ++bj) {
                        const size_t o = (size_t)tok * DM + u.pn * 256 + bj * 128 + wc * 32 + fq * 8;
                        const f32x4 v0 = acc[ai][bj][m][0] + *(const f32x4*)(x + o), v1 = acc[ai][bj][m][1] + *(const f32x4*)(x + o + 4);
                        *(f32x4*)(x + o) = v0; *(f32x4*)(x + o + 4) = v1;
                        *(u32x4*)(xb + o) = pack8(v0, v1);
                        ss += (v0[0] * v0[0] + v0[1] * v0[1]) + (v0[2] * v0[2] + v0[3] * v0[3]) + (v1[0] * v1[0] + v1[1] * v1[1]) + (v1[2] * v1[2] + v1[3] * v1[3]);
                    }
                }
                ss += swz_xor<16>(ss); ss = x32_sum(ss);
                if (valid && fq == 0) ssq[(size_t)tok * 16 + u.pn * 4 + wc] = ss;
                __builtin_amdgcn_sched_barrier(0);
            }
    }
};

struct SchedGrid {
    int nM, nN, nwg, G, c; const char* Ab; const char* Bb; size_t astride, bstride, bbatch; int ldc;
    __device__ __forceinline__ bool next(int i, Unit& u) const {
        const long L = (long)i * G + c; if (L >= nwg) return false;
        int wgid = (int)L; { const int q = nwg / 8, r = nwg % 8, xcd = wgid % 8, off = wgid / 8; wgid = (xcd < r ? xcd * (q + 1) : r * (q + 1) + (xcd - r) * q) + off; }
        const int nig = 8 * nN, gid = wgid / nig, fm = gid * 8, gsz = (nM - fm) < 8 ? (nM - fm) : 8;
        u.pm = fm + ((wgid % nig) % gsz); u.pn = (wgid % nig) / gsz;
        u.a0 = u.pm * 256 * ldc + u.pn * 256; u.a1 = u.pm * 256; u.a2 = 0; u.a3 = 0; return true;
    }
    __device__ __forceinline__ const char* A(const Unit& u) const { return Ab + (size_t)u.pm * astride; }
    __device__ __forceinline__ const char* B(const Unit& u) const { return Bb + (size_t)u.pn * bstride + (u.pm >= 32 ? bbatch : 0); }
    __device__ __forceinline__ const char* B2(const Unit& u) const { return B(u); }
    __device__ __forceinline__ unsigned arow(const Unit&, int) const { return 0u; }
};
struct SchedKV {
    int G, c; const char* memn; const char* wkvt;
    __device__ __forceinline__ bool next(int i, Unit& u) const {
        const int L = i * G + c; if (L >= 64) return false;
        const int l = L >> 4; u.pm = (L >> 3) & 1; u.pn = L & 7; u.a2 = l; u.a3 = 0;
        u.a0 = l * 512 * 2048 + u.pm * 256 * 2048 + u.pn * 256; u.a1 = 0; return true;
    }
    __device__ __forceinline__ const char* A(const Unit& u) const { return memn + (size_t)u.pm * 256 * 2048; }
    __device__ __forceinline__ const char* B(const Unit& u) const { return wkvt + ((size_t)u.a2 * 2048 + (size_t)u.pn * 256) * 2048; }
    __device__ __forceinline__ const char* B2(const Unit& u) const { return B(u); }
    __device__ __forceinline__ unsigned arow(const Unit&, int) const { return 0u; }
};
struct SchedQK {
    int G, c; const char* kv; const char* wqs;
    __device__ __forceinline__ bool next(int i, Unit& u) const {
        const int L = i * G + c; if (L >= 128) return false;
        const int l = L >> 5, b = (L >> 4) & 1, h = (L >> 2) & 3; u.pn = L & 3; u.pm = 0; u.a1 = l; u.a2 = b; u.a3 = h;
        u.a0 = ((l * 2 + b) * 1024 + h * 256) * 1024 + u.pn * 256; return true;
    }
    __device__ __forceinline__ const char* A(const Unit& u) const { return kv + (((size_t)u.a1 * 512 + u.a2 * 256) * 2048 + u.a3 * 256) * 2; }
    __device__ __forceinline__ const char* B(const Unit& u) const { return wqs + (((size_t)u.a1 * 1024 + u.pn * 256) * 1024 + u.a3 * 256) * 2; }
    __device__ __forceinline__ const char* B2(const Unit& u) const { return B(u); }
    __device__ __forceinline__ unsigned arow(const Unit&, int) const { return 0u; }
};
struct SchedVO {
    int G, c; const char* kv; const char* wot;
    __device__ __forceinline__ bool next(int i, Unit& u) const {
        const int L = i * G + c; if (L >= 128) return false;
        const int l = L >> 5, b = (L >> 4) & 1, h = (L >> 2) & 3; u.pm = L & 3; u.pn = 0; u.a1 = l; u.a2 = b; u.a3 = h;
        u.a0 = ((l * 2 + b) * 1024 + u.pm * 256) * 1024 + h * 256; return true;
    }
    __device__ __forceinline__ const char* A(const Unit& u) const { return wot + (((size_t)u.a1 * 1024 + u.pm * 256) * 1024 + u.a3 * 256) * 2; }
    __device__ __forceinline__ const char* B(const Unit& u) const { return kv + (((size_t)u.a1 * 512 + u.a2 * 256) * 2048 + 1024 + u.a3 * 256) * 2; }
    __device__ __forceinline__ const char* B2(const Unit& u) const { return B(u); }
    __device__ __forceinline__ unsigned arow(const Unit&, int) const { return 0u; }
};
struct SchedMoe {
    int G, c; bool down; const volatile LAS int* tab; const int* tokc; const char* Ab; const char* Wb;
    __device__ __forceinline__ bool next(int i, Unit& u) const {
        const int L = i * G + c; const int nun = __builtin_amdgcn_readfirstlane(tab[24]) * 4; if (L >= nun) return false;
        const int q = L >> 2, sub = L & 3;
        int cc = 0;
        for (int k = 0; k < 24; ++k) if (q >= tab[k + 1]) cc = k + 1;
        const int j = q - tab[cc], n = tab[32 + cc];
        const int g = cc / 6, pi = cc % 6;
        const int e1 = pi < 3 ? 0 : (pi < 5 ? 1 : 2), e2 = pi < 3 ? pi + 1 : (pi < 5 ? pi - 1 : 3);
        u.a0 = q * 256; u.a1 = cc * 16384 + j * 256; u.a2 = (n - j * 256) < 256 ? (n - j * 256) : 256;
        if (!down) { const int s = sub >> 1; u.a3 = s; u.pn = sub & 1; u.pm = g * 4 + (s ? e2 : e1); }
        else { u.a3 = 0; u.pn = sub; u.pm = (g * 4 + e1) | ((g * 4 + e2) << 8); }
        u.pm = __builtin_amdgcn_readfirstlane(u.pm); u.pn = __builtin_amdgcn_readfirstlane(u.pn); u.a0 = __builtin_amdgcn_readfirstlane(u.a0);
        u.a1 = __builtin_amdgcn_readfirstlane(u.a1); u.a2 = __builtin_amdgcn_readfirstlane(u.a2); u.a3 = __builtin_amdgcn_readfirstlane(u.a3);
        return true;
    }
    __device__ __forceinline__ const char* A(const Unit& u) const { return down ? Ab + (size_t)u.a0 * 1024 : Ab; }
    __device__ __forceinline__ const char* B(const Unit& u) const {
        return down ? Wb + (((size_t)(u.pm & 255) * 1024 + u.pn * 256) * 256) * 2 : Wb + (((size_t)u.pm * 512 + u.pn * 256) * 1024) * 2; }
    __device__ __forceinline__ const char* B2(const Unit& u) const { return Wb + (((size_t)(u.pm >> 8) * 1024 + u.pn * 256) * 256) * 2 - (size_t)4 * 128; }
    __device__ __forceinline__ unsigned arow(const Unit& u, int r) const { const int tok = (r < u.a2) ? tokc[u.a1 + r] : 0; return (unsigned)tok * 2048u; }
};

struct Params { const float* in[27]; float* out; unsigned char* ws; int ph_lo, ph_hi; };
__device__ __forceinline__ const float* pin_(const Params& p, int i) { asm volatile("" : "+s"(i)); return p.in[i]; }
#define PIN(k) pin_(p, (k))

__device__ __forceinline__ void tr_item(const float* src, int ld, int c0, int K, int k0, const float* gain, float scale, bf16_t* dst, LAS float* scr, int lane) {
#pragma unroll 8
    for (int i = 0; i < 32; ++i) { const int kk = 2 * i + (lane >> 5); const float gsc = gain ? gain[k0 + kk] * scale : scale;
        scr[kk * 33 + (lane & 31)] = src[(size_t)(k0 + kk) * ld + c0 + (lane & 31)] * gsc; }
    LDS_WAIT(); asm volatile("" ::: "memory");
    const int c = lane & 7;
#pragma unroll
    for (int j = 0; j < 4; ++j) { const int n = (lane >> 3) + 8 * j; const LAS float* s = scr + (8 * c) * 33 + n;
        u32x4 o; o.x = cvt_pk_bf16(s[0 * 33], s[1 * 33]); o.y = cvt_pk_bf16(s[2 * 33], s[3 * 33]); o.z = cvt_pk_bf16(s[4 * 33], s[5 * 33]); o.w = cvt_pk_bf16(s[6 * 33], s[7 * 33]);
        *(u32x4*)(dst + (size_t)n * K + k0 + 8 * c) = o; }
    LDS_WAIT(); asm volatile("" ::: "memory");
}

__device__ __forceinline__ void phase_pro_a(const Params& p, LAS unsigned char* lds, int bid, int G) {
    int tid = threadIdx.x; asm volatile("" : "+v"(tid));
    const int lane = tid & 63, wave = tid >> 6;
    unsigned char* ws = p.ws; asm volatile("" : "+s"(ws));
    LAS float* scr = (LAS float*)(lds + wave * 16384);
    const int gw = bid * NWAVES + wave, NGW = G * NWAVES;
    constexpr int PER_L = 1536 + 512 + 1024 + 512 + 4096 + 2048;
    for (int it = gw; it < PER_L * NLAYER; it += NGW) {
        const int l = it / PER_L; int r = it % PER_L;
        if (r < 1536) {
            const int kb = r / 96, nb = r % 96, n0 = nb * 32, c0 = n0 < 1536 ? n0 : n0 + 8;
            tr_item(PIN(3) + (size_t)l * 1024 * 3080, 3080, c0, 1024, kb * 64, PIN(2) + l * 1024, n0 < 512 ? C2 : 1.f, (bf16_t*)(ws + WS_WIN) + ((size_t)l * 3072 + n0) * 1024, scr, lane); continue; }
        r -= 1536;
        if (r < 512) {
            const int kb = r / 32, nb = r % 32, k0 = kb * 64;
            const float* gain = k0 < 512 ? PIN(5) + l * 512 : (k0 < 768 ? PIN(7) + l * 256 - 512 : nullptr);
            tr_item(PIN(12) + (size_t)l * 1024 * 1024, 1024, nb * 32, 1024, k0, gain, 1.f, (bf16_t*)(ws + WS_WOUT) + ((size_t)l * 1024 + nb * 32) * 1024, scr, lane); continue; }
        r -= 512;
        if (r < 1024) {
            const int kb = r / 64, nb = r % 64;
            tr_item(PIN(16) + (size_t)l * 1024 * 2048, 2048, nb * 32, 1024, kb * 64, nullptr, 1.f, (bf16_t*)(ws + WS_WKVT) + ((size_t)l * 2048 + nb * 32) * 1024, scr, lane); continue; }
        r -= 1024;
        if (r < 512) {
            const int kb = r / 32, nb = r % 32;
            tr_item(PIN(17) + (size_t)l * 1024 * 1024, 1024, nb * 32, 1024, kb * 64, nullptr, 1.f, (bf16_t*)(ws + WS_WOT) + ((size_t)l * 1024 + nb * 32) * 1024, scr, lane); continue; }
        r -= 512;
        if (r < 4096) {
            const int e = r >> 8, rr = r & 255, kb = rr >> 4, nb = rr & 15;
            const int orow = nb * 32, t = orow >> 8, half = (orow >> 7) & 1, j = orow & 127;
            const float* src = (half ? PIN(24) : PIN(23)) + ((size_t)l * 16 + e) * 1024 * 256;
            tr_item(src, 256, t * 128 + j, 1024, kb * 64, PIN(18) + l * 1024, 1.f, (bf16_t*)(ws + WS_WGU) + (((size_t)l * 16 + e) * 512 + orow) * 1024, scr, lane); continue; }
        r -= 4096;
        {
            const int e = r >> 7, rr = r & 127, kb = rr >> 5, nb = rr & 31;
            tr_item(PIN(25) + ((size_t)l * 16 + e) * 256 * 1024, 1024, nb * 32, 256, kb * 64, nullptr, 1.f, (bf16_t*)(ws + WS_WD) + (((size_t)l * 16 + e) * 1024 + nb * 32) * 256, scr, lane); }
    }
    for (size_t i4 = (size_t)bid * NTHR + tid; i4 < (size_t)NLAYER * 1024 * 256; i4 += (size_t)G * NTHR) {
        const size_t e = i4 * 4; const int l = (int)(e >> 20), k = (int)((e >> 10) & 1023);
        const f32x4 v = *(const f32x4*)(PIN(15) + e); const float gsc = PIN(13)[l * 1024 + k];
        u32x2 o; o.x = cvt_pk_bf16(v.x * gsc, v.y * gsc); o.y = cvt_pk_bf16(v.z * gsc, v.w * gsc);
        *(u32x2*)((bf16_t*)(ws + WS_WQS) + e) = o;
    }
    for (int i = bid * NTHR + tid; i < NLAYER * 28 * 1024; i += G * NTHR) {
        const int l = i / (28 * 1024), r = i % (28 * 1024), j = r >> 10, k = r & 1023;
        if (j < 8) ((float*)(ws + WS_WFF))[(l * 8 + j) * 1024 + k] = PIN(2)[l * 1024 + k] * PIN(3)[((size_t)l * 1024 + k) * 3080 + 1536 + j];
        else { const int jj = j - 8; const float w = jj < 4 ? PIN(19)[(l * 1024 + k) * 4 + jj] : PIN(21)[(l * 1024 + k) * 16 + jj - 4];
            ((float*)(ws + WS_WR))[(l * 20 + jj) * 1024 + k] = PIN(18)[l * 1024 + k] * w; }
    }
    for (int row = gw; row < 512; row += NGW) {
        const f32x4* xr = (const f32x4*)(PIN(1) + (size_t)row * 1024) + lane; f32x4 v[4]; float s = 0.f;
#pragma unroll
        for (int j = 0; j < 4; ++j) { v[j] = xr[64 * j]; s += (v[j].x * v[j].x + v[j].y * v[j].y) + (v[j].z * v[j].z + v[j].w * v[j].w); }
        const float rstd = rsqrtf(wave_sum(s) * (1.f / 1024.f) + EPS);
#pragma unroll
        for (int j = 0; j < 4; ++j) { const f32x4 gg = ((const f32x4*)PIN(14))[64 * j + lane]; u32x2 o; o.x = cvt_pk_bf16(v[j].x * rstd * gg.x, v[j].y * rstd * gg.y); o.y = cvt_pk_bf16(v[j].z * rstd * gg.z, v[j].w * rstd * gg.w);
            ((u32x2*)((bf16_t*)(ws + WS_MEMN) + (size_t)row * 1024))[64 * j + lane] = o; }
    }
    for (int row = gw; row < NTOK; row += NGW) {
        const f32x4* xr = (const f32x4*)(PIN(0) + (size_t)row * 1024) + lane; float s = 0.f;
#pragma unroll
        for (int j = 0; j < 4; ++j) { const f32x4 v = xr[64 * j]; s += (v.x * v.x + v.y * v.y) + (v.z * v.z + v.w * v.w); u32x2 o; o.x = cvt_pk_bf16(v.x, v.y); o.y = cvt_pk_bf16(v.z, v.w);
            ((u32x2*)((bf16_t*)(ws + WS_XB) + (size_t)row * 1024))[64 * j + lane] = o; }
        s = wave_sum(s);
        if (lane < 16) ((float*)(ws + WS_SSQ))[(size_t)row * 16 + lane] = lane == 0 ? s : 0.f;
    }
}

__device__ __forceinline__ void phase_logf(const Params& p, LAS unsigned char* lds, int l, int bid, int G) {
    int tid = threadIdx.x; asm volatile("" : "+v"(tid));
    const int lane = tid & 63, wave = tid >> 6;
    unsigned char* ws = p.ws; asm volatile("" : "+s"(ws));
    LAS float* wl = (LAS float*)lds;
    for (int i = tid; i < 8 * 1024; i += NTHR) wl[i] = ((const float*)(ws + WS_WFF))[l * 8192 + i];
    __syncthreads();
    const int gw = bid * NWAVES + wave, NGW = G * NWAVES;
    for (int row = gw; row < NTOK; row += NGW) {
        const u32x4* xr = (const u32x4*)((const bf16_t*)(ws + WS_XB) + (size_t)row * 1024 + lane * 16);
        const u32x4 a = xr[0], b = xr[1];
        float x[16];
        x[0] = bf2f(a.x & 0xffffu); x[1] = bf2f(a.x >> 16); x[2] = bf2f(a.y & 0xffffu); x[3] = bf2f(a.y >> 16); x[4] = bf2f(a.z & 0xffffu); x[5] = bf2f(a.z >> 16); x[6] = bf2f(a.w & 0xffffu); x[7] = bf2f(a.w >> 16);
        x[8] = bf2f(b.x & 0xffffu); x[9] = bf2f(b.x >> 16); x[10] = bf2f(b.y & 0xffffu); x[11] = bf2f(b.y >> 16); x[12] = bf2f(b.z & 0xffffu); x[13] = bf2f(b.z >> 16); x[14] = bf2f(b.w & 0xffffu); x[15] = bf2f(b.w >> 16);
        const float rs = row_rstd((const float*)(ws + WS_SSQ), row);
        float mine = 0.f;
#pragma unroll
        for (int h = 0; h < 8; ++h) {
            float s = 0.f;
#pragma unroll
            for (int q = 0; q < 4; ++q) { const f32x4 w = *(const LAS f32x4*)(wl + h * 1024 + lane * 16 + q * 4); s += x[4 * q] * w.x + x[4 * q + 1] * w.y + x[4 * q + 2] * w.z + x[4 * q + 3] * w.w; }
            s = wave_sum(s);
            if (lane == h) mine = s;
        }
        if (lane < 8) { const float z = mine * rs + PIN(4)[l * 8 + lane]; ((float*)(ws + WS_LOGF))[(size_t)row * 8 + lane] = fminf(z, 0.f) - __logf(1.f + __expf(-fabsf(z))); }
    }
    __syncthreads();
}

template <bool FINAL>
__device__ __forceinline__ void hgrn_unit(const Params& p, LAS unsigned char* lds, int l, int unit) {
    int tid = threadIdx.x; asm volatile("" : "+v"(tid));
    const int lane = tid & 63, kg = tid >> 6;
    unsigned char* ws = p.ws; asm volatile("" : "+s"(ws));
    const int bh = unit >> 5, sc = unit & 31, b = bh >> 2, h = bh & 3;
    const bf16_t* y = (const bf16_t*)(ws + WS_R1);
    LAS float* F = (LAS float*)lds; LAS float* Q = F + 4096; LAS float* V = F + 8192; LAS float* OP = F + 12288; LAS float* lbv = F + 12288 + 8192;
    if (tid < 64) {
        const int k = h * 64 + tid; float e[4], mx = -INFINITY, den = 0.f, num = 0.f;
#pragma unroll
        for (int i = 0; i < 4; ++i) { e[i] = PIN(6)[i * 256 + k]; mx = fmaxf(mx, e[i]); }
#pragma unroll
        for (int i = 0; i < 4; ++i) { e[i] = __expf(e[i] - mx); den += e[i]; if (i >= 1 && i <= l) num += e[i]; }
        lbv[tid] = num / den;
    }
    float s[8], dp[8];
#pragma unroll
    for (int j = 0; j < 8; ++j) { s[j] = 0.f; dp[j] = 1.f; }
    if (FINAL) {
        const float* U = (const float*)(ws + WS_HU); const float* Dd = (const float*)(ws + WS_HD);
        for (int jj = 0; jj < sc; ++jj) { const int uu = bh * 32 + jj;
#pragma unroll
            for (int j = 0; j < 8; ++j) s[j] = Dd[uu * 64 + kg * 8 + j] * s[j] + U[(size_t)uu * 4096 + (kg * 8 + j) * 64 + lane]; }
    }
    __syncthreads();
    const size_t row0 = (size_t)b * SEQ + sc * 256;
    for (int ch = 0; ch < 4; ++ch) {
#pragma unroll
        for (int j = 0; j < 8; ++j) { const int idx = tid + NTHR * j, tt = idx >> 6, k = idx & 63; const bf16_t* yr = y + (row0 + ch * 64 + tt) * NY;
            const float lb = lbv[k];
            F[idx] = lb + (1.f - lb) * sigmoidf_(bf2f(yr[1792 + h * 64 + k])); Q[idx] = bf2f(yr[1536 + h * 64 + k]); V[idx] = bf2f(yr[2048 + h * 64 + k]); }
        __syncthreads();
        for (int sub = 0; sub < 4; ++sub) {
            for (int t16 = 0; t16 < 16; ++t16) {
                const int tt = sub * 16 + t16;
                const f32x4 f0 = *(const LAS f32x4*)(F + tt * 64 + kg * 8), f1 = *(const LAS f32x4*)(F + tt * 64 + kg * 8 + 4);
                const float vt = V[tt * 64 + lane];
                float fk[8] = {f0.x, f0.y, f0.z, f0.w, f1.x, f1.y, f1.z, f1.w};
                if (FINAL) {
                    const f32x4 q0 = *(const LAS f32x4*)(Q + tt * 64 + kg * 8), q1 = *(const LAS f32x4*)(Q + tt * 64 + kg * 8 + 4);
                    float qk[8] = {q0.x, q0.y, q0.z, q0.w, q1.x, q1.y, q1.z, q1.w}; float op = 0.f;
#pragma unroll
                    for (int j = 0; j < 8; ++j) { s[j] = fk[j] * s[j] + (1.f - fk[j]) * vt; op += qk[j] * s[j]; }
                    OP[(t16 * 8 + kg) * 64 + lane] = op;
                } else {
#pragma unroll
                    for (int j = 0; j < 8; ++j) { s[j] = fk[j] * s[j] + (1.f - fk[j]) * vt; dp[j] *= fk[j]; }
                }
            }
            if (FINAL) {
                __syncthreads();
#pragma unroll
                for (int w2 = 0; w2 < 2; ++w2) { const int t16 = kg * 2 + w2; float o = 0.f;
#pragma unroll
                    for (int g8 = 0; g8 < 8; ++g8) o += OP[(t16 * 8 + g8) * 64 + lane];
                    const float ss = wave_sum(o * o), rstd = rsqrtf(ss * (1.f / 64.f) + EPS);
                    const size_t row = row0 + ch * 64 + sub * 16 + t16;
                    const float hg = bf2f(y[row * NY + 2304 + h * 64 + lane]);
                    ((bf16_t*)(ws + WS_CAT))[row * DM + 512 + h * 64 + lane] = f2bf1(o * rstd * hg * sigmoidf_(hg)); }
                __syncthreads();
            }
        }
        __syncthreads();
    }
    if (!FINAL) {
        float* U = (float*)(ws + WS_HU); float* Dd = (float*)(ws + WS_HD);
#pragma unroll
        for (int j = 0; j < 8; ++j) { U[(size_t)unit * 4096 + (kg * 8 + j) * 64 + lane] = s[j]; if (lane == 0) Dd[unit * 64 + kg * 8 + j] = dp[j]; }
    }
    __syncthreads();
}

__device__ __forceinline__ void conv_unit(const Params& p, LAS unsigned char* lds, int l, int unit) {
    int tid = threadIdx.x; asm volatile("" : "+v"(tid));
    const int lane = tid & 63, wave = tid >> 6;
    unsigned char* ws = p.ws; asm volatile("" : "+s"(ws));
    const bf16_t* y = (const bf16_t*)(ws + WS_R1);
    LAS float* A = (LAS float*)lds; LAS float* Y = (LAS float*)(lds + 65536);
    const int row0 = unit * 32, b = row0 / SEQ, t0 = row0 % SEQ;
    for (int idx = tid; idx < 62 * 256; idx += NTHR) { const int j = idx >> 8, c = idx & 255, t = t0 - 30 + j; float v = 0.f;
        if (t >= 0) { const bf16_t* yr = y + ((size_t)b * SEQ + t) * NY; v = bf2f(yr[2560 + c]) * sigmoidf_(bf2f(yr[2816 + c])); }
        A[idx] = v; }
    __syncthreads();
    { const int c = tid & 255, th = tid >> 8; float w[31];
#pragma unroll
        for (int j = 0; j < 31; ++j) w[j] = PIN(8)[(l * 31 + j) * 256 + c];
        const float bias = PIN(9)[l * 256 + c];
        for (int tl = th * 16; tl < th * 16 + 16; ++tl) { float a = bias;
#pragma unroll
            for (int j = 0; j < 31; ++j) a += w[j] * A[(tl + j) * 256 + c];
            Y[tl * 256 + c] = a; } }
    __syncthreads();
    for (int pr = wave * 16; pr < wave * 16 + 16; ++pr) { const int tl = pr >> 2, grp = pr & 3, c = grp * 64 + lane;
        const float v = Y[tl * 256 + c], mean = wave_sum(v) * (1.f / 64.f), d = v - mean, var = wave_sum(d * d) * (1.f / 64.f);
        const float yn = d * rsqrtf(var + EPS) * PIN(10)[l * 256 + c] + PIN(11)[l * 256 + c];
        ((bf16_t*)(ws + WS_CAT))[(size_t)(row0 + tl) * DM + 768 + c] = f2bf1(yn * sigmoidf_(yn)); }
    __syncthreads();
}

__device__ __forceinline__ void phase_p2a(const Params& p, LAS unsigned char* lds, int l, int bid, int G) {
    int tid = threadIdx.x; asm volatile("" : "+v"(tid));
    const int lane = tid & 63, wave = tid >> 6;
    unsigned char* ws = p.ws; asm volatile("" : "+s"(ws));
    for (int bh = bid; bh < 16; bh += G) { const int b = bh >> 3, h = bh & 7;
        const float* lf = (const float*)(ws + WS_LOGF) + (size_t)b * SEQ * 8 + h;
        float v[16]; float run = 0.f;
#pragma unroll
        for (int i = 0; i < 16; ++i) { run += lf[(size_t)(tid * 16 + i) * 8]; v[i] = run; }
        float incl = run;
#pragma unroll
        for (int o = 1; o < 64; o <<= 1) { const float t = __int_as_float(__builtin_amdgcn_ds_bpermute(((lane - o) & 63) * 4, __float_as_int(incl))); if (lane >= o) incl += t; }
        LAS float* wt = (LAS float*)lds;
        if (lane == 63) wt[wave] = incl;
        __syncthreads();
        float base = incl - run;
        for (int w = 0; w < wave; ++w) base += wt[w];
        float* c = (float*)(ws + WS_CFOX) + (size_t)bh * SEQ + tid * 16;
#pragma unroll
        for (int i = 0; i < 16; ++i) c[i] = base + v[i];
        __syncthreads();
    }
    for (int u = bid; u < 512; u += G) conv_unit(p, lds, l, u);
    for (int u = bid; u < 256; u += G) if ((u & 31) != 31) hgrn_unit<false>(p, lds, l, u);
    { const bf16_t* y = (const bf16_t*)(ws + WS_R1); unsigned* ctl = (unsigned*)(ws + WS_CTL);
        const int gw = bid * NWAVES + wave, NGW = G * NWAVES, rpw = (NTOK + NGW - 1) / NGW;
        float mq = 0.f, mk = 0.f; int curb = -1;
        for (int row = gw * rpw; row < (gw + 1) * rpw && row < NTOK; ++row) {
            const int b = row / SEQ;
            if (b != curb) { if (curb >= 0 && (lane & 7) == 0) { atomicMax(&ctl[CW_KQMAX + ((l * 2 + curb) * 8 + (lane >> 3)) * 2], __float_as_uint(mq)); atomicMax(&ctl[CW_KQMAX + ((l * 2 + curb) * 8 + (lane >> 3)) * 2 + 1], __float_as_uint(mk)); } mq = 0.f; mk = 0.f; curb = b; }
            const u32x4 qa = *(const u32x4*)(y + (size_t)row * NY + lane * 8), ka = *(const u32x4*)(y + (size_t)row * NY + 512 + lane * 8);
            float sq = 0.f, sk = 0.f;
#pragma unroll
            for (int j = 0; j < 4; ++j) { const float a0 = bf2f(qa[j] & 0xffffu), a1 = bf2f(qa[j] >> 16), k0 = bf2f(ka[j] & 0xffffu), k1 = bf2f(ka[j] >> 16); sq += a0 * a0 + a1 * a1; sk += k0 * k0 + k1 * k1; }
            sq += swz_xor<1>(sq); sq += swz_xor<2>(sq); sq += swz_xor<4>(sq);
            sk += swz_xor<1>(sk); sk += swz_xor<2>(sk); sk += swz_xor<4>(sk);
            mq = fmaxf(mq, sq); mk = fmaxf(mk, sk);
        }
        if (curb >= 0 && (lane & 7) == 0) { atomicMax(&ctl[CW_KQMAX + ((l * 2 + curb) * 8 + (lane >> 3)) * 2], __float_as_uint(mq)); atomicMax(&ctl[CW_KQMAX + ((l * 2 + curb) * 8 + (lane >> 3)) * 2 + 1], __float_as_uint(mk)); }
    }
}

__device__ __forceinline__ void attn_unit_simple(const Params& p, int l, int unit) {
    int tid = threadIdx.x; asm volatile("" : "+v"(tid));
    const int lane = tid & 63, wave = tid >> 6;
    unsigned char* ws = p.ws; asm volatile("" : "+s"(ws));
    const int bh = unit >> 4, qb = unit & 15, b = bh >> 3, h = bh & 7;
    const bf16_t* y = (const bf16_t*)(ws + WS_R1);
    const float* cf = (const float*)(ws + WS_CFOX) + (size_t)bh * SEQ;
    const int t = qb * 512 + tid;
    const size_t rowb = (size_t)b * SEQ;
    float q[64], o[64];
    { const u32x4* qr = (const u32x4*)(y + (rowb + t) * NY + h * 64);
#pragma unroll
        for (int i = 0; i < 8; ++i) { const u32x4 a = qr[i];
#pragma unroll
            for (int j = 0; j < 4; ++j) { q[i * 8 + 2 * j] = bf2f(a[j] & 0xffffu); q[i * 8 + 2 * j + 1] = bf2f(a[j] >> 16); } } }
#pragma unroll
    for (int d = 0; d < 64; ++d) o[d] = 0.f;
    const float ct = cf[t] * LOG2E;
    float m = -INFINITY, lsum = 0.f;
    const int twmin = qb * 512 + wave * 64, smax = twmin + 63;
#if FOX_PRUNE
    const unsigned* ctl = (const unsigned*)(ws + WS_CTL);
    const float B2 = sqrtf(__uint_as_float(ctl[CW_KQMAX + ((l * 2 + b) * 8 + h) * 2]) * __uint_as_float(ctl[CW_KQMAX + ((l * 2 + b) * 8 + h) * 2 + 1]));
    const float cmin = cf[twmin] * LOG2E;
#endif
    for (int s = smax; s >= 0; --s) {
        const float cs = cf[s] * LOG2E;
#if FOX_PRUNE
        if (cmin - cs + 2.f * B2 < -44.f) break;
#endif
        const u32x4* kr = (const u32x4*)(y + (rowb + s) * NY + 512 + h * 64);
        float dot = 0.f;
#pragma unroll
        for (int i = 0; i < 8; ++i) { const u32x4 a = kr[i];
#pragma unroll
            for (int j = 0; j < 4; ++j) dot += q[i * 8 + 2 * j] * bf2f(a[j] & 0xffffu) + q[i * 8 + 2 * j + 1] * bf2f(a[j] >> 16); }
        const float sc = dot + ct - cs;
        if (s <= t) {
            if (sc > m) { const float al = __builtin_amdgcn_exp2f(m - sc); lsum *= al;
#pragma unroll
                for (int d = 0; d < 64; ++d) o[d] *= al;
                m = sc; }
            const float pr = __builtin_amdgcn_exp2f(sc - m); lsum += pr;
            const u32x4* vr = (const u32x4*)(y + (rowb + s) * NY + 1024 + h * 64);
#pragma unroll
            for (int i = 0; i < 8; ++i) { const u32x4 a = vr[i];
#pragma unroll
                for (int j = 0; j < 4; ++j) { o[i * 8 + 2 * j] += pr * bf2f(a[j] & 0xffffu); o[i * 8 + 2 * j + 1] += pr * bf2f(a[j] >> 16); } }
        }
    }
    const float inv = 1.f / lsum; float ss = 0.f;
#pragma unroll
    for (int d = 0; d < 64; ++d) { o[d] *= inv; ss += o[d] * o[d]; }
    const float rstd = rsqrtf(ss * (1.f / 64.f) + EPS);
    u32x4* dst = (u32x4*)((bf16_t*)(ws + WS_CAT) + (rowb + t) * DM + h * 64);
#pragma unroll
    for (int i = 0; i < 8; ++i) { u32x4 w; w.x = cvt_pk_bf16(o[i * 8] * rstd, o[i * 8 + 1] * rstd); w.y = cvt_pk_bf16(o[i * 8 + 2] * rstd, o[i * 8 + 3] * rstd); w.z = cvt_pk_bf16(o[i * 8 + 4] * rstd, o[i * 8 + 5] * rstd); w.w = cvt_pk_bf16(o[i * 8 + 6] * rstd, o[i * 8 + 7] * rstd); dst[i] = w; }
}

__device__ __forceinline__ void phase_route(const Params& p, LAS unsigned char* lds, int l, int bid, int G) {
    int tid = threadIdx.x; asm volatile("" : "+v"(tid));
    const int lane = tid & 63, wave = tid >> 6;
    unsigned char* ws = p.ws; asm volatile("" : "+s"(ws));
    LAS float* wl = (LAS float*)lds;
    LAS int* cls = (LAS int*)(lds + 20 * 4096);
    LAS int* basel = cls + 64;
    for (int i = tid; i < 20 * 1024; i += NTHR) wl[i] = ((const float*)(ws + WS_WR))[l * 20480 + i];
    __syncthreads();
    const float* x = p.out; unsigned* ctl = (unsigned*)(ws + WS_CTL);
    for (int u = bid; u < NTOK / 64; u += G) {
        for (int i = 0; i < 8; ++i) {
            const int row = u * 64 + wave * 8 + i;
            const f32x4* xr = (const f32x4*)(x + (size_t)row * 1024) + lane;
            f32x4 v[4]; float ss = 0.f;
#pragma unroll
            for (int j = 0; j < 4; ++j) { v[j] = xr[64 * j]; ss += (v[j].x * v[j].x + v[j].y * v[j].y) + (v[j].z * v[j].z + v[j].w * v[j].w); }
            const float rstd = rsqrtf(wave_sum(ss) * (1.f / 1024.f) + EPS);
            float lg[20];
#pragma unroll
            for (int jj = 0; jj < 20; ++jj) { float s = 0.f;
#pragma unroll
                for (int j = 0; j < 4; ++j) { const f32x4 w = *(const LAS f32x4*)(wl + jj * 1024 + j * 256 + lane * 4); s += v[j].x * w.x + v[j].y * w.y + v[j].z * w.z + v[j].w * w.w; }
                lg[jj] = wave_sum(s) * rstd + (jj < 4 ? PIN(20)[l * 4 + jj] : PIN(22)[l * 16 + jj - 4]); }
            int gi = 0; float gm = lg[0];
#pragma unroll
            for (int j = 1; j < 4; ++j) if (lg[j] > gm) { gm = lg[j]; gi = j; }
            float den = 0.f;
#pragma unroll
            for (int j = 0; j < 4; ++j) den += __expf(lg[j] - gm);
            const float pg = 1.f / den;
            float e[4];
#pragma unroll
            for (int j = 0; j < 4; ++j) e[j] = gi == 0 ? lg[4 + j] : (gi == 1 ? lg[8 + j] : (gi == 2 ? lg[12 + j] : lg[16 + j]));
            int a = 0; float ea = e[0];
#pragma unroll
            for (int j = 1; j < 4; ++j) if (e[j] > ea) { ea = e[j]; a = j; }
            int bq = -1; float eb = -INFINITY;
#pragma unroll
            for (int j = 0; j < 4; ++j) if (j != a && e[j] > eb) { eb = e[j]; bq = j; }
            const float pb = __expf(eb - ea), wa = pg / (1.f + pb), wb = pg * pb / (1.f + pb);
            const int e1 = a < bq ? a : bq, e2 = a < bq ? bq : a;
            const int pi = e1 == 0 ? e2 - 1 : (e1 == 1 ? e2 + 1 : 5);
            if (lane == 0) { cls[wave * 8 + i] = gi * 6 + pi; ((f32x2*)(ws + WS_WTS))[row] = (f32x2){a < bq ? wa : wb, a < bq ? wb : wa}; }
        }
        __syncthreads();
        if (tid < 24) { int n = 0; for (int i = 0; i < 64; ++i) n += (cls[i] == tid); basel[tid] = n ? (int)atomicAdd(&ctl[CW_MOECNT + l * 32 + tid], (unsigned)n) : 0; }
        __syncthreads();
        if (tid < 64) { const int c = cls[tid]; int rank = 0; for (int i = 0; i < tid; ++i) rank += (cls[i] == c); ((int*)(ws + WS_TOKC))[c * 16384 + basel[c] + rank] = u * 64 + tid; }
        __syncthreads();
    }
}

__device__ __forceinline__ void moe_table(const Params& p, volatile LAS int* tab, int l) {
    int tid = threadIdx.x; asm volatile("" : "+v"(tid));
    if (tid < 24) { const unsigned voff = (unsigned)(CW_MOECNT + l * 32 + tid) * 4u; const unsigned* ctl = (const unsigned*)((const char*)p.ws + voff); tab[32 + tid] = (int)__hip_atomic_load(ctl, __ATOMIC_RELAXED, __HIP_MEMORY_SCOPE_AGENT); }
    __syncthreads();
    if (tid == 0) { int pre = 0; for (int c = 0; c < 24; ++c) { tab[c] = pre; pre += (tab[32 + c] + 255) >> 8; } tab[24] = pre; }
    __syncthreads();
}

__device__ __forceinline__ void phase_final(const Params& p, int bid, int G) {
    int tid = threadIdx.x; asm volatile("" : "+v"(tid));
    const int lane = tid & 63, wave = tid >> 6;
    const int gw = bid * NWAVES + wave, NGW = G * NWAVES;
    for (int row = gw; row < NTOK; row += NGW) {
        f32x4* xr = (f32x4*)(p.out + (size_t)row * 1024) + lane; f32x4 v[4]; float s = 0.f;
#pragma unroll
        for (int j = 0; j < 4; ++j) { v[j] = xr[64 * j]; s += (v[j].x * v[j].x + v[j].y * v[j].y) + (v[j].z * v[j].z + v[j].w * v[j].w); }
        const float rstd = rsqrtf(wave_sum(s) * (1.f / 1024.f) + EPS);
#pragma unroll
        for (int j = 0; j < 4; ++j) { const f32x4 gg = ((const f32x4*)PIN(26))[64 * j + lane]; xr[64 * j] = (f32x4){v[j].x * rstd * gg.x, v[j].y * rstd * gg.y, v[j].z * rstd * gg.z, v[j].w * rstd * gg.w}; }
    }
}

constexpr int N_PHASES = 3 + 9 * NLAYER + 1;
__global__ void __launch_bounds__(NTHR, 2) mk_fwd(Params p) {
    extern __shared__ __attribute__((aligned(16))) unsigned char lds_raw[];
    LAS unsigned char* lds = (LAS unsigned char*)lds_raw;
    volatile LAS unsigned* MISC = (volatile LAS unsigned*)(lds + LDS_MISC);
    const int tid = threadIdx.x;
    const int G = gridDim.x, bid = blockIdx.x;
    unsigned char* ws = p.ws; asm volatile("" : "+s"(ws));
    for (int u = tid; u < 256; u += NTHR) MISC[u] = 0u;
    __syncthreads();
    const int lo = p.ph_lo, hi = p.ph_hi;
    const bool use_bar = (hi - lo) > 1;
    XcdBarrier bar; bar.bar = (unsigned*)(ws + WS_CTL) + CW_BAR; bar.x = 0; bar.st = MISC + 8;
    if (use_bar) bar = xcd_barrier_post((unsigned*)(ws + WS_CTL) + CW_BAR, MISC + 8);
#define IN(k) (lo <= (k) && (k) < hi)
#define SEAM(k) do { if ((k) + 1 < hi) xcd_barrier(bar); } while (0)
    const float* ssq = (const float*)(ws + WS_SSQ);
    bf16_t* xb = (bf16_t*)(ws + WS_XB);

    if (PHON(0) && IN(0)) { phase_pro_a(p, lds, bid, G); SEAM(0); }
    if (PHON(1) && IN(1)) {
        SchedKV S{G, bid, (const char*)(ws + WS_MEMN), (const char*)(ws + WS_WKVT)};
        EpiBf16 E{(bf16_t*)(ws + WS_KV), 2048, nullptr};
        pg8::gemm_phase<EpiBf16, SchedKV, false, false, false>(lds, GemmDesc{1024, 2048u, 2048u, 0}, S, E);
        SEAM(1);
    }
    if (PHON(2) && IN(2)) {
        { SchedQK S{G, bid, (const char*)(ws + WS_KV), (const char*)(ws + WS_WQS)};
          EpiBf16 E{(bf16_t*)(ws + WS_WQK), 1024, nullptr};
          pg8::gemm_phase<EpiBf16, SchedQK, false, false, false>(lds, GemmDesc{256, 4096u, 2048u, 0}, S, E); }
        { SchedVO S{G, bid, (const char*)(ws + WS_KV), (const char*)(ws + WS_WOT)};
          EpiBf16 E{(bf16_t*)(ws + WS_WVO), 1024, nullptr};
          pg8::gemm_phase<EpiBf16, SchedVO, false, false, false>(lds, GemmDesc{256, 2048u, 4096u, 0}, S, E); }
        SEAM(2);
    }
    for (int l = 0; l < NLAYER; ++l) {
        const int pb = 3 + 9 * l;
        if (!(lo < pb + 9 && pb < hi)) continue;
        if (PHON(3) && IN(pb + 0)) {
            SchedGrid S{64, 12, 768, G, bid, (const char*)xb, (const char*)(ws + WS_WIN) + (size_t)l * 3072 * 2048, (size_t)256 * 2048, (size_t)256 * 2048, 0, NY};
            EpiBf16 E{(bf16_t*)(ws + WS_R1), NY, ssq};
            pg8::gemm_phase<EpiBf16, SchedGrid, false, false, false>(lds, GemmDesc{1024, 2048u, 2048u, 0}, S, E);
            phase_logf(p, lds, l, bid, G);
            SEAM(pb + 0);
        }
        if (PHON(4) && IN(pb + 1)) { phase_p2a(p, lds, l, bid, G); SEAM(pb + 1); }
        if (PHON(5) && IN(pb + 2)) {
            for (int u = bid; u < 256; u += G) hgrn_unit<true>(p, lds, l, u);
            for (int u = bid; u < 256; u += G) attn_unit_simple(p, l, u);
            SEAM(pb + 2);
        }
        if (PHON(6) && IN(pb + 3)) {
            SchedGrid S{64, 4, 256, G, bid, (const char*)(ws + WS_CAT), (const char*)(ws + WS_WOUT) + (size_t)l * 1024 * 2048, (size_t)256 * 2048, (size_t)256 * 2048, 0, DM};
            EpiResidual E{l == 0 ? PIN(0) : p.out, p.out, xb, (float*)(ws + WS_SSQ)};
            pg8::gemm_phase<EpiResidual, SchedGrid, false, false, false>(lds, GemmDesc{1024, 2048u, 2048u, 0}, S, E);
            SEAM(pb + 3);
        }
        if (PHON(7) && IN(pb + 4)) {
            SchedGrid S{64, 4, 256, G, bid, (const char*)xb, (const char*)(ws + WS_WQK) + (size_t)l * 2 * 1024 * 2048, (size_t)256 * 2048, (size_t)256 * 2048, (size_t)1024 * 2048, DM};
            EpiSoftmax E{(bf16_t*)(ws + WS_PBUF), ssq, (LAS float*)(lds + LDS_EPI)};
            pg8::gemm_phase<EpiSoftmax, SchedGrid, true, false, false>(lds, GemmDesc{1024, 2048u, 2048u, 0}, S, E);
            SEAM(pb + 4);
        }
        if (PHON(8) && IN(pb + 5)) {
            SchedGrid S{64, 4, 256, G, bid, (const char*)(ws + WS_PBUF), (const char*)(ws + WS_WVO) + (size_t)l * 2 * 1024 * 2048, (size_t)256 * 2048, (size_t)256 * 2048, (size_t)1024 * 2048, DM};
            EpiResidual E{p.out, p.out, xb, (float*)(ws + WS_SSQ)};
            pg8::gemm_phase<EpiResidual, SchedGrid, false, false, false>(lds, GemmDesc{1024, 2048u, 2048u, 0}, S, E);
            SEAM(pb + 5);
        }
        if (PHON(9) && IN(pb + 6)) { phase_route(p, lds, l, bid, G); SEAM(pb + 6); }
        if (PHON(10) && IN(pb + 7)) {
            volatile LAS int* tab = (volatile LAS int*)(MISC + 16);
            moe_table(p, tab, l);
            SchedMoe S{G, bid, false, tab, (const int*)(ws + WS_TOKC), (const char*)xb, (const char*)(ws + WS_WGU) + (size_t)l * 16 * 512 * 2048};
            EpiMoeUp E{(bf16_t*)(ws + WS_HID), (const int*)(ws + WS_TOKC), ssq, (const f32x2*)(ws + WS_WTS)};
            pg8::gemm_phase<EpiMoeUp, SchedMoe, false, true, false>(lds, GemmDesc{1024, 2048u, 2048u, 0}, S, E);
            SEAM(pb + 7);
        }
        if (PHON(11) && IN(pb + 8)) {
            volatile LAS int* tab = (volatile LAS int*)(MISC + 16);
            moe_table(p, tab, l);
            SchedMoe S{G, bid, true, tab, (const int*)(ws + WS_TOKC), (const char*)(ws + WS_HID), (const char*)(ws + WS_WD) + (size_t)l * 16 * 1024 * 512};
            EpiMoeDown E{p.out, xb, (float*)(ws + WS_SSQ), (const int*)(ws + WS_TOKC)};
            pg8::gemm_phase<EpiMoeDown, SchedMoe, false, false, true>(lds, GemmDesc{512, 1024u, 512u, 4}, S, E);
            SEAM(pb + 8);
        }
    }
    if (IN(N_PHASES - 1)) phase_final(p, bid, G);
#undef IN
#undef SEAM
}

extern "C" void kernel_launch(void* const* d_in, const int* in_sizes, int n_in, void* d_out, int out_size, void* d_ws, size_t ws_size, hipStream_t stream) {
    static int grid = 0;
    if (grid == 0) {
        if (n_in != 27 || out_size != NTOK * DM || ws_size < WS_END) { fprintf(stderr, "kernel_launch: unexpected shapes (n_in %d out %d ws %zu)\n", n_in, out_size, ws_size); grid = -1; return; }
        int dev = 0, cus = 0, per_cu = 0;
        if (hipGetDevice(&dev) != hipSuccess || hipDeviceGetAttribute(&cus, hipDeviceAttributeMultiprocessorCount, dev) != hipSuccess) { grid = -1; return; }
        if (hipFuncSetAttribute((const void*)mk_fwd, hipFuncAttributeMaxDynamicSharedMemorySize, LDS_BYTES) != hipSuccess) { fprintf(stderr, "kernel_launch: hipFuncSetAttribute failed\n"); grid = -1; return; }
        if (hipOccupancyMaxActiveBlocksPerMultiprocessor(&per_cu, (const void*)mk_fwd, NTHR, LDS_BYTES) != hipSuccess || per_cu < 1) { fprintf(stderr, "kernel_launch: occupancy query reports %d\n", per_cu); }
        (void)hipGetLastError();
        grid = cus;
    }
    if (grid < 0) return;
    (void)hipMemsetAsync((char*)d_ws + WS_CTL, 0, CTL_ZERO_BYTES, stream);
    Params a{};
    for (int i = 0; i < 27; ++i) a.in[i] = (const float*)d_in[i];
    a.out = (float*)d_out; a.ws = (unsigned char*)d_ws;
#if ONE_LAUNCH
    a.ph_lo = 0; a.ph_hi = N_PHASES;
    hipLaunchKernelGGL(mk_fwd, dim3(grid), dim3(NTHR), LDS_BYTES, stream, a);
#else
    for (int k = 0; k < N_PHASES; ++k) { a.ph_lo = k; a.ph_hi = k + 1; hipLaunchKernelGGL(mk_fwd, dim3(grid), dim3(NTHR), LDS_BYTES, stream, a); }
#endif
}
```

```cpp
#include <hip/hip_runtime.h>
#include <cstdio>
#include <cstdint>

#ifndef USE_MFMA
#define USE_MFMA 1
#endif
#ifndef ONE_LAUNCH
#define ONE_LAUNCH 1
#endif
#ifndef DIS
#define DIS 0
#endif
#define PHON(k) (!(((DIS) >> (k)) & 1))
#ifndef FOX_PRUNE
#define FOX_PRUNE 1
#endif

#define LAS __attribute__((address_space(3)))
#define GAS __attribute__((address_space(1)))
typedef unsigned short bf16_t;
typedef short bf16x8 __attribute__((ext_vector_type(8)));
typedef float f32x4 __attribute__((ext_vector_type(4)));
typedef float f32x2 __attribute__((ext_vector_type(2)));
typedef unsigned u32x4 __attribute__((ext_vector_type(4)));
typedef unsigned u32x2 __attribute__((ext_vector_type(2)));

constexpr int NTOK = 16384, DM = 1024, SEQ = 8192, NLAYER = 4, NY = 3072;
constexpr float EPS = 1e-6f, LOG2E = 1.4426950408889634f;
constexpr float C2 = 0.125f * LOG2E;
constexpr int NWAVES = 8, NTHR = 512;

constexpr size_t MiB = 1u << 20;
constexpr size_t WS_CTL = 0, CTL_ZERO_BYTES = 64 * 1024;
constexpr size_t WS_WFF = 1 * MiB;
constexpr size_t WS_WR = 1 * MiB + 256 * 1024;
constexpr size_t WS_LOGF = 2 * MiB;
constexpr size_t WS_CFOX = 2 * MiB + 512 * 1024;
constexpr size_t WS_SSQ = 3 * MiB;
constexpr size_t WS_HU = 4 * MiB;
constexpr size_t WS_HD = 8 * MiB;
constexpr size_t WS_TOKC = 9 * MiB;
constexpr size_t WS_WTS = 10 * MiB + 512 * 1024;
constexpr size_t WS_MEMN = 11 * MiB;
constexpr size_t WS_KV = 12 * MiB;
constexpr size_t WS_WIN = 20 * MiB;
constexpr size_t WS_WOUT = 44 * MiB;
constexpr size_t WS_WQK = 52 * MiB;
constexpr size_t WS_WVO = 68 * MiB;
constexpr size_t WS_WGU = 84 * MiB;
constexpr size_t WS_WD = 148 * MiB;
constexpr size_t WS_XB = 180 * MiB;
constexpr size_t WS_CAT = 212 * MiB;
constexpr size_t WS_R1 = 244 * MiB;
constexpr size_t WS_PBUF = WS_R1;
constexpr size_t WS_HID = WS_R1 + 32 * MiB;
constexpr size_t WS_WQS = WS_R1;
constexpr size_t WS_WKVT = WS_R1 + 8 * MiB;
constexpr size_t WS_WOT = WS_R1 + 24 * MiB;
constexpr size_t WS_END = 340 * MiB;

constexpr int CW_TMO = 0, CW_KQMAX = 256, CW_MOECNT = 512, CW_BAR = 4096;

constexpr int LDS_STAGE = 0, LDS_STAGE_BYTES = 131072;
constexpr int LDS_EPI = 131072;
constexpr int LDS_MISC = 131072 + 8192;
constexpr int LDS_BYTES = 131072 + 8192 + 1024;

__device__ __forceinline__ float bf2f(unsigned b) { return __uint_as_float(b << 16); }
__device__ __forceinline__ unsigned cvt_pk_bf16(float lo, float hi) { unsigned r; asm volatile("v_cvt_pk_bf16_f32 %0, %1, %2" : "=v"(r) : "v"(lo), "v"(hi)); return r; }
__device__ __forceinline__ unsigned short f2bf1(float f) { return (unsigned short)(cvt_pk_bf16(f, 0.f) & 0xffffu); }
template <int K> __device__ __forceinline__ float swz_xor(float v) { return __int_as_float(__builtin_amdgcn_ds_swizzle(__float_as_int(v), (K << 10) | 0x1f)); }
__device__ __forceinline__ float x32_sum(float v) { auto r = __builtin_amdgcn_permlane32_swap(__float_as_uint(v), __float_as_uint(v), false, false); return __uint_as_float(r[0]) + __uint_as_float(r[1]); }
__device__ __forceinline__ float x32_max(float v) { auto r = __builtin_amdgcn_permlane32_swap(__float_as_uint(v), __float_as_uint(v), false, false); return fmaxf(__uint_as_float(r[0]), __uint_as_float(r[1])); }
__device__ __forceinline__ float wave_sum(float v) {
    v += swz_xor<1>(v); v += swz_xor<2>(v); v += swz_xor<4>(v); v += swz_xor<8>(v); v += swz_xor<16>(v);
    return x32_sum(v);
}
__device__ __forceinline__ float sigmoidf_(float x) { return 1.f / (1.f + __expf(-x)); }
#define LDS_WAIT() asm volatile("s_waitcnt lgkmcnt(0)" ::: "memory")
#define VM_WAIT() asm volatile("s_waitcnt vmcnt(0)" ::: "memory")

#define XB_TMO      128
#define XB_XCNT(j)  (256  + 64 * (j))
#define XB_XSUB(j)  (1280 + 64 * (j))
#define XB_XGEN(j)  (2304 + 64 * (j))
#define XB_TOP      3328
#define XB_TOPGEN   3392
#define XCD_BAR_WORDS 3456
#define XB_SPIN_CAP (1u << 22)
__device__ __forceinline__ unsigned xb_ld(unsigned* p)              { return __hip_atomic_load(p, __ATOMIC_RELAXED, __HIP_MEMORY_SCOPE_AGENT); }
__device__ __forceinline__ unsigned xb_add(unsigned* p, unsigned v) { return __hip_atomic_fetch_add(p, v, __ATOMIC_RELAXED, __HIP_MEMORY_SCOPE_AGENT); }
__device__ __forceinline__ unsigned xb_xcc_id() { return (unsigned)__builtin_amdgcn_s_getreg((3 << 11) | 20) & 0xFu; }
#define XB_SPIN(cond, bar) do { unsigned _sp = 0; while (cond) { __builtin_amdgcn_s_sleep(1); \
    if ((++_sp & 255u) == 0u) { if (xb_ld(&(bar)[XB_TMO])) break; if (_sp > XB_SPIN_CAP) { atomicAdd(&(bar)[XB_TMO], 1u); break; } } } } while (0)
struct XcdBarrier { unsigned* bar; unsigned x; volatile LAS unsigned* st; };
__device__ __forceinline__ XcdBarrier xcd_barrier_post(unsigned* bar, volatile LAS unsigned* st) {
    XcdBarrier b; b.bar = bar; b.x = xb_xcc_id(); b.st = st;
    if (threadIdx.x == 0) (void)xb_add(&bar[XB_XCNT(b.x)], 1u);
    return b;
}
__device__ __forceinline__ void xcd_barrier_complete(unsigned* bar, unsigned x, unsigned& nloc, unsigned& nx) {
    const unsigned G = gridDim.x * gridDim.y * gridDim.z;
    unsigned sum, cnt, mine, sp = 0u;
    for (;;) {
        sum = 0u; cnt = 0u; mine = 0u;
#pragma unroll
        for (unsigned j = 0; j < 16; ++j) { const unsigned c = xb_ld(&bar[XB_XCNT(j)]); sum += c; cnt += (c > 0u) ? 1u : 0u; mine = (j == x) ? c : mine; }
        if (sum == G) break;
        __builtin_amdgcn_s_sleep(1);
        if ((++sp & 255u) == 0u) { if (xb_ld(&bar[XB_TMO])) break; if (sp > XB_SPIN_CAP) { atomicAdd(&bar[XB_TMO], 1u); break; } }
    }
    nloc = mine > 0u ? mine : 1u; nx = cnt > 0u ? cnt : 1u;
}
__device__ __forceinline__ void xcd_barrier(const XcdBarrier& b) {
    asm volatile("s_waitcnt vmcnt(0)" ::: "memory");
    __syncthreads();
    if (threadIdx.x == 0) {
        unsigned* bar = b.bar;
        __builtin_amdgcn_s_waitcnt(0);
        unsigned nloc = b.st[0], nx = b.st[1];
        if (nloc == 0u) { xcd_barrier_complete(bar, b.x, nloc, nx); b.st[0] = nloc; b.st[1] = nx; }
        const unsigned old = xb_add(&bar[XB_XSUB(b.x)], 1u);
        const unsigned gen = old / nloc;
        if (old + 1u == (gen + 1u) * nloc) {
            __builtin_amdgcn_fence(__ATOMIC_RELEASE, "agent");
            asm volatile("s_waitcnt vmcnt(0)" ::: "memory");
            const unsigned og = xb_add(&bar[XB_TOP], 1u);
            const unsigned tg = og / nx;
            if (og + 1u == (tg + 1u) * nx) xb_add(&bar[XB_TOPGEN], 1u);
            else XB_SPIN(xb_ld(&bar[XB_TOPGEN]) == tg, bar);
            __builtin_amdgcn_fence(__ATOMIC_ACQUIRE, "agent");
            xb_add(&bar[XB_XGEN(b.x)], 1u);
            asm volatile("s_waitcnt vmcnt(0)" ::: "memory");
        } else {
            XB_SPIN(xb_ld(&bar[XB_XGEN(b.x)]) == gen, bar);
            __builtin_amdgcn_fence(__ATOMIC_ACQUIRE, "agent");
            asm volatile("s_waitcnt vmcnt(0)" ::: "memory");
        }
    }
    __syncthreads();
}

namespace pg8 {
constexpr int BM = 256, BK = 64, HALF = 128, HTB = HALF * BK * 2;
__host__ __device__ __forceinline__ int lds_byte(int r, int c) { const int st = (r >> 4) * 2 + (c >> 5), rr = r & 15, cc = c & 31, ob = rr * 64 + cc * 2; return st * 1024 + (ob ^ (((ob >> 9) & 1) << 5)); }
__host__ __device__ __forceinline__ void stage_rc(int b, int& R, int& C) { const int st = b / 1024, sb = b % 1024, swz = sb ^ (((sb >> 9) & 1) << 5); R = (st >> 1) * 16 + swz / 64; C = (st & 1) * 32 + (swz % 64) / 2; }
__host__ __device__ __forceinline__ int perm32(int rho) { const int n = rho >> 4, i = rho & 15; return 8 * (i >> 2) + 4 * n + (i & 3); }

struct Unit { int pm, pn, a0, a1, a2, a3; };
struct GemmDesc { int K; unsigned lda, ldb; int ksplit; };


#if USE_MFMA
template <class Epi, class Sched, bool ALIGN_EPI, bool GATHER, bool BSPLIT>
__device__ __forceinline__ void gemm_phase(LAS unsigned char* lds, const GemmDesc g, const Sched& S, const Epi& E) {
    int tid = threadIdx.x; asm volatile("" : "+v"(tid));
    const int wid = __builtin_amdgcn_readfirstlane(tid >> 6), lane = tid & 63, wr = wid >> 2, wc = wid & 3, fr = lane & 15, fq = lane >> 4;
    const int nt = g.K / BK;
    int R0, C0; stage_rc(tid * 16, R0, C0);
    const unsigned voffB = (unsigned)((R0 & ~31) + perm32(R0 & 31)) * g.ldb + (unsigned)C0 * 2u, voffA = (unsigned)R0 * g.lda + (unsigned)C0 * 2u;
    const size_t qstepA = (size_t)64 * g.lda, qstepB = (size_t)64 * g.ldb;
    const size_t kstep = (size_t)(BK * 2);
    const size_t hstepB = (size_t)HALF * g.ldb, hstepA = GATHER ? (size_t)0 : (size_t)HALF * g.lda;
    const unsigned ldsw = (unsigned)wid * 1024u;
    const int aoff = lds_byte(wr * 64 + fr, fq * 8), boff = lds_byte(wc * 32 + fr, fq * 8);
#define PG8_SA(b, h) (((b) * 2 + (h)) * HTB)
#define PG8_SB(b, h) ((4 + (b) * 2 + (h)) * HTB)
#define PG8_STAGE(bufoff, gbase, voff) do { _Pragma("unroll") for (int _i = 0; _i < 2; ++_i) \
        __builtin_amdgcn_global_load_lds((const unsigned*)((const char*)(gbase) + (voff)[_i]), (LAS unsigned*)(lds + (bufoff) + ldsw + _i * 8192), 16, 0, 0); } while (0)
#define PG8_STAGE1(bufoff, gbase, voff, qstep) do { _Pragma("unroll") for (int _i = 0; _i < 2; ++_i) \
        __builtin_amdgcn_global_load_lds((const unsigned*)((const char*)(gbase) + _i * (qstep) + (voff)), (LAS unsigned*)(lds + (bufoff) + ldsw + _i * 8192), 16, 0, 0); } while (0)
#define PG8_STAGE_B(bufoff, gbase) PG8_STAGE1(bufoff, gbase, voffB, qstepB)
#define PG8_LDA(dst, b, h) do { _Pragma("unroll") for (int m = 0; m < 4; ++m) _Pragma("unroll") for (int k = 0; k < 2; ++k) dst[m][k] = *(const LAS bf16x8*)(lds + PG8_SA(b, h) + aoff + m * 2048 + k * 1024); } while (0)
#define PG8_LDB(dst, b, h) do { _Pragma("unroll") for (int n = 0; n < 2; ++n) _Pragma("unroll") for (int k = 0; k < 2; ++k) dst[n][k] = *(const LAS bf16x8*)(lds + PG8_SB(b, h) + boff + n * 2048 + k * 1024); } while (0)
#define PG8_MMA(ai, bj, At, Bt) do { __builtin_amdgcn_s_setprio(1); _Pragma("unroll") for (int m = 0; m < 4; ++m) _Pragma("unroll") for (int n = 0; n < 2; ++n) _Pragma("unroll") for (int k = 0; k < 2; ++k) \
        acc[ai][bj][m][n] = __builtin_amdgcn_mfma_f32_16x16x32_bf16(Bt[n][k], At[m][k], acc[ai][bj][m][n], 0, 0, 0); __builtin_amdgcn_s_setprio(0); } while (0)
#define PG8_WAIT_V(n) asm volatile("s_waitcnt vmcnt(" #n ")" ::: "memory")
#define PG8_WAIT_L(n) asm volatile("s_waitcnt lgkmcnt(" #n ")" ::: "memory")
#define PG8_BAR __builtin_amdgcn_s_barrier()
#define PG8_SCHED __builtin_amdgcn_sched_barrier(0)
#define PG8_OFFS(u, o) do { if constexpr (GATHER) { _Pragma("unroll") for (int _h = 0; _h < 2; ++_h) _Pragma("unroll") for (int _i = 0; _i < 2; ++_i) \
        o[_h][_i] = S.arow(u, _h * 128 + _i * 64 + R0) + (unsigned)C0 * 2u; } } while (0)
#define PG8_STAGE_A(bufoff, gbase, h, OFF) do { if constexpr (GATHER) { PG8_STAGE(bufoff, gbase, OFF[h]); } else { PG8_STAGE1(bufoff, (gbase) + (h) * hstepA, voffA, qstepA); } } while (0)
#define PG8_BP(base, base2, tt) (((BSPLIT && (tt) >= g.ksplit) ? (base2) : (base)) + (size_t)(tt) * kstep)
    Unit cur, nxt; int ui = 0;
    if (!S.next(0, cur)) return;
    f32x4 acc[2][2][4][2];
#pragma unroll
    for (int a = 0; a < 2; ++a)
#pragma unroll
        for (int b = 0; b < 2; ++b)
#pragma unroll
            for (int m = 0; m < 4; ++m)
#pragma unroll
                for (int n = 0; n < 2; ++n) acc[a][b][m][n] = (f32x4){0.f, 0.f, 0.f, 0.f};
    bf16x8 At[4][2], B0[2][2], B1[2][2];
    unsigned coff[2][2], noff[2][2];
#pragma unroll
    for (int h = 0; h < 2; ++h)
#pragma unroll
        for (int i = 0; i < 2; ++i) { coff[h][i] = 0u; noff[h][i] = 0u; }
    PG8_OFFS(cur, coff);
    const char* cA = S.A(cur); const char* cB = S.B(cur); const char* cB2 = BSPLIT ? S.B2(cur) : cB;
    PG8_STAGE_B(PG8_SB(0, 0), cB); PG8_STAGE_B(PG8_SB(0, 1), cB + hstepB); PG8_STAGE_A(PG8_SA(0, 0), cA, 0, coff); PG8_STAGE_A(PG8_SA(0, 1), cA, 1, coff);
    if (wr == 1) PG8_BAR;
    PG8_WAIT_V(2); PG8_BAR;
    PG8_STAGE_B(PG8_SB(1, 0), cB + kstep); PG8_STAGE_A(PG8_SA(1, 0), cA + kstep, 0, coff); PG8_STAGE_B(PG8_SB(1, 1), cB + hstepB + kstep);
    PG8_WAIT_V(6); PG8_BAR;
    for (;;) {
        const bool has_next = S.next(ui + 1, nxt);
        const char* nA = has_next ? S.A(nxt) : cA; const char* nB = has_next ? S.B(nxt) : cB; const char* nB2 = (BSPLIT && has_next) ? S.B2(nxt) : cB2;
        if constexpr (GATHER) { if (has_next) { PG8_OFFS(nxt, noff); } else {
#pragma unroll
            for (int h = 0; h < 2; ++h)
#pragma unroll
                for (int i = 0; i < 2; ++i) noff[h][i] = coff[h][i]; } }
        for (int t = 0; t < nt; t += 2) {
            const bool last = (t == nt - 2);
            const char* a1 = cA + (size_t)(t + 1) * kstep;
            const char* a2 = last ? nA : cA + (size_t)(t + 2) * kstep;
            const char* b2 = last ? nB : PG8_BP(cB, cB2, t + 2);
            const char* a3 = a2 + kstep;
            const char* b3 = last ? nB + kstep : PG8_BP(cB, cB2, t + 3);
            unsigned o2[2][2];
#pragma unroll
            for (int h = 0; h < 2; ++h)
#pragma unroll
                for (int i = 0; i < 2; ++i) o2[h][i] = GATHER ? (last ? noff[h][i] : coff[h][i]) : 0u;
            PG8_LDB(B0, 0, 0); PG8_LDB(B1, 0, 1); PG8_SCHED; PG8_LDA(At, 0, 0); PG8_STAGE_A(PG8_SA(1, 1), a1, 1, coff);
            PG8_WAIT_V(8); PG8_WAIT_L(0); PG8_BAR; PG8_MMA(0, 0, At, B0); PG8_MMA(0, 1, At, B1); PG8_BAR; PG8_SCHED;
            PG8_LDA(At, 0, 1); PG8_STAGE_B(PG8_SB(0, 0), b2); PG8_STAGE_B(PG8_SB(0, 1), b2 + hstepB); PG8_STAGE_A(PG8_SA(0, 0), a2, 0, o2);
            PG8_WAIT_V(8); PG8_WAIT_L(0); PG8_BAR; PG8_MMA(1, 0, At, B0); PG8_MMA(1, 1, At, B1); PG8_BAR; PG8_SCHED;
            PG8_LDB(B0, 1, 0); PG8_LDB(B1, 1, 1); PG8_SCHED; PG8_LDA(At, 1, 0); PG8_STAGE_A(PG8_SA(0, 1), a2, 1, o2);
            PG8_WAIT_V(8); PG8_WAIT_L(0); PG8_BAR; PG8_MMA(0, 0, At, B0); PG8_MMA(0, 1, At, B1); PG8_BAR; PG8_SCHED;
            PG8_LDA(At, 1, 1); PG8_STAGE_B(PG8_SB(1, 0), b3); PG8_STAGE_B(PG8_SB(1, 1), b3 + hstepB); PG8_STAGE_A(PG8_SA(1, 0), a3, 0, o2);
            PG8_WAIT_V(8); PG8_WAIT_L(0); PG8_BAR; PG8_MMA(1, 0, At, B0); PG8_MMA(1, 1, At, B1); PG8_BAR; PG8_SCHED;
        }
        if constexpr (ALIGN_EPI) { if (wr == 0) PG8_BAR; }
        { int t2 = threadIdx.x; asm volatile("" : "+v"(t2)); const int l2 = t2 & 63; E(acc, cur, wr, wc, l2 & 15, l2 >> 4); }
        if (!has_next) break;
#pragma unroll
        for (int a = 0; a < 2; ++a)
#pragma unroll
            for (int b = 0; b < 2; ++b)
#pragma unroll
                for (int m = 0; m < 4; ++m)
#pragma unroll
                    for (int n = 0; n < 2; ++n) acc[a][b][m][n] = (f32x4){0.f, 0.f, 0.f, 0.f};
        cur = nxt; cA = nA; cB = nB; cB2 = nB2; ++ui;
#pragma unroll
        for (int h = 0; h < 2; ++h)
#pragma unroll
            for (int i = 0; i < 2; ++i) coff[h][i] = noff[h][i];
        if constexpr (ALIGN_EPI) { if (wr == 1) PG8_BAR; }
    }
    PG8_WAIT_V(0);
    if constexpr (!ALIGN_EPI) { if (wr == 0) PG8_BAR; }
    PG8_BAR;
#undef PG8_SA
#undef PG8_SB
#undef PG8_STAGE
#undef PG8_LDA
#undef PG8_LDB
#undef PG8_MMA
#undef PG8_WAIT_V
#undef PG8_WAIT_L
#undef PG8_BAR
#undef PG8_SCHED
#undef PG8_OFFS
#undef PG8_STAGE_A
#undef PG8_STAGE1
#undef PG8_STAGE_B
#undef PG8_BP
}
#else
template <class Epi, class Sched, bool ALIGN_EPI, bool GATHER, bool BSPLIT>
__device__ __forceinline__ void gemm_phase(LAS unsigned char* lds, const GemmDesc g, const Sched& S, const Epi& E) {
    const int tid = threadIdx.x, wid = __builtin_amdgcn_readfirstlane(tid >> 6), lane = tid & 63, wr = wid >> 2, wc = wid & 3, fr = lane & 15, fq = lane >> 4;
    Unit cur;
    for (int ui = 0; S.next(ui, cur); ++ui) {
        f32x4 acc[2][2][4][2];
#pragma unroll
        for (int a = 0; a < 2; ++a)
#pragma unroll
            for (int b = 0; b < 2; ++b)
#pragma unroll
                for (int m = 0; m < 4; ++m)
#pragma unroll
                    for (int n = 0; n < 2; ++n) acc[a][b][m][n] = (f32x4){0.f, 0.f, 0.f, 0.f};
        const char* cA = S.A(cur); const char* cB = S.B(cur); const char* cB2 = BSPLIT ? S.B2(cur) : cB;
        unsigned aro[2][4];
#pragma unroll
        for (int ai = 0; ai < 2; ++ai)
#pragma unroll
            for (int m = 0; m < 4; ++m) { const int r = ai * 128 + wr * 64 + m * 16 + fr; aro[ai][m] = GATHER ? S.arow(cur, r) : (unsigned)r * g.lda; }
        for (int k0 = 0; k0 < g.K; k0 += 4) {
            u32x2 av[2][4];
#pragma unroll
            for (int ai = 0; ai < 2; ++ai)
#pragma unroll
                for (int m = 0; m < 4; ++m) av[ai][m] = *(const u32x2*)(cA + aro[ai][m] + (size_t)k0 * 2);
            const char* bb = (BSPLIT && k0 >= g.ksplit * 64) ? cB2 : cB;
#pragma unroll
            for (int bj = 0; bj < 2; ++bj)
#pragma unroll
                for (int n = 0; n < 2; ++n)
#pragma unroll
                    for (int j = 0; j < 4; ++j) {
                        const int c = bj * 128 + wc * 32 + fq * 8 + n * 4 + j;
                        const u32x2 bv = *(const u32x2*)(bb + (size_t)c * g.ldb + (size_t)k0 * 2);
                        const float b0 = bf2f(bv.x & 0xffffu), b1 = bf2f(bv.x >> 16), b2 = bf2f(bv.y & 0xffffu), b3 = bf2f(bv.y >> 16);
#pragma unroll
                        for (int ai = 0; ai < 2; ++ai)
#pragma unroll
                            for (int m = 0; m < 4; ++m) {
                                const u32x2 a = av[ai][m];
                                acc[ai][bj][m][n][j] += bf2f(a.x & 0xffffu) * b0 + bf2f(a.x >> 16) * b1 + bf2f(a.y & 0xffffu) * b2 + bf2f(a.y >> 16) * b3;
                            }
                    }
        }
        E(acc, cur, wr, wc, fr, fq);
    }
    __syncthreads();
}
#endif
}
using pg8::Unit; using pg8::GemmDesc;

__device__ __forceinline__ float row_rstd(const float* ssq, int row) {
    const f32x4* p = (const f32x4*)(ssq + (size_t)row * 16);
    const f32x4 a = p[0], b = p[1], c = p[2], d = p[3];
    const float s = ((a.x + a.y) + (a.z + a.w)) + ((b.x + b.y) + (b.z + b.w)) + ((c.x + c.y) + (c.z + c.w)) + ((d.x + d.y) + (d.z + d.w));
    return rsqrtf(s * (1.f / 1024.f) + EPS);
}
__device__ __forceinline__ u32x4 pack8(f32x4 v0, f32x4 v1) { u32x4 w; w.x = cvt_pk_bf16(v0[0], v0[1]); w.y = cvt_pk_bf16(v0[2], v0[3]); w.z = cvt_pk_bf16(v1[0], v1[1]); w.w = cvt_pk_bf16(v1[2], v1[3]); return w; }

struct EpiBf16 {
    bf16_t* O; int ldc; const float* ssq;
    __device__ __forceinline__ void operator()(const f32x4 (&acc)[2][2][4][2], const Unit& u, int wr, int wc, int fr, int fq) const {
#pragma unroll
        for (int ai = 0; ai < 2; ++ai)
#pragma unroll
            for (int m = 0; m < 4; ++m) {
                const int r = ai * 128 + wr * 64 + m * 16 + fr;
                const float rs = ssq ? row_rstd(ssq, u.a1 + r) : 1.f;
                bf16_t* rowp = O + (size_t)u.a0 + (size_t)r * ldc + wc * 32 + fq * 8;
#pragma unroll
                for (int bj = 0; bj < 2; ++bj) *(u32x4*)(rowp + bj * 128) = pack8(acc[ai][bj][m][0] * rs, acc[ai][bj][m][1] * rs);
                __builtin_amdgcn_sched_barrier(0);
            }
    }
};
struct EpiResidual {
    const float* xin; float* xout; bf16_t* xb; float* ssq;
    __device__ __forceinline__ void operator()(const f32x4 (&acc)[2][2][4][2], const Unit& u, int wr, int wc, int fr, int fq) const {
#pragma unroll
        for (int ai = 0; ai < 2; ++ai)
#pragma unroll
            for (int m = 0; m < 4; ++m) {
                const int row = u.pm * 256 + ai * 128 + wr * 64 + m * 16 + fr;
                float ss = 0.f;
#pragma unroll
                for (int bj = 0; bj < 2; ++bj) {
                    const size_t o = (size_t)row * DM + u.pn * 256 + bj * 128 + wc * 32 + fq * 8;
                    const f32x4 v0 = acc[ai][bj][m][0] + *(const f32x4*)(xin + o), v1 = acc[ai][bj][m][1] + *(const f32x4*)(xin + o + 4);
                    *(f32x4*)(xout + o) = v0; *(f32x4*)(xout + o + 4) = v1;
                    *(u32x4*)(xb + o) = pack8(v0, v1);
                    ss += (v0[0] * v0[0] + v0[1] * v0[1]) + (v0[2] * v0[2] + v0[3] * v0[3]) + (v1[0] * v1[0] + v1[1] * v1[1]) + (v1[2] * v1[2] + v1[3] * v1[3]);
                }
                ss += swz_xor<16>(ss); ss = x32_sum(ss);
                if (fq == 0) ssq[(size_t)row * 16 + u.pn * 4 + wc] = ss;
                __builtin_amdgcn_sched_barrier(0);
            }
    }
};
struct EpiSoftmax {
    bf16_t* P; const float* ssq; LAS float* scr;
    __device__ __forceinline__ void operator()(const f32x4 (&acc)[2][2][4][2], const Unit& u, int wr, int wc, int fr, int fq) const {
#pragma unroll
        for (int ai = 0; ai < 2; ++ai)
#pragma unroll
            for (int m = 0; m < 4; ++m) {
                const int rl = ai * 128 + wr * 64 + m * 16 + fr;
                const float rs = row_rstd(ssq, u.pm * 256 + rl) * (LOG2E / 16.f);
                float mm = -INFINITY;
#pragma unroll
                for (int bj = 0; bj < 2; ++bj)
#pragma unroll
                    for (int n = 0; n < 2; ++n)
#pragma unroll
                        for (int j = 0; j < 4; ++j) mm = fmaxf(mm, acc[ai][bj][m][n][j] * rs);
                mm = fmaxf(mm, swz_xor<16>(mm)); mm = x32_max(mm);
                if (fq == 0) scr[rl * 4 + wc] = mm;
            }
        LDS_WAIT(); __builtin_amdgcn_s_barrier();
#pragma unroll
        for (int ai = 0; ai < 2; ++ai)
#pragma unroll
            for (int m = 0; m < 4; ++m) {
                const int rl = ai * 128 + wr * 64 + m * 16 + fr;
                const float rs = row_rstd(ssq, u.pm * 256 + rl) * (LOG2E / 16.f);
                const f32x4 q = *(const LAS f32x4*)(scr + rl * 4);
                const float M = fmaxf(fmaxf(q.x, q.y), fmaxf(q.z, q.w));
                float s = 0.f;
#pragma unroll
                for (int bj = 0; bj < 2; ++bj)
#pragma unroll
                    for (int n = 0; n < 2; ++n)
#pragma unroll
                        for (int j = 0; j < 4; ++j) s += __builtin_amdgcn_exp2f(acc[ai][bj][m][n][j] * rs - M);
                s += swz_xor<16>(s); s = x32_sum(s);
                if (fq == 0) scr[1024 + rl * 4 + wc] = s;
            }
        LDS_WAIT(); __builtin_amdgcn_s_barrier();
#pragma unroll
        for (int ai = 0; ai < 2; ++ai)
#pragma unroll
            for (int m = 0; m < 4; ++m) {
                const int rl = ai * 128 + wr * 64 + m * 16 + fr;
                const float r = row_rstd(ssq, u.pm * 256 + rl) * (LOG2E / 16.f);
                const f32x4 qm = *(const LAS f32x4*)(scr + rl * 4);
                const float M = fmaxf(fmaxf(qm.x, qm.y), fmaxf(qm.z, qm.w));
                const f32x4 q = *(const LAS f32x4*)(scr + 1024 + rl * 4);
                const float inv = 1.f / ((q.x + q.y) + (q.z + q.w));
                bf16_t* rowp = P + (size_t)(u.pm * 256 + rl) * DM + u.pn * 256 + wc * 32 + fq * 8;
#pragma unroll
                for (int bj = 0; bj < 2; ++bj) {
                    f32x4 v0, v1;
#pragma unroll
                    for (int j = 0; j < 4; ++j) { v0[j] = __builtin_amdgcn_exp2f(acc[ai][bj][m][0][j] * r - M) * inv; v1[j] = __builtin_amdgcn_exp2f(acc[ai][bj][m][1][j] * r - M) * inv; }
                    *(u32x4*)(rowp + bj * 128) = pack8(v0, v1);
                }
            }
        LDS_WAIT(); __builtin_amdgcn_s_barrier();
    }
};
struct EpiMoeUp {
    bf16_t* hid; const int* tokc; const float* ssq; const f32x2* wts;
    __device__ __forceinline__ void operator()(const f32x4 (&acc)[2][2][4][2], const Unit& u, int wr, int wc, int fr, int fq) const {
#pragma unroll
        for (int ai = 0; ai < 2; ++ai)
#pragma unroll
            for (int m = 0; m < 4; ++m) {
                const int rl = ai * 128 + wr * 64 + m * 16 + fr;
                const bool valid = rl < u.a2;
                const int tok = valid ? tokc[u.a1 + rl] : 0;
                const float rs = row_rstd(ssq, tok);
                const f32x2 w2 = wts[tok];
                const float w = valid ? (u.a3 ? w2.y : w2.x) : 0.f;
                f32x4 h[2];
#pragma unroll
                for (int n = 0; n < 2; ++n)
#pragma unroll
                    for (int j = 0; j < 4; ++j) { const float gt = acc[ai][0][m][n][j] * rs, up = acc[ai][1][m][n][j] * rs; h[n][j] = gt / (1.f + __expf(-gt)) * up * w; }
                *(u32x4*)(hid + (size_t)(u.a0 + rl) * 512 + u.a3 * 256 + u.pn * 128 + wc * 32 + fq * 8) = pack8(h[0], h[1]);
            }
    }
};
struct EpiMoeDown {
    float* x; bf16_t* xb; float* ssq; const int* tokc;
    __device__ __forceinline__ void operator()(const f32x4 (&acc)[2][2][4][2], const Unit& u, int wr, int wc, int fr, int fq) const {
#pragma unroll
        for (int ai = 0; ai < 2; ++ai)
#pragma unroll
            for (int m = 0; m < 4; ++m) {
                const int rl = ai * 128 + wr * 64 + m * 16 + fr;
                const bool valid = rl < u.a2;
                const int tok = valid ? tokc[u.a1 + rl] : 0;
                float ss = 0.f;
                if (valid) {
#pragma unroll
                    for (int bj = 0; bj < 2; ++bj) {
                        const size_t o = (size_t)tok * DM + u.pn * 256 + bj * 128 + wc * 32 + fq * 8;
                        const f32x4 v0 = acc[ai][bj][m][0] + *(const f32x4*)(x + o), v1 = acc[ai][bj][m][1] + *(const f32x4*)(x + o + 4);
                        *(f32x4*)(x + o) = v0; *(f32x4*)(x + o + 4) = v1;
                        *(u32x4*)(xb + o) = pack8(v0, v1);
                        ss += (v0[0] * v0[0] + v0[1] * v0[1]) + (v0[2] * v0[2] + v0[3] * v0[3]) + (v1[0] * v1[0] + v1[1] * v1[1]) + (v1[2] * v1[2] + v1[3] * v1[3]);
                    }
                }
                ss += swz_xor<16>(ss); ss = x32_sum(ss);
                if (valid && fq == 0) ssq[(size_t)tok * 16 + u.pn * 4 + wc] = ss;
                __builtin_amdgcn_sched_barrier(0);
            }
    }
};

struct SchedGrid {
    int nM, nN, nwg, G, c; const char* Ab; const char* Bb; size_t astride, bstride, bbatch; int ldc;
    __device__ __forceinline__ bool next(int i, Unit& u) const {
        const long L = (long)i * G + c; if (L >= nwg) return false;
        int wgid = (int)L; { const int q = nwg / 8, r = nwg % 8, xcd = wgid % 8, off = wgid / 8; wgid = (xcd < r ? xcd * (q + 1) : r * (q + 1) + (xcd - r) * q) + off; }
        const int nig = 8 * nN, gid = wgid / nig, fm = gid * 8, gsz = (nM - fm) < 8 ? (nM - fm) : 8;
        u.pm = fm + ((wgid % nig) % gsz); u.pn = (wgid % nig) / gsz;
        u.a0 = u.pm * 256 * ldc + u.pn * 256; u.a1 = u.pm * 256; u.a2 = 0; u.a3 = 0; return true;
    }
    __device__ __forceinline__ const char* A(const Unit& u) const { return Ab + (size_t)u.pm * astride; }
    __device__ __forceinline__ const char* B(const Unit& u) const { return Bb + (size_t)u.pn * bstride + (u.pm >= 32 ? bbatch : 0); }
    __device__ __forceinline__ const char* B2(const Unit& u) const { return B(u); }
    __device__ __forceinline__ unsigned arow(const Unit&, int) const { return 0u; }
};
struct SchedKV {
    int G, c; const char* memn; const char* wkvt;
    __device__ __forceinline__ bool next(int i, Unit& u) const {
        const int L = i * G + c; if (L >= 64) return false;
        const int l = L >> 4; u.pm = (L >> 3) & 1; u.pn = L & 7; u.a2 = l; u.a3 = 0;
        u.a0 = l * 512 * 2048 + u.pm * 256 * 2048 + u.pn * 256; u.a1 = 0; return true;
    }
    __device__ __forceinline__ const char* A(const Unit& u) const { return memn + (size_t)u.pm * 256 * 2048; }
    __device__ __forceinline__ const char* B(const Unit& u) const { return wkvt + ((size_t)u.a2 * 2048 + (size_t)u.pn * 256) * 2048; }
    __device__ __forceinline__ const char* B2(const Unit& u) const { return B(u); }
    __device__ __forceinline__ unsigned arow(const Unit&, int) const { return 0u; }
};
struct SchedQK {
    int G, c; const char* kv; const char* wqs;
    __device__ __forceinline__ bool next(int i, Unit& u) const {
        const int L = i * G + c; if (L >= 128) return false;
        const int l = L >> 5, b = (L >> 4) & 1, h = (L >> 2) & 3; u.pn = L & 3; u.pm = 0; u.a1 = l; u.a2 = b; u.a3 = h;
        u.a0 = ((l * 2 + b) * 1024 + h * 256) * 1024 + u.pn * 256; return true;
    }
    __device__ __forceinline__ const char* A(const Unit& u) const { return kv + (((size_t)u.a1 * 512 + u.a2 * 256) * 2048 + u.a3 * 256) * 2; }
    __device__ __forceinline__ const char* B(const Unit& u) const { return wqs + (((size_t)u.a1 * 1024 + u.pn * 256) * 1024 + u.a3 * 256) * 2; }
    __device__ __forceinline__ const char* B2(const Unit& u) const { return B(u); }
    __device__ __forceinline__ unsigned arow(const Unit&, int) const { return 0u; }
};
struct SchedVO {
    int G, c; const char* kv; const char* wot;
    __device__ __forceinline__ bool next(int i, Unit& u) const {
        const int L = i * G + c; if (L >= 128) return false;
        const int l = L >> 5, b = (L >> 4) & 1, h = (L >> 2) & 3; u.pm = L & 3; u.pn = 0; u.a1 = l; u.a2 = b; u.a3 = h;
        u.a0 = ((l * 2 + b) * 1024 + u.pm * 256) * 1024 + h * 256; return true;
    }
    __device__ __forceinline__ const char* A(const Unit& u) const { return wot + (((size_t)u.a1 * 1024 + u.pm * 256) * 1024 + u.a3 * 256) * 2; }
    __device__ __forceinline__ const char* B(const Unit& u) const { return kv + (((size_t)u.a1 * 512 + u.a2 * 256) * 2048 + 1024 + u.a3 * 256) * 2; }
    __device__ __forceinline__ const char* B2(const Unit& u) const { return B(u); }
    __device__ __forceinline__ unsigned arow(const Unit&, int) const { return 0u; }
};
struct SchedMoe {
    int G, c; bool down; const volatile LAS int* tab; const int* tokc; const char* Ab; const char* Wb;
    __device__ __forceinline__ bool next(int i, Unit& u) const {
        const int L = i * G + c; const int nun = __builtin_amdgcn_readfirstlane(tab[24]) * 4; if (L >= nun) return false;
        const int q = L >> 2, sub = L & 3;
        int cc = 0;
        for (int k = 0; k < 24; ++k) if (q >= tab[k + 1]) cc = k + 1;
        const int j = q - tab[cc], n = tab[32 + cc];
        const int g = cc / 6, pi = cc % 6;
        const int e1 = pi < 3 ? 0 : (pi < 5 ? 1 : 2), e2 = pi < 3 ? pi + 1 : (pi < 5 ? pi - 1 : 3);
        u.a0 = q * 256; u.a1 = cc * 16384 + j * 256; u.a2 = (n - j * 256) < 256 ? (n - j * 256) : 256;
        if (!down) { const int s = sub >> 1; u.a3 = s; u.pn = sub & 1; u.pm = g * 4 + (s ? e2 : e1); }
        else { u.a3 = 0; u.pn = sub; u.pm = (g * 4 + e1) | ((g * 4 + e2) << 8); }
        u.pm = __builtin_amdgcn_readfirstlane(u.pm); u.pn = __builtin_amdgcn_readfirstlane(u.pn); u.a0 = __builtin_amdgcn_readfirstlane(u.a0);
        u.a1 = __builtin_amdgcn_readfirstlane(u.a1); u.a2 = __builtin_amdgcn_readfirstlane(u.a2); u.a3 = __builtin_amdgcn_readfirstlane(u.a3);
        return true;
    }
    __device__ __forceinline__ const char* A(const Unit& u) const { return down ? Ab + (size_t)u.a0 * 1024 : Ab; }
    __device__ __forceinline__ const char* B(const Unit& u) const {
        return down ? Wb + (((size_t)(u.pm & 255) * 1024 + u.pn * 256) * 256) * 2 : Wb + (((size_t)u.pm * 512 + u.pn * 256) * 1024) * 2; }
    __device__ __forceinline__ const char* B2(const Unit& u) const { return Wb + (((size_t)(u.pm >> 8) * 1024 + u.pn * 256) * 256) * 2 - (size_t)4 * 128; }
    __device__ __forceinline__ unsigned arow(const Unit& u, int r) const { const int tok = (r < u.a2) ? tokc[u.a1 + r] : 0; return (unsigned)tok * 2048u; }
};

struct Params { const float* in[27]; float* out; unsigned char* ws; int ph_lo, ph_hi; };
__device__ __forceinline__ const float* pin_(const Params& p, int i) { asm volatile("" : "+s"(i)); return p.in[i]; }
#define PIN(k) pin_(p, (k))

__device__ __forceinline__ void tr_item(const float* src, int ld, int c0, int K, int k0, const float* gain, float scale, bf16_t* dst, LAS float* scr, int lane) {
#pragma unroll 8
    for (int i = 0; i < 32; ++i) { const int kk = 2 * i + (lane >> 5); const float gsc = gain ? gain[k0 + kk] * scale : scale;
        scr[kk * 33 + (lane & 31)] = src[(size_t)(k0 + kk) * ld + c0 + (lane & 31)] * gsc; }
    LDS_WAIT(); asm volatile("" ::: "memory");
    const int c = lane & 7;
#pragma unroll
    for (int j = 0; j < 4; ++j) { const int n = (lane >> 3) + 8 * j; const LAS float* s = scr + (8 * c) * 33 + n;
        u32x4 o; o.x = cvt_pk_bf16(s[0 * 33], s[1 * 33]); o.y = cvt_pk_bf16(s[2 * 33], s[3 * 33]); o.z = cvt_pk_bf16(s[4 * 33], s[5 * 33]); o.w = cvt_pk_bf16(s[6 * 33], s[7 * 33]);
        *(u32x4*)(dst + (size_t)n * K + k0 + 8 * c) = o; }
    LDS_WAIT(); asm volatile("" ::: "memory");
}

__device__ __forceinline__ void phase_pro_a(const Params& p, LAS unsigned char* lds, int bid, int G) {
    int tid = threadIdx.x; asm volatile("" : "+v"(tid));
    const int lane = tid & 63, wave = tid >> 6;
    unsigned char* ws = p.ws; asm volatile("" : "+s"(ws));
    LAS float* scr = (LAS float*)(lds + wave * 16384);
    const int gw = bid * NWAVES + wave, NGW = G * NWAVES;
    constexpr int PER_L = 1536 + 512 + 1024 + 512 + 4096 + 2048;
    for (int it = gw; it < PER_L * NLAYER; it += NGW) {
        const int l = it / PER_L; int r = it % PER_L;
        if (r < 1536) {
            const int kb = r / 96, nb = r % 96, n0 = nb * 32, c0 = n0 < 1536 ? n0 : n0 + 8;
            tr_item(PIN(3) + (size_t)l * 1024 * 3080, 3080, c0, 1024, kb * 64, PIN(2) + l * 1024, n0 < 512 ? C2 : 1.f, (bf16_t*)(ws + WS_WIN) + ((size_t)l * 3072 + n0) * 1024, scr, lane); continue; }
        r -= 1536;
        if (r < 512) {
            const int kb = r / 32, nb = r % 32, k0 = kb * 64;
            const float* gain = k0 < 512 ? PIN(5) + l * 512 : (k0 < 768 ? PIN(7) + l * 256 - 512 : nullptr);
            tr_item(PIN(12) + (size_t)l * 1024 * 1024, 1024, nb * 32, 1024, k0, gain, 1.f, (bf16_t*)(ws + WS_WOUT) + ((size_t)l * 1024 + nb * 32) * 1024, scr, lane); continue; }
        r -= 512;
        if (r < 1024) {
            const int kb = r / 64, nb = r % 64;
            tr_item(PIN(16) + (size_t)l * 1024 * 2048, 2048, nb * 32, 1024, kb * 64, nullptr, 1.f, (bf16_t*)(ws + WS_WKVT) + ((size_t)l * 2048 + nb * 32) * 1024, scr, lane); continue; }
        r -= 1024;
        if (r < 512) {
            const int kb = r / 32, nb = r % 32;
            tr_item(PIN(17) + (size_t)l * 1024 * 1024, 1024, nb * 32, 1024, kb * 64, nullptr, 1.f, (bf16_t*)(ws + WS_WOT) + ((size_t)l * 1024 + nb * 32) * 1024, scr, lane); continue; }
        r -= 512;
        if (r < 4096) {
            const int e = r >> 8, rr = r & 255, kb = rr >> 4, nb = rr & 15;
            const int orow = nb * 32, t = orow >> 8, half = (orow >> 7) & 1, j = orow & 127;
            const float* src = (half ? PIN(24) : PIN(23)) + ((size_t)l * 16 + e) * 1024 * 256;
            tr_item(src, 256, t * 128 + j, 1024, kb * 64, PIN(18) + l * 1024, 1.f, (bf16_t*)(ws + WS_WGU) + (((size_t)l * 16 + e) * 512 + orow) * 1024, scr, lane); continue; }
        r -= 4096;
        {
            const int e = r >> 7, rr = r & 127, kb = rr >> 5, nb = rr & 31;
            tr_item(PIN(25) + ((size_t)l * 16 + e) * 256 * 1024, 1024, nb * 32, 256, kb * 64, nullptr, 1.f, (bf16_t*)(ws + WS_WD) + (((size_t)l * 16 + e) * 1024 + nb * 32) * 256, scr, lane); }
    }
    for (size_t i4 = (size_t)bid * NTHR + tid; i4 < (size_t)NLAYER * 1024 * 256; i4 += (size_t)G * NTHR) {
        const size_t e = i4 * 4; const int l = (int)(e >> 20), k = (int)((e >> 10) & 1023);
        const f32x4 v = *(const f32x4*)(PIN(15) + e); const float gsc = PIN(13)[l * 1024 + k];
        u32x2 o; o.x = cvt_pk_bf16(v.x * gsc, v.y * gsc); o.y = cvt_pk_bf16(v.z * gsc, v.w * gsc);
        *(u32x2*)((bf16_t*)(ws + WS_WQS) + e) = o;
    }
    for (int i = bid * NTHR + tid; i < NLAYER * 28 * 1024; i += G * NTHR) {
        const int l = i / (28 * 1024), r = i % (28 * 1024), j = r >> 10, k = r & 1023;
        if (j < 8) ((float*)(ws + WS_WFF))[(l * 8 + j) * 1024 + k] = PIN(2)[l * 1024 + k] * PIN(3)[((size_t)l * 1024 + k) * 3080 + 1536 + j];
        else { const int jj = j - 8; const float w = jj < 4 ? PIN(19)[(l * 1024 + k) * 4 + jj] : PIN(21)[(l * 1024 + k) * 16 + jj - 4];
            ((float*)(ws + WS_WR))[(l * 20 + jj) * 1024 + k] = PIN(18)[l * 1024 + k] * w; }
    }
    for (int row = gw; row < 512; row += NGW) {
        const f32x4* xr = (const f32x4*)(PIN(1) + (size_t)row * 1024) + lane; f32x4 v[4]; float s = 0.f;
#pragma unroll
        for (int j = 0; j < 4; ++j) { v[j] = xr[64 * j]; s += (v[j].x * v[j].x + v[j].y * v[j].y) + (v[j].z * v[j].z + v[j].w * v[j].w); }
        const float rstd = rsqrtf(wave_sum(s) * (1.f / 1024.f) + EPS);
#pragma unroll
        for (int j = 0; j < 4; ++j) { const f32x4 gg = ((const f32x4*)PIN(14))[64 * j + lane]; u32x2 o; o.x = cvt_pk_bf16(v[j].x * rstd * gg.x, v[j].y * rstd * gg.y); o.y = cvt_pk_bf16(v[j].z * rstd * gg.z, v[j].w * rstd * gg.w);
            ((u32x2*)((bf16_t*)(ws + WS_MEMN) + (size_t)row * 1024))[64 * j + lane] = o; }
    }
    for (int row = gw; row < NTOK; row += NGW) {
        const f32x4* xr = (const f32x4*)(PIN(0) + (size_t)row * 1024) + lane; float s = 0.f;
#pragma unroll
        for (int j = 0; j < 4; ++j) { const f32x4 v = xr[64 * j]; s += (v.x * v.x + v.y * v.y) + (v.z * v.z + v.w * v.w); u32x2 o; o.x = cvt_pk_bf16(v.x, v.y); o.y = cvt_pk_bf16(v.z, v.w);
            ((u32x2*)((bf16_t*)(ws + WS_XB) + (size_t)row * 1024))[64 * j + lane] = o; }
        s = wave_sum(s);
        if (lane < 16) ((float*)(ws + WS_SSQ))[(size_t)row * 16 + lane] = lane == 0 ? s : 0.f;
    }
}

__device__ __forceinline__ void phase_logf(const Params& p, LAS unsigned char* lds, int l, int bid, int G) {
    int tid = threadIdx.x; asm volatile("" : "+v"(tid));
    const int lane = tid & 63, wave = tid >> 6;
    unsigned char* ws = p.ws; asm volatile("" : "+s"(ws));
    LAS float* wl = (LAS float*)lds;
    for (int i = tid; i < 8 * 1024; i += NTHR) wl[i] = ((const float*)(ws + WS_WFF))[l * 8192 + i];
    __syncthreads();
    const int gw = bid * NWAVES + wave, NGW = G * NWAVES;
    for (int row = gw; row < NTOK; row += NGW) {
        const u32x4* xr = (const u32x4*)((const bf16_t*)(ws + WS_XB) + (size_t)row * 1024 + lane * 16);
        const u32x4 a = xr[0], b = xr[1];
        float x[16];
        x[0] = bf2f(a.x & 0xffffu); x[1] = bf2f(a.x >> 16); x[2] = bf2f(a.y & 0xffffu); x[3] = bf2f(a.y >> 16); x[4] = bf2f(a.z & 0xffffu); x[5] = bf2f(a.z >> 16); x[6] = bf2f(a.w & 0xffffu); x[7] = bf2f(a.w >> 16);
        x[8] = bf2f(b.x & 0xffffu); x[9] = bf2f(b.x >> 16); x[10] = bf2f(b.y & 0xffffu); x[11] = bf2f(b.y >> 16); x[12] = bf2f(b.z & 0xffffu); x[13] = bf2f(b.z >> 16); x[14] = bf2f(b.w & 0xffffu); x[15] = bf2f(b.w >> 16);
        const float rs = row_rstd((const float*)(ws + WS_SSQ), row);
        float mine = 0.f;
#pragma unroll
        for (int h = 0; h < 8; ++h) {
            float s = 0.f;
#pragma unroll
            for (int q = 0; q < 4; ++q) { const f32x4 w = *(const LAS f32x4*)(wl + h * 1024 + lane * 16 + q * 4); s += x[4 * q] * w.x + x[4 * q + 1] * w.y + x[4 * q + 2] * w.z + x[4 * q + 3] * w.w; }
            s = wave_sum(s);
            if (lane == h) mine = s;
        }
        if (lane < 8) { const float z = mine * rs + PIN(4)[l * 8 + lane]; ((float*)(ws + WS_LOGF))[(size_t)row * 8 + lane] = fminf(z, 0.f) - __logf(1.f + __expf(-fabsf(z))); }
    }
    __syncthreads();
}

template <bool FINAL>
__device__ __forceinline__ void hgrn_unit(const Params& p, LAS unsigned char* lds, int l, int unit) {
    int tid = threadIdx.x; asm volatile("" : "+v"(tid));
    const int lane = tid & 63, kg = tid >> 6;
    unsigned char* ws = p.ws; asm volatile("" : "+s"(ws));
    const int bh = unit >> 5, sc = unit & 31, b = bh >> 2, h = bh & 3;
    const bf16_t* y = (const bf16_t*)(ws + WS_R1);
    LAS float* F = (LAS float*)lds; LAS float* Q = F + 4096; LAS float* V = F + 8192; LAS float* OP = F + 12288; LAS float* lbv = F + 12288 + 8192;
    if (tid < 64) {
        const int k = h * 64 + tid; float e[4], mx = -INFINITY, den = 0.f, num = 0.f;
#pragma unroll
        for (int i = 0; i < 4; ++i) { e[i] = PIN(6)[i * 256 + k]; mx = fmaxf(mx, e[i]); }
#pragma unroll
        for (int i = 0; i < 4; ++i) { e[i] = __expf(e[i] - mx); den += e[i]; if (i >= 1 && i <= l) num += e[i]; }
        lbv[tid] = num / den;
    }
    float s[8], dp[8];
#pragma unroll
    for (int j = 0; j < 8; ++j) { s[j] = 0.f; dp[j] = 1.f; }
    if (FINAL) {
        const float* U = (const float*)(ws + WS_HU); const float* Dd = (const float*)(ws + WS_HD);
        for (int jj = 0; jj < sc; ++jj) { const int uu = bh * 32 + jj;
#pragma unroll
            for (int j = 0; j < 8; ++j) s[j] = Dd[uu * 64 + kg * 8 + j] * s[j] + U[(size_t)uu * 4096 + (kg * 8 + j) * 64 + lane]; }
    }
    __syncthreads();
    const size_t row0 = (size_t)b * SEQ + sc * 256;
    for (int ch = 0; ch < 4; ++ch) {
#pragma unroll
        for (int j = 0; j < 8; ++j) { const int idx = tid + NTHR * j, tt = idx >> 6, k = idx & 63; const bf16_t* yr = y + (row0 + ch * 64 + tt) * NY;
            const float lb = lbv[k];
            F[idx] = lb + (1.f - lb) * sigmoidf_(bf2f(yr[1792 + h * 64 + k])); Q[idx] = bf2f(yr[1536 + h * 64 + k]); V[idx] = bf2f(yr[2048 + h * 64 + k]); }
        __syncthreads();
        for (int sub = 0; sub < 4; ++sub) {
            for (int t16 = 0; t16 < 16; ++t16) {
                const int tt = sub * 16 + t16;
                const f32x4 f0 = *(const LAS f32x4*)(F + tt * 64 + kg * 8), f1 = *(const LAS f32x4*)(F + tt * 64 + kg * 8 + 4);
                const float vt = V[tt * 64 + lane];
                float fk[8] = {f0.x, f0.y, f0.z, f0.w, f1.x, f1.y, f1.z, f1.w};
                if (FINAL) {
                    const f32x4 q0 = *(const LAS f32x4*)(Q + tt * 64 + kg * 8), q1 = *(const LAS f32x4*)(Q + tt * 64 + kg * 8 + 4);
                    float qk[8] = {q0.x, q0.y, q0.z, q0.w, q1.x, q1.y, q1.z, q1.w}; float op = 0.f;
#pragma unroll
                    for (int j = 0; j < 8; ++j) { s[j] = fk[j] * s[j] + (1.f - fk[j]) * vt; op += qk[j] * s[j]; }
                    OP[(t16 * 8 + kg) * 64 + lane] = op;
                } else {
#pragma unroll
                    for (int j = 0; j < 8; ++j) { s[j] = fk[j] * s[j] + (1.f - fk[j]) * vt; dp[j] *= fk[j]; }
                }
            }
            if (FINAL) {
                __syncthreads();
#pragma unroll
                for (int w2 = 0; w2 < 2; ++w2) { const int t16 = kg * 2 + w2; float o = 0.f;
#pragma unroll
                    for (int g8 = 0; g8 < 8; ++g8) o += OP[(t16 * 8 + g8) * 64 + lane];
                    const float ss = wave_sum(o * o), rstd = rsqrtf(ss * (1.f / 64.f) + EPS);
                    const size_t row = row0 + ch * 64 + sub * 16 + t16;
                    const float hg = bf2f(y[row * NY + 2304 + h * 64 + lane]);
                    ((bf16_t*)(ws + WS_CAT))[row * DM + 512 + h * 64 + lane] = f2bf1(o * rstd * hg * sigmoidf_(hg)); }
                __syncthreads();
            }
        }
        __syncthreads();
    }
    if (!FINAL) {
        float* U = (float*)(ws + WS_HU); float* Dd = (float*)(ws + WS_HD);
#pragma unroll
        for (int j = 0; j < 8; ++j) { U[(size_t)unit * 4096 + (kg * 8 + j) * 64 + lane] = s[j]; if (lane == 0) Dd[unit * 64 + kg * 8 + j] = dp[j]; }
    }
    __syncthreads();
}

__device__ __forceinline__ void conv_unit(const Params& p, LAS unsigned char* lds, int l, int unit) {
    int tid = threadIdx.x; asm volatile("" : "+v"(tid));
    const int lane = tid & 63, wave = tid >> 6;
    unsigned char* ws = p.ws; asm volatile("" : "+s"(ws));
    const bf16_t* y = (const bf16_t*)(ws + WS_R1);
    LAS float* A = (LAS float*)lds; LAS float* Y = (LAS float*)(lds + 65536);
    const int row0 = unit * 32, b = row0 / SEQ, t0 = row0 % SEQ;
    for (int idx = tid; idx < 62 * 256; idx += NTHR) { const int j = idx >> 8, c = idx & 255, t = t0 - 30 + j; float v = 0.f;
        if (t >= 0) { const bf16_t* yr = y + ((size_t)b * SEQ + t) * NY; v = bf2f(yr[2560 + c]) * sigmoidf_(bf2f(yr[2816 + c])); }
        A[idx] = v; }
    __syncthreads();
    { const int c = tid & 255, th = tid >> 8; float w[31];
#pragma unroll
        for (int j = 0; j < 31; ++j) w[j] = PIN(8)[(l * 31 + j) * 256 + c];
        const float bias = PIN(9)[l * 256 + c];
        for (int tl = th * 16; tl < th * 16 + 16; ++tl) { float a = bias;
#pragma unroll
            for (int j = 0; j < 31; ++j) a += w[j] * A[(tl + j) * 256 + c];
            Y[tl * 256 + c] = a; } }
    __syncthreads();
    for (int pr = wave * 16; pr < wave * 16 + 16; ++pr) { const int tl = pr >> 2, grp = pr & 3, c = grp * 64 + lane;
        const float v = Y[tl * 256 + c], mean = wave_sum(v) * (1.f / 64.f), d = v - mean, var = wave_sum(d * d) * (1.f / 64.f);
        const float yn = d * rsqrtf(var + EPS) * PIN(10)[l * 256 + c] + PIN(11)[l * 256 + c];
        ((bf16_t*)(ws + WS_CAT))[(size_t)(row0 + tl) * DM + 768 + c] = f2bf1(yn * sigmoidf_(yn)); }
    __syncthreads();
}

__device__ __forceinline__ void phase_p2a(const Params& p, LAS unsigned char* lds, int l, int bid, int G) {
    int tid = threadIdx.x; asm volatile("" : "+v"(tid));
    const int lane = tid & 63, wave = tid >> 6;
    unsigned char* ws = p.ws; asm volatile("" : "+s"(ws));
    for (int bh = bid; bh < 16; bh += G) { const int b = bh >> 3, h = bh & 7;
        const float* lf = (const float*)(ws + WS_LOGF) + (size_t)b * SEQ * 8 + h;
        float v[16]; float run = 0.f;
#pragma unroll
        for (int i = 0; i < 16; ++i) { run += lf[(size_t)(tid * 16 + i) * 8]; v[i] = run; }
        float incl = run;
#pragma unroll
        for (int o = 1; o < 64; o <<= 1) { const float t = __int_as_float(__builtin_amdgcn_ds_bpermute(((lane - o) & 63) * 4, __float_as_int(incl))); if (lane >= o) incl += t; }
        LAS float* wt = (LAS float*)lds;
        if (lane == 63) wt[wave] = incl;
        __syncthreads();
        float base = incl - run;
        for (int w = 0; w < wave; ++w) base += wt[w];
        float* c = (float*)(ws + WS_CFOX) + (size_t)bh * SEQ + tid * 16;
#pragma unroll
        for (int i = 0; i < 16; ++i) c[i] = base + v[i];
        __syncthreads();
    }
    for (int u = bid; u < 512; u += G) conv_unit(p, lds, l, u);
    for (int u = bid; u < 256; u += G) if ((u & 31) != 31) hgrn_unit<false>(p, lds, l, u);
    { const bf16_t* y = (const bf16_t*)(ws + WS_R1); unsigned* ctl = (unsigned*)(ws + WS_CTL);
        const int gw = bid * NWAVES + wave, NGW = G * NWAVES, rpw = (NTOK + NGW - 1) / NGW;
        float mq = 0.f, mk = 0.f; int curb = -1;
        for (int row = gw * rpw; row < (gw + 1) * rpw && row < NTOK; ++row) {
            const int b = row / SEQ;
            if (b != curb) { if (curb >= 0 && (lane & 7) == 0) { atomicMax(&ctl[CW_KQMAX + ((l * 2 + curb) * 8 + (lane >> 3)) * 2], __float_as_uint(mq)); atomicMax(&ctl[CW_KQMAX + ((l * 2 + curb) * 8 + (lane >> 3)) * 2 + 1], __float_as_uint(mk)); } mq = 0.f; mk = 0.f; curb = b; }
            const u32x4 qa = *(const u32x4*)(y + (size_t)row * NY + lane * 8), ka = *(const u32x4*)(y + (size_t)row * NY + 512 + lane * 8);
            float sq = 0.f, sk = 0.f;
#pragma unroll
            for (int j = 0; j < 4; ++j) { const float a0 = bf2f(qa[j] & 0xffffu), a1 = bf2f(qa[j] >> 16), k0 = bf2f(ka[j] & 0xffffu), k1 = bf2f(ka[j] >> 16); sq += a0 * a0 + a1 * a1; sk += k0 * k0 + k1 * k1; }
            sq += swz_xor<1>(sq); sq += swz_xor<2>(sq); sq += swz_xor<4>(sq);
            sk += swz_xor<1>(sk); sk += swz_xor<2>(sk); sk += swz_xor<4>(sk);
            mq = fmaxf(mq, sq); mk = fmaxf(mk, sk);
        }
        if (curb >= 0 && (lane & 7) == 0) { atomicMax(&ctl[CW_KQMAX + ((l * 2 + curb) * 8 + (lane >> 3)) * 2], __float_as_uint(mq)); atomicMax(&ctl[CW_KQMAX + ((l * 2 + curb) * 8 + (lane >> 3)) * 2 + 1], __float_as_uint(mk)); }
    }
}

__device__ __forceinline__ void attn_unit_simple(const Params& p, int l, int unit) {
    int tid = threadIdx.x; asm volatile("" : "+v"(tid));
    const int lane = tid & 63, wave = tid >> 6;
    unsigned char* ws = p.ws; asm volatile("" : "+s"(ws));
    const int bh = unit >> 4, qb = unit & 15, b = bh >> 3, h = bh & 7;
    const bf16_t* y = (const bf16_t*)(ws + WS_R1);
    const float* cf = (const float*)(ws + WS_CFOX) + (size_t)bh * SEQ;
    const int t = qb * 512 + tid;
    const size_t rowb = (size_t)b * SEQ;
    float q[64], o[64];
    { const u32x4* qr = (const u32x4*)(y + (rowb + t) * NY + h * 64);
#pragma unroll
        for (int i = 0; i < 8; ++i) { const u32x4 a = qr[i];
#pragma unroll
            for (int j = 0; j < 4; ++j) { q[i * 8 + 2 * j] = bf2f(a[j] & 0xffffu); q[i * 8 + 2 * j + 1] = bf2f(a[j] >> 16); } } }
#pragma unroll
    for (int d = 0; d < 64; ++d) o[d] = 0.f;
    const float ct = cf[t] * LOG2E;
    float m = -INFINITY, lsum = 0.f;
    const int twmin = qb * 512 + wave * 64, smax = twmin + 63;
#if FOX_PRUNE
    const unsigned* ctl = (const unsigned*)(ws + WS_CTL);
    const float B2 = sqrtf(__uint_as_float(ctl[CW_KQMAX + ((l * 2 + b) * 8 + h) * 2]) * __uint_as_float(ctl[CW_KQMAX + ((l * 2 + b) * 8 + h) * 2 + 1]));
    const float cmin = cf[twmin] * LOG2E;
#endif
    for (int s = smax; s >= 0; --s) {
        const float cs = cf[s] * LOG2E;
#if FOX_PRUNE
        if (cmin - cs + 2.f * B2 < -44.f) break;
#endif
        const u32x4* kr = (const u32x4*)(y + (rowb + s) * NY + 512 + h * 64);
        float dot = 0.f;
#pragma unroll
        for (int i = 0; i < 8; ++i) { const u32x4 a = kr[i];
#pragma unroll
            for (int j = 0; j < 4; ++j) dot += q[i * 8 + 2 * j] * bf2f(a[j] & 0xffffu) + q[i * 8 + 2 * j + 1] * bf2f(a[j] >> 16); }
        const float sc = dot + ct - cs;
        if (s <= t) {
            if (sc > m) { const float al = __builtin_amdgcn_exp2f(m - sc); lsum *= al;
#pragma unroll
                for (int d = 0; d < 64; ++d) o[d] *= al;
                m = sc; }
            const float pr = __builtin_amdgcn_exp2f(sc - m); lsum += pr;
            const u32x4* vr = (const u32x4*)(y + (rowb + s) * NY + 1024 + h * 64);
#pragma unroll
            for (int i = 0; i < 8; ++i) { const u32x4 a = vr[i];
#pragma unroll
                for (int j = 0; j < 4; ++j) { o[i * 8 + 2 * j] += pr * bf2f(a[j] & 0xffffu); o[i * 8 + 2 * j + 1] += pr * bf2f(a[j] >> 16); } }
        }
    }
    const float inv = 1.f / lsum; float ss = 0.f;
#pragma unroll
    for (int d = 0; d < 64; ++d) { o[d] *= inv; ss += o[d] * o[d]; }
    const float rstd = rsqrtf(ss * (1.f / 64.f) + EPS);
    u32x4* dst = (u32x4*)((bf16_t*)(ws + WS_CAT) + (rowb + t) * DM + h * 64);
#pragma unroll
    for (int i = 0; i < 8; ++i) { u32x4 w; w.x = cvt_pk_bf16(o[i * 8] * rstd, o[i * 8 + 1] * rstd); w.y = cvt_pk_bf16(o[i * 8 + 2] * rstd, o[i * 8 + 3] * rstd); w.z = cvt_pk_bf16(o[i * 8 + 4] * rstd, o[i * 8 + 5] * rstd); w.w = cvt_pk_bf16(o[i * 8 + 6] * rstd, o[i * 8 + 7] * rstd); dst[i] = w; }
}

__device__ __forceinline__ void phase_route(const Params& p, LAS unsigned char* lds, int l, int bid, int G) {
    int tid = threadIdx.x; asm volatile("" : "+v"(tid));
    const int lane = tid & 63, wave = tid >> 6;
    unsigned char* ws = p.ws; asm volatile("" : "+s"(ws));
    LAS float* wl = (LAS float*)lds;
    LAS int* cls = (LAS int*)(lds + 20 * 4096);
    LAS int* basel = cls + 64;
    for (int i = tid; i < 20 * 1024; i += NTHR) wl[i] = ((const float*)(ws + WS_WR))[l * 20480 + i];
    __syncthreads();
    const float* x = p.out; unsigned* ctl = (unsigned*)(ws + WS_CTL);
    for (int u = bid; u < NTOK / 64; u += G) {
        for (int i = 0; i < 8; ++i) {
            const int row = u * 64 + wave * 8 + i;
            const f32x4* xr = (const f32x4*)(x + (size_t)row * 1024) + lane;
            f32x4 v[4]; float ss = 0.f;
#pragma unroll
            for (int j = 0; j < 4; ++j) { v[j] = xr[64 * j]; ss += (v[j].x * v[j].x + v[j].y * v[j].y) + (v[j].z * v[j].z + v[j].w * v[j].w); }
            const float rstd = rsqrtf(wave_sum(ss) * (1.f / 1024.f) + EPS);
            float lg[20];
#pragma unroll
            for (int jj = 0; jj < 20; ++jj) { float s = 0.f;
#pragma unroll
                for (int j = 0; j < 4; ++j) { const f32x4 w = *(const LAS f32x4*)(wl + jj * 1024 + j * 256 + lane * 4); s += v[j].x * w.x + v[j].y * w.y + v[j].z * w.z + v[j].w * w.w; }
                lg[jj] = wave_sum(s) * rstd + (jj < 4 ? PIN(20)[l * 4 + jj] : PIN(22)[l * 16 + jj - 4]); }
            int gi = 0; float gm = lg[0];
#pragma unroll
            for (int j = 1; j < 4; ++j) if (lg[j] > gm) { gm = lg[j]; gi = j; }
            float den = 0.f;
#pragma unroll
            for (int j = 0; j < 4; ++j) den += __expf(lg[j] - gm);
            const float pg = 1.f / den;
            float e[4];
#pragma unroll
            for (int j = 0; j < 4; ++j) e[j] = gi == 0 ? lg[4 + j] : (gi == 1 ? lg[8 + j] : (gi == 2 ? lg[12 + j] : lg[16 + j]));
            int a = 0; float ea = e[0];
#pragma unroll
            for (int j = 1; j < 4; ++j) if (e[j] > ea) { ea = e[j]; a = j; }
            int bq = -1; float eb = -INFINITY;
#pragma unroll
            for (int j = 0; j < 4; ++j) if (j != a && e[j] > eb) { eb = e[j]; bq = j; }
            const float pb = __expf(eb - ea), wa = pg / (1.f + pb), wb = pg * pb / (1.f + pb);
            const int e1 = a < bq ? a : bq, e2 = a < bq ? bq : a;
            const int pi = e1 == 0 ? e2 - 1 : (e1 == 1 ? e2 + 1 : 5);
            if (lane == 0) { cls[wave * 8 + i] = gi * 6 + pi; ((f32x2*)(ws + WS_WTS))[row] = (f32x2){a < bq ? wa : wb, a < bq ? wb : wa}; }
        }
        __syncthreads();
        if (tid < 24) { int n = 0; for (int i = 0; i < 64; ++i) n += (cls[i] == tid); basel[tid] = n ? (int)atomicAdd(&ctl[CW_MOECNT + l * 32 + tid], (unsigned)n) : 0; }
        __syncthreads();
        if (tid < 64) { const int c = cls[tid]; int rank = 0; for (int i = 0; i < tid; ++i) rank += (cls[i] == c); ((int*)(ws + WS_TOKC))[c * 16384 + basel[c] + rank] = u * 64 + tid; }
        __syncthreads();
    }
}

__device__ __forceinline__ void moe_table(const Params& p, volatile LAS int* tab, int l) {
    int tid = threadIdx.x; asm volatile("" : "+v"(tid));
    if (tid < 24) { const unsigned voff = (unsigned)(CW_MOECNT + l * 32 + tid) * 4u; const unsigned* ctl = (const unsigned*)((const char*)p.ws + voff); tab[32 + tid] = (int)__hip_atomic_load(ctl, __ATOMIC_RELAXED, __HIP_MEMORY_SCOPE_AGENT); }
    __syncthreads();
    if (tid == 0) { int pre = 0; for (int c = 0; c < 24; ++c) { tab[c] = pre; pre += (tab[32 + c] + 255) >> 8; } tab[24] = pre; }
    __syncthreads();
}

__device__ __forceinline__ void phase_final(const Params& p, int bid, int G) {
    int tid = threadIdx.x; asm volatile("" : "+v"(tid));
    const int lane = tid & 63, wave = tid >> 6;
    const int gw = bid * NWAVES + wave, NGW = G * NWAVES;
    for (int row = gw; row < NTOK; row += NGW) {
        f32x4* xr = (f32x4*)(p.out + (size_t)row * 1024) + lane; f32x4 v[4]; float s = 0.f;
#pragma unroll
        for (int j = 0; j < 4; ++j) { v[j] = xr[64 * j]; s += (v[j].x * v[j].x + v[j].y * v[j].y) + (v[j].z * v[j].z + v[j].w * v[j].w); }
        const float rstd = rsqrtf(wave_sum(s) * (1.f / 1024.f) + EPS);
#pragma unroll
        for (int j = 0; j < 4; ++j) { const f32x4 gg = ((const f32x4*)PIN(26))[64 * j + lane]; xr[64 * j] = (f32x4){v[j].x * rstd * gg.x, v[j].y * rstd * gg.y, v[j].z * rstd * gg.z, v[j].w * rstd * gg.w}; }
    }
}

constexpr int N_PHASES = 3 + 9 * NLAYER + 1;
__global__ void __launch_bounds__(NTHR, 2) mk_fwd(Params p) {
    extern __shared__ __attribute__((aligned(16))) unsigned char lds_raw[];
    LAS unsigned char* lds = (LAS unsigned char*)lds_raw;
    volatile LAS unsigned* MISC = (volatile LAS unsigned*)(lds + LDS_MISC);
    const int tid = threadIdx.x;
    const int G = gridDim.x, bid = blockIdx.x;
    unsigned char* ws = p.ws; asm volatile("" : "+s"(ws));
    for (int u = tid; u < 256; u += NTHR) MISC[u] = 0u;
    __syncthreads();
    const int lo = p.ph_lo, hi = p.ph_hi;
    const bool use_bar = (hi - lo) > 1;
    XcdBarrier bar; bar.bar = (unsigned*)(ws + WS_CTL) + CW_BAR; bar.x = 0; bar.st = MISC + 8;
    if (use_bar) bar = xcd_barrier_post((unsigned*)(ws + WS_CTL) + CW_BAR, MISC + 8);
#define IN(k) (lo <= (k) && (k) < hi)
#define SEAM(k) do { if ((k) + 1 < hi) xcd_barrier(bar); } while (0)
    const float* ssq = (const float*)(ws + WS_SSQ);
    bf16_t* xb = (bf16_t*)(ws + WS_XB);

    if (PHON(0) && IN(0)) { phase_pro_a(p, lds, bid, G); SEAM(0); }
    if (PHON(1) && IN(1)) {
        SchedKV S{G, bid, (const char*)(ws + WS_MEMN), (const char*)(ws + WS_WKVT)};
        EpiBf16 E{(bf16_t*)(ws + WS_KV), 2048, nullptr};
        pg8::gemm_phase<EpiBf16, SchedKV, false, false, false>(lds, GemmDesc{1024, 2048u, 2048u, 0}, S, E);
        SEAM(1);
    }
    if (PHON(2) && IN(2)) {
        { SchedQK S{G, bid, (const char*)(ws + WS_KV), (const char*)(ws + WS_WQS)};
          EpiBf16 E{(bf16_t*)(ws + WS_WQK), 1024, nullptr};
          pg8::gemm_phase<EpiBf16, SchedQK, false, false, false>(lds, GemmDesc{256, 4096u, 2048u, 0}, S, E); }
        { SchedVO S{G, bid, (const char*)(ws + WS_KV), (const char*)(ws + WS_WOT)};
          EpiBf16 E{(bf16_t*)(ws + WS_WVO), 1024, nullptr};
          pg8::gemm_phase<EpiBf16, SchedVO, false, false, false>(lds, GemmDesc{256, 2048u, 4096u, 0}, S, E); }
        SEAM(2);
    }
    for (int l = 0; l < NLAYER; ++l) {
        const int pb = 3 + 9 * l;
        if (!(lo < pb + 9 && pb < hi)) continue;
        if (PHON(3) && IN(pb + 0)) {
            SchedGrid S{64, 12, 768, G, bid, (const char*)xb, (const char*)(ws + WS_WIN) + (size_t)l * 3072 * 2048, (size_t)256 * 2048, (size_t)256 * 2048, 0, NY};
            EpiBf16 E{(bf16_t*)(ws + WS_R1), NY, ssq};
            pg8::gemm_phase<EpiBf16, SchedGrid, false, false, false>(lds, GemmDesc{1024, 2048u, 2048u, 0}, S, E);
            phase_logf(p, lds, l, bid, G);
            SEAM(pb + 0);
        }
        if (PHON(4) && IN(pb + 1)) { phase_p2a(p, lds, l, bid, G); SEAM(pb + 1); }
        if (PHON(5) && IN(pb + 2)) {
            for (int u = bid; u < 256; u += G) hgrn_unit<true>(p, lds, l, u);
            for (int u = bid; u < 256; u += G) attn_unit_simple(p, l, u);
            SEAM(pb + 2);
        }
        if (PHON(6) && IN(pb + 3)) {
            SchedGrid S{64, 4, 256, G, bid, (const char*)(ws + WS_CAT), (const char*)(ws + WS_WOUT) + (size_t)l * 1024 * 2048, (size_t)256 * 2048, (size_t)256 * 2048, 0, DM};
            EpiResidual E{l == 0 ? PIN(0) : p.out, p.out, xb, (float*)(ws + WS_SSQ)};
            pg8::gemm_phase<EpiResidual, SchedGrid, false, false, false>(lds, GemmDesc{1024, 2048u, 2048u, 0}, S, E);
            SEAM(pb + 3);
        }
        if (PHON(7) && IN(pb + 4)) {
            SchedGrid S{64, 4, 256, G, bid, (const char*)xb, (const char*)(ws + WS_WQK) + (size_t)l * 2 * 1024 * 2048, (size_t)256 * 2048, (size_t)256 * 2048, (size_t)1024 * 2048, DM};
            EpiSoftmax E{(bf16_t*)(ws + WS_PBUF), ssq, (LAS float*)(lds + LDS_EPI)};
            pg8::gemm_phase<EpiSoftmax, SchedGrid, true, false, false>(lds, GemmDesc{1024, 2048u, 2048u, 0}, S, E);
            SEAM(pb + 4);
        }
        if (PHON(8) && IN(pb + 5)) {
            SchedGrid S{64, 4, 256, G, bid, (const char*)(ws + WS_PBUF), (const char*)(ws + WS_WVO) + (size_t)l * 2 * 1024 * 2048, (size_t)256 * 2048, (size_t)256 * 2048, (size_t)1024 * 2048, DM};
            EpiResidual E{p.out, p.out, xb, (float*)(ws + WS_SSQ)};
            pg8::gemm_phase<EpiResidual, SchedGrid, false, false, false>(lds, GemmDesc{1024, 2048u, 2048u, 0}, S, E);
            SEAM(pb + 5);
        }
        if (PHON(9) && IN(pb + 6)) { phase_route(p, lds, l, bid, G); SEAM(pb + 6); }
        if (PHON(10) && IN(pb + 7)) {
            volatile LAS int* tab = (volatile LAS int*)(MISC + 16);
            moe_table(p, tab, l);
            SchedMoe S{G, bid, false, tab, (const int*)(ws + WS_TOKC), (const char*)xb, (const char*)(ws + WS_WGU) + (size_t)l * 16 * 512 * 2048};
            EpiMoeUp E{(bf16_t*)(ws + WS_HID), (const int*)(ws + WS_TOKC), ssq, (const f32x2*)(ws + WS_WTS)};
            pg8::gemm_phase<EpiMoeUp, SchedMoe, false, true, false>(lds, GemmDesc{1024, 2048u, 2048u, 0}, S, E);
            SEAM(pb + 7);
        }
        if (PHON(11) && IN(pb + 8)) {
            volatile LAS int* tab = (volatile LAS int*)(MISC + 16);
            moe_table(p, tab, l);
            SchedMoe S{G, bid, true, tab, (const int*)(ws + WS_TOKC), (const char*)(ws + WS_HID), (const char*)(ws + WS_WD) + (size_t)l * 16 * 1024 * 512};
            EpiMoeDown E{p.out, xb, (float*)(ws + WS_SSQ), (const int*)(ws + WS_TOKC)};
            pg8::gemm_phase<EpiMoeDown, SchedMoe, false, false, true>(lds, GemmDesc{512, 1024u, 512u, 4}, S, E);
            SEAM(pb + 8);
        }
    }
    if (IN(N_PHASES - 1)) phase_final(p, bid, G);
#undef IN
#undef SEAM
}

extern "C" void kernel_launch(void* const* d_in, const int* in_sizes, int n_in, void* d_out, int out_size, void* d_ws, size_t ws_size, hipStream_t stream) {
    static int grid = 0;
    if (grid == 0) {
        if (n_in != 27 || out_size != NTOK * DM || ws_size < WS_END) { fprintf(stderr, "kernel_launch: unexpected shapes (n_in %d out %d ws %zu)\n", n_in, out_size, ws_size); grid = -1; return; }
        int dev = 0, cus = 0, per_cu = 0;
        if (hipGetDevice(&dev) != hipSuccess || hipDeviceGetAttribute(&cus, hipDeviceAttributeMultiprocessorCount, dev) != hipSuccess) { grid = -1; return; }
        if (hipFuncSetAttribute((const void*)mk_fwd, hipFuncAttributeMaxDynamicSharedMemorySize, LDS_BYTES) != hipSuccess) { fprintf(stderr, "kernel_launch: hipFuncSetAttribute failed\n"); grid = -1; return; }
        if (hipOccupancyMaxActiveBlocksPerMultiprocessor(&per_cu, (const void*)mk_fwd, NTHR, LDS_BYTES) != hipSuccess || per_cu < 1) { fprintf(stderr, "kernel_launch: occupancy query reports %d\n", per_cu); }
        (void)hipGetLastError();
        grid = cus;
    }
    if (grid < 0) return;
    (void)hipMemsetAsync((char*)d_ws + WS_CTL, 0, CTL_ZERO_BYTES, stream);
    Params a{};
    for (int i = 0; i < 27; ++i) a.in[i] = (const float*)d_in[i];
    a.out = (float*)d_out; a.ws = (unsigned char*)d_ws;
#if ONE_LAUNCH
    a.ph_lo = 0; a.ph_hi = N_PHASES;
    hipLaunchKernelGGL(mk_fwd, dim3(grid), dim3(NTHR), LDS_BYTES, stream, a);
#else
    for (int k = 0; k < N_PHASES; ++k) { a.ph_lo = k; a.ph_hi = k + 1; hipLaunchKernelGGL(mk_fwd, dim3(grid), dim3(NTHR), LDS_BYTES, stream, a); }
#endif
}
```

```cpp
#include <hip/hip_runtime.h>
#include <cstdio>
#include <cstdint>

#ifndef USE_MFMA
#define USE_MFMA 1
#endif
#ifndef ONE_LAUNCH
#define ONE_LAUNCH 1
#endif
#ifndef DIS
#define DIS 0
#endif
#define PHON(k) (!(((DIS) >> (k)) & 1))
#ifndef ATTN_MFMA
#define ATTN_MFMA 1
#endif
#ifndef FOX_PRUNE
#define FOX_PRUNE 1
#endif

#define LAS __attribute__((address_space(3)))
#define GAS __attribute__((address_space(1)))
typedef unsigned short bf16_t;
typedef short bf16x8 __attribute__((ext_vector_type(8)));
typedef float f32x4 __attribute__((ext_vector_type(4)));
typedef float f32x2 __attribute__((ext_vector_type(2)));
typedef unsigned u32x4 __attribute__((ext_vector_type(4)));
typedef unsigned u32x2 __attribute__((ext_vector_type(2)));

constexpr int NTOK = 16384, DM = 1024, SEQ = 8192, NLAYER = 4, NY = 3072;
constexpr float EPS = 1e-6f, LOG2E = 1.4426950408889634f;
constexpr float C2 = 0.125f * LOG2E;
constexpr int NWAVES = 8, NTHR = 512;

constexpr size_t MiB = 1u << 20;
constexpr size_t WS_CTL = 0, CTL_ZERO_BYTES = 64 * 1024;
constexpr size_t WS_WFF = 1 * MiB;
constexpr size_t WS_WR = 1 * MiB + 256 * 1024;
constexpr size_t WS_LOGF = 2 * MiB;
constexpr size_t WS_CFOX = 2 * MiB + 512 * 1024;
constexpr size_t WS_SSQ = 3 * MiB;
constexpr size_t WS_HU = 4 * MiB;
constexpr size_t WS_HD = 8 * MiB;
constexpr size_t WS_TOKC = 9 * MiB;
constexpr size_t WS_WTS = 10 * MiB + 512 * 1024;
constexpr size_t WS_MEMN = 11 * MiB;
constexpr size_t WS_KV = 12 * MiB;
constexpr size_t WS_WIN = 20 * MiB;
constexpr size_t WS_WOUT = 44 * MiB;
constexpr size_t WS_WQK = 52 * MiB;
constexpr size_t WS_WVO = 68 * MiB;
constexpr size_t WS_WGU = 84 * MiB;
constexpr size_t WS_WD = 148 * MiB;
constexpr size_t WS_XB = 180 * MiB;
constexpr size_t WS_CAT = 212 * MiB;
constexpr size_t WS_R1 = 244 * MiB;
constexpr size_t WS_PBUF = WS_R1;
constexpr size_t WS_HID = WS_R1 + 32 * MiB;
constexpr size_t WS_WQS = WS_R1;
constexpr size_t WS_WKVT = WS_R1 + 8 * MiB;
constexpr size_t WS_WOT = WS_R1 + 24 * MiB;
constexpr size_t WS_END = 340 * MiB;

constexpr int CW_TMO = 0, CW_KQMAX = 256, CW_MOECNT = 512, CW_BAR = 4096;

constexpr int LDS_STAGE = 0, LDS_STAGE_BYTES = 131072;
constexpr int LDS_EPI = 131072;
constexpr int LDS_MISC = 131072 + 8192;
constexpr int LDS_BYTES = 131072 + 8192 + 1024;

__device__ __forceinline__ float bf2f(unsigned b) { return __uint_as_float(b << 16); }
__device__ __forceinline__ unsigned cvt_pk_bf16(float lo, float hi) { unsigned r; asm volatile("v_cvt_pk_bf16_f32 %0, %1, %2" : "=v"(r) : "v"(lo), "v"(hi)); return r; }
__device__ __forceinline__ unsigned short f2bf1(float f) { return (unsigned short)(cvt_pk_bf16(f, 0.f) & 0xffffu); }
template <int K> __device__ __forceinline__ float swz_xor(float v) { return __int_as_float(__builtin_amdgcn_ds_swizzle(__float_as_int(v), (K << 10) | 0x1f)); }
__device__ __forceinline__ float x32_sum(float v) { auto r = __builtin_amdgcn_permlane32_swap(__float_as_uint(v), __float_as_uint(v), false, false); return __uint_as_float(r[0]) + __uint_as_float(r[1]); }
__device__ __forceinline__ float x32_max(float v) { auto r = __builtin_amdgcn_permlane32_swap(__float_as_uint(v), __float_as_uint(v), false, false); return fmaxf(__uint_as_float(r[0]), __uint_as_float(r[1])); }
__device__ __forceinline__ float wave_sum(float v) {
    v += swz_xor<1>(v); v += swz_xor<2>(v); v += swz_xor<4>(v); v += swz_xor<8>(v); v += swz_xor<16>(v);
    return x32_sum(v);
}
__device__ __forceinline__ float sigmoidf_(float x) { return 1.f / (1.f + __expf(-x)); }
#define LDS_WAIT() asm volatile("s_waitcnt lgkmcnt(0)" ::: "memory")
#define VM_WAIT() asm volatile("s_waitcnt vmcnt(0)" ::: "memory")

#define XB_TMO      128
#define XB_XCNT(j)  (256  + 64 * (j))
#define XB_XSUB(j)  (1280 + 64 * (j))
#define XB_XGEN(j)  (2304 + 64 * (j))
#define XB_TOP      3328
#define XB_TOPGEN   3392
#define XCD_BAR_WORDS 3456
#define XB_SPIN_CAP (1u << 22)
__device__ __forceinline__ unsigned xb_ld(unsigned* p)              { return __hip_atomic_load(p, __ATOMIC_RELAXED, __HIP_MEMORY_SCOPE_AGENT); }
__device__ __forceinline__ unsigned xb_add(unsigned* p, unsigned v) { return __hip_atomic_fetch_add(p, v, __ATOMIC_RELAXED, __HIP_MEMORY_SCOPE_AGENT); }
__device__ __forceinline__ unsigned xb_xcc_id() { return (unsigned)__builtin_amdgcn_s_getreg((3 << 11) | 20) & 0xFu; }
#define XB_SPIN(cond, bar) do { unsigned _sp = 0; while (cond) { __builtin_amdgcn_s_sleep(1); \
    if ((++_sp & 255u) == 0u) { if (xb_ld(&(bar)[XB_TMO])) break; if (_sp > XB_SPIN_CAP) { atomicAdd(&(bar)[XB_TMO], 1u); break; } } } } while (0)
struct XcdBarrier { unsigned* bar; unsigned x; volatile LAS unsigned* st; };
__device__ __forceinline__ XcdBarrier xcd_barrier_post(unsigned* bar, volatile LAS unsigned* st) {
    XcdBarrier b; b.bar = bar; b.x = xb_xcc_id(); b.st = st;
    if (threadIdx.x == 0) (void)xb_add(&bar[XB_XCNT(b.x)], 1u);
    return b;
}
__device__ __forceinline__ void xcd_barrier_complete(unsigned* bar, unsigned x, unsigned& nloc, unsigned& nx) {
    const unsigned G = gridDim.x * gridDim.y * gridDim.z;
    unsigned sum, cnt, mine, sp = 0u;
    for (;;) {
        sum = 0u; cnt = 0u; mine = 0u;
#pragma unroll
        for (unsigned j = 0; j < 16; ++j) { const unsigned c = xb_ld(&bar[XB_XCNT(j)]); sum += c; cnt += (c > 0u) ? 1u : 0u; mine = (j == x) ? c : mine; }
        if (sum == G) break;
        __builtin_amdgcn_s_sleep(1);
        if ((++sp & 255u) == 0u) { if (xb_ld(&bar[XB_TMO])) break; if (sp > XB_SPIN_CAP) { atomicAdd(&bar[XB_TMO], 1u); break; } }
    }
    nloc = mine > 0u ? mine : 1u; nx = cnt > 0u ? cnt : 1u;
}
__device__ __forceinline__ void xcd_barrier(const XcdBarrier& b) {
    asm volatile("s_waitcnt vmcnt(0)" ::: "memory");
    __syncthreads();
    if (threadIdx.x == 0) {
        unsigned* bar = b.bar;
        __builtin_amdgcn_s_waitcnt(0);
        unsigned nloc = b.st[0], nx = b.st[1];
        if (nloc == 0u) { xcd_barrier_complete(bar, b.x, nloc, nx); b.st[0] = nloc; b.st[1] = nx; }
        const unsigned old = xb_add(&bar[XB_XSUB(b.x)], 1u);
        const unsigned gen = old / nloc;
        if (old + 1u == (gen + 1u) * nloc) {
            __builtin_amdgcn_fence(__ATOMIC_RELEASE, "agent");
            asm volatile("s_waitcnt vmcnt(0)" ::: "memory");
            const unsigned og = xb_add(&bar[XB_TOP], 1u);
            const unsigned tg = og / nx;
            if (og + 1u == (tg + 1u) * nx) xb_add(&bar[XB_TOPGEN], 1u);
            else XB_SPIN(xb_ld(&bar[XB_TOPGEN]) == tg, bar);
            __builtin_amdgcn_fence(__ATOMIC_ACQUIRE, "agent");
            xb_add(&bar[XB_XGEN(b.x)], 1u);
            asm volatile("s_waitcnt vmcnt(0)" ::: "memory");
        } else {
            XB_SPIN(xb_ld(&bar[XB_XGEN(b.x)]) == gen, bar);
            __builtin_amdgcn_fence(__ATOMIC_ACQUIRE, "agent");
            asm volatile("s_waitcnt vmcnt(0)" ::: "memory");
        }
    }
    __syncthreads();
}

namespace pg8 {
constexpr int BM = 256, BK = 64, HALF = 128, HTB = HALF * BK * 2;
__host__ __device__ __forceinline__ int lds_byte(int r, int c) { const int st = (r >> 4) * 2 + (c >> 5), rr = r & 15, cc = c & 31, ob = rr * 64 + cc * 2; return st * 1024 + (ob ^ (((ob >> 9) & 1) << 5)); }
__host__ __device__ __forceinline__ void stage_rc(int b, int& R, int& C) { const int st = b / 1024, sb = b % 1024, swz = sb ^ (((sb >> 9) & 1) << 5); R = (st >> 1) * 16 + swz / 64; C = (st & 1) * 32 + (swz % 64) / 2; }
__host__ __device__ __forceinline__ int perm32(int rho) { const int n = rho >> 4, i = rho & 15; return 8 * (i >> 2) + 4 * n + (i & 3); }

struct Unit { int pm, pn, a0, a1, a2, a3; };
struct GemmDesc { int K; unsigned lda, ldb; int ksplit; };


#if USE_MFMA
template <class Epi, class Sched, bool ALIGN_EPI, bool GATHER, bool BSPLIT>
__device__ __forceinline__ void gemm_phase(LAS unsigned char* lds, const GemmDesc g, const Sched& S, const Epi& E) {
    int tid = threadIdx.x; asm volatile("" : "+v"(tid));
    const int wid = __builtin_amdgcn_readfirstlane(tid >> 6), lane = tid & 63, wr = wid >> 2, wc = wid & 3, fr = lane & 15, fq = lane >> 4;
    const int nt = g.K / BK;
    int R0, C0; stage_rc(tid * 16, R0, C0);
    const unsigned voffB = (unsigned)((R0 & ~31) + perm32(R0 & 31)) * g.ldb + (unsigned)C0 * 2u, voffA = (unsigned)R0 * g.lda + (unsigned)C0 * 2u;
    const size_t qstepA = (size_t)64 * g.lda, qstepB = (size_t)64 * g.ldb;
    const size_t kstep = (size_t)(BK * 2);
    const size_t hstepB = (size_t)HALF * g.ldb, hstepA = GATHER ? (size_t)0 : (size_t)HALF * g.lda;
    const unsigned ldsw = (unsigned)wid * 1024u;
    const int aoff = lds_byte(wr * 64 + fr, fq * 8), boff = lds_byte(wc * 32 + fr, fq * 8);
#define PG8_SA(b, h) (((b) * 2 + (h)) * HTB)
#define PG8_SB(b, h) ((4 + (b) * 2 + (h)) * HTB)
#define PG8_STAGE(bufoff, gbase, voff) do { _Pragma("unroll") for (int _i = 0; _i < 2; ++_i) \
        __builtin_amdgcn_global_load_lds((const unsigned*)((const char*)(gbase) + (voff)[_i]), (LAS unsigned*)(lds + (bufoff) + ldsw + _i * 8192), 16, 0, 0); } while (0)
#define PG8_STAGE1(bufoff, gbase, voff, qstep) do { _Pragma("unroll") for (int _i = 0; _i < 2; ++_i) \
        __builtin_amdgcn_global_load_lds((const unsigned*)((const char*)(gbase) + _i * (qstep) + (voff)), (LAS unsigned*)(lds + (bufoff) + ldsw + _i * 8192), 16, 0, 0); } while (0)
#define PG8_STAGE_B(bufoff, gbase) PG8_STAGE1(bufoff, gbase, voffB, qstepB)
#define PG8_LDA(dst, b, h) do { _Pragma("unroll") for (int m = 0; m < 4; ++m) _Pragma("unroll") for (int k = 0; k < 2; ++k) dst[m][k] = *(const LAS bf16x8*)(lds + PG8_SA(b, h) + aoff + m * 2048 + k * 1024); } while (0)
#define PG8_LDB(dst, b, h) do { _Pragma("unroll") for (int n = 0; n < 2; ++n) _Pragma("unroll") for (int k = 0; k < 2; ++k) dst[n][k] = *(const LAS bf16x8*)(lds + PG8_SB(b, h) + boff + n * 2048 + k * 1024); } while (0)
#define PG8_MMA(ai, bj, At, Bt) do { __builtin_amdgcn_s_setprio(1); _Pragma("unroll") for (int m = 0; m < 4; ++m) _Pragma("unroll") for (int n = 0; n < 2; ++n) _Pragma("unroll") for (int k = 0; k < 2; ++k) \
        acc[ai][bj][m][n] = __builtin_amdgcn_mfma_f32_16x16x32_bf16(Bt[n][k], At[m][k], acc[ai][bj][m][n], 0, 0, 0); __builtin_amdgcn_s_setprio(0); } while (0)
#define PG8_WAIT_V(n) asm volatile("s_waitcnt vmcnt(" #n ")" ::: "memory")
#define PG8_WAIT_L(n) asm volatile("s_waitcnt lgkmcnt(" #n ")" ::: "memory")
#define PG8_BAR __builtin_amdgcn_s_barrier()
#define PG8_SCHED __builtin_amdgcn_sched_barrier(0)
#define PG8_OFFS(u, o) do { if constexpr (GATHER) { _Pragma("unroll") for (int _h = 0; _h < 2; ++_h) _Pragma("unroll") for (int _i = 0; _i < 2; ++_i) \
        o[_h][_i] = S.arow(u, _h * 128 + _i * 64 + R0) + (unsigned)C0 * 2u; } } while (0)
#define PG8_STAGE_A(bufoff, gbase, h, OFF) do { if constexpr (GATHER) { PG8_STAGE(bufoff, gbase, OFF[h]); } else { PG8_STAGE1(bufoff, (gbase) + (h) * hstepA, voffA, qstepA); } } while (0)
#define PG8_BP(base, base2, tt) (((BSPLIT && (tt) >= g.ksplit) ? (base2) : (base)) + (size_t)(tt) * kstep)
    Unit cur, nxt; int ui = 0;
    if (!S.next(0, cur)) return;
    f32x4 acc[2][2][4][2];
#pragma unroll
    for (int a = 0; a < 2; ++a)
#pragma unroll
        for (int b = 0; b < 2; ++b)
#pragma unroll
            for (int m = 0; m < 4; ++m)
#pragma unroll
                for (int n = 0; n < 2; ++n) acc[a][b][m][n] = (f32x4){0.f, 0.f, 0.f, 0.f};
    bf16x8 At[4][2], B0[2][2], B1[2][2];
    unsigned coff[2][2], noff[2][2];
#pragma unroll
    for (int h = 0; h < 2; ++h)
#pragma unroll
        for (int i = 0; i < 2; ++i) { coff[h][i] = 0u; noff[h][i] = 0u; }
    PG8_OFFS(cur, coff);
    const char* cA = S.A(cur); const char* cB = S.B(cur); const char* cB2 = BSPLIT ? S.B2(cur) : cB;
    PG8_STAGE_B(PG8_SB(0, 0), cB); PG8_STAGE_B(PG8_SB(0, 1), cB + hstepB); PG8_STAGE_A(PG8_SA(0, 0), cA, 0, coff); PG8_STAGE_A(PG8_SA(0, 1), cA, 1, coff);
    if (wr == 1) PG8_BAR;
    PG8_WAIT_V(2); PG8_BAR;
    PG8_STAGE_B(PG8_SB(1, 0), cB + kstep); PG8_STAGE_A(PG8_SA(1, 0), cA + kstep, 0, coff); PG8_STAGE_B(PG8_SB(1, 1), cB + hstepB + kstep);
    PG8_WAIT_V(6); PG8_BAR;
    for (;;) {
        const bool has_next = S.next(ui + 1, nxt);
        const char* nA = has_next ? S.A(nxt) : cA; const char* nB = has_next ? S.B(nxt) : cB; const char* nB2 = (BSPLIT && has_next) ? S.B2(nxt) : cB2;
        if constexpr (GATHER) { if (has_next) { PG8_OFFS(nxt, noff); } else {
#pragma unroll
            for (int h = 0; h < 2; ++h)
#pragma unroll
                for (int i = 0; i < 2; ++i) noff[h][i] = coff[h][i]; } }
        for (int t = 0; t < nt; t += 2) {
            const bool last = (t == nt - 2);
            const char* a1 = cA + (size_t)(t + 1) * kstep;
            const char* a2 = last ? nA : cA + (size_t)(t + 2) * kstep;
            const char* b2 = last ? nB : PG8_BP(cB, cB2, t + 2);
            const char* a3 = a2 + kstep;
            const char* b3 = last ? nB + kstep : PG8_BP(cB, cB2, t + 3);
            unsigned o2[2][2];
#pragma unroll
            for (int h = 0; h < 2; ++h)
#pragma unroll
                for (int i = 0; i < 2; ++i) o2[h][i] = GATHER ? (last ? noff[h][i] : coff[h][i]) : 0u;
            PG8_LDB(B0, 0, 0); PG8_LDB(B1, 0, 1); PG8_SCHED; PG8_LDA(At, 0, 0); PG8_STAGE_A(PG8_SA(1, 1), a1, 1, coff);
            PG8_WAIT_V(8); PG8_WAIT_L(0); PG8_BAR; PG8_MMA(0, 0, At, B0); PG8_MMA(0, 1, At, B1); PG8_BAR; PG8_SCHED;
            PG8_LDA(At, 0, 1); PG8_STAGE_B(PG8_SB(0, 0), b2); PG8_STAGE_B(PG8_SB(0, 1), b2 + hstepB); PG8_STAGE_A(PG8_SA(0, 0), a2, 0, o2);
            PG8_WAIT_V(8); PG8_WAIT_L(0); PG8_BAR; PG8_MMA(1, 0, At, B0); PG8_MMA(1, 1, At, B1); PG8_BAR; PG8_SCHED;
            PG8_LDB(B0, 1, 0); PG8_LDB(B1, 1, 1); PG8_SCHED; PG8_LDA(At, 1, 0); PG8_STAGE_A(PG8_SA(0, 1), a2, 1, o2);
            PG8_WAIT_V(8); PG8_WAIT_L(0); PG8_BAR; PG8_MMA(0, 0, At, B0); PG8_MMA(0, 1, At, B1); PG8_BAR; PG8_SCHED;
            PG8_LDA(At, 1, 1); PG8_STAGE_B(PG8_SB(1, 0), b3); PG8_STAGE_B(PG8_SB(1, 1), b3 + hstepB); PG8_STAGE_A(PG8_SA(1, 0), a3, 0, o2);
            PG8_WAIT_V(8); PG8_WAIT_L(0); PG8_BAR; PG8_MMA(1, 0, At, B0); PG8_MMA(1, 1, At, B1); PG8_BAR; PG8_SCHED;
        }
        if constexpr (ALIGN_EPI) { if (wr == 0) PG8_BAR; }
        { int t2 = threadIdx.x; asm volatile("" : "+v"(t2)); const int l2 = t2 & 63; E(acc, cur, wr, wc, l2 & 15, l2 >> 4); }
        if (!has_next) break;
#pragma unroll
        for (int a = 0; a < 2; ++a)
#pragma unroll
            for (int b = 0; b < 2; ++b)
#pragma unroll
                for (int m = 0; m < 4; ++m)
#pragma unroll
                    for (int n = 0; n < 2; ++n) acc[a][b][m][n] = (f32x4){0.f, 0.f, 0.f, 0.f};
        cur = nxt; cA = nA; cB = nB; cB2 = nB2; ++ui;
#pragma unroll
        for (int h = 0; h < 2; ++h)
#pragma unroll
            for (int i = 0; i < 2; ++i) coff[h][i] = noff[h][i];
        if constexpr (ALIGN_EPI) { if (wr == 1) PG8_BAR; }
    }
    PG8_WAIT_V(0);
    if constexpr (!ALIGN_EPI) { if (wr == 0) PG8_BAR; }
    PG8_BAR;
#undef PG8_SA
#undef PG8_SB
#undef PG8_STAGE
#undef PG8_LDA
#undef PG8_LDB
#undef PG8_MMA
#undef PG8_WAIT_V
#undef PG8_WAIT_L
#undef PG8_BAR
#undef PG8_SCHED
#undef PG8_OFFS
#undef PG8_STAGE_A
#undef PG8_STAGE1
#undef PG8_STAGE_B
#undef PG8_BP
}
#else
template <class Epi, class Sched, bool ALIGN_EPI, bool GATHER, bool BSPLIT>
__device__ __forceinline__ void gemm_phase(LAS unsigned char* lds, const GemmDesc g, const Sched& S, const Epi& E) {
    const int tid = threadIdx.x, wid = __builtin_amdgcn_readfirstlane(tid >> 6), lane = tid & 63, wr = wid >> 2, wc = wid & 3, fr = lane & 15, fq = lane >> 4;
    Unit cur;
    for (int ui = 0; S.next(ui, cur); ++ui) {
        f32x4 acc[2][2][4][2];
#pragma unroll
        for (int a = 0; a < 2; ++a)
#pragma unroll
            for (int b = 0; b < 2; ++b)
#pragma unroll
                for (int m = 0; m < 4; ++m)
#pragma unroll
                    for (int n = 0; n < 2; ++n) acc[a][b][m][n] = (f32x4){0.f, 0.f, 0.f, 0.f};
        const char* cA = S.A(cur); const char* cB = S.B(cur); const char* cB2 = BSPLIT ? S.B2(cur) : cB;
        unsigned aro[2][4];
#pragma unroll
        for (int ai = 0; ai < 2; ++ai)
#pragma unroll
            for (int m = 0; m < 4; ++m) { const int r = ai * 128 + wr * 64 + m * 16 + fr; aro[ai][m] = GATHER ? S.arow(cur, r) : (unsigned)r * g.lda; }
        for (int k0 = 0; k0 < g.K; k0 += 4) {
            u32x2 av[2][4];
#pragma unroll
            for (int ai = 0; ai < 2; ++ai)
#pragma unroll
                for (int m = 0; m < 4; ++m) av[ai][m] = *(const u32x2*)(cA + aro[ai][m] + (size_t)k0 * 2);
            const char* bb = (BSPLIT && k0 >= g.ksplit * 64) ? cB2 : cB;
#pragma unroll
            for (int bj = 0; bj < 2; ++bj)
#pragma unroll
                for (int n = 0; n < 2; ++n)
#pragma unroll
                    for (int j = 0; j < 4; ++j) {
                        const int c = bj * 128 + wc * 32 + fq * 8 + n * 4 + j;
                        const u32x2 bv = *(const u32x2*)(bb + (size_t)c * g.ldb + (size_t)k0 * 2);
                        const float b0 = bf2f(bv.x & 0xffffu), b1 = bf2f(bv.x >> 16), b2 = bf2f(bv.y & 0xffffu), b3 = bf2f(bv.y >> 16);
#pragma unroll
                        for (int ai = 0; ai < 2; ++ai)
#pragma unroll
                            for (int m = 0; m < 4; ++m) {
                                const u32x2 a = av[ai][m];
                                acc[ai][bj][m][n][j] += bf2f(a.x & 0xffffu) * b0 + bf2f(a.x >> 16) * b1 + bf2f(a.y & 0xffffu) * b2 + bf2f(a.y >> 16) * b3;
                            }
                    }
        }
        E(acc, cur, wr, wc, fr, fq);
    }
    __syncthreads();
}
#endif
}
using pg8::Unit; using pg8::GemmDesc;

__device__ __forceinline__ float row_rstd(const float* ssq, int row) {
    const f32x4* p = (const f32x4*)(ssq + (size_t)row * 16);
    const f32x4 a = p[0], b = p[1], c = p[2], d = p[3];
    const float s = ((a.x + a.y) + (a.z + a.w)) + ((b.x + b.y) + (b.z + b.w)) + ((c.x + c.y) + (c.z + c.w)) + ((d.x + d.y) + (d.z + d.w));
    return rsqrtf(s * (1.f / 1024.f) + EPS);
}
__device__ __forceinline__ u32x4 pack8(f32x4 v0, f32x4 v1) { u32x4 w; w.x = cvt_pk_bf16(v0[0], v0[1]); w.y = cvt_pk_bf16(v0[2], v0[3]); w.z = cvt_pk_bf16(v1[0], v1[1]); w.w = cvt_pk_bf16(v1[2], v1[3]); return w; }

struct EpiBf16 {
    bf16_t* O; int ldc; const float* ssq;
    __device__ __forceinline__ void operator()(const f32x4 (&acc)[2][2][4][2], const Unit& u, int wr, int wc, int fr, int fq) const {
#pragma unroll
        for (int ai = 0; ai < 2; ++ai)
#pragma unroll
            for (int m = 0; m < 4; ++m) {
                const int r = ai * 128 + wr * 64 + m * 16 + fr;
                const float rs = ssq ? row_rstd(ssq, u.a1 + r) : 1.f;
                bf16_t* rowp = O + (size_t)u.a0 + (size_t)r * ldc + wc * 32 + fq * 8;
#pragma unroll
                for (int bj = 0; bj < 2; ++bj) *(u32x4*)(rowp + bj * 128) = pack8(acc[ai][bj][m][0] * rs, acc[ai][bj][m][1] * rs);
                __builtin_amdgcn_sched_barrier(0);
            }
    }
};
struct EpiResidual {
    const float* xin; float* xout; bf16_t* xb; float* ssq;
    __device__ __forceinline__ void operator()(const f32x4 (&acc)[2][2][4][2], const Unit& u, int wr, int wc, int fr, int fq) const {
#pragma unroll
        for (int ai = 0; ai < 2; ++ai)
#pragma unroll
            for (int m = 0; m < 4; ++m) {
                const int row = u.pm * 256 + ai * 128 + wr * 64 + m * 16 + fr;
                float ss = 0.f;
#pragma unroll
                for (int bj = 0; bj < 2; ++bj) {
                    const size_t o = (size_t)row * DM + u.pn * 256 + bj * 128 + wc * 32 + fq * 8;
                    const f32x4 v0 = acc[ai][bj][m][0] + *(const f32x4*)(xin + o), v1 = acc[ai][bj][m][1] + *(const f32x4*)(xin + o + 4);
                    *(f32x4*)(xout + o) = v0; *(f32x4*)(xout + o + 4) = v1;
                    *(u32x4*)(xb + o) = pack8(v0, v1);
                    ss += (v0[0] * v0[0] + v0[1] * v0[1]) + (v0[2] * v0[2] + v0[3] * v0[3]) + (v1[0] * v1[0] + v1[1] * v1[1]) + (v1[2] * v1[2] + v1[3] * v1[3]);
                }
                ss += swz_xor<16>(ss); ss = x32_sum(ss);
                if (fq == 0) ssq[(size_t)row * 16 + u.pn * 4 + wc] = ss;
                __builtin_amdgcn_sched_barrier(0);
            }
    }
};
struct EpiSoftmax {
    bf16_t* P; const float* ssq; LAS float* scr;
    __device__ __forceinline__ void operator()(const f32x4 (&acc)[2][2][4][2], const Unit& u, int wr, int wc, int fr, int fq) const {
#pragma unroll
        for (int ai = 0; ai < 2; ++ai)
#pragma unroll
            for (int m = 0; m < 4; ++m) {
                const int rl = ai * 128 + wr * 64 + m * 16 + fr;
                const float rs = row_rstd(ssq, u.pm * 256 + rl) * (LOG2E / 16.f);
                float mm = -INFINITY;
#pragma unroll
                for (int bj = 0; bj < 2; ++bj)
#pragma unroll
                    for (int n = 0; n < 2; ++n)
#pragma unroll
                        for (int j = 0; j < 4; ++j) mm = fmaxf(mm, acc[ai][bj][m][n][j] * rs);
                mm = fmaxf(mm, swz_xor<16>(mm)); mm = x32_max(mm);
                if (fq == 0) scr[rl * 4 + wc] = mm;
            }
        LDS_WAIT(); __builtin_amdgcn_s_barrier();
#pragma unroll
        for (int ai = 0; ai < 2; ++ai)
#pragma unroll
            for (int m = 0; m < 4; ++m) {
                const int rl = ai * 128 + wr * 64 + m * 16 + fr;
                const float rs = row_rstd(ssq, u.pm * 256 + rl) * (LOG2E / 16.f);
                const f32x4 q = *(const LAS f32x4*)(scr + rl * 4);
                const float M = fmaxf(fmaxf(q.x, q.y), fmaxf(q.z, q.w));
                float s = 0.f;
#pragma unroll
                for (int bj = 0; bj < 2; ++bj)
#pragma unroll
                    for (int n = 0; n < 2; ++n)
#pragma unroll
                        for (int j = 0; j < 4; ++j) s += __builtin_amdgcn_exp2f(acc[ai][bj][m][n][j] * rs - M);
                s += swz_xor<16>(s); s = x32_sum(s);
                if (fq == 0) scr[1024 + rl * 4 + wc] = s;
            }
        LDS_WAIT(); __builtin_amdgcn_s_barrier();
#pragma unroll
        for (int ai = 0; ai < 2; ++ai)
#pragma unroll
            for (int m = 0; m < 4; ++m) {
                const int rl = ai * 128 + wr * 64 + m * 16 + fr;
                const float r = row_rstd(ssq, u.pm * 256 + rl) * (LOG2E / 16.f);
                const f32x4 qm = *(const LAS f32x4*)(scr + rl * 4);
                const float M = fmaxf(fmaxf(qm.x, qm.y), fmaxf(qm.z, qm.w));
                const f32x4 q = *(const LAS f32x4*)(scr + 1024 + rl * 4);
                const float inv = 1.f / ((q.x + q.y) + (q.z + q.w));
                bf16_t* rowp = P + (size_t)(u.pm * 256 + rl) * DM + u.pn * 256 + wc * 32 + fq * 8;
#pragma unroll
                for (int bj = 0; bj < 2; ++bj) {
                    f32x4 v0, v1;
#pragma unroll
                    for (int j = 0; j < 4; ++j) { v0[j] = __builtin_amdgcn_exp2f(acc[ai][bj][m][0][j] * r - M) * inv; v1[j] = __builtin_amdgcn_exp2f(acc[ai][bj][m][1][j] * r - M) * inv; }
                    *(u32x4*)(rowp + bj * 128) = pack8(v0, v1);
                }
            }
        LDS_WAIT(); __builtin_amdgcn_s_barrier();
    }
};
struct EpiMoeUp {
    bf16_t* hid; const int* tokc; const float* ssq; const f32x2* wts;
    __device__ __forceinline__ void operator()(const f32x4 (&acc)[2][2][4][2], const Unit& u, int wr, int wc, int fr, int fq) const {
#pragma unroll
        for (int ai = 0; ai < 2; ++ai)
#pragma unroll
            for (int m = 0; m < 4; ++m) {
                const int rl = ai * 128 + wr * 64 + m * 16 + fr;
                const bool valid = rl < u.a2;
                const int tok = valid ? tokc[u.a1 + rl] : 0;
                const float rs = row_rstd(ssq, tok);
                const f32x2 w2 = wts[tok];
                const float w = valid ? (u.a3 ? w2.y : w2.x) : 0.f;
                f32x4 h[2];
#pragma unroll
                for (int n = 0; n < 2; ++n)
#pragma unroll
                    for (int j = 0; j < 4; ++j) { const float gt = acc[ai][0][m][n][j] * rs, up = acc[ai][1][m][n][j] * rs; h[n][j] = gt / (1.f + __expf(-gt)) * up * w; }
                *(u32x4*)(hid + (size_t)(u.a0 + rl) * 512 + u.a3 * 256 + u.pn * 128 + wc * 32 + fq * 8) = pack8(h[0], h[1]);
            }
    }
};
struct EpiMoeDown {
    float* x; bf16_t* xb; float* ssq; const int* tokc;
    __device__ __forceinline__ void operator()(const f32x4 (&acc)[2][2][4][2], const Unit& u, int wr, int wc, int fr, int fq) const {
#pragma unroll
        for (int ai = 0; ai < 2; ++ai)
#pragma unroll
            for (int m = 0; m < 4; ++m) {
                const int rl = ai * 128 + wr * 64 + m * 16 + fr;
                const bool valid = rl < u.a2;
                const int tok = valid ? tokc[u.a1 + rl] : 0;
                float ss = 0.f;
                if (valid) {
#pragma unroll
                    for (int bj = 0; bj < 2; ++bj) {
                        const size_t o = (size_t)tok * DM + u.pn * 256 + bj * 128 + wc * 32 + fq * 8;
                        const f32x4 v0 = acc[ai][bj][m][0] + *(const f32x4*)(x + o), v1 = acc[ai][bj][m][1] + *(const f32x4*)(x + o + 4);
                        *(f32x4*)(x + o) = v0; *(f32x4*)(x + o + 4) = v1;
                        *(u32x4*)(xb + o) = pack8(v0, v1);
                        ss += (v0[0] * v0[0] + v0[1] * v0[1]) + (v0[2] * v0[2] + v0[3] * v0[3]) + (v1[0] * v1[0] + v1[1] * v1[1]) + (v1[2] * v1[2] + v1[3] * v1[3]);
                    }
                }
                ss += swz_xor<16>(ss); ss = x32_sum(ss);
                if (valid && fq == 0) ssq[(size_t)tok * 16 + u.pn * 4 + wc] = ss;
                __builtin_amdgcn_sched_barrier(0);
            }
    }
};

struct SchedGrid {
    int nM, nN, nwg, G, c; const char* Ab; const char* Bb; size_t astride, bstride, bbatch; int ldc;
    __device__ __forceinline__ bool next(int i, Unit& u) const {
        const long L = (long)i * G + c; if (L >= nwg) return false;
        int wgid = (int)L; { const int q = nwg / 8, r = nwg % 8, xcd = wgid % 8, off = wgid / 8; wgid = (xcd < r ? xcd * (q + 1) : r * (q + 1) + (xcd - r) * q) + off; }
        const int nig = 8 * nN, gid = wgid / nig, fm = gid * 8, gsz = (nM - fm) < 8 ? (nM - fm) : 8;
        u.pm = fm + ((wgid % nig) % gsz); u.pn = (wgid % nig) / gsz;
        u.a0 = u.pm * 256 * ldc + u.pn * 256; u.a1 = u.pm * 256; u.a2 = 0; u.a3 = 0; return true;
    }
    __device__ __forceinline__ const char* A(const Unit& u) const { return Ab + (size_t)u.pm * astride; }
    __device__ __forceinline__ const char* B(const Unit& u) const { return Bb + (size_t)u.pn * bstride + (u.pm >= 32 ? bbatch : 0); }
    __device__ __forceinline__ const char* B2(const Unit& u) const { return B(u); }
    __device__ __forceinline__ unsigned arow(const Unit&, int) const { return 0u; }
};
struct SchedKV {
    int G, c; const char* memn; const char* wkvt;
    __device__ __forceinline__ bool next(int i, Unit& u) const {
        const int L = i * G + c; if (L >= 64) return false;
        const int l = L >> 4; u.pm = (L >> 3) & 1; u.pn = L & 7; u.a2 = l; u.a3 = 0;
        u.a0 = l * 512 * 2048 + u.pm * 256 * 2048 + u.pn * 256; u.a1 = 0; return true;
    }
    __device__ __forceinline__ const char* A(const Unit& u) const { return memn + (size_t)u.pm * 256 * 2048; }
    __device__ __forceinline__ const char* B(const Unit& u) const { return wkvt + ((size_t)u.a2 * 2048 + (size_t)u.pn * 256) * 2048; }
    __device__ __forceinline__ const char* B2(const Unit& u) const { return B(u); }
    __device__ __forceinline__ unsigned arow(const Unit&, int) const { return 0u; }
};
struct SchedQK {
    int G, c; const char* kv; const char* wqs;
    __device__ __forceinline__ bool next(int i, Unit& u) const {
        const int L = i * G + c; if (L >= 128) return false;
        const int l = L >> 5, b = (L >> 4) & 1, h = (L >> 2) & 3; u.pn = L & 3; u.pm = 0; u.a1 = l; u.a2 = b; u.a3 = h;
        u.a0 = ((l * 2 + b) * 1024 + h * 256) * 1024 + u.pn * 256; return true;
    }
    __device__ __forceinline__ const char* A(const Unit& u) const { return kv + (((size_t)u.a1 * 512 + u.a2 * 256) * 2048 + u.a3 * 256) * 2; }
    __device__ __forceinline__ const char* B(const Unit& u) const { return wqs + (((size_t)u.a1 * 1024 + u.pn * 256) * 1024 + u.a3 * 256) * 2; }
    __device__ __forceinline__ const char* B2(const Unit& u) const { return B(u); }
    __device__ __forceinline__ unsigned arow(const Unit&, int) const { return 0u; }
};
struct SchedVO {
    int G, c; const char* kv; const char* wot;
    __device__ __forceinline__ bool next(int i, Unit& u) const {
        const int L = i * G + c; if (L >= 128) return false;
        const int l = L >> 5, b = (L >> 4) & 1, h = (L >> 2) & 3; u.pm = L & 3; u.pn = 0; u.a1 = l; u.a2 = b; u.a3 = h;
        u.a0 = ((l * 2 + b) * 1024 + u.pm * 256) * 1024 + h * 256; return true;
    }
    __device__ __forceinline__ const char* A(const Unit& u) const { return wot + (((size_t)u.a1 * 1024 + u.pm * 256) * 1024 + u.a3 * 256) * 2; }
    __device__ __forceinline__ const char* B(const Unit& u) const { return kv + (((size_t)u.a1 * 512 + u.a2 * 256) * 2048 + 1024 + u.a3 * 256) * 2; }
    __device__ __forceinline__ const char* B2(const Unit& u) const { return B(u); }
    __device__ __forceinline__ unsigned arow(const Unit&, int) const { return 0u; }
};
struct SchedMoe {
    int G, c; bool down; const volatile LAS int* tab; const int* tokc; const char* Ab; const char* Wb;
    __device__ __forceinline__ bool next(int i, Unit& u) const {
        const int L = i * G + c; const int nun = __builtin_amdgcn_readfirstlane(tab[24]) * 4; if (L >= nun) return false;
        const int q = L >> 2, sub = L & 3;
        int cc = 0;
        for (int k = 0; k < 24; ++k) if (q >= tab[k + 1]) cc = k + 1;
        const int j = q - tab[cc], n = tab[32 + cc];
        const int g = cc / 6, pi = cc % 6;
        const int e1 = pi < 3 ? 0 : (pi < 5 ? 1 : 2), e2 = pi < 3 ? pi + 1 : (pi < 5 ? pi - 1 : 3);
        u.a0 = q * 256; u.a1 = cc * 16384 + j * 256; u.a2 = (n - j * 256) < 256 ? (n - j * 256) : 256;
        if (!down) { const int s = sub >> 1; u.a3 = s; u.pn = sub & 1; u.pm = g * 4 + (s ? e2 : e1); }
        else { u.a3 = 0; u.pn = sub; u.pm = (g * 4 + e1) | ((g * 4 + e2) << 8); }
        u.pm = __builtin_amdgcn_readfirstlane(u.pm); u.pn = __builtin_amdgcn_readfirstlane(u.pn); u.a0 = __builtin_amdgcn_readfirstlane(u.a0);
        u.a1 = __builtin_amdgcn_readfirstlane(u.a1); u.a2 = __builtin_amdgcn_readfirstlane(u.a2); u.a3 = __builtin_amdgcn_readfirstlane(u.a3);
        return true;
    }
    __device__ __forceinline__ const char* A(const Unit& u) const { return down ? Ab + (size_t)u.a0 * 1024 : Ab; }
    __device__ __forceinline__ const char* B(const Unit& u) const {
        return down ? Wb + (((size_t)(u.pm & 255) * 1024 + u.pn * 256) * 256) * 2 : Wb + (((size_t)u.pm * 512 + u.pn * 256) * 1024) * 2; }
    __device__ __forceinline__ const char* B2(const Unit& u) const { return Wb + (((size_t)(u.pm >> 8) * 1024 + u.pn * 256) * 256) * 2 - (size_t)4 * 128; }
    __device__ __forceinline__ unsigned arow(const Unit& u, int r) const { const int tok = (r < u.a2) ? tokc[u.a1 + r] : 0; return (unsigned)tok * 2048u; }
};

struct Params { const float* in[27]; float* out; unsigned char* ws; int ph_lo, ph_hi; };
__device__ __forceinline__ const float* pin_(const Params& p, int i) { asm volatile("" : "+s"(i)); return p.in[i]; }
#define PIN(k) pin_(p, (k))

__device__ __forceinline__ void tr_item(const float* src, int ld, int c0, int K, int k0, const float* gain, float scale, bf16_t* dst, LAS float* scr, int lane) {
#pragma unroll 8
    for (int i = 0; i < 32; ++i) { const int kk = 2 * i + (lane >> 5); const float gsc = gain ? gain[k0 + kk] * scale : scale;
        scr[kk * 33 + (lane & 31)] = src[(size_t)(k0 + kk) * ld + c0 + (lane & 31)] * gsc; }
    LDS_WAIT(); asm volatile("" ::: "memory");
    const int c = lane & 7;
#pragma unroll
    for (int j = 0; j < 4; ++j) { const int n = (lane >> 3) + 8 * j; const LAS float* s = scr + (8 * c) * 33 + n;
        u32x4 o; o.x = cvt_pk_bf16(s[0 * 33], s[1 * 33]); o.y = cvt_pk_bf16(s[2 * 33], s[3 * 33]); o.z = cvt_pk_bf16(s[4 * 33], s[5 * 33]); o.w = cvt_pk_bf16(s[6 * 33], s[7 * 33]);
        *(u32x4*)(dst + (size_t)n * K + k0 + 8 * c) = o; }
    LDS_WAIT(); asm volatile("" ::: "memory");
}

__device__ __forceinline__ void phase_pro_a(const Params& p, LAS unsigned char* lds, int bid, int G) {
    int tid = threadIdx.x; asm volatile("" : "+v"(tid));
    const int lane = tid & 63, wave = tid >> 6;
    unsigned char* ws = p.ws; asm volatile("" : "+s"(ws));
    LAS float* scr = (LAS float*)(lds + wave * 16384);
    const int gw = bid * NWAVES + wave, NGW = G * NWAVES;
    constexpr int PER_L = 1536 + 512 + 1024 + 512 + 4096 + 2048;
    for (int it = gw; it < PER_L * NLAYER; it += NGW) {
        const int l = it / PER_L; int r = it % PER_L;
        if (r < 1536) {
            const int kb = r / 96, nb = r % 96, n0 = nb * 32, c0 = n0 < 1536 ? n0 : n0 + 8;
            tr_item(PIN(3) + (size_t)l * 1024 * 3080, 3080, c0, 1024, kb * 64, PIN(2) + l * 1024, n0 < 512 ? C2 : 1.f, (bf16_t*)(ws + WS_WIN) + ((size_t)l * 3072 + n0) * 1024, scr, lane); continue; }
        r -= 1536;
        if (r < 512) {
            const int kb = r / 32, nb = r % 32, k0 = kb * 64;
            const float* gain = k0 < 512 ? PIN(5) + l * 512 : (k0 < 768 ? PIN(7) + l * 256 - 512 : nullptr);
            tr_item(PIN(12) + (size_t)l * 1024 * 1024, 1024, nb * 32, 1024, k0, gain, 1.f, (bf16_t*)(ws + WS_WOUT) + ((size_t)l * 1024 + nb * 32) * 1024, scr, lane); continue; }
        r -= 512;
        if (r < 1024) {
            const int kb = r / 64, nb = r % 64;
            tr_item(PIN(16) + (size_t)l * 1024 * 2048, 2048, nb * 32, 1024, kb * 64, nullptr, 1.f, (bf16_t*)(ws + WS_WKVT) + ((size_t)l * 2048 + nb * 32) * 1024, scr, lane); continue; }
        r -= 1024;
        if (r < 512) {
            const int kb = r / 32, nb = r % 32;
            tr_item(PIN(17) + (size_t)l * 1024 * 1024, 1024, nb * 32, 1024, kb * 64, nullptr, 1.f, (bf16_t*)(ws + WS_WOT) + ((size_t)l * 1024 + nb * 32) * 1024, scr, lane); continue; }
        r -= 512;
        if (r < 4096) {
            const int e = r >> 8, rr = r & 255, kb = rr >> 4, nb = rr & 15;
            const int orow = nb * 32, t = orow >> 8, half = (orow >> 7) & 1, j = orow & 127;
            const float* src = (half ? PIN(24) : PIN(23)) + ((size_t)l * 16 + e) * 1024 * 256;
            tr_item(src, 256, t * 128 + j, 1024, kb * 64, PIN(18) + l * 1024, 1.f, (bf16_t*)(ws + WS_WGU) + (((size_t)l * 16 + e) * 512 + orow) * 1024, scr, lane); continue; }
        r -= 4096;
        {
            const int e = r >> 7, rr = r & 127, kb = rr >> 5, nb = rr & 31;
            tr_item(PIN(25) + ((size_t)l * 16 + e) * 256 * 1024, 1024, nb * 32, 256, kb * 64, nullptr, 1.f, (bf16_t*)(ws + WS_WD) + (((size_t)l * 16 + e) * 1024 + nb * 32) * 256, scr, lane); }
    }
    for (size_t i4 = (size_t)bid * NTHR + tid; i4 < (size_t)NLAYER * 1024 * 256; i4 += (size_t)G * NTHR) {
        const size_t e = i4 * 4; const int l = (int)(e >> 20), k = (int)((e >> 10) & 1023);
        const f32x4 v = *(const f32x4*)(PIN(15) + e); const float gsc = PIN(13)[l * 1024 + k];
        u32x2 o; o.x = cvt_pk_bf16(v.x * gsc, v.y * gsc); o.y = cvt_pk_bf16(v.z * gsc, v.w * gsc);
        *(u32x2*)((bf16_t*)(ws + WS_WQS) + e) = o;
    }
    for (int i = bid * NTHR + tid; i < NLAYER * 28 * 1024; i += G * NTHR) {
        const int l = i / (28 * 1024), r = i % (28 * 1024), j = r >> 10, k = r & 1023;
        if (j < 8) ((float*)(ws + WS_WFF))[(l * 8 + j) * 1024 + k] = PIN(2)[l * 1024 + k] * PIN(3)[((size_t)l * 1024 + k) * 3080 + 1536 + j];
        else { const int jj = j - 8; const float w = jj < 4 ? PIN(19)[(l * 1024 + k) * 4 + jj] : PIN(21)[(l * 1024 + k) * 16 + jj - 4];
            ((float*)(ws + WS_WR))[(l * 20 + jj) * 1024 + k] = PIN(18)[l * 1024 + k] * w; }
    }
    for (int row = gw; row < 512; row += NGW) {
        const f32x4* xr = (const f32x4*)(PIN(1) + (size_t)row * 1024) + lane; f32x4 v[4]; float s = 0.f;
#pragma unroll
        for (int j = 0; j < 4; ++j) { v[j] = xr[64 * j]; s += (v[j].x * v[j].x + v[j].y * v[j].y) + (v[j].z * v[j].z + v[j].w * v[j].w); }
        const float rstd = rsqrtf(wave_sum(s) * (1.f / 1024.f) + EPS);
#pragma unroll
        for (int j = 0; j < 4; ++j) { const f32x4 gg = ((const f32x4*)PIN(14))[64 * j + lane]; u32x2 o; o.x = cvt_pk_bf16(v[j].x * rstd * gg.x, v[j].y * rstd * gg.y); o.y = cvt_pk_bf16(v[j].z * rstd * gg.z, v[j].w * rstd * gg.w);
            ((u32x2*)((bf16_t*)(ws + WS_MEMN) + (size_t)row * 1024))[64 * j + lane] = o; }
    }
    for (int row = gw; row < NTOK; row += NGW) {
        const f32x4* xr = (const f32x4*)(PIN(0) + (size_t)row * 1024) + lane; float s = 0.f;
#pragma unroll
        for (int j = 0; j < 4; ++j) { const f32x4 v = xr[64 * j]; s += (v.x * v.x + v.y * v.y) + (v.z * v.z + v.w * v.w); u32x2 o; o.x = cvt_pk_bf16(v.x, v.y); o.y = cvt_pk_bf16(v.z, v.w);
            ((u32x2*)((bf16_t*)(ws + WS_XB) + (size_t)row * 1024))[64 * j + lane] = o; }
        s = wave_sum(s);
        if (lane < 16) ((float*)(ws + WS_SSQ))[(size_t)row * 16 + lane] = lane == 0 ? s : 0.f;
    }
}

__device__ __forceinline__ void phase_logf(const Params& p, LAS unsigned char* lds, int l, int bid, int G) {
    int tid = threadIdx.x; asm volatile("" : "+v"(tid));
    const int lane = tid & 63, wave = tid >> 6;
    unsigned char* ws = p.ws; asm volatile("" : "+s"(ws));
    LAS float* wl = (LAS float*)lds;
    for (int i = tid; i < 8 * 1024; i += NTHR) wl[i] = ((const float*)(ws + WS_WFF))[l * 8192 + i];
    __syncthreads();
    const int gw = bid * NWAVES + wave, NGW = G * NWAVES;
    for (int row = gw; row < NTOK; row += NGW) {
        const u32x4* xr = (const u32x4*)((const bf16_t*)(ws + WS_XB) + (size_t)row * 1024 + lane * 16);
        const u32x4 a = xr[0], b = xr[1];
        float x[16];
        x[0] = bf2f(a.x & 0xffffu); x[1] = bf2f(a.x >> 16); x[2] = bf2f(a.y & 0xffffu); x[3] = bf2f(a.y >> 16); x[4] = bf2f(a.z & 0xffffu); x[5] = bf2f(a.z >> 16); x[6] = bf2f(a.w & 0xffffu); x[7] = bf2f(a.w >> 16);
        x[8] = bf2f(b.x & 0xffffu); x[9] = bf2f(b.x >> 16); x[10] = bf2f(b.y & 0xffffu); x[11] = bf2f(b.y >> 16); x[12] = bf2f(b.z & 0xffffu); x[13] = bf2f(b.z >> 16); x[14] = bf2f(b.w & 0xffffu); x[15] = bf2f(b.w >> 16);
        const float rs = row_rstd((const float*)(ws + WS_SSQ), row);
        float mine = 0.f;
#pragma unroll
        for (int h = 0; h < 8; ++h) {
            float s = 0.f;
#pragma unroll
            for (int q = 0; q < 4; ++q) { const f32x4 w = *(const LAS f32x4*)(wl + h * 1024 + lane * 16 + q * 4); s += x[4 * q] * w.x + x[4 * q + 1] * w.y + x[4 * q + 2] * w.z + x[4 * q + 3] * w.w; }
            s = wave_sum(s);
            if (lane == h) mine = s;
        }
        if (lane < 8) { const float z = mine * rs + PIN(4)[l * 8 + lane]; ((float*)(ws + WS_LOGF))[(size_t)row * 8 + lane] = fminf(z, 0.f) - __logf(1.f + __expf(-fabsf(z))); }
    }
    __syncthreads();
}

template <bool FINAL>
__device__ __forceinline__ void hgrn_unit(const Params& p, LAS unsigned char* lds, int l, int unit) {
    int tid = threadIdx.x; asm volatile("" : "+v"(tid));
    const int lane = tid & 63, kg = tid >> 6;
    unsigned char* ws = p.ws; asm volatile("" : "+s"(ws));
    const int bh = unit >> 5, sc = unit & 31, b = bh >> 2, h = bh & 3;
    const bf16_t* y = (const bf16_t*)(ws + WS_R1);
    LAS float* F = (LAS float*)lds; LAS float* Q = F + 4096; LAS float* V = F + 8192; LAS float* OP = F + 12288; LAS float* lbv = F + 12288 + 8192;
    if (tid < 64) {
        const int k = h * 64 + tid; float e[4], mx = -INFINITY, den = 0.f, num = 0.f;
#pragma unroll
        for (int i = 0; i < 4; ++i) { e[i] = PIN(6)[i * 256 + k]; mx = fmaxf(mx, e[i]); }
#pragma unroll
        for (int i = 0; i < 4; ++i) { e[i] = __expf(e[i] - mx); den += e[i]; if (i >= 1 && i <= l) num += e[i]; }
        lbv[tid] = num / den;
    }
    float s[8], dp[8];
#pragma unroll
    for (int j = 0; j < 8; ++j) { s[j] = 0.f; dp[j] = 1.f; }
    if (FINAL) {
        const float* U = (const float*)(ws + WS_HU); const float* Dd = (const float*)(ws + WS_HD);
        for (int jj = 0; jj < sc; ++jj) { const int uu = bh * 32 + jj;
#pragma unroll
            for (int j = 0; j < 8; ++j) s[j] = Dd[uu * 64 + kg * 8 + j] * s[j] + U[(size_t)uu * 4096 + (kg * 8 + j) * 64 + lane]; }
    }
    __syncthreads();
    const size_t row0 = (size_t)b * SEQ + sc * 256;
    for (int ch = 0; ch < 4; ++ch) {
#pragma unroll
        for (int j = 0; j < 8; ++j) { const int idx = tid + NTHR * j, tt = idx >> 6, k = idx & 63; const bf16_t* yr = y + (row0 + ch * 64 + tt) * NY;
            const float lb = lbv[k];
            F[idx] = lb + (1.f - lb) * sigmoidf_(bf2f(yr[1792 + h * 64 + k])); Q[idx] = bf2f(yr[1536 + h * 64 + k]); V[idx] = bf2f(yr[2048 + h * 64 + k]); }
        __syncthreads();
        for (int sub = 0; sub < 4; ++sub) {
            for (int t16 = 0; t16 < 16; ++t16) {
                const int tt = sub * 16 + t16;
                const f32x4 f0 = *(const LAS f32x4*)(F + tt * 64 + kg * 8), f1 = *(const LAS f32x4*)(F + tt * 64 + kg * 8 + 4);
                const float vt = V[tt * 64 + lane];
                float fk[8] = {f0.x, f0.y, f0.z, f0.w, f1.x, f1.y, f1.z, f1.w};
                if (FINAL) {
                    const f32x4 q0 = *(const LAS f32x4*)(Q + tt * 64 + kg * 8), q1 = *(const LAS f32x4*)(Q + tt * 64 + kg * 8 + 4);
                    float qk[8] = {q0.x, q0.y, q0.z, q0.w, q1.x, q1.y, q1.z, q1.w}; float op = 0.f;
#pragma unroll
                    for (int j = 0; j < 8; ++j) { s[j] = fk[j] * s[j] + (1.f - fk[j]) * vt; op += qk[j] * s[j]; }
                    OP[(t16 * 8 + kg) * 64 + lane] = op;
                } else {
#pragma unroll
                    for (int j = 0; j < 8; ++j) { s[j] = fk[j] * s[j] + (1.f - fk[j]) * vt; dp[j] *= fk[j]; }
                }
            }
            if (FINAL) {
                __syncthreads();
#pragma unroll
                for (int w2 = 0; w2 < 2; ++w2) { const int t16 = kg * 2 + w2; float o = 0.f;
#pragma unroll
                    for (int g8 = 0; g8 < 8; ++g8) o += OP[(t16 * 8 + g8) * 64 + lane];
                    const float ss = wave_sum(o * o), rstd = rsqrtf(ss * (1.f / 64.f) + EPS);
                    const size_t row = row0 + ch * 64 + sub * 16 + t16;
                    const float hg = bf2f(y[row * NY + 2304 + h * 64 + lane]);
                    ((bf16_t*)(ws + WS_CAT))[row * DM + 512 + h * 64 + lane] = f2bf1(o * rstd * hg * sigmoidf_(hg)); }
                __syncthreads();
            }
        }
        __syncthreads();
    }
    if (!FINAL) {
        float* U = (float*)(ws + WS_HU); float* Dd = (float*)(ws + WS_HD);
#pragma unroll
        for (int j = 0; j < 8; ++j) { U[(size_t)unit * 4096 + (kg * 8 + j) * 64 + lane] = s[j]; if (lane == 0) Dd[unit * 64 + kg * 8 + j] = dp[j]; }
    }
    __syncthreads();
}

__device__ __forceinline__ void conv_unit(const Params& p, LAS unsigned char* lds, int l, int unit) {
    int tid = threadIdx.x; asm volatile("" : "+v"(tid));
    const int lane = tid & 63, wave = tid >> 6;
    unsigned char* ws = p.ws; asm volatile("" : "+s"(ws));
    const bf16_t* y = (const bf16_t*)(ws + WS_R1);
    LAS float* A = (LAS float*)lds; LAS float* Y = (LAS float*)(lds + 65536);
    const int row0 = unit * 32, b = row0 / SEQ, t0 = row0 % SEQ;
    for (int idx = tid; idx < 62 * 256; idx += NTHR) { const int j = idx >> 8, c = idx & 255, t = t0 - 30 + j; float v = 0.f;
        if (t >= 0) { const bf16_t* yr = y + ((size_t)b * SEQ + t) * NY; v = bf2f(yr[2560 + c]) * sigmoidf_(bf2f(yr[2816 + c])); }
        A[idx] = v; }
    __syncthreads();
    { const int c = tid & 255, th = tid >> 8; float w[31];
#pragma unroll
        for (int j = 0; j < 31; ++j) w[j] = PIN(8)[(l * 31 + j) * 256 + c];
        const float bias = PIN(9)[l * 256 + c];
        for (int tl = th * 16; tl < th * 16 + 16; ++tl) { float a = bias;
#pragma unroll
            for (int j = 0; j < 31; ++j) a += w[j] * A[(tl + j) * 256 + c];
            Y[tl * 256 + c] = a; } }
    __syncthreads();
    for (int pr = wave * 16; pr < wave * 16 + 16; ++pr) { const int tl = pr >> 2, grp = pr & 3, c = grp * 64 + lane;
        const float v = Y[tl * 256 + c], mean = wave_sum(v) * (1.f / 64.f), d = v - mean, var = wave_sum(d * d) * (1.f / 64.f);
        const float yn = d * rsqrtf(var + EPS) * PIN(10)[l * 256 + c] + PIN(11)[l * 256 + c];
        ((bf16_t*)(ws + WS_CAT))[(size_t)(row0 + tl) * DM + 768 + c] = f2bf1(yn * sigmoidf_(yn)); }
    __syncthreads();
}

__device__ __forceinline__ void phase_p2a(const Params& p, LAS unsigned char* lds, int l, int bid, int G) {
    int tid = threadIdx.x; asm volatile("" : "+v"(tid));
    const int lane = tid & 63, wave = tid >> 6;
    unsigned char* ws = p.ws; asm volatile("" : "+s"(ws));
    for (int bh = bid; bh < 16; bh += G) { const int b = bh >> 3, h = bh & 7;
        const float* lf = (const float*)(ws + WS_LOGF) + (size_t)b * SEQ * 8 + h;
        float v[16]; float run = 0.f;
#pragma unroll
        for (int i = 0; i < 16; ++i) { run += lf[(size_t)(tid * 16 + i) * 8]; v[i] = run; }
        float incl = run;
#pragma unroll
        for (int o = 1; o < 64; o <<= 1) { const float t = __int_as_float(__builtin_amdgcn_ds_bpermute(((lane - o) & 63) * 4, __float_as_int(incl))); if (lane >= o) incl += t; }
        LAS float* wt = (LAS float*)lds;
        if (lane == 63) wt[wave] = incl;
        __syncthreads();
        float base = incl - run;
        for (int w = 0; w < wave; ++w) base += wt[w];
        float* c = (float*)(ws + WS_CFOX) + (size_t)bh * SEQ + tid * 16;
#pragma unroll
        for (int i = 0; i < 16; ++i) c[i] = base + v[i];
        __syncthreads();
    }
    for (int u = bid; u < 512; u += G) conv_unit(p, lds, l, u);
    for (int u = bid; u < 256; u += G) if ((u & 31) != 31) hgrn_unit<false>(p, lds, l, u);
    { const bf16_t* y = (const bf16_t*)(ws + WS_R1); unsigned* ctl = (unsigned*)(ws + WS_CTL);
        const int gw = bid * NWAVES + wave, NGW = G * NWAVES, rpw = (NTOK + NGW - 1) / NGW;
        float mq = 0.f, mk = 0.f; int curb = -1;
        for (int row = gw * rpw; row < (gw + 1) * rpw && row < NTOK; ++row) {
            const int b = row / SEQ;
            if (b != curb) { if (curb >= 0 && (lane & 7) == 0) { atomicMax(&ctl[CW_KQMAX + ((l * 2 + curb) * 8 + (lane >> 3)) * 2], __float_as_uint(mq)); atomicMax(&ctl[CW_KQMAX + ((l * 2 + curb) * 8 + (lane >> 3)) * 2 + 1], __float_as_uint(mk)); } mq = 0.f; mk = 0.f; curb = b; }
            const u32x4 qa = *(const u32x4*)(y + (size_t)row * NY + lane * 8), ka = *(const u32x4*)(y + (size_t)row * NY + 512 + lane * 8);
            float sq = 0.f, sk = 0.f;
#pragma unroll
            for (int j = 0; j < 4; ++j) { const float a0 = bf2f(qa[j] & 0xffffu), a1 = bf2f(qa[j] >> 16), k0 = bf2f(ka[j] & 0xffffu), k1 = bf2f(ka[j] >> 16); sq += a0 * a0 + a1 * a1; sk += k0 * k0 + k1 * k1; }
            sq += swz_xor<1>(sq); sq += swz_xor<2>(sq); sq += swz_xor<4>(sq);
            sk += swz_xor<1>(sk); sk += swz_xor<2>(sk); sk += swz_xor<4>(sk);
            mq = fmaxf(mq, sq); mk = fmaxf(mk, sk);
        }
        if (curb >= 0 && (lane & 7) == 0) { atomicMax(&ctl[CW_KQMAX + ((l * 2 + curb) * 8 + (lane >> 3)) * 2], __float_as_uint(mq)); atomicMax(&ctl[CW_KQMAX + ((l * 2 + curb) * 8 + (lane >> 3)) * 2 + 1], __float_as_uint(mk)); }
    }
}

__device__ __forceinline__ void attn_unit_simple(const Params& p, int l, int unit) {
    int tid = threadIdx.x; asm volatile("" : "+v"(tid));
    const int lane = tid & 63, wave = tid >> 6;
    unsigned char* ws = p.ws; asm volatile("" : "+s"(ws));
    const int bh = unit >> 4, qb = unit & 15, b = bh >> 3, h = bh & 7;
    const bf16_t* y = (const bf16_t*)(ws + WS_R1);
    const float* cf = (const float*)(ws + WS_CFOX) + (size_t)bh * SEQ;
    const int t = qb * 512 + tid;
    const size_t rowb = (size_t)b * SEQ;
    float q[64], o[64];
    { const u32x4* qr = (const u32x4*)(y + (rowb + t) * NY + h * 64);
#pragma unroll
        for (int i = 0; i < 8; ++i) { const u32x4 a = qr[i];
#pragma unroll
            for (int j = 0; j < 4; ++j) { q[i * 8 + 2 * j] = bf2f(a[j] & 0xffffu); q[i * 8 + 2 * j + 1] = bf2f(a[j] >> 16); } } }
#pragma unroll
    for (int d = 0; d < 64; ++d) o[d] = 0.f;
    const float ct = cf[t] * LOG2E;
    float m = -INFINITY, lsum = 0.f;
    const int twmin = qb * 512 + wave * 64, smax = twmin + 63;
#if FOX_PRUNE
    const unsigned* ctl = (const unsigned*)(ws + WS_CTL);
    const float B2 = sqrtf(__uint_as_float(ctl[CW_KQMAX + ((l * 2 + b) * 8 + h) * 2]) * __uint_as_float(ctl[CW_KQMAX + ((l * 2 + b) * 8 + h) * 2 + 1]));
    const float cmin = cf[twmin] * LOG2E;
#endif
    for (int s = smax; s >= 0; --s) {
        const float cs = cf[s] * LOG2E;
#if FOX_PRUNE
        if (cmin - cs + 2.f * B2 < -44.f) break;
#endif
        const u32x4* kr = (const u32x4*)(y + (rowb + s) * NY + 512 + h * 64);
        float dot = 0.f;
#pragma unroll
        for (int i = 0; i < 8; ++i) { const u32x4 a = kr[i];
#pragma unroll
            for (int j = 0; j < 4; ++j) dot += q[i * 8 + 2 * j] * bf2f(a[j] & 0xffffu) + q[i * 8 + 2 * j + 1] * bf2f(a[j] >> 16); }
        const float sc = dot + ct - cs;
        if (s <= t) {
            if (sc > m) { const float al = __builtin_amdgcn_exp2f(m - sc); lsum *= al;
#pragma unroll
                for (int d = 0; d < 64; ++d) o[d] *= al;
                m = sc; }
            const float pr = __builtin_amdgcn_exp2f(sc - m); lsum += pr;
            const u32x4* vr = (const u32x4*)(y + (rowb + s) * NY + 1024 + h * 64);
#pragma unroll
            for (int i = 0; i < 8; ++i) { const u32x4 a = vr[i];
#pragma unroll
                for (int j = 0; j < 4; ++j) { o[i * 8 + 2 * j] += pr * bf2f(a[j] & 0xffffu); o[i * 8 + 2 * j + 1] += pr * bf2f(a[j] >> 16); } }
        }
    }
    const float inv = 1.f / lsum; float ss = 0.f;
#pragma unroll
    for (int d = 0; d < 64; ++d) { o[d] *= inv; ss += o[d] * o[d]; }
    const float rstd = rsqrtf(ss * (1.f / 64.f) + EPS);
    u32x4* dst = (u32x4*)((bf16_t*)(ws + WS_CAT) + (rowb + t) * DM + h * 64);
#pragma unroll
    for (int i = 0; i < 8; ++i) { u32x4 w; w.x = cvt_pk_bf16(o[i * 8] * rstd, o[i * 8 + 1] * rstd); w.y = cvt_pk_bf16(o[i * 8 + 2] * rstd, o[i * 8 + 3] * rstd); w.z = cvt_pk_bf16(o[i * 8 + 4] * rstd, o[i * 8 + 5] * rstd); w.w = cvt_pk_bf16(o[i * 8 + 6] * rstd, o[i * 8 + 7] * rstd); dst[i] = w; }
}

typedef float f32x16 __attribute__((ext_vector_type(16)));
constexpr int AT_KP = 144, AT_VP = 136, AT_BUF = 18432;
__device__ __forceinline__ void attn_unit_mfma(const Params& p, LAS unsigned char* lds, int l, int unit) {
    int tid = threadIdx.x; asm volatile("" : "+v"(tid));
    const int lane = tid & 63, wave = __builtin_amdgcn_readfirstlane(tid >> 6), r32 = lane & 31, hi = lane >> 5;
    unsigned char* ws = p.ws;
    const int bh = unit >> 5, qb = unit & 31, b = bh >> 3, h = bh & 7, q0 = qb * 256, qw0 = q0 + wave * 32;
    const bf16_t* y = (const bf16_t*)(ws + WS_R1) + (size_t)b * SEQ * NY;
    const float* cf = (const float*)(ws + WS_CFOX) + (size_t)bh * SEQ;
    bf16x8 qr[4];
    { const bf16_t* qrow = y + (size_t)(qw0 + r32) * NY + h * 64;
#pragma unroll
      for (int d0 = 0; d0 < 4; ++d0) qr[d0] = *(const bf16x8*)(qrow + d0 * 16 + hi * 8); }
    const float cq = cf[qw0 + r32] * LOG2E;
    const unsigned* ctl = (const unsigned*)(ws + WS_CTL);
    const float B2 = sqrtf(__uint_as_float(ctl[CW_KQMAX + ((l * 2 + b) * 8 + h) * 2]) * __uint_as_float(ctl[CW_KQMAX + ((l * 2 + b) * 8 + h) * 2 + 1]));
    const float thr = -44.f - 2.f * B2;
    const float cblk = cf[q0] * LOG2E, cwv = cf[qw0] * LOG2E;
    const int jmax = (q0 + 255) >> 6;
    u32x4 kreg, vreg; float creg = 0.f;
#define AT_LOAD(j) do { const int kb_ = (j) * 64; \
        kreg = *(const u32x4*)(y + (size_t)(kb_ + (tid >> 3)) * NY + 512 + h * 64 + (tid & 7) * 8); \
        vreg = *(const u32x4*)(y + (size_t)(kb_ + lane) * NY + 1024 + h * 64 + wave * 8); \
        if (tid < 64) creg = cf[kb_ + tid] * LOG2E; } while (0)
    AT_LOAD(jmax);
    float m = -INFINITY, lsum = 0.f;
    f32x16 o0, o1;
#pragma unroll
    for (int r = 0; r < 16; ++r) { o0[r] = 0.f; o1[r] = 0.f; }
    for (int j = jmax;; --j) {
        LAS unsigned char* Kb = lds + (j & 1) * AT_BUF; LAS unsigned char* Vb = Kb + 9216; LAS float* cb = (LAS float*)(Kb + 9216 + 8704);
        *(LAS u32x4*)(Kb + (tid >> 3) * AT_KP + (tid & 7) * 16) = kreg;
#pragma unroll
        for (int i = 0; i < 4; ++i) { *(LAS unsigned short*)(Vb + (wave * 8 + 2 * i) * AT_VP + lane * 2) = (unsigned short)(vreg[i] & 0xffffu); *(LAS unsigned short*)(Vb + (wave * 8 + 2 * i + 1) * AT_VP + lane * 2) = (unsigned short)(vreg[i] >> 16); }
        if (tid < 64) cb[tid] = creg;
        __syncthreads();
        const bool more = (j > 0) && ((cblk - cf[64 * j - 1] * LOG2E) >= thr);
        if (more) AT_LOAD(j - 1);
        const int kb = j * 64;
        const bool need = (kb <= qw0 + 31) && ((cwv - cf[kb + 63] * LOG2E) >= thr);
        if (need) {
            f32x16 p0, p1;
#pragma unroll
            for (int r = 0; r < 16; ++r) { p0[r] = 0.f; p1[r] = 0.f; }
#pragma unroll
            for (int d0 = 0; d0 < 4; ++d0) {
                const bf16x8 k0 = *(const LAS bf16x8*)(Kb + r32 * AT_KP + d0 * 32 + hi * 16);
                const bf16x8 k1 = *(const LAS bf16x8*)(Kb + (32 + r32) * AT_KP + d0 * 32 + hi * 16);
                p0 = __builtin_amdgcn_mfma_f32_32x32x16_bf16(k0, qr[d0], p0, 0, 0, 0);
                p1 = __builtin_amdgcn_mfma_f32_32x32x16_bf16(k1, qr[d0], p1, 0, 0, 0);
            }
#pragma unroll
            for (int g4 = 0; g4 < 4; ++g4) {
                const f32x4 c0 = *(const LAS f32x4*)(cb + 8 * g4 + 4 * hi), c1 = *(const LAS f32x4*)(cb + 32 + 8 * g4 + 4 * hi);
#pragma unroll
                for (int i = 0; i < 4; ++i) { p0[4 * g4 + i] += cq - c0[i]; p1[4 * g4 + i] += cq - c1[i]; }
            }
            if (kb + 63 > qw0) {
                const int qg = qw0 + r32;
#pragma unroll
                for (int r = 0; r < 16; ++r) { const int kg = kb + (r & 3) + 8 * (r >> 2) + 4 * hi; if (kg > qg) p0[r] = -INFINITY; if (kg + 32 > qg) p1[r] = -INFINITY; }
            }
            float rm = fmaxf(p0[0], p1[0]);
#pragma unroll
            for (int r = 1; r < 16; ++r) rm = fmaxf(rm, fmaxf(p0[r], p1[r]));
            rm = x32_max(rm);
            const float mn = fmaxf(m, rm), msafe = (mn == -INFINITY) ? 0.f : mn;
            const float alpha = __builtin_amdgcn_exp2f(m - msafe);
            float rs = 0.f;
#pragma unroll
            for (int r = 0; r < 16; ++r) { p0[r] = __builtin_amdgcn_exp2f(p0[r] - msafe); p1[r] = __builtin_amdgcn_exp2f(p1[r] - msafe); rs += p0[r] + p1[r]; }
            lsum = lsum * alpha + rs; m = mn;
#pragma unroll
            for (int r = 0; r < 16; ++r) { o0[r] *= alpha; o1[r] *= alpha; }
#pragma unroll
            for (int mt = 0; mt < 2; ++mt)
#pragma unroll
                for (int ks = 0; ks < 2; ++ks) {
                    u32x4 pw;
#pragma unroll
                    for (int i = 0; i < 4; ++i) pw[i] = mt ? cvt_pk_bf16(p1[8 * ks + 2 * i], p1[8 * ks + 2 * i + 1]) : cvt_pk_bf16(p0[8 * ks + 2 * i], p0[8 * ks + 2 * i + 1]);
                    const bf16x8 pb = __builtin_bit_cast(bf16x8, pw);
                    const int kbase = 32 * mt + 16 * ks + 4 * hi;
#pragma unroll
                    for (int dt = 0; dt < 2; ++dt) {
                        const LAS unsigned char* vp = Vb + (32 * dt + r32) * AT_VP + kbase * 2;
                        const u32x2 va = *(const LAS u32x2*)vp, vb2 = *(const LAS u32x2*)(vp + 16);
                        const u32x4 vw = {va.x, va.y, vb2.x, vb2.y};
                        const bf16x8 vf = __builtin_bit_cast(bf16x8, vw);
                        if (dt == 0) o0 = __builtin_amdgcn_mfma_f32_32x32x16_bf16(vf, pb, o0, 0, 0, 0); else o1 = __builtin_amdgcn_mfma_f32_32x32x16_bf16(vf, pb, o1, 0, 0, 0);
                    }
                }
        }
        if (!more) break;
    }
#undef AT_LOAD
    lsum = x32_sum(lsum);
    const float inv = 1.f / lsum;
    float ss = 0.f;
#pragma unroll
    for (int r = 0; r < 16; ++r) { o0[r] *= inv; o1[r] *= inv; ss += o0[r] * o0[r] + o1[r] * o1[r]; }
    ss = x32_sum(ss);
    const float rstd = rsqrtf(ss * (1.f / 64.f) + EPS);
    bf16_t* orow = (bf16_t*)(ws + WS_CAT) + ((size_t)b * SEQ + qw0 + r32) * DM + h * 64;
#pragma unroll
    for (int g4 = 0; g4 < 4; ++g4) {
        u32x2 w0, w1;
        w0.x = cvt_pk_bf16(o0[4 * g4] * rstd, o0[4 * g4 + 1] * rstd); w0.y = cvt_pk_bf16(o0[4 * g4 + 2] * rstd, o0[4 * g4 + 3] * rstd);
        w1.x = cvt_pk_bf16(o1[4 * g4] * rstd, o1[4 * g4 + 1] * rstd); w1.y = cvt_pk_bf16(o1[4 * g4 + 2] * rstd, o1[4 * g4 + 3] * rstd);
        *(u32x2*)(orow + 8 * g4 + 4 * hi) = w0; *(u32x2*)(orow + 32 + 8 * g4 + 4 * hi) = w1;
    }
    __syncthreads();
}

__device__ __forceinline__ void phase_route(const Params& p, LAS unsigned char* lds, int l, int bid, int G) {
    int tid = threadIdx.x; asm volatile("" : "+v"(tid));
    const int lane = tid & 63, wave = tid >> 6;
    unsigned char* ws = p.ws; asm volatile("" : "+s"(ws));
    LAS float* wl = (LAS float*)lds;
    LAS int* cls = (LAS int*)(lds + 20 * 4096);
    LAS int* basel = cls + 64;
    for (int i = tid; i < 20 * 1024; i += NTHR) wl[i] = ((const float*)(ws + WS_WR))[l * 20480 + i];
    __syncthreads();
    const float* x = p.out; unsigned* ctl = (unsigned*)(ws + WS_CTL);
    for (int u = bid; u < NTOK / 64; u += G) {
        for (int i = 0; i < 8; ++i) {
            const int row = u * 64 + wave * 8 + i;
            const f32x4* xr = (const f32x4*)(x + (size_t)row * 1024) + lane;
            f32x4 v[4]; float ss = 0.f;
#pragma unroll
            for (int j = 0; j < 4; ++j) { v[j] = xr[64 * j]; ss += (v[j].x * v[j].x + v[j].y * v[j].y) + (v[j].z * v[j].z + v[j].w * v[j].w); }
            const float rstd = rsqrtf(wave_sum(ss) * (1.f / 1024.f) + EPS);
            float lg[20];
#pragma unroll
            for (int jj = 0; jj < 20; ++jj) { float s = 0.f;
#pragma unroll
                for (int j = 0; j < 4; ++j) { const f32x4 w = *(const LAS f32x4*)(wl + jj * 1024 + j * 256 + lane * 4); s += v[j].x * w.x + v[j].y * w.y + v[j].z * w.z + v[j].w * w.w; }
                lg[jj] = wave_sum(s) * rstd + (jj < 4 ? PIN(20)[l * 4 + jj] : PIN(22)[l * 16 + jj - 4]); }
            int gi = 0; float gm = lg[0];
#pragma unroll
            for (int j = 1; j < 4; ++j) if (lg[j] > gm) { gm = lg[j]; gi = j; }
            float den = 0.f;
#pragma unroll
            for (int j = 0; j < 4; ++j) den += __expf(lg[j] - gm);
            const float pg = 1.f / den;
            float e[4];
#pragma unroll
            for (int j = 0; j < 4; ++j) e[j] = gi == 0 ? lg[4 + j] : (gi == 1 ? lg[8 + j] : (gi == 2 ? lg[12 + j] : lg[16 + j]));
            int a = 0; float ea = e[0];
#pragma unroll
            for (int j = 1; j < 4; ++j) if (e[j] > ea) { ea = e[j]; a = j; }
            int bq = -1; float eb = -INFINITY;
#pragma unroll
            for (int j = 0; j < 4; ++j) if (j != a && e[j] > eb) { eb = e[j]; bq = j; }
            const float pb = __expf(eb - ea), wa = pg / (1.f + pb), wb = pg * pb / (1.f + pb);
            const int e1 = a < bq ? a : bq, e2 = a < bq ? bq : a;
            const int pi = e1 == 0 ? e2 - 1 : (e1 == 1 ? e2 + 1 : 5);
            if (lane == 0) { cls[wave * 8 + i] = gi * 6 + pi; ((f32x2*)(ws + WS_WTS))[row] = (f32x2){a < bq ? wa : wb, a < bq ? wb : wa}; }
        }
        __syncthreads();
        if (tid < 24) { int n = 0; for (int i = 0; i < 64; ++i) n += (cls[i] == tid); basel[tid] = n ? (int)atomicAdd(&ctl[CW_MOECNT + l * 32 + tid], (unsigned)n) : 0; }
        __syncthreads();
        if (tid < 64) { const int c = cls[tid]; int rank = 0; for (int i = 0; i < tid; ++i) rank += (cls[i] == c); ((int*)(ws + WS_TOKC))[c * 16384 + basel[c] + rank] = u * 64 + tid; }
        __syncthreads();
    }
}

__device__ __forceinline__ void moe_table(const Params& p, volatile LAS int* tab, int l) {
    int tid = threadIdx.x; asm volatile("" : "+v"(tid));
    if (tid < 24) { const unsigned voff = (unsigned)(CW_MOECNT + l * 32 + tid) * 4u; const unsigned* ctl = (const unsigned*)((const char*)p.ws + voff); tab[32 + tid] = (int)__hip_atomic_load(ctl, __ATOMIC_RELAXED, __HIP_MEMORY_SCOPE_AGENT); }
    __syncthreads();
    if (tid == 0) { int pre = 0; for (int c = 0; c < 24; ++c) { tab[c] = pre; pre += (tab[32 + c] + 255) >> 8; } tab[24] = pre; }
    __syncthreads();
}

__device__ __forceinline__ void phase_final(const Params& p, int bid, int G) {
    int tid = threadIdx.x; asm volatile("" : "+v"(tid));
    const int lane = tid & 63, wave = tid >> 6;
    const int gw = bid * NWAVES + wave, NGW = G * NWAVES;
    for (int row = gw; row < NTOK; row += NGW) {
        f32x4* xr = (f32x4*)(p.out + (size_t)row * 1024) + lane; f32x4 v[4]; float s = 0.f;
#pragma unroll
        for (int j = 0; j < 4; ++j) { v[j] = xr[64 * j]; s += (v[j].x * v[j].x + v[j].y * v[j].y) + (v[j].z * v[j].z + v[j].w * v[j].w); }
        const float rstd = rsqrtf(wave_sum(s) * (1.f / 1024.f) + EPS);
#pragma unroll
        for (int j = 0; j < 4; ++j) { const f32x4 gg = ((const f32x4*)PIN(26))[64 * j + lane]; xr[64 * j] = (f32x4){v[j].x * rstd * gg.x, v[j].y * rstd * gg.y, v[j].z * rstd * gg.z, v[j].w * rstd * gg.w}; }
    }
}

constexpr int N_PHASES = 3 + 9 * NLAYER + 1;
__global__ void __launch_bounds__(NTHR, 2) mk_fwd(Params p) {
    extern __shared__ __attribute__((aligned(16))) unsigned char lds_raw[];
    LAS unsigned char* lds = (LAS unsigned char*)lds_raw;
    volatile LAS unsigned* MISC = (volatile LAS unsigned*)(lds + LDS_MISC);
    const int tid = threadIdx.x;
    const int G = gridDim.x, bid = blockIdx.x;
    unsigned char* ws = p.ws; asm volatile("" : "+s"(ws));
    for (int u = tid; u < 256; u += NTHR) MISC[u] = 0u;
    __syncthreads();
    const int lo = p.ph_lo, hi = p.ph_hi;
    const bool use_bar = (hi - lo) > 1;
    XcdBarrier bar; bar.bar = (unsigned*)(ws + WS_CTL) + CW_BAR; bar.x = 0; bar.st = MISC + 8;
    if (use_bar) bar = xcd_barrier_post((unsigned*)(ws + WS_CTL) + CW_BAR, MISC + 8);
#define IN(k) (lo <= (k) && (k) < hi)
#define SEAM(k) do { if ((k) + 1 < hi) xcd_barrier(bar); } while (0)
    const float* ssq = (const float*)(ws + WS_SSQ);
    bf16_t* xb = (bf16_t*)(ws + WS_XB);

    if (PHON(0) && IN(0)) { phase_pro_a(p, lds, bid, G); SEAM(0); }
    if (PHON(1) && IN(1)) {
        SchedKV S{G, bid, (const char*)(ws + WS_MEMN), (const char*)(ws + WS_WKVT)};
        EpiBf16 E{(bf16_t*)(ws + WS_KV), 2048, nullptr};
        pg8::gemm_phase<EpiBf16, SchedKV, false, false, false>(lds, GemmDesc{1024, 2048u, 2048u, 0}, S, E);
        SEAM(1);
    }
    if (PHON(2) && IN(2)) {
        { SchedQK S{G, bid, (const char*)(ws + WS_KV), (const char*)(ws + WS_WQS)};
          EpiBf16 E{(bf16_t*)(ws + WS_WQK), 1024, nullptr};
          pg8::gemm_phase<EpiBf16, SchedQK, false, false, false>(lds, GemmDesc{256, 4096u, 2048u, 0}, S, E); }
        { SchedVO S{G, bid, (const char*)(ws + WS_KV), (const char*)(ws + WS_WOT)};
          EpiBf16 E{(bf16_t*)(ws + WS_WVO), 1024, nullptr};
          pg8::gemm_phase<EpiBf16, SchedVO, false, false, false>(lds, GemmDesc{256, 2048u, 4096u, 0}, S, E); }
        SEAM(2);
    }
    for (int l = 0; l < NLAYER; ++l) {
        const int pb = 3 + 9 * l;
        if (!(lo < pb + 9 && pb < hi)) continue;
        if (PHON(3) && IN(pb + 0)) {
            SchedGrid S{64, 12, 768, G, bid, (const char*)xb, (const char*)(ws + WS_WIN) + (size_t)l * 3072 * 2048, (size_t)256 * 2048, (size_t)256 * 2048, 0, NY};
            EpiBf16 E{(bf16_t*)(ws + WS_R1), NY, ssq};
            pg8::gemm_phase<EpiBf16, SchedGrid, false, false, false>(lds, GemmDesc{1024, 2048u, 2048u, 0}, S, E);
            phase_logf(p, lds, l, bid, G);
            SEAM(pb + 0);
        }
        if (PHON(4) && IN(pb + 1)) { phase_p2a(p, lds, l, bid, G); SEAM(pb + 1); }
        if (PHON(5) && IN(pb + 2)) {
            for (int u = bid; u < 256; u += G) hgrn_unit<true>(p, lds, l, u);
#if ATTN_MFMA
            for (int u = bid; u < 512; u += G) attn_unit_mfma(p, lds, l, u);
#else
            for (int u = bid; u < 256; u += G) attn_unit_simple(p, l, u);
#endif
            SEAM(pb + 2);
        }
        if (PHON(6) && IN(pb + 3)) {
            SchedGrid S{64, 4, 256, G, bid, (const char*)(ws + WS_CAT), (const char*)(ws + WS_WOUT) + (size_t)l * 1024 * 2048, (size_t)256 * 2048, (size_t)256 * 2048, 0, DM};
            EpiResidual E{l == 0 ? PIN(0) : p.out, p.out, xb, (float*)(ws + WS_SSQ)};
            pg8::gemm_phase<EpiResidual, SchedGrid, false, false, false>(lds, GemmDesc{1024, 2048u, 2048u, 0}, S, E);
            SEAM(pb + 3);
        }
        if (PHON(7) && IN(pb + 4)) {
            SchedGrid S{64, 4, 256, G, bid, (const char*)xb, (const char*)(ws + WS_WQK) + (size_t)l * 2 * 1024 * 2048, (size_t)256 * 2048, (size_t)256 * 2048, (size_t)1024 * 2048, DM};
            EpiSoftmax E{(bf16_t*)(ws + WS_PBUF), ssq, (LAS float*)(lds + LDS_EPI)};
            pg8::gemm_phase<EpiSoftmax, SchedGrid, true, false, false>(lds, GemmDesc{1024, 2048u, 2048u, 0}, S, E);
            SEAM(pb + 4);
        }
        if (PHON(8) && IN(pb + 5)) {
            SchedGrid S{64, 4, 256, G, bid, (const char*)(ws + WS_PBUF), (const char*)(ws + WS_WVO) + (size_t)l * 2 * 1024 * 2048, (size_t)256 * 2048, (size_t)256 * 2048, (size_t)1024 * 2048, DM};
            EpiResidual E{p.out, p.out, xb, (float*)(ws + WS_SSQ)};
            pg8::gemm_phase<EpiResidual, SchedGrid, false, false, false>(lds, GemmDesc{1024, 2048u, 2048u, 0}, S, E);
            SEAM(pb + 5);
        }
        if (PHON(9) && IN(pb + 6)) { phase_route(p, lds, l, bid, G); SEAM(pb + 6); }
        if (PHON(10) && IN(pb + 7)) {
            volatile LAS int* tab = (volatile LAS int*)(MISC + 16);
            moe_table(p, tab, l);
            SchedMoe S{G, bid, false, tab, (const int*)(ws + WS_TOKC), (const char*)xb, (const char*)(ws + WS_WGU) + (size_t)l * 16 * 512 * 2048};
            EpiMoeUp E{(bf16_t*)(ws + WS_HID), (const int*)(ws + WS_TOKC), ssq, (const f32x2*)(ws + WS_WTS)};
            pg8::gemm_phase<EpiMoeUp, SchedMoe, false, true, false>(lds, GemmDesc{1024, 2048u, 2048u, 0}, S, E);
            SEAM(pb + 7);
        }
        if (PHON(11) && IN(pb + 8)) {
            volatile LAS int* tab = (volatile LAS int*)(MISC + 16);
            moe_table(p, tab, l);
            SchedMoe S{G, bid, true, tab, (const int*)(ws + WS_TOKC), (const char*)(ws + WS_HID), (const char*)(ws + WS_WD) + (size_t)l * 16 * 1024 * 512};
            EpiMoeDown E{p.out, xb, (float*)(ws + WS_SSQ), (const int*)(ws + WS_TOKC)};
            pg8::gemm_phase<EpiMoeDown, SchedMoe, false, false, true>(lds, GemmDesc{512, 1024u, 512u, 4}, S, E);
            SEAM(pb + 8);
        }
    }
    if (IN(N_PHASES - 1)) phase_final(p, bid, G);
#undef IN
#undef SEAM
}

extern "C" void kernel_launch(void* const* d_in, const int* in_sizes, int n_in, void* d_out, int out_size, void* d_ws, size_t ws_size, hipStream_t stream) {
    static int grid = 0;
    if (grid == 0) {
        if (n_in != 27 || out_size != NTOK * DM || ws_size < WS_END) { fprintf(stderr, "kernel_launch: unexpected shapes (n_in %d out %d ws %zu)\n", n_in, out_size, ws_size); grid = -1; return; }
        int dev = 0, cus = 0, per_cu = 0;
        if (hipGetDevice(&dev) != hipSuccess || hipDeviceGetAttribute(&cus, hipDeviceAttributeMultiprocessorCount, dev) != hipSuccess) { grid = -1; return; }
        if (hipFuncSetAttribute((const void*)mk_fwd, hipFuncAttributeMaxDynamicSharedMemorySize, LDS_BYTES) != hipSuccess) { fprintf(stderr, "kernel_launch: hipFuncSetAttribute failed\n"); grid = -1; return; }
        if (hipOccupancyMaxActiveBlocksPerMultiprocessor(&per_cu, (const void*)mk_fwd, NTHR, LDS_BYTES) != hipSuccess || per_cu < 1) { fprintf(stderr, "kernel_launch: occupancy query reports %d\n", per_cu); }
        (void)hipGetLastError();
        grid = cus;
    }
    if (grid < 0) return;
    (void)hipMemsetAsync((char*)d_ws + WS_CTL, 0, CTL_ZERO_BYTES, stream);
    Params a{};
    for (int i = 0; i < 27; ++i) a.in[i] = (const float*)d_in[i];
    a.out = (float*)d_out; a.ws = (unsigned char*)d_ws;
#if ONE_LAUNCH
    a.ph_lo = 0; a.ph_hi = N_PHASES;
    hipLaunchKernelGGL(mk_fwd, dim3(grid), dim3(NTHR), LDS_BYTES, stream, a);
#else
    for (int k = 0; k < N_PHASES; ++k) { a.ph_lo = k; a.ph_hi = k + 1; hipLaunchKernelGGL(mk_fwd, dim3(grid), dim3(NTHR), LDS_BYTES, stream, a); }
#endif
}
```

```cpp
#include <hip/hip_runtime.h>
#include <cstdio>
#include <cstdint>

#ifndef USE_MFMA
#define USE_MFMA 1
#endif
#ifndef ONE_LAUNCH
#define ONE_LAUNCH 1
#endif
#ifndef DIS
#define DIS 0
#endif
#define PHON(k) (!(((DIS) >> (k)) & 1))
#ifndef REP
#define REP 0
#endif
#define RUNS(k) ((((REP) >> (k)) & 1) ? 2 : 1)
#ifndef SREP
#define SREP 0
#endif
#define SUBR(k) ((((SREP) >> (k)) & 1) ? 2 : 1)
#ifndef ATTN_MFMA
#define ATTN_MFMA 1
#endif
#ifndef FOX_PRUNE
#define FOX_PRUNE 1
#endif

#define LAS __attribute__((address_space(3)))
#define GAS __attribute__((address_space(1)))
typedef unsigned short bf16_t;
typedef short bf16x8 __attribute__((ext_vector_type(8)));
typedef float f32x4 __attribute__((ext_vector_type(4)));
typedef float f32x2 __attribute__((ext_vector_type(2)));
typedef unsigned u32x4 __attribute__((ext_vector_type(4)));
typedef unsigned u32x2 __attribute__((ext_vector_type(2)));

constexpr int NTOK = 16384, DM = 1024, SEQ = 8192, NLAYER = 4, NY = 3072;
constexpr float EPS = 1e-6f, LOG2E = 1.4426950408889634f;
constexpr float C2 = 0.125f * LOG2E;
constexpr int NWAVES = 8, NTHR = 512;

constexpr size_t MiB = 1u << 20;
constexpr size_t WS_CTL = 0, CTL_ZERO_BYTES = 64 * 1024;
constexpr size_t WS_WFF = 1 * MiB;
constexpr size_t WS_WR = 1 * MiB + 256 * 1024;
constexpr size_t WS_WFFB = 1 * MiB + 640 * 1024;
constexpr size_t WS_LOGF = 2 * MiB;
constexpr size_t WS_CFOX = 2 * MiB + 512 * 1024;
constexpr size_t WS_SSQ = 3 * MiB;
constexpr size_t WS_HU = 4 * MiB;
constexpr size_t WS_HD = 8 * MiB;
constexpr size_t WS_TOKC = 9 * MiB;
constexpr size_t WS_WTS = 10 * MiB + 512 * 1024;
constexpr size_t WS_MEMN = 11 * MiB;
constexpr size_t WS_KV = 12 * MiB;
constexpr size_t WS_WIN = 20 * MiB;
constexpr size_t WS_WOUT = 44 * MiB;
constexpr size_t WS_WQK = 52 * MiB;
constexpr size_t WS_WVO = 68 * MiB;
constexpr size_t WS_WGU = 84 * MiB;
constexpr size_t WS_WD = 148 * MiB;
constexpr size_t WS_XB = 180 * MiB;
constexpr size_t WS_CAT = 212 * MiB;
constexpr size_t WS_R1 = 244 * MiB;
constexpr size_t WS_PBUF = WS_R1;
constexpr size_t WS_HID = WS_R1 + 32 * MiB;
constexpr size_t WS_WQS = WS_R1;
constexpr size_t WS_WKVT = WS_R1 + 8 * MiB;
constexpr size_t WS_WOT = WS_R1 + 24 * MiB;
constexpr size_t WS_END = 340 * MiB;

constexpr int CW_TMO = 0, CW_KQMAX = 256, CW_MOECNT = 512, CW_BAR = 4096;

constexpr int LDS_STAGE = 0, LDS_STAGE_BYTES = 131072;
constexpr int LDS_EPI = 131072;
constexpr int LDS_MISC = 131072 + 8192;
constexpr int LDS_BYTES = 131072 + 8192 + 1024;

__device__ __forceinline__ float bf2f(unsigned b) { return __uint_as_float(b << 16); }
__device__ __forceinline__ unsigned cvt_pk_bf16(float lo, float hi) { unsigned r; asm volatile("v_cvt_pk_bf16_f32 %0, %1, %2" : "=v"(r) : "v"(lo), "v"(hi)); return r; }
__device__ __forceinline__ unsigned short f2bf1(float f) { return (unsigned short)(cvt_pk_bf16(f, 0.f) & 0xffffu); }
template <int K> __device__ __forceinline__ float swz_xor(float v) { return __int_as_float(__builtin_amdgcn_ds_swizzle(__float_as_int(v), (K << 10) | 0x1f)); }
__device__ __forceinline__ float x32_sum(float v) { auto r = __builtin_amdgcn_permlane32_swap(__float_as_uint(v), __float_as_uint(v), false, false); return __uint_as_float(r[0]) + __uint_as_float(r[1]); }
__device__ __forceinline__ float x32_max(float v) { auto r = __builtin_amdgcn_permlane32_swap(__float_as_uint(v), __float_as_uint(v), false, false); return fmaxf(__uint_as_float(r[0]), __uint_as_float(r[1])); }
template <int CTRL> __device__ __forceinline__ float dpp_f(float v) { return __int_as_float(__builtin_amdgcn_update_dpp(0, __float_as_int(v), CTRL, 0xf, 0xf, true)); }
__device__ __forceinline__ float wave_sum(float v) {
    v += dpp_f<0xB1>(v); v += dpp_f<0x4E>(v); v += dpp_f<0x141>(v); v += dpp_f<0x140>(v); v += swz_xor<16>(v);
    return x32_sum(v);
}
__device__ __forceinline__ float sigmoidf_(float x) { return 1.f / (1.f + __expf(-x)); }
#define LDS_WAIT() asm volatile("s_waitcnt lgkmcnt(0)" ::: "memory")
#define VM_WAIT() asm volatile("s_waitcnt vmcnt(0)" ::: "memory")

#define XB_TMO      128
#define XB_XCNT(j)  (256  + 64 * (j))
#define XB_XSUB(j)  (1280 + 64 * (j))
#define XB_XGEN(j)  (2304 + 64 * (j))
#define XB_TOP      3328
#define XB_TOPGEN   3392
#define XCD_BAR_WORDS 3456
#define XB_SPIN_CAP (1u << 22)
__device__ __forceinline__ unsigned xb_ld(unsigned* p)              { return __hip_atomic_load(p, __ATOMIC_RELAXED, __HIP_MEMORY_SCOPE_AGENT); }
__device__ __forceinline__ unsigned xb_add(unsigned* p, unsigned v) { return __hip_atomic_fetch_add(p, v, __ATOMIC_RELAXED, __HIP_MEMORY_SCOPE_AGENT); }
__device__ __forceinline__ unsigned xb_xcc_id() { return (unsigned)__builtin_amdgcn_s_getreg((3 << 11) | 20) & 0xFu; }
#define XB_SPIN(cond, bar) do { unsigned _sp = 0; while (cond) { __builtin_amdgcn_s_sleep(1); \
    if ((++_sp & 255u) == 0u) { if (xb_ld(&(bar)[XB_TMO])) break; if (_sp > XB_SPIN_CAP) { atomicAdd(&(bar)[XB_TMO], 1u); break; } } } } while (0)
struct XcdBarrier { unsigned* bar; unsigned x; volatile LAS unsigned* st; };
__device__ __forceinline__ XcdBarrier xcd_barrier_post(unsigned* bar, volatile LAS unsigned* st) {
    XcdBarrier b; b.bar = bar; b.x = xb_xcc_id(); b.st = st;
    if (threadIdx.x == 0) (void)xb_add(&bar[XB_XCNT(b.x)], 1u);
    return b;
}
__device__ __forceinline__ void xcd_barrier_complete(unsigned* bar, unsigned x, unsigned& nloc, unsigned& nx) {
    const unsigned G = gridDim.x * gridDim.y * gridDim.z;
    unsigned sum, cnt, mine, sp = 0u;
    for (;;) {
        sum = 0u; cnt = 0u; mine = 0u;
#pragma unroll
        for (unsigned j = 0; j < 16; ++j) { const unsigned c = xb_ld(&bar[XB_XCNT(j)]); sum += c; cnt += (c > 0u) ? 1u : 0u; mine = (j == x) ? c : mine; }
        if (sum == G) break;
        __builtin_amdgcn_s_sleep(1);
        if ((++sp & 255u) == 0u) { if (xb_ld(&bar[XB_TMO])) break; if (sp > XB_SPIN_CAP) { atomicAdd(&bar[XB_TMO], 1u); break; } }
    }
    nloc = mine > 0u ? mine : 1u; nx = cnt > 0u ? cnt : 1u;
}
__device__ __forceinline__ void xcd_barrier(const XcdBarrier& b) {
    asm volatile("s_waitcnt vmcnt(0)" ::: "memory");
    __syncthreads();
    if (threadIdx.x == 0) {
        unsigned* bar = b.bar;
        __builtin_amdgcn_s_waitcnt(0);
        unsigned nloc = b.st[0], nx = b.st[1];
        if (nloc == 0u) { xcd_barrier_complete(bar, b.x, nloc, nx); b.st[0] = nloc; b.st[1] = nx; }
        const unsigned old = xb_add(&bar[XB_XSUB(b.x)], 1u);
        const unsigned gen = old / nloc;
        if (old + 1u == (gen + 1u) * nloc) {
            __builtin_amdgcn_fence(__ATOMIC_RELEASE, "agent");
            asm volatile("s_waitcnt vmcnt(0)" ::: "memory");
            const unsigned og = xb_add(&bar[XB_TOP], 1u);
            const unsigned tg = og / nx;
            if (og + 1u == (tg + 1u) * nx) xb_add(&bar[XB_TOPGEN], 1u);
            else XB_SPIN(xb_ld(&bar[XB_TOPGEN]) == tg, bar);
            __builtin_amdgcn_fence(__ATOMIC_ACQUIRE, "agent");
            xb_add(&bar[XB_XGEN(b.x)], 1u);
            asm volatile("s_waitcnt vmcnt(0)" ::: "memory");
        } else {
            XB_SPIN(xb_ld(&bar[XB_XGEN(b.x)]) == gen, bar);
            __builtin_amdgcn_fence(__ATOMIC_ACQUIRE, "agent");
            asm volatile("s_waitcnt vmcnt(0)" ::: "memory");
        }
    }
    __syncthreads();
}

namespace pg8 {
constexpr int BM = 256, BK = 64, HALF = 128, HTB = HALF * BK * 2;
__host__ __device__ __forceinline__ int lds_byte(int r, int c) { const int st = (r >> 4) * 2 + (c >> 5), rr = r & 15, cc = c & 31, ob = rr * 64 + cc * 2; return st * 1024 + (ob ^ (((ob >> 9) & 1) << 5)); }
__host__ __device__ __forceinline__ void stage_rc(int b, int& R, int& C) { const int st = b / 1024, sb = b % 1024, swz = sb ^ (((sb >> 9) & 1) << 5); R = (st >> 1) * 16 + swz / 64; C = (st & 1) * 32 + (swz % 64) / 2; }
__host__ __device__ __forceinline__ int perm32(int rho) { const int n = rho >> 4, i = rho & 15; return 8 * (i >> 2) + 4 * n + (i & 3); }

struct Unit { int pm, pn, a0, a1, a2, a3; };
struct GemmDesc { int K; unsigned lda, ldb; int ksplit; };


#if USE_MFMA
template <class Epi, class Sched, bool ALIGN_EPI, bool GATHER, bool BSPLIT>
__device__ __forceinline__ void gemm_phase(LAS unsigned char* lds, const GemmDesc g, const Sched& S, const Epi& E) {
    int tid = threadIdx.x; asm volatile("" : "+v"(tid));
    const int wid = __builtin_amdgcn_readfirstlane(tid >> 6), lane = tid & 63, wr = wid >> 2, wc = wid & 3, fr = lane & 15, fq = lane >> 4;
    const int nt = g.K / BK;
    int R0, C0; stage_rc(tid * 16, R0, C0);
    const unsigned voffB = (unsigned)((R0 & ~31) + perm32(R0 & 31)) * g.ldb + (unsigned)C0 * 2u, voffA = (unsigned)R0 * g.lda + (unsigned)C0 * 2u;
    const size_t qstepA = (size_t)64 * g.lda, qstepB = (size_t)64 * g.ldb;
    const size_t kstep = (size_t)(BK * 2);
    const size_t hstepB = (size_t)HALF * g.ldb, hstepA = GATHER ? (size_t)0 : (size_t)HALF * g.lda;
    const unsigned ldsw = (unsigned)wid * 1024u;
    const int aoff = lds_byte(wr * 64 + fr, fq * 8), boff = lds_byte(wc * 32 + fr, fq * 8);
#define PG8_SA(b, h) (((b) * 2 + (h)) * HTB)
#define PG8_SB(b, h) ((4 + (b) * 2 + (h)) * HTB)
#define PG8_STAGE(bufoff, gbase, voff) do { _Pragma("unroll") for (int _i = 0; _i < 2; ++_i) \
        __builtin_amdgcn_global_load_lds((const unsigned*)((const char*)(gbase) + (voff)[_i]), (LAS unsigned*)(lds + (bufoff) + ldsw + _i * 8192), 16, 0, 0); } while (0)
#define PG8_STAGE1(bufoff, gbase, voff, qstep) do { _Pragma("unroll") for (int _i = 0; _i < 2; ++_i) \
        __builtin_amdgcn_global_load_lds((const unsigned*)((const char*)(gbase) + _i * (qstep) + (voff)), (LAS unsigned*)(lds + (bufoff) + ldsw + _i * 8192), 16, 0, 0); } while (0)
#define PG8_STAGE_B(bufoff, gbase) PG8_STAGE1(bufoff, gbase, voffB, qstepB)
#define PG8_LDA(dst, b, h) do { _Pragma("unroll") for (int m = 0; m < 4; ++m) _Pragma("unroll") for (int k = 0; k < 2; ++k) dst[m][k] = *(const LAS bf16x8*)(lds + PG8_SA(b, h) + aoff + m * 2048 + k * 1024); } while (0)
#define PG8_LDB(dst, b, h) do { _Pragma("unroll") for (int n = 0; n < 2; ++n) _Pragma("unroll") for (int k = 0; k < 2; ++k) dst[n][k] = *(const LAS bf16x8*)(lds + PG8_SB(b, h) + boff + n * 2048 + k * 1024); } while (0)
#define PG8_MMA(ai, bj, At, Bt) do { __builtin_amdgcn_s_setprio(1); _Pragma("unroll") for (int m = 0; m < 4; ++m) _Pragma("unroll") for (int n = 0; n < 2; ++n) _Pragma("unroll") for (int k = 0; k < 2; ++k) \
        acc[ai][bj][m][n] = __builtin_amdgcn_mfma_f32_16x16x32_bf16(Bt[n][k], At[m][k], acc[ai][bj][m][n], 0, 0, 0); __builtin_amdgcn_s_setprio(0); } while (0)
#define PG8_WAIT_V(n) asm volatile("s_waitcnt vmcnt(" #n ")" ::: "memory")
#define PG8_WAIT_L(n) asm volatile("s_waitcnt lgkmcnt(" #n ")" ::: "memory")
#define PG8_BAR __builtin_amdgcn_s_barrier()
#define PG8_SCHED __builtin_amdgcn_sched_barrier(0)
#define PG8_OFFS(u, o) do { if constexpr (GATHER) { _Pragma("unroll") for (int _h = 0; _h < 2; ++_h) _Pragma("unroll") for (int _i = 0; _i < 2; ++_i) \
        o[_h][_i] = S.arow(u, _h * 128 + _i * 64 + R0) + (unsigned)C0 * 2u; } } while (0)
#define PG8_STAGE_A(bufoff, gbase, h, OFF) do { if constexpr (GATHER) { PG8_STAGE(bufoff, gbase, OFF[h]); } else { PG8_STAGE1(bufoff, (gbase) + (h) * hstepA, voffA, qstepA); } } while (0)
#define PG8_BP(base, base2, tt) (((BSPLIT && (tt) >= g.ksplit) ? (base2) : (base)) + (size_t)(tt) * kstep)
    Unit cur, nxt; int ui = 0;
    if (!S.next(0, cur)) return;
    f32x4 acc[2][2][4][2];
#pragma unroll
    for (int a = 0; a < 2; ++a)
#pragma unroll
        for (int b = 0; b < 2; ++b)
#pragma unroll
            for (int m = 0; m < 4; ++m)
#pragma unroll
                for (int n = 0; n < 2; ++n) acc[a][b][m][n] = (f32x4){0.f, 0.f, 0.f, 0.f};
    bf16x8 At[4][2], B0[2][2], B1[2][2];
    unsigned coff[2][2], noff[2][2];
#pragma unroll
    for (int h = 0; h < 2; ++h)
#pragma unroll
        for (int i = 0; i < 2; ++i) { coff[h][i] = 0u; noff[h][i] = 0u; }
    PG8_OFFS(cur, coff);
    const char* cA = S.A(cur); const char* cB = S.B(cur); const char* cB2 = BSPLIT ? S.B2(cur) : cB;
    PG8_STAGE_B(PG8_SB(0, 0), cB); PG8_STAGE_B(PG8_SB(0, 1), cB + hstepB); PG8_STAGE_A(PG8_SA(0, 0), cA, 0, coff); PG8_STAGE_A(PG8_SA(0, 1), cA, 1, coff);
    if (wr == 1) PG8_BAR;
    PG8_WAIT_V(2); PG8_BAR;
    PG8_STAGE_B(PG8_SB(1, 0), cB + kstep); PG8_STAGE_A(PG8_SA(1, 0), cA + kstep, 0, coff); PG8_STAGE_B(PG8_SB(1, 1), cB + hstepB + kstep);
    PG8_WAIT_V(6); PG8_BAR;
    for (;;) {
        const bool has_next = S.next(ui + 1, nxt);
        const char* nA = has_next ? S.A(nxt) : cA; const char* nB = has_next ? S.B(nxt) : cB; const char* nB2 = (BSPLIT && has_next) ? S.B2(nxt) : cB2;
        if constexpr (GATHER) { if (has_next) { PG8_OFFS(nxt, noff); } else {
#pragma unroll
            for (int h = 0; h < 2; ++h)
#pragma unroll
                for (int i = 0; i < 2; ++i) noff[h][i] = coff[h][i]; } }
        for (int t = 0; t < nt; t += 2) {
            const bool last = (t == nt - 2);
            const char* a1 = cA + (size_t)(t + 1) * kstep;
            const char* a2 = last ? nA : cA + (size_t)(t + 2) * kstep;
            const char* b2 = last ? nB : PG8_BP(cB, cB2, t + 2);
            const char* a3 = a2 + kstep;
            const char* b3 = last ? nB + kstep : PG8_BP(cB, cB2, t + 3);
            unsigned o2[2][2];
#pragma unroll
            for (int h = 0; h < 2; ++h)
#pragma unroll
                for (int i = 0; i < 2; ++i) o2[h][i] = GATHER ? (last ? noff[h][i] : coff[h][i]) : 0u;
            PG8_LDB(B0, 0, 0); PG8_LDB(B1, 0, 1); PG8_SCHED; PG8_LDA(At, 0, 0); PG8_STAGE_A(PG8_SA(1, 1), a1, 1, coff);
            PG8_WAIT_V(8); PG8_WAIT_L(0); PG8_BAR; PG8_MMA(0, 0, At, B0); PG8_MMA(0, 1, At, B1); PG8_BAR; PG8_SCHED;
            PG8_LDA(At, 0, 1); PG8_STAGE_B(PG8_SB(0, 0), b2); PG8_STAGE_B(PG8_SB(0, 1), b2 + hstepB); PG8_STAGE_A(PG8_SA(0, 0), a2, 0, o2);
            PG8_WAIT_V(8); PG8_WAIT_L(0); PG8_BAR; PG8_MMA(1, 0, At, B0); PG8_MMA(1, 1, At, B1); PG8_BAR; PG8_SCHED;
            PG8_LDB(B0, 1, 0); PG8_LDB(B1, 1, 1); PG8_SCHED; PG8_LDA(At, 1, 0); PG8_STAGE_A(PG8_SA(0, 1), a2, 1, o2);
            PG8_WAIT_V(8); PG8_WAIT_L(0); PG8_BAR; PG8_MMA(0, 0, At, B0); PG8_MMA(0, 1, At, B1); PG8_BAR; PG8_SCHED;
            PG8_LDA(At, 1, 1); PG8_STAGE_B(PG8_SB(1, 0), b3); PG8_STAGE_B(PG8_SB(1, 1), b3 + hstepB); PG8_STAGE_A(PG8_SA(1, 0), a3, 0, o2);
            PG8_WAIT_V(8); PG8_WAIT_L(0); PG8_BAR; PG8_MMA(1, 0, At, B0); PG8_MMA(1, 1, At, B1); PG8_BAR; PG8_SCHED;
        }
        if constexpr (ALIGN_EPI) { if (wr == 0) PG8_BAR; }
        { int t2 = threadIdx.x; asm volatile("" : "+v"(t2)); const int l2 = t2 & 63; E(acc, cur, wr, wc, l2 & 15, l2 >> 4); }
        if (!has_next) break;
#pragma unroll
        for (int a = 0; a < 2; ++a)
#pragma unroll
            for (int b = 0; b < 2; ++b)
#pragma unroll
                for (int m = 0; m < 4; ++m)
#pragma unroll
                    for (int n = 0; n < 2; ++n) acc[a][b][m][n] = (f32x4){0.f, 0.f, 0.f, 0.f};
        cur = nxt; cA = nA; cB = nB; cB2 = nB2; ++ui;
#pragma unroll
        for (int h = 0; h < 2; ++h)
#pragma unroll
            for (int i = 0; i < 2; ++i) coff[h][i] = noff[h][i];
        if constexpr (ALIGN_EPI) { if (wr == 1) PG8_BAR; }
    }
    PG8_WAIT_V(0);
    if constexpr (!ALIGN_EPI) { if (wr == 0) PG8_BAR; }
    PG8_BAR;
#undef PG8_SA
#undef PG8_SB
#undef PG8_STAGE
#undef PG8_LDA
#undef PG8_LDB
#undef PG8_MMA
#undef PG8_WAIT_V
#undef PG8_WAIT_L
#undef PG8_BAR
#undef PG8_SCHED
#undef PG8_OFFS
#undef PG8_STAGE_A
#undef PG8_STAGE1
#undef PG8_STAGE_B
#undef PG8_BP
}
#else
template <class Epi, class Sched, bool ALIGN_EPI, bool GATHER, bool BSPLIT>
__device__ __forceinline__ void gemm_phase(LAS unsigned char* lds, const GemmDesc g, const Sched& S, const Epi& E) {
    const int tid = threadIdx.x, wid = __builtin_amdgcn_readfirstlane(tid >> 6), lane = tid & 63, wr = wid >> 2, wc = wid & 3, fr = lane & 15, fq = lane >> 4;
    Unit cur;
    for (int ui = 0; S.next(ui, cur); ++ui) {
        f32x4 acc[2][2][4][2];
#pragma unroll
        for (int a = 0; a < 2; ++a)
#pragma unroll
            for (int b = 0; b < 2; ++b)
#pragma unroll
                for (int m = 0; m < 4; ++m)
#pragma unroll
                    for (int n = 0; n < 2; ++n) acc[a][b][m][n] = (f32x4){0.f, 0.f, 0.f, 0.f};
        const char* cA = S.A(cur); const char* cB = S.B(cur); const char* cB2 = BSPLIT ? S.B2(cur) : cB;
        unsigned aro[2][4];
#pragma unroll
        for (int ai = 0; ai < 2; ++ai)
#pragma unroll
            for (int m = 0; m < 4; ++m) { const int r = ai * 128 + wr * 64 + m * 16 + fr; aro[ai][m] = GATHER ? S.arow(cur, r) : (unsigned)r * g.lda; }
        for (int k0 = 0; k0 < g.K; k0 += 4) {
            u32x2 av[2][4];
#pragma unroll
            for (int ai = 0; ai < 2; ++ai)
#pragma unroll
                for (int m = 0; m < 4; ++m) av[ai][m] = *(const u32x2*)(cA + aro[ai][m] + (size_t)k0 * 2);
            const char* bb = (BSPLIT && k0 >= g.ksplit * 64) ? cB2 : cB;
#pragma unroll
            for (int bj = 0; bj < 2; ++bj)
#pragma unroll
                for (int n = 0; n < 2; ++n)
#pragma unroll
                    for (int j = 0; j < 4; ++j) {
                        const int c = bj * 128 + wc * 32 + fq * 8 + n * 4 + j;
                        const u32x2 bv = *(const u32x2*)(bb + (size_t)c * g.ldb + (size_t)k0 * 2);
                        const float b0 = bf2f(bv.x & 0xffffu), b1 = bf2f(bv.x >> 16), b2 = bf2f(bv.y & 0xffffu), b3 = bf2f(bv.y >> 16);
#pragma unroll
                        for (int ai = 0; ai < 2; ++ai)
#pragma unroll
                            for (int m = 0; m < 4; ++m) {
                                const u32x2 a = av[ai][m];
                                acc[ai][bj][m][n][j] += bf2f(a.x & 0xffffu) * b0 + bf2f(a.x >> 16) * b1 + bf2f(a.y & 0xffffu) * b2 + bf2f(a.y >> 16) * b3;
                            }
                    }
        }
        E(acc, cur, wr, wc, fr, fq);
    }
    __syncthreads();
}
#endif
}
using pg8::Unit; using pg8::GemmDesc;

__device__ __forceinline__ float row_rstd(const float* ssq, int row) {
    const f32x4* p = (const f32x4*)(ssq + (size_t)row * 16);
    const f32x4 a = p[0], b = p[1], c = p[2], d = p[3];
    const float s = ((a.x + a.y) + (a.z + a.w)) + ((b.x + b.y) + (b.z + b.w)) + ((c.x + c.y) + (c.z + c.w)) + ((d.x + d.y) + (d.z + d.w));
    return rsqrtf(s * (1.f / 1024.f) + EPS);
}
__device__ __forceinline__ u32x4 pack8(f32x4 v0, f32x4 v1) { u32x4 w; w.x = cvt_pk_bf16(v0[0], v0[1]); w.y = cvt_pk_bf16(v0[2], v0[3]); w.z = cvt_pk_bf16(v1[0], v1[1]); w.w = cvt_pk_bf16(v1[2], v1[3]); return w; }

struct EpiBf16 {
    bf16_t* O; int ldc; const float* ssq;
    __device__ __forceinline__ void operator()(const f32x4 (&acc)[2][2][4][2], const Unit& u, int wr, int wc, int fr, int fq) const {
#pragma unroll
        for (int ai = 0; ai < 2; ++ai)
#pragma unroll
            for (int m = 0; m < 4; ++m) {
                const int r = ai * 128 + wr * 64 + m * 16 + fr;
                const float rs = ssq ? row_rstd(ssq, u.a1 + r) : 1.f;
                bf16_t* rowp = O + (size_t)u.a0 + (size_t)r * ldc + wc * 32 + fq * 8;
#pragma unroll
                for (int bj = 0; bj < 2; ++bj) *(u32x4*)(rowp + bj * 128) = pack8(acc[ai][bj][m][0] * rs, acc[ai][bj][m][1] * rs);
                __builtin_amdgcn_sched_barrier(0);
            }
    }
};
struct EpiResidual {
    const float* xin; float* xout; bf16_t* xb; float* ssq;
    __device__ __forceinline__ void operator()(const f32x4 (&acc)[2][2][4][2], const Unit& u, int wr, int wc, int fr, int fq) const {
#pragma unroll
        for (int ai = 0; ai < 2; ++ai)
#pragma unroll
            for (int m = 0; m < 4; ++m) {
                const int row = u.pm * 256 + ai * 128 + wr * 64 + m * 16 + fr;
                float ss = 0.f;
#pragma unroll
                for (int bj = 0; bj < 2; ++bj) {
                    const size_t o = (size_t)row * DM + u.pn * 256 + bj * 128 + wc * 32 + fq * 8;
                    const f32x4 v0 = acc[ai][bj][m][0] + *(const f32x4*)(xin + o), v1 = acc[ai][bj][m][1] + *(const f32x4*)(xin + o + 4);
                    *(f32x4*)(xout + o) = v0; *(f32x4*)(xout + o + 4) = v1;
                    *(u32x4*)(xb + o) = pack8(v0, v1);
                    ss += (v0[0] * v0[0] + v0[1] * v0[1]) + (v0[2] * v0[2] + v0[3] * v0[3]) + (v1[0] * v1[0] + v1[1] * v1[1]) + (v1[2] * v1[2] + v1[3] * v1[3]);
                }
                ss += swz_xor<16>(ss); ss = x32_sum(ss);
                if (fq == 0) ssq[(size_t)row * 16 + u.pn * 4 + wc] = ss;
                __builtin_amdgcn_sched_barrier(0);
            }
    }
};
struct EpiSoftmax {
    bf16_t* P; const float* ssq; LAS float* scr;
    __device__ __forceinline__ void operator()(const f32x4 (&acc)[2][2][4][2], const Unit& u, int wr, int wc, int fr, int fq) const {
#pragma unroll
        for (int ai = 0; ai < 2; ++ai)
#pragma unroll
            for (int m = 0; m < 4; ++m) {
                const int rl = ai * 128 + wr * 64 + m * 16 + fr;
                const float rs = row_rstd(ssq, u.pm * 256 + rl) * (LOG2E / 16.f);
                float mm = -INFINITY;
#pragma unroll
                for (int bj = 0; bj < 2; ++bj)
#pragma unroll
                    for (int n = 0; n < 2; ++n)
#pragma unroll
                        for (int j = 0; j < 4; ++j) mm = fmaxf(mm, acc[ai][bj][m][n][j] * rs);
                mm = fmaxf(mm, swz_xor<16>(mm)); mm = x32_max(mm);
                if (fq == 0) scr[rl * 4 + wc] = mm;
            }
        LDS_WAIT(); __builtin_amdgcn_s_barrier();
#pragma unroll
        for (int ai = 0; ai < 2; ++ai)
#pragma unroll
            for (int m = 0; m < 4; ++m) {
                const int rl = ai * 128 + wr * 64 + m * 16 + fr;
                const float rs = row_rstd(ssq, u.pm * 256 + rl) * (LOG2E / 16.f);
                const f32x4 q = *(const LAS f32x4*)(scr + rl * 4);
                const float M = fmaxf(fmaxf(q.x, q.y), fmaxf(q.z, q.w));
                float s = 0.f;
#pragma unroll
                for (int bj = 0; bj < 2; ++bj)
#pragma unroll
                    for (int n = 0; n < 2; ++n)
#pragma unroll
                        for (int j = 0; j < 4; ++j) s += __builtin_amdgcn_exp2f(acc[ai][bj][m][n][j] * rs - M);
                s += swz_xor<16>(s); s = x32_sum(s);
                if (fq == 0) scr[1024 + rl * 4 + wc] = s;
            }
        LDS_WAIT(); __builtin_amdgcn_s_barrier();
#pragma unroll
        for (int ai = 0; ai < 2; ++ai)
#pragma unroll
            for (int m = 0; m < 4; ++m) {
                const int rl = ai * 128 + wr * 64 + m * 16 + fr;
                const float r = row_rstd(ssq, u.pm * 256 + rl) * (LOG2E / 16.f);
                const f32x4 qm = *(const LAS f32x4*)(scr + rl * 4);
                const float M = fmaxf(fmaxf(qm.x, qm.y), fmaxf(qm.z, qm.w));
                const f32x4 q = *(const LAS f32x4*)(scr + 1024 + rl * 4);
                const float inv = 1.f / ((q.x + q.y) + (q.z + q.w));
                bf16_t* rowp = P + (size_t)(u.pm * 256 + rl) * DM + u.pn * 256 + wc * 32 + fq * 8;
#pragma unroll
                for (int bj = 0; bj < 2; ++bj) {
                    f32x4 v0, v1;
#pragma unroll
                    for (int j = 0; j < 4; ++j) { v0[j] = __builtin_amdgcn_exp2f(acc[ai][bj][m][0][j] * r - M) * inv; v1[j] = __builtin_amdgcn_exp2f(acc[ai][bj][m][1][j] * r - M) * inv; }
                    *(u32x4*)(rowp + bj * 128) = pack8(v0, v1);
                }
            }
        LDS_WAIT(); __builtin_amdgcn_s_barrier();
    }
};
struct EpiMoeUp {
    bf16_t* hid; const int* tokc; const float* ssq; const f32x2* wts;
    __device__ __forceinline__ void operator()(const f32x4 (&acc)[2][2][4][2], const Unit& u, int wr, int wc, int fr, int fq) const {
#pragma unroll
        for (int ai = 0; ai < 2; ++ai)
#pragma unroll
            for (int m = 0; m < 4; ++m) {
                const int rl = ai * 128 + wr * 64 + m * 16 + fr;
                const bool valid = rl < u.a2;
                const int tok = valid ? tokc[u.a1 + rl] : 0;
                const float rs = row_rstd(ssq, tok);
                const f32x2 w2 = wts[tok];
                const float w = valid ? (u.a3 ? w2.y : w2.x) : 0.f;
                f32x4 h[2];
#pragma unroll
                for (int n = 0; n < 2; ++n)
#pragma unroll
                    for (int j = 0; j < 4; ++j) { const float gt = acc[ai][0][m][n][j] * rs, up = acc[ai][1][m][n][j] * rs; h[n][j] = gt / (1.f + __expf(-gt)) * up * w; }
                *(u32x4*)(hid + (size_t)(u.a0 + rl) * 512 + u.a3 * 256 + u.pn * 128 + wc * 32 + fq * 8) = pack8(h[0], h[1]);
            }
    }
};
struct EpiMoeDown {
    float* x; bf16_t* xb; float* ssq; const int* tokc;
    __device__ __forceinline__ void operator()(const f32x4 (&acc)[2][2][4][2], const Unit& u, int wr, int wc, int fr, int fq) const {
#pragma unroll
        for (int ai = 0; ai < 2; ++ai)
#pragma unroll
            for (int m = 0; m < 4; ++m) {
                const int rl = ai * 128 + wr * 64 + m * 16 + fr;
                const bool valid = rl < u.a2;
                const int tok = valid ? tokc[u.a1 + rl] : 0;
                float ss = 0.f;
                if (valid) {
#pragma unroll
                    for (int bj = 0; bj < 2; ++bj) {
                        const size_t o = (size_t)tok * DM + u.pn * 256 + bj * 128 + wc * 32 + fq * 8;
                        const f32x4 v0 = acc[ai][bj][m][0] + *(const f32x4*)(x + o), v1 = acc[ai][bj][m][1] + *(const f32x4*)(x + o + 4);
                        *(f32x4*)(x + o) = v0; *(f32x4*)(x + o + 4) = v1;
                        *(u32x4*)(xb + o) = pack8(v0, v1);
                        ss += (v0[0] * v0[0] + v0[1] * v0[1]) + (v0[2] * v0[2] + v0[3] * v0[3]) + (v1[0] * v1[0] + v1[1] * v1[1]) + (v1[2] * v1[2] + v1[3] * v1[3]);
                    }
                }
                ss += swz_xor<16>(ss); ss = x32_sum(ss);
                if (valid && fq == 0) ssq[(size_t)tok * 16 + u.pn * 4 + wc] = ss;
                __builtin_amdgcn_sched_barrier(0);
            }
    }
};

struct SchedGrid {
    int nM, nN, nwg, G, c; const char* Ab; const char* Bb; size_t astride, bstride, bbatch; int ldc;
    __device__ __forceinline__ bool next(int i, Unit& u) const {
        const long L = (long)i * G + c; if (L >= nwg) return false;
        int wgid = (int)L; { const int q = nwg / 8, r = nwg % 8, xcd = wgid % 8, off = wgid / 8; wgid = (xcd < r ? xcd * (q + 1) : r * (q + 1) + (xcd - r) * q) + off; }
        const int nig = 8 * nN, gid = wgid / nig, fm = gid * 8, gsz = (nM - fm) < 8 ? (nM - fm) : 8;
        u.pm = fm + ((wgid % nig) % gsz); u.pn = (wgid % nig) / gsz;
        u.a0 = u.pm * 256 * ldc + u.pn * 256; u.a1 = u.pm * 256; u.a2 = 0; u.a3 = 0; return true;
    }
    __device__ __forceinline__ const char* A(const Unit& u) const { return Ab + (size_t)u.pm * astride; }
    __device__ __forceinline__ const char* B(const Unit& u) const { return Bb + (size_t)u.pn * bstride + (u.pm >= 32 ? bbatch : 0); }
    __device__ __forceinline__ const char* B2(const Unit& u) const { return B(u); }
    __device__ __forceinline__ unsigned arow(const Unit&, int) const { return 0u; }
};
struct SchedKV {
    int G, c; const char* memn; const char* wkvt;
    __device__ __forceinline__ bool next(int i, Unit& u) const {
        const int L = i * G + c; if (L >= 64) return false;
        const int l = L >> 4; u.pm = (L >> 3) & 1; u.pn = L & 7; u.a2 = l; u.a3 = 0;
        u.a0 = l * 512 * 2048 + u.pm * 256 * 2048 + u.pn * 256; u.a1 = 0; return true;
    }
    __device__ __forceinline__ const char* A(const Unit& u) const { return memn + (size_t)u.pm * 256 * 2048; }
    __device__ __forceinline__ const char* B(const Unit& u) const { return wkvt + ((size_t)u.a2 * 2048 + (size_t)u.pn * 256) * 2048; }
    __device__ __forceinline__ const char* B2(const Unit& u) const { return B(u); }
    __device__ __forceinline__ unsigned arow(const Unit&, int) const { return 0u; }
};
struct SchedQK {
    int G, c; const char* kv; const char* wqs;
    __device__ __forceinline__ bool next(int i, Unit& u) const {
        const int L = i * G + c; if (L >= 128) return false;
        const int l = L >> 5, b = (L >> 4) & 1, h = (L >> 2) & 3; u.pn = L & 3; u.pm = 0; u.a1 = l; u.a2 = b; u.a3 = h;
        u.a0 = ((l * 2 + b) * 1024 + h * 256) * 1024 + u.pn * 256; return true;
    }
    __device__ __forceinline__ const char* A(const Unit& u) const { return kv + (((size_t)u.a1 * 512 + u.a2 * 256) * 2048 + u.a3 * 256) * 2; }
    __device__ __forceinline__ const char* B(const Unit& u) const { return wqs + (((size_t)u.a1 * 1024 + u.pn * 256) * 1024 + u.a3 * 256) * 2; }
    __device__ __forceinline__ const char* B2(const Unit& u) const { return B(u); }
    __device__ __forceinline__ unsigned arow(const Unit&, int) const { return 0u; }
};
struct SchedVO {
    int G, c; const char* kv; const char* wot;
    __device__ __forceinline__ bool next(int i, Unit& u) const {
        const int L = i * G + c; if (L >= 128) return false;
        const int l = L >> 5, b = (L >> 4) & 1, h = (L >> 2) & 3; u.pm = L & 3; u.pn = 0; u.a1 = l; u.a2 = b; u.a3 = h;
        u.a0 = ((l * 2 + b) * 1024 + u.pm * 256) * 1024 + h * 256; return true;
    }
    __device__ __forceinline__ const char* A(const Unit& u) const { return wot + (((size_t)u.a1 * 1024 + u.pm * 256) * 1024 + u.a3 * 256) * 2; }
    __device__ __forceinline__ const char* B(const Unit& u) const { return kv + (((size_t)u.a1 * 512 + u.a2 * 256) * 2048 + 1024 + u.a3 * 256) * 2; }
    __device__ __forceinline__ const char* B2(const Unit& u) const { return B(u); }
    __device__ __forceinline__ unsigned arow(const Unit&, int) const { return 0u; }
};
struct SchedMoe {
    int G, c; bool down; const volatile LAS int* tab; const int* tokc; const char* Ab; const char* Wb;
    __device__ __forceinline__ bool next(int i, Unit& u) const {
        const int L = i * G + c; const int nun = __builtin_amdgcn_readfirstlane(tab[24]) * 4; if (L >= nun) return false;
        const int q = L >> 2, sub = L & 3;
        int cc = 0;
        for (int k = 0; k < 24; ++k) if (q >= tab[k + 1]) cc = k + 1;
        const int j = q - tab[cc], n = tab[32 + cc];
        const int g = cc / 6, pi = cc % 6;
        const int e1 = pi < 3 ? 0 : (pi < 5 ? 1 : 2), e2 = pi < 3 ? pi + 1 : (pi < 5 ? pi - 1 : 3);
        u.a0 = q * 256; u.a1 = cc * 16384 + j * 256; u.a2 = (n - j * 256) < 256 ? (n - j * 256) : 256;
        if (!down) { const int s = sub >> 1; u.a3 = s; u.pn = sub & 1; u.pm = g * 4 + (s ? e2 : e1); }
        else { u.a3 = 0; u.pn = sub; u.pm = (g * 4 + e1) | ((g * 4 + e2) << 8); }
        u.pm = __builtin_amdgcn_readfirstlane(u.pm); u.pn = __builtin_amdgcn_readfirstlane(u.pn); u.a0 = __builtin_amdgcn_readfirstlane(u.a0);
        u.a1 = __builtin_amdgcn_readfirstlane(u.a1); u.a2 = __builtin_amdgcn_readfirstlane(u.a2); u.a3 = __builtin_amdgcn_readfirstlane(u.a3);
        return true;
    }
    __device__ __forceinline__ const char* A(const Unit& u) const { return down ? Ab + (size_t)u.a0 * 1024 : Ab; }
    __device__ __forceinline__ const char* B(const Unit& u) const {
        return down ? Wb + (((size_t)(u.pm & 255) * 1024 + u.pn * 256) * 256) * 2 : Wb + (((size_t)u.pm * 512 + u.pn * 256) * 1024) * 2; }
    __device__ __forceinline__ const char* B2(const Unit& u) const { return Wb + (((size_t)(u.pm >> 8) * 1024 + u.pn * 256) * 256) * 2 - (size_t)4 * 128; }
    __device__ __forceinline__ unsigned arow(const Unit& u, int r) const { const int tok = (r < u.a2) ? tokc[u.a1 + r] : 0; return (unsigned)tok * 2048u; }
};

struct Params { const float* in[27]; float* out; unsigned char* ws; int ph_lo, ph_hi; };
__device__ __forceinline__ const float* pin_(const Params& p, int i) { asm volatile("" : "+s"(i)); return p.in[i]; }
#define PIN(k) pin_(p, (k))

__device__ __forceinline__ void tr_item(const float* src, int ld, int c0, int K, int k0, const float* gain, float scale, bf16_t* dst, LAS float* scr, int lane) {
    float tv[32];
#pragma unroll
    for (int i = 0; i < 32; ++i) tv[i] = src[(size_t)(k0 + 2 * i + (lane >> 5)) * ld + c0 + (lane & 31)];
#pragma unroll
    for (int i = 0; i < 32; ++i) { const int kk = 2 * i + (lane >> 5); const float gsc = gain ? gain[k0 + kk] * scale : scale; scr[kk * 33 + (lane & 31)] = tv[i] * gsc; }
    LDS_WAIT(); asm volatile("" ::: "memory");
    const int c = lane & 7;
#pragma unroll
    for (int j = 0; j < 4; ++j) { const int n = (lane >> 3) + 8 * j; const LAS float* s = scr + (8 * c) * 33 + n;
        u32x4 o; o.x = cvt_pk_bf16(s[0 * 33], s[1 * 33]); o.y = cvt_pk_bf16(s[2 * 33], s[3 * 33]); o.z = cvt_pk_bf16(s[4 * 33], s[5 * 33]); o.w = cvt_pk_bf16(s[6 * 33], s[7 * 33]);
        *(u32x4*)(dst + (size_t)n * K + k0 + 8 * c) = o; }
    LDS_WAIT(); asm volatile("" ::: "memory");
}

__device__ __forceinline__ void phase_pro_a(const Params& p, LAS unsigned char* lds, int bid, int G) {
    int tid = threadIdx.x; asm volatile("" : "+v"(tid));
    const int lane = tid & 63, wave = tid >> 6;
    unsigned char* ws = p.ws; asm volatile("" : "+s"(ws));
    LAS float* scr = (LAS float*)(lds + wave * 16384);
    const int gw = bid * NWAVES + wave, NGW = G * NWAVES;
    constexpr int PER_L = 1536 + 512 + 1024 + 512 + 4096 + 2048;
    for (int it = gw; it < PER_L * NLAYER; it += NGW) {
        const int l = it / PER_L; int r = it % PER_L;
        if (r < 1536) {
            const int kb = r / 96, nb = r % 96, n0 = nb * 32, c0 = n0 < 1536 ? n0 : n0 + 8;
            tr_item(PIN(3) + (size_t)l * 1024 * 3080, 3080, c0, 1024, kb * 64, PIN(2) + l * 1024, n0 < 512 ? C2 : 1.f, (bf16_t*)(ws + WS_WIN) + ((size_t)l * 3072 + n0) * 1024, scr, lane); continue; }
        r -= 1536;
        if (r < 512) {
            const int kb = r / 32, nb = r % 32, k0 = kb * 64;
            const float* gain = k0 < 512 ? PIN(5) + l * 512 : (k0 < 768 ? PIN(7) + l * 256 - 512 : nullptr);
            tr_item(PIN(12) + (size_t)l * 1024 * 1024, 1024, nb * 32, 1024, k0, gain, 1.f, (bf16_t*)(ws + WS_WOUT) + ((size_t)l * 1024 + nb * 32) * 1024, scr, lane); continue; }
        r -= 512;
        if (r < 1024) {
            const int kb = r / 64, nb = r % 64;
            tr_item(PIN(16) + (size_t)l * 1024 * 2048, 2048, nb * 32, 1024, kb * 64, nullptr, 1.f, (bf16_t*)(ws + WS_WKVT) + ((size_t)l * 2048 + nb * 32) * 1024, scr, lane); continue; }
        r -= 1024;
        if (r < 512) {
            const int kb = r / 32, nb = r % 32;
            tr_item(PIN(17) + (size_t)l * 1024 * 1024, 1024, nb * 32, 1024, kb * 64, nullptr, 1.f, (bf16_t*)(ws + WS_WOT) + ((size_t)l * 1024 + nb * 32) * 1024, scr, lane); continue; }
        r -= 512;
        if (r < 4096) {
            const int e = r >> 8, rr = r & 255, kb = rr >> 4, nb = rr & 15;
            const int orow = nb * 32, t = orow >> 8, half = (orow >> 7) & 1, j = orow & 127;
            const float* src = (half ? PIN(24) : PIN(23)) + ((size_t)l * 16 + e) * 1024 * 256;
            tr_item(src, 256, t * 128 + j, 1024, kb * 64, PIN(18) + l * 1024, 1.f, (bf16_t*)(ws + WS_WGU) + (((size_t)l * 16 + e) * 512 + orow) * 1024, scr, lane); continue; }
        r -= 4096;
        {
            const int e = r >> 7, rr = r & 127, kb = rr >> 5, nb = rr & 31;
            tr_item(PIN(25) + ((size_t)l * 16 + e) * 256 * 1024, 1024, nb * 32, 256, kb * 64, nullptr, 1.f, (bf16_t*)(ws + WS_WD) + (((size_t)l * 16 + e) * 1024 + nb * 32) * 256, scr, lane); }
    }
    for (size_t i4 = (size_t)bid * NTHR + tid; i4 < (size_t)NLAYER * 1024 * 256; i4 += (size_t)G * NTHR) {
        const size_t e = i4 * 4; const int l = (int)(e >> 20), k = (int)((e >> 10) & 1023);
        const f32x4 v = *(const f32x4*)(PIN(15) + e); const float gsc = PIN(13)[l * 1024 + k];
        u32x2 o; o.x = cvt_pk_bf16(v.x * gsc, v.y * gsc); o.y = cvt_pk_bf16(v.z * gsc, v.w * gsc);
        *(u32x2*)((bf16_t*)(ws + WS_WQS) + e) = o;
    }
    for (int i = bid * NTHR + tid; i < NLAYER * 28 * 1024; i += G * NTHR) {
        const int l = i / (28 * 1024), r = i % (28 * 1024), j = r >> 10, k = r & 1023;
        if (j < 8) { const float wv = PIN(2)[l * 1024 + k] * PIN(3)[((size_t)l * 1024 + k) * 3080 + 1536 + j]; ((float*)(ws + WS_WFF))[(l * 8 + j) * 1024 + k] = wv;
            ((bf16_t*)(ws + WS_WFFB))[(l * 16 + j) * 1024 + k] = f2bf1(wv); ((bf16_t*)(ws + WS_WFFB))[(l * 16 + 8 + j) * 1024 + k] = 0; }
        else { const int jj = j - 8; const float w = jj < 4 ? PIN(19)[(l * 1024 + k) * 4 + jj] : PIN(21)[(l * 1024 + k) * 16 + jj - 4];
            ((float*)(ws + WS_WR))[(l * 20 + jj) * 1024 + k] = PIN(18)[l * 1024 + k] * w; }
    }
    for (int row = gw; row < 512; row += NGW) {
        const f32x4* xr = (const f32x4*)(PIN(1) + (size_t)row * 1024) + lane; f32x4 v[4]; float s = 0.f;
#pragma unroll
        for (int j = 0; j < 4; ++j) { v[j] = xr[64 * j]; s += (v[j].x * v[j].x + v[j].y * v[j].y) + (v[j].z * v[j].z + v[j].w * v[j].w); }
        const float rstd = rsqrtf(wave_sum(s) * (1.f / 1024.f) + EPS);
#pragma unroll
        for (int j = 0; j < 4; ++j) { const f32x4 gg = ((const f32x4*)PIN(14))[64 * j + lane]; u32x2 o; o.x = cvt_pk_bf16(v[j].x * rstd * gg.x, v[j].y * rstd * gg.y); o.y = cvt_pk_bf16(v[j].z * rstd * gg.z, v[j].w * rstd * gg.w);
            ((u32x2*)((bf16_t*)(ws + WS_MEMN) + (size_t)row * 1024))[64 * j + lane] = o; }
    }
    for (int row = gw; row < NTOK; row += NGW) {
        const f32x4* xr = (const f32x4*)(PIN(0) + (size_t)row * 1024) + lane; float s = 0.f;
#pragma unroll
        for (int j = 0; j < 4; ++j) { const f32x4 v = xr[64 * j]; s += (v.x * v.x + v.y * v.y) + (v.z * v.z + v.w * v.w); u32x2 o; o.x = cvt_pk_bf16(v.x, v.y); o.y = cvt_pk_bf16(v.z, v.w);
            ((u32x2*)((bf16_t*)(ws + WS_XB) + (size_t)row * 1024))[64 * j + lane] = o; }
        s = wave_sum(s);
        if (lane < 16) ((float*)(ws + WS_SSQ))[(size_t)row * 16 + lane] = lane == 0 ? s : 0.f;
    }
}

__device__ __forceinline__ void phase_logf(const Params& p, LAS unsigned char* lds, int l, int bid, int G) {
    int tid = threadIdx.x; asm volatile("" : "+v"(tid));
    const int lane = tid & 63, wave = tid >> 6;
    unsigned char* ws = p.ws; asm volatile("" : "+s"(ws));
    const int gw = bid * NWAVES + wave, NGW = G * NWAVES;
    const bf16_t* wb = (const bf16_t*)(ws + WS_WFFB) + (size_t)l * 16 * 1024 + (lane & 15) * 1024 + (lane >> 4) * 8;
    for (int g16 = gw; g16 < NTOK / 16; g16 += NGW) {
        const bf16_t* xa = (const bf16_t*)(ws + WS_XB) + (size_t)(g16 * 16 + (lane & 15)) * 1024 + (lane >> 4) * 8;
        f32x4 acc = {0.f, 0.f, 0.f, 0.f};
#pragma unroll 16
        for (int ks = 0; ks < 32; ++ks) { const bf16x8 a = *(const bf16x8*)(xa + ks * 32), w = *(const bf16x8*)(wb + ks * 32); acc = __builtin_amdgcn_mfma_f32_16x16x32_bf16(a, w, acc, 0, 0, 0); }
        if ((lane & 15) < 8) { const float bias = PIN(4)[l * 8 + (lane & 15)];
#pragma unroll
            for (int t = 0; t < 4; ++t) { const int row = g16 * 16 + (lane >> 4) * 4 + t; const float z = acc[t] * row_rstd((const float*)(ws + WS_SSQ), row) + bias;
                ((float*)(ws + WS_LOGF))[(size_t)row * 8 + (lane & 15)] = fminf(z, 0.f) - __logf(1.f + __expf(-fabsf(z))); } }
    }
}

template <bool FINAL>
__device__ __forceinline__ void hgrn_unit(const Params& p, LAS unsigned char* lds, int l, int unit) {
    int tid = threadIdx.x; asm volatile("" : "+v"(tid));
    const int lane = tid & 63, kg = tid >> 6;
    unsigned char* ws = p.ws; asm volatile("" : "+s"(ws));
    const int bh = unit >> 5, sc = unit & 31, b = bh >> 2, h = bh & 3;
    const bf16_t* y = (const bf16_t*)(ws + WS_R1);
    LAS float* F = (LAS float*)lds; LAS float* K1 = F + 4096; LAS float* Q = F + 8192; LAS float* V = F + 12288; LAS float* OP = F + 16384; LAS float* lbv = F + 16384 + 8192; LAS float* dpl = lbv + 64;
    if (tid < 64) {
        const int k = h * 64 + tid; float e[4], mx = -INFINITY, den = 0.f, num = 0.f;
#pragma unroll
        for (int i = 0; i < 4; ++i) { e[i] = PIN(6)[i * 256 + k]; mx = fmaxf(mx, e[i]); }
#pragma unroll
        for (int i = 0; i < 4; ++i) { e[i] = __expf(e[i] - mx); den += e[i]; if (i >= 1 && i <= l) num += e[i]; }
        lbv[tid] = num / den;
    }
    f32x2 s2[4];
#pragma unroll
    for (int j = 0; j < 4; ++j) s2[j] = (f32x2){0.f, 0.f};
    float dprod = 1.f;
    if (FINAL) {
        const float* U = (const float*)(ws + WS_HU); const float* Dd = (const float*)(ws + WS_HD);
        float s[8];
#pragma unroll
        for (int j = 0; j < 8; ++j) s[j] = 0.f;
        int jj = 0;
        for (; jj + 4 <= sc; jj += 4) {
            float uu_[4][8], dd_[4][8];
#pragma unroll
            for (int q4 = 0; q4 < 4; ++q4) { const int uu = bh * 32 + jj + q4;
#pragma unroll
                for (int j = 0; j < 8; ++j) { dd_[q4][j] = Dd[uu * 64 + kg * 8 + j]; uu_[q4][j] = U[(size_t)uu * 4096 + (kg * 8 + j) * 64 + lane]; } }
#pragma unroll
            for (int q4 = 0; q4 < 4; ++q4)
#pragma unroll
                for (int j = 0; j < 8; ++j) s[j] = dd_[q4][j] * s[j] + uu_[q4][j];
        }
        for (; jj < sc; ++jj) { const int uu = bh * 32 + jj;
#pragma unroll
            for (int j = 0; j < 8; ++j) s[j] = Dd[uu * 64 + kg * 8 + j] * s[j] + U[(size_t)uu * 4096 + (kg * 8 + j) * 64 + lane]; }
#pragma unroll
        for (int j = 0; j < 4; ++j) s2[j] = (f32x2){s[2 * j], s[2 * j + 1]};
    }
    __syncthreads();
    const size_t row0 = (size_t)b * SEQ + sc * 256;
    for (int ch = 0; ch < 4; ++ch) {
        { unsigned short hf_[8], hq_[8], hv_[8];
#pragma unroll
          for (int j = 0; j < 8; ++j) { const int tt = kg + 8 * j; const bf16_t* yr = y + (row0 + ch * 64 + tt) * NY; hf_[j] = yr[1792 + h * 64 + lane]; hq_[j] = FINAL ? yr[1536 + h * 64 + lane] : (unsigned short)0; hv_[j] = yr[2048 + h * 64 + lane]; }
          const float lb = lbv[lane];
#pragma unroll
          for (int j = 0; j < 8; ++j) { const int idx = (kg + 8 * j) * 64 + lane; const float f = lb + (1.f - lb) * sigmoidf_(bf2f(hf_[j]));
              F[idx] = f; K1[idx] = 1.f - f; V[idx] = bf2f(hv_[j]); if (FINAL) Q[idx] = bf2f(hq_[j]); else dprod *= f; } }
        __syncthreads();
        for (int sub = 0; sub < 4; ++sub) {
#pragma unroll 4
            for (int t16 = 0; t16 < 16; ++t16) {
                const int tt = sub * 16 + t16;
                const f32x4 fa = *(const LAS f32x4*)(F + tt * 64 + kg * 8), fb = *(const LAS f32x4*)(F + tt * 64 + kg * 8 + 4);
                const f32x4 ka = *(const LAS f32x4*)(K1 + tt * 64 + kg * 8), kb2 = *(const LAS f32x4*)(K1 + tt * 64 + kg * 8 + 4);
                const float vt = V[tt * 64 + lane];
                const f32x2 vt2 = {vt, vt};
                const f32x2 f2[4] = {{fa.x, fa.y}, {fa.z, fa.w}, {fb.x, fb.y}, {fb.z, fb.w}};
                const f32x2 k2[4] = {{ka.x, ka.y}, {ka.z, ka.w}, {kb2.x, kb2.y}, {kb2.z, kb2.w}};
#pragma unroll
                for (int j = 0; j < 4; ++j) s2[j] = f2[j] * s2[j] + k2[j] * vt2;
                if (FINAL) {
                    const f32x4 qa = *(const LAS f32x4*)(Q + tt * 64 + kg * 8), qb2 = *(const LAS f32x4*)(Q + tt * 64 + kg * 8 + 4);
                    const f32x2 q2[4] = {{qa.x, qa.y}, {qa.z, qa.w}, {qb2.x, qb2.y}, {qb2.z, qb2.w}};
                    f32x2 o2 = q2[0] * s2[0];
#pragma unroll
                    for (int j = 1; j < 4; ++j) o2 = q2[j] * s2[j] + o2;
                    OP[(t16 * 8 + kg) * 64 + lane] = o2.x + o2.y;
                }
            }
            if (FINAL) {
                __syncthreads();
#pragma unroll
                for (int w2 = 0; w2 < 2; ++w2) { const int t16 = kg * 2 + w2; float o = 0.f;
#pragma unroll
                    for (int g8 = 0; g8 < 8; ++g8) o += OP[(t16 * 8 + g8) * 64 + lane];
                    const float ss = wave_sum(o * o), rstd = rsqrtf(ss * (1.f / 64.f) + EPS);
                    const size_t row = row0 + ch * 64 + sub * 16 + t16;
                    const float hg = bf2f(y[row * NY + 2304 + h * 64 + lane]);
                    ((bf16_t*)(ws + WS_CAT))[row * DM + 512 + h * 64 + lane] = f2bf1(o * rstd * hg * sigmoidf_(hg)); }
                __syncthreads();
            }
        }
        __syncthreads();
    }
    if (!FINAL) {
        float* U = (float*)(ws + WS_HU); float* Dd = (float*)(ws + WS_HD);
#pragma unroll
        for (int j = 0; j < 4; ++j) { U[(size_t)unit * 4096 + (kg * 8 + 2 * j) * 64 + lane] = s2[j].x; U[(size_t)unit * 4096 + (kg * 8 + 2 * j + 1) * 64 + lane] = s2[j].y; }
        dpl[kg * 64 + lane] = dprod;
        __syncthreads();
        if (tid < 64) { float d = 1.f;
#pragma unroll
            for (int w = 0; w < 8; ++w) d *= dpl[w * 64 + tid];
            Dd[unit * 64 + tid] = d; }
    }
    __syncthreads();
}

__device__ __forceinline__ void conv_unit(const Params& p, LAS unsigned char* lds, int l, int unit) {
    int tid = threadIdx.x; asm volatile("" : "+v"(tid));
    const int lane = tid & 63, wave = tid >> 6;
    unsigned char* ws = p.ws; asm volatile("" : "+s"(ws));
    const bf16_t* y = (const bf16_t*)(ws + WS_R1);
    LAS float* A = (LAS float*)lds; LAS float* Y = (LAS float*)(lds + 65536);
    const int row0 = unit * 32, b = row0 / SEQ, t0 = row0 % SEQ;
    { u32x4 cu[4], cg[4];
#pragma unroll
        for (int q = 0; q < 4; ++q) { const int it = tid + NTHR * q, j = it >> 5, c8 = (it & 31) * 8, t = t0 - 30 + j;
            cu[q] = (u32x4){0u, 0u, 0u, 0u}; cg[q] = cu[q];
            if (it < 62 * 32 && t >= 0) { const bf16_t* yr = y + ((size_t)b * SEQ + t) * NY; cu[q] = *(const u32x4*)(yr + 2560 + c8); cg[q] = *(const u32x4*)(yr + 2816 + c8); } }
#pragma unroll
        for (int q = 0; q < 4; ++q) { const int it = tid + NTHR * q, j = it >> 5, c8 = (it & 31) * 8;
            if (it < 62 * 32) { f32x4 a0, a1;
#pragma unroll
                for (int e = 0; e < 4; ++e) { const float u0 = bf2f(cu[q][e] & 0xffffu), u1 = bf2f(cu[q][e] >> 16), g0 = bf2f(cg[q][e] & 0xffffu), g1 = bf2f(cg[q][e] >> 16);
                    const float r0 = u0 * sigmoidf_(g0), r1 = u1 * sigmoidf_(g1);
                    if (e < 2) { a0[2 * e] = r0; a0[2 * e + 1] = r1; } else { a1[2 * (e - 2)] = r0; a1[2 * (e - 2) + 1] = r1; } }
                *(LAS f32x4*)(A + j * 256 + c8) = a0; *(LAS f32x4*)(A + j * 256 + c8 + 4) = a1; } } }
    __syncthreads();
    { const int c = tid & 255, th = tid >> 8; float w[31];
#pragma unroll
        for (int j = 0; j < 31; ++j) w[j] = PIN(8)[(l * 31 + j) * 256 + c];
        const float bias = PIN(9)[l * 256 + c];
        for (int tl = th * 16; tl < th * 16 + 16; ++tl) { float a = bias;
#pragma unroll
            for (int j = 0; j < 31; ++j) a += w[j] * A[(tl + j) * 256 + c];
            Y[tl * 256 + c] = a; } }
    __syncthreads();
#pragma unroll 4
    for (int pr = wave * 16; pr < wave * 16 + 16; ++pr) { const int tl = pr >> 2, grp = pr & 3, c = grp * 64 + lane;
        const float v = Y[tl * 256 + c], mean = wave_sum(v) * (1.f / 64.f), ex2 = wave_sum(v * v) * (1.f / 64.f), var = fmaxf(ex2 - mean * mean, 0.f);
        const float yn = (v - mean) * rsqrtf(var + EPS) * PIN(10)[l * 256 + c] + PIN(11)[l * 256 + c];
        ((bf16_t*)(ws + WS_CAT))[(size_t)(row0 + tl) * DM + 768 + c] = f2bf1(yn * sigmoidf_(yn)); }
    __syncthreads();
}

__device__ __forceinline__ void phase_p2a(const Params& p, LAS unsigned char* lds, int l, int bid, int G) {
    int tid = threadIdx.x; asm volatile("" : "+v"(tid));
    const int lane = tid & 63, wave = tid >> 6;
    unsigned char* ws = p.ws; asm volatile("" : "+s"(ws));
    for (int sr = 0; sr < SUBR(1); ++sr)
    for (int bh = bid; bh < 16; bh += G) { const int b = bh >> 3, h = bh & 7;
        const float* lf = (const float*)(ws + WS_LOGF) + (size_t)b * SEQ * 8 + h;
        float v[16]; float run = 0.f;
#pragma unroll
        for (int i = 0; i < 16; ++i) { run += lf[(size_t)(tid * 16 + i) * 8]; v[i] = run; }
        float incl = run;
#pragma unroll
        for (int o = 1; o < 64; o <<= 1) { const float t = __int_as_float(__builtin_amdgcn_ds_bpermute(((lane - o) & 63) * 4, __float_as_int(incl))); if (lane >= o) incl += t; }
        LAS float* wt = (LAS float*)lds;
        if (lane == 63) wt[wave] = incl;
        __syncthreads();
        float base = incl - run;
        for (int w = 0; w < wave; ++w) base += wt[w];
        float* c = (float*)(ws + WS_CFOX) + (size_t)bh * SEQ + tid * 16;
#pragma unroll
        for (int i = 0; i < 16; ++i) c[i] = base + v[i];
        __syncthreads();
    }
    for (int sr = 0; sr < SUBR(2); ++sr) for (int u = bid; u < 512; u += G) conv_unit(p, lds, l, u);
    for (int sr = 0; sr < SUBR(3); ++sr) for (int u = bid; u < 256; u += G) if ((u & 31) != 31) hgrn_unit<false>(p, lds, l, u);
    for (int sr = 0; sr < SUBR(4); ++sr) { const bf16_t* y = (const bf16_t*)(ws + WS_R1); unsigned* ctl = (unsigned*)(ws + WS_CTL);
        const int gw = bid * NWAVES + wave, NGW = G * NWAVES, rpw = (NTOK + NGW - 1) / NGW;
        float mq = 0.f, mk = 0.f; int curb = -1;
        const int rbeg = gw * rpw, rend = ((gw + 1) * rpw < NTOK) ? (gw + 1) * rpw : NTOK;
        for (int row0 = rbeg; row0 < rend; row0 += 4) {
            u32x4 qa[4], ka[4];
#pragma unroll
            for (int q = 0; q < 4; ++q) { const int row = (row0 + q < rend) ? row0 + q : rend - 1; qa[q] = *(const u32x4*)(y + (size_t)row * NY + lane * 8); ka[q] = *(const u32x4*)(y + (size_t)row * NY + 512 + lane * 8); }
#pragma unroll
            for (int q = 0; q < 4; ++q) { const int row = (row0 + q < rend) ? row0 + q : rend - 1;
                const int b = row / SEQ;
                if (b != curb) { if (curb >= 0 && (lane & 7) == 0) { atomicMax(&ctl[CW_KQMAX + ((l * 2 + curb) * 8 + (lane >> 3)) * 2], __float_as_uint(mq)); atomicMax(&ctl[CW_KQMAX + ((l * 2 + curb) * 8 + (lane >> 3)) * 2 + 1], __float_as_uint(mk)); } mq = 0.f; mk = 0.f; curb = b; }
                float sq = 0.f, sk = 0.f;
#pragma unroll
                for (int j = 0; j < 4; ++j) { const float a0 = bf2f(qa[q][j] & 0xffffu), a1 = bf2f(qa[q][j] >> 16), k0 = bf2f(ka[q][j] & 0xffffu), k1 = bf2f(ka[q][j] >> 16); sq += a0 * a0 + a1 * a1; sk += k0 * k0 + k1 * k1; }
                sq += swz_xor<1>(sq); sq += swz_xor<2>(sq); sq += swz_xor<4>(sq);
                sk += swz_xor<1>(sk); sk += swz_xor<2>(sk); sk += swz_xor<4>(sk);
                mq = fmaxf(mq, sq); mk = fmaxf(mk, sk); }
        }
        if (curb >= 0 && (lane & 7) == 0) { atomicMax(&ctl[CW_KQMAX + ((l * 2 + curb) * 8 + (lane >> 3)) * 2], __float_as_uint(mq)); atomicMax(&ctl[CW_KQMAX + ((l * 2 + curb) * 8 + (lane >> 3)) * 2 + 1], __float_as_uint(mk)); }
    }
}

__device__ __forceinline__ void attn_unit_simple(const Params& p, int l, int unit) {
    int tid = threadIdx.x; asm volatile("" : "+v"(tid));
    const int lane = tid & 63, wave = tid >> 6;
    unsigned char* ws = p.ws; asm volatile("" : "+s"(ws));
    const int bh = unit >> 4, qb = unit & 15, b = bh >> 3, h = bh & 7;
    const bf16_t* y = (const bf16_t*)(ws + WS_R1);
    const float* cf = (const float*)(ws + WS_CFOX) + (size_t)bh * SEQ;
    const int t = qb * 512 + tid;
    const size_t rowb = (size_t)b * SEQ;
    float q[64], o[64];
    { const u32x4* qr = (const u32x4*)(y + (rowb + t) * NY + h * 64);
#pragma unroll
        for (int i = 0; i < 8; ++i) { const u32x4 a = qr[i];
#pragma unroll
            for (int j = 0; j < 4; ++j) { q[i * 8 + 2 * j] = bf2f(a[j] & 0xffffu); q[i * 8 + 2 * j + 1] = bf2f(a[j] >> 16); } } }
#pragma unroll
    for (int d = 0; d < 64; ++d) o[d] = 0.f;
    const float ct = cf[t] * LOG2E;
    float m = -INFINITY, lsum = 0.f;
    const int twmin = qb * 512 + wave * 64, smax = twmin + 63;
#if FOX_PRUNE
    const unsigned* ctl = (const unsigned*)(ws + WS_CTL);
    const float B2 = sqrtf(__uint_as_float(ctl[CW_KQMAX + ((l * 2 + b) * 8 + h) * 2]) * __uint_as_float(ctl[CW_KQMAX + ((l * 2 + b) * 8 + h) * 2 + 1]));
    const float cmin = cf[twmin] * LOG2E;
#endif
    for (int s = smax; s >= 0; --s) {
        const float cs = cf[s] * LOG2E;
#if FOX_PRUNE
        if (cmin - cs + 2.f * B2 < -44.f) break;
#endif
        const u32x4* kr = (const u32x4*)(y + (rowb + s) * NY + 512 + h * 64);
        float dot = 0.f;
#pragma unroll
        for (int i = 0; i < 8; ++i) { const u32x4 a = kr[i];
#pragma unroll
            for (int j = 0; j < 4; ++j) dot += q[i * 8 + 2 * j] * bf2f(a[j] & 0xffffu) + q[i * 8 + 2 * j + 1] * bf2f(a[j] >> 16); }
        const float sc = dot + ct - cs;
        if (s <= t) {
            if (sc > m) { const float al = __builtin_amdgcn_exp2f(m - sc); lsum *= al;
#pragma unroll
                for (int d = 0; d < 64; ++d) o[d] *= al;
                m = sc; }
            const float pr = __builtin_amdgcn_exp2f(sc - m); lsum += pr;
            const u32x4* vr = (const u32x4*)(y + (rowb + s) * NY + 1024 + h * 64);
#pragma unroll
            for (int i = 0; i < 8; ++i) { const u32x4 a = vr[i];
#pragma unroll
                for (int j = 0; j < 4; ++j) { o[i * 8 + 2 * j] += pr * bf2f(a[j] & 0xffffu); o[i * 8 + 2 * j + 1] += pr * bf2f(a[j] >> 16); } }
        }
    }
    const float inv = 1.f / lsum; float ss = 0.f;
#pragma unroll
    for (int d = 0; d < 64; ++d) { o[d] *= inv; ss += o[d] * o[d]; }
    const float rstd = rsqrtf(ss * (1.f / 64.f) + EPS);
    u32x4* dst = (u32x4*)((bf16_t*)(ws + WS_CAT) + (rowb + t) * DM + h * 64);
#pragma unroll
    for (int i = 0; i < 8; ++i) { u32x4 w; w.x = cvt_pk_bf16(o[i * 8] * rstd, o[i * 8 + 1] * rstd); w.y = cvt_pk_bf16(o[i * 8 + 2] * rstd, o[i * 8 + 3] * rstd); w.z = cvt_pk_bf16(o[i * 8 + 4] * rstd, o[i * 8 + 5] * rstd); w.w = cvt_pk_bf16(o[i * 8 + 6] * rstd, o[i * 8 + 7] * rstd); dst[i] = w; }
}

typedef float f32x16 __attribute__((ext_vector_type(16)));
constexpr int AT_KP = 144, AT_VP = 136, AT_BUF = 18432;
__device__ __forceinline__ void attn_unit_mfma(const Params& p, LAS unsigned char* lds, int l, int unit) {
    int tid = threadIdx.x; asm volatile("" : "+v"(tid));
    const int lane = tid & 63, wave = __builtin_amdgcn_readfirstlane(tid >> 6), r32 = lane & 31, hi = lane >> 5;
    unsigned char* ws = p.ws;
    const int bh = unit >> 5, qb = unit & 31, b = bh >> 3, h = bh & 7, q0 = qb * 256, qw0 = q0 + wave * 32;
    const bf16_t* y = (const bf16_t*)(ws + WS_R1) + (size_t)b * SEQ * NY;
    const float* cf = (const float*)(ws + WS_CFOX) + (size_t)bh * SEQ;
    bf16x8 qr[4];
    { const bf16_t* qrow = y + (size_t)(qw0 + r32) * NY + h * 64;
#pragma unroll
      for (int d0 = 0; d0 < 4; ++d0) qr[d0] = *(const bf16x8*)(qrow + d0 * 16 + hi * 8); }
    const float cq = cf[qw0 + r32] * LOG2E;
    const unsigned* ctl = (const unsigned*)(ws + WS_CTL);
    const float B2 = sqrtf(__uint_as_float(ctl[CW_KQMAX + ((l * 2 + b) * 8 + h) * 2]) * __uint_as_float(ctl[CW_KQMAX + ((l * 2 + b) * 8 + h) * 2 + 1]));
    const float thr = -44.f - 2.f * B2;
    const float cblk = cf[q0] * LOG2E, cwv = cf[qw0] * LOG2E;
    const int jmax = (q0 + 255) >> 6;
    const int jhi = (qw0 + 31) >> 6;
    int jmin = 0, jlo = 0;
    { int base = jmax;
      for (;;) { const int t = base - lane; const bool nd = (t >= 0) && ((cblk - cf[t >= 0 ? 64 * t + 63 : 0] * LOG2E) >= thr);
          const unsigned long long mk = __ballot(nd); const int n = (mk == ~0ull) ? 64 : (int)__builtin_ctzll(~mk);
          if (n < 64 || base < 64) { jmin = base - n + 1; break; } base -= 64; }
      base = jhi;
      for (;;) { const int t = base - lane; const bool nd = (t >= 0) && ((cwv - cf[t >= 0 ? 64 * t + 63 : 0] * LOG2E) >= thr);
          const unsigned long long mk = __ballot(nd); const int n = (mk == ~0ull) ? 64 : (int)__builtin_ctzll(~mk);
          if (n < 64 || base < 64) { jlo = base - n + 1; break; } base -= 64; }
      jmin = __builtin_amdgcn_readfirstlane(jmin); jlo = __builtin_amdgcn_readfirstlane(jlo); }
    u32x4 kreg, vreg, kreg2, vreg2; float creg = 0.f, creg2 = 0.f;
#define AT_LOAD(j, KR, VR, CR) do { const int kb_ = (j) * 64; \
        KR = *(const u32x4*)(y + (size_t)(kb_ + (tid >> 3)) * NY + 512 + h * 64 + (tid & 7) * 8); \
        VR = *(const u32x4*)(y + (size_t)(kb_ + lane) * NY + 1024 + h * 64 + wave * 8); \
        if (tid < 64) CR = cf[kb_ + tid] * LOG2E; } while (0)
    AT_LOAD(jmax, kreg, vreg, creg);
    kreg2 = kreg; vreg2 = vreg;
    if (jmax - 1 >= jmin) AT_LOAD(jmax - 1, kreg2, vreg2, creg2);
    float m = -INFINITY, lsum = 0.f;
    f32x16 o0, o1;
#pragma unroll
    for (int r = 0; r < 16; ++r) { o0[r] = 0.f; o1[r] = 0.f; }
    for (int j = jmax; j >= jmin; --j) {
        LAS unsigned char* Kb = lds + (j & 1) * AT_BUF; LAS unsigned char* Vb = Kb + 9216; LAS float* cb = (LAS float*)(Kb + 9216 + 8704);
        *(LAS u32x4*)(Kb + (tid >> 3) * AT_KP + (tid & 7) * 16) = kreg;
#pragma unroll
        for (int i = 0; i < 4; ++i) { *(LAS unsigned short*)(Vb + (wave * 8 + 2 * i) * AT_VP + lane * 2) = (unsigned short)(vreg[i] & 0xffffu); *(LAS unsigned short*)(Vb + (wave * 8 + 2 * i + 1) * AT_VP + lane * 2) = (unsigned short)(vreg[i] >> 16); }
        if (tid < 64) cb[tid] = creg;
        __syncthreads();
        kreg = kreg2; vreg = vreg2; creg = creg2;
        if (j - 2 >= jmin) AT_LOAD(j - 2, kreg2, vreg2, creg2);
        const int kb = j * 64;
        if (j >= jlo && j <= jhi) {
            f32x16 p0, p1;
#pragma unroll
            for (int g4 = 0; g4 < 4; ++g4) {
                const f32x4 c0 = *(const LAS f32x4*)(cb + 8 * g4 + 4 * hi), c1 = *(const LAS f32x4*)(cb + 32 + 8 * g4 + 4 * hi);
#pragma unroll
                for (int i = 0; i < 4; ++i) { p0[4 * g4 + i] = cq - c0[i]; p1[4 * g4 + i] = cq - c1[i]; }
            }
#pragma unroll
            for (int d0 = 0; d0 < 4; ++d0) {
                const bf16x8 k0 = *(const LAS bf16x8*)(Kb + r32 * AT_KP + d0 * 32 + hi * 16);
                const bf16x8 k1 = *(const LAS bf16x8*)(Kb + (32 + r32) * AT_KP + d0 * 32 + hi * 16);
                p0 = __builtin_amdgcn_mfma_f32_32x32x16_bf16(k0, qr[d0], p0, 0, 0, 0);
                p1 = __builtin_amdgcn_mfma_f32_32x32x16_bf16(k1, qr[d0], p1, 0, 0, 0);
            }
            if (kb + 63 > qw0) {
                const int qg = qw0 + r32;
#pragma unroll
                for (int r = 0; r < 16; ++r) { const int kg = kb + (r & 3) + 8 * (r >> 2) + 4 * hi; if (kg > qg) p0[r] = -INFINITY; if (kg + 32 > qg) p1[r] = -INFINITY; }
            }
            float rm = fmaxf(p0[0], p1[0]);
#pragma unroll
            for (int r = 1; r < 16; ++r) rm = fmaxf(rm, fmaxf(p0[r], p1[r]));
            rm = x32_max(rm);
            const float mn = fmaxf(m, rm);
            if (__any(mn > m)) {
                const float ms_ = (mn == -INFINITY) ? 0.f : mn;
                const float alpha = __builtin_amdgcn_exp2f(m - ms_);
                lsum *= alpha;
#pragma unroll
                for (int r = 0; r < 16; ++r) { o0[r] *= alpha; o1[r] *= alpha; }
                m = mn;
            }
            const float msafe = (m == -INFINITY) ? 0.f : m;
            float rs = 0.f;
#pragma unroll
            for (int r = 0; r < 16; ++r) { p0[r] = __builtin_amdgcn_exp2f(p0[r] - msafe); p1[r] = __builtin_amdgcn_exp2f(p1[r] - msafe); rs += p0[r] + p1[r]; }
            lsum += rs;
#pragma unroll
            for (int mt = 0; mt < 2; ++mt)
#pragma unroll
                for (int ks = 0; ks < 2; ++ks) {
                    u32x4 pw;
#pragma unroll
                    for (int i = 0; i < 4; ++i) pw[i] = mt ? cvt_pk_bf16(p1[8 * ks + 2 * i], p1[8 * ks + 2 * i + 1]) : cvt_pk_bf16(p0[8 * ks + 2 * i], p0[8 * ks + 2 * i + 1]);
                    const bf16x8 pb = __builtin_bit_cast(bf16x8, pw);
                    const int kbase = 32 * mt + 16 * ks + 4 * hi;
#pragma unroll
                    for (int dt = 0; dt < 2; ++dt) {
                        const LAS unsigned char* vp = Vb + (32 * dt + r32) * AT_VP + kbase * 2;
                        const u32x2 va = *(const LAS u32x2*)vp, vb2 = *(const LAS u32x2*)(vp + 16);
                        const u32x4 vw = {va.x, va.y, vb2.x, vb2.y};
                        const bf16x8 vf = __builtin_bit_cast(bf16x8, vw);
                        if (dt == 0) o0 = __builtin_amdgcn_mfma_f32_32x32x16_bf16(vf, pb, o0, 0, 0, 0); else o1 = __builtin_amdgcn_mfma_f32_32x32x16_bf16(vf, pb, o1, 0, 0, 0);
                    }
                }
        }
    }
#undef AT_LOAD
    lsum = x32_sum(lsum);
    const float inv = 1.f / lsum;
    float ss = 0.f;
#pragma unroll
    for (int r = 0; r < 16; ++r) { o0[r] *= inv; o1[r] *= inv; ss += o0[r] * o0[r] + o1[r] * o1[r]; }
    ss = x32_sum(ss);
    const float rstd = rsqrtf(ss * (1.f / 64.f) + EPS);
    bf16_t* orow = (bf16_t*)(ws + WS_CAT) + ((size_t)b * SEQ + qw0 + r32) * DM + h * 64;
#pragma unroll
    for (int g4 = 0; g4 < 4; ++g4) {
        u32x2 w0, w1;
        w0.x = cvt_pk_bf16(o0[4 * g4] * rstd, o0[4 * g4 + 1] * rstd); w0.y = cvt_pk_bf16(o0[4 * g4 + 2] * rstd, o0[4 * g4 + 3] * rstd);
        w1.x = cvt_pk_bf16(o1[4 * g4] * rstd, o1[4 * g4 + 1] * rstd); w1.y = cvt_pk_bf16(o1[4 * g4 + 2] * rstd, o1[4 * g4 + 3] * rstd);
        *(u32x2*)(orow + 8 * g4 + 4 * hi) = w0; *(u32x2*)(orow + 32 + 8 * g4 + 4 * hi) = w1;
    }
    __syncthreads();
}

__device__ __forceinline__ void phase_route(const Params& p, LAS unsigned char* lds, int l, int bid, int G) {
    int tid = threadIdx.x; asm volatile("" : "+v"(tid));
    const int lane = tid & 63, wave = tid >> 6;
    unsigned char* ws = p.ws; asm volatile("" : "+s"(ws));
    LAS float* wl = (LAS float*)lds;
    LAS int* cls = (LAS int*)(lds + 20 * 4096);
    LAS int* basel = cls + 64;
    for (int i = tid; i < 20 * 1024; i += NTHR) wl[i] = ((const float*)(ws + WS_WR))[l * 20480 + i];
    __syncthreads();
    const float* x = p.out; unsigned* ctl = (unsigned*)(ws + WS_CTL);
    for (int u = bid; u < NTOK / 64; u += G) {
        for (int sr = 0; sr < SUBR(7); ++sr)
        for (int i = 0; i < 8; ++i) {
            const int row = u * 64 + wave * 8 + i;
            const f32x4* xr = (const f32x4*)(x + (size_t)row * 1024) + lane;
            f32x4 v[4]; float ss = 0.f;
#pragma unroll
            for (int j = 0; j < 4; ++j) { v[j] = xr[64 * j]; ss += (v[j].x * v[j].x + v[j].y * v[j].y) + (v[j].z * v[j].z + v[j].w * v[j].w); }
            const float rstd = rsqrtf(wave_sum(ss) * (1.f / 1024.f) + EPS);
            float lg[20];
#pragma unroll
            for (int jj = 0; jj < 20; ++jj) { float s = 0.f;
#pragma unroll
                for (int j = 0; j < 4; ++j) { const f32x4 w = *(const LAS f32x4*)(wl + jj * 1024 + j * 256 + lane * 4); s += v[j].x * w.x + v[j].y * w.y + v[j].z * w.z + v[j].w * w.w; }
                lg[jj] = wave_sum(s) * rstd + (jj < 4 ? PIN(20)[l * 4 + jj] : PIN(22)[l * 16 + jj - 4]); }
            int gi = 0; float gm = lg[0];
#pragma unroll
            for (int j = 1; j < 4; ++j) if (lg[j] > gm) { gm = lg[j]; gi = j; }
            float den = 0.f;
#pragma unroll
            for (int j = 0; j < 4; ++j) den += __expf(lg[j] - gm);
            const float pg = 1.f / den;
            float e[4];
#pragma unroll
            for (int j = 0; j < 4; ++j) e[j] = gi == 0 ? lg[4 + j] : (gi == 1 ? lg[8 + j] : (gi == 2 ? lg[12 + j] : lg[16 + j]));
            int a = 0; float ea = e[0];
#pragma unroll
            for (int j = 1; j < 4; ++j) if (e[j] > ea) { ea = e[j]; a = j; }
            int bq = -1; float eb = -INFINITY;
#pragma unroll
            for (int j = 0; j < 4; ++j) if (j != a && e[j] > eb) { eb = e[j]; bq = j; }
            const float pb = __expf(eb - ea), wa = pg / (1.f + pb), wb = pg * pb / (1.f + pb);
            const int e1 = a < bq ? a : bq, e2 = a < bq ? bq : a;
            const int pi = e1 == 0 ? e2 - 1 : (e1 == 1 ? e2 + 1 : 5);
            if (lane == 0) { cls[wave * 8 + i] = gi * 6 + pi; ((f32x2*)(ws + WS_WTS))[row] = (f32x2){a < bq ? wa : wb, a < bq ? wb : wa}; }
        }
        __syncthreads();
        if (tid < 24) { int n = 0; for (int i = 0; i < 64; ++i) n += (cls[i] == tid); basel[tid] = n ? (int)atomicAdd(&ctl[CW_MOECNT + l * 32 + tid], (unsigned)n) : 0; }
        __syncthreads();
        if (tid < 64) { const int c = cls[tid]; int rank = 0; for (int i = 0; i < tid; ++i) rank += (cls[i] == c); ((int*)(ws + WS_TOKC))[c * 16384 + basel[c] + rank] = u * 64 + tid; }
        __syncthreads();
    }
}

__device__ __forceinline__ void moe_table(const Params& p, volatile LAS int* tab, int l) {
    int tid = threadIdx.x; asm volatile("" : "+v"(tid));
    if (tid < 24) { const unsigned voff = (unsigned)(CW_MOECNT + l * 32 + tid) * 4u; const unsigned* ctl = (const unsigned*)((const char*)p.ws + voff); tab[32 + tid] = (int)__hip_atomic_load(ctl, __ATOMIC_RELAXED, __HIP_MEMORY_SCOPE_AGENT); }
    __syncthreads();
    if (tid == 0) { int pre = 0; for (int c = 0; c < 24; ++c) { tab[c] = pre; pre += (tab[32 + c] + 255) >> 8; } tab[24] = pre; }
    __syncthreads();
}

__device__ __forceinline__ void phase_final(const Params& p, int bid, int G) {
    int tid = threadIdx.x; asm volatile("" : "+v"(tid));
    const int lane = tid & 63, wave = tid >> 6;
    const int gw = bid * NWAVES + wave, NGW = G * NWAVES;
    for (int row = gw; row < NTOK; row += NGW) {
        f32x4* xr = (f32x4*)(p.out + (size_t)row * 1024) + lane; f32x4 v[4]; float s = 0.f;
#pragma unroll
        for (int j = 0; j < 4; ++j) { v[j] = xr[64 * j]; s += (v[j].x * v[j].x + v[j].y * v[j].y) + (v[j].z * v[j].z + v[j].w * v[j].w); }
        const float rstd = rsqrtf(wave_sum(s) * (1.f / 1024.f) + EPS);
#pragma unroll
        for (int j = 0; j < 4; ++j) { const f32x4 gg = ((const f32x4*)PIN(26))[64 * j + lane]; xr[64 * j] = (f32x4){v[j].x * rstd * gg.x, v[j].y * rstd * gg.y, v[j].z * rstd * gg.z, v[j].w * rstd * gg.w}; }
    }
}

constexpr int N_PHASES = 3 + 9 * NLAYER + 1;
__global__ void __launch_bounds__(NTHR, 2) mk_fwd(Params p) {
    extern __shared__ __attribute__((aligned(16))) unsigned char lds_raw[];
    LAS unsigned char* lds = (LAS unsigned char*)lds_raw;
    volatile LAS unsigned* MISC = (volatile LAS unsigned*)(lds + LDS_MISC);
    const int tid = threadIdx.x;
    const int G = gridDim.x, bid = blockIdx.x;
    unsigned char* ws = p.ws; asm volatile("" : "+s"(ws));
    for (int u = tid; u < 256; u += NTHR) MISC[u] = 0u;
    __syncthreads();
    const int lo = p.ph_lo, hi = p.ph_hi;
    const bool use_bar = (hi - lo) > 1;
    XcdBarrier bar; bar.bar = (unsigned*)(ws + WS_CTL) + CW_BAR; bar.x = 0; bar.st = MISC + 8;
    if (use_bar) bar = xcd_barrier_post((unsigned*)(ws + WS_CTL) + CW_BAR, MISC + 8);
#define IN(k) (lo <= (k) && (k) < hi)
#define SEAM(k) do { if ((k) + 1 < hi) xcd_barrier(bar); } while (0)
    const float* ssq = (const float*)(ws + WS_SSQ);
    bf16_t* xb = (bf16_t*)(ws + WS_XB);

    if (PHON(0) && IN(0)) { phase_pro_a(p, lds, bid, G); SEAM(0); }
    if (PHON(1) && IN(1)) {
        SchedKV S{G, bid, (const char*)(ws + WS_MEMN), (const char*)(ws + WS_WKVT)};
        EpiBf16 E{(bf16_t*)(ws + WS_KV), 2048, nullptr};
        pg8::gemm_phase<EpiBf16, SchedKV, false, false, false>(lds, GemmDesc{1024, 2048u, 2048u, 0}, S, E);
        SEAM(1);
    }
    if (PHON(2) && IN(2)) {
        { SchedQK S{G, bid, (const char*)(ws + WS_KV), (const char*)(ws + WS_WQS)};
          EpiBf16 E{(bf16_t*)(ws + WS_WQK), 1024, nullptr};
          pg8::gemm_phase<EpiBf16, SchedQK, false, false, false>(lds, GemmDesc{256, 4096u, 2048u, 0}, S, E); }
        { SchedVO S{G, bid, (const char*)(ws + WS_KV), (const char*)(ws + WS_WOT)};
          EpiBf16 E{(bf16_t*)(ws + WS_WVO), 1024, nullptr};
          pg8::gemm_phase<EpiBf16, SchedVO, false, false, false>(lds, GemmDesc{256, 2048u, 4096u, 0}, S, E); }
        SEAM(2);
    }
    for (int l = 0; l < NLAYER; ++l) {
        const int pb = 3 + 9 * l;
        if (!(lo < pb + 9 && pb < hi)) continue;
        if (PHON(3) && IN(pb + 0)) {
            SchedGrid S{64, 12, 768, G, bid, (const char*)xb, (const char*)(ws + WS_WIN) + (size_t)l * 3072 * 2048, (size_t)256 * 2048, (size_t)256 * 2048, 0, NY};
            EpiBf16 E{(bf16_t*)(ws + WS_R1), NY, ssq};
            pg8::gemm_phase<EpiBf16, SchedGrid, false, false, false>(lds, GemmDesc{1024, 2048u, 2048u, 0}, S, E);
            for (int sr = 0; sr < SUBR(0); ++sr) phase_logf(p, lds, l, bid, G);
            SEAM(pb + 0);
        }
        if (PHON(4) && IN(pb + 1)) { phase_p2a(p, lds, l, bid, G); SEAM(pb + 1); }
        if (PHON(5) && IN(pb + 2)) {
            for (int sr = 0; sr < SUBR(5); ++sr) for (int u = bid; u < 256; u += G) hgrn_unit<true>(p, lds, l, u);
#if ATTN_MFMA
            for (int sr = 0; sr < SUBR(6); ++sr) for (int u = bid; u < 512; u += G) attn_unit_mfma(p, lds, l, u);
#else
            for (int u = bid; u < 256; u += G) attn_unit_simple(p, l, u);
#endif
            SEAM(pb + 2);
        }
        if (PHON(6) && IN(pb + 3)) {
            SchedGrid S{64, 4, 256, G, bid, (const char*)(ws + WS_CAT), (const char*)(ws + WS_WOUT) + (size_t)l * 1024 * 2048, (size_t)256 * 2048, (size_t)256 * 2048, 0, DM};
            EpiResidual E{l == 0 ? PIN(0) : p.out, p.out, xb, (float*)(ws + WS_SSQ)};
            pg8::gemm_phase<EpiResidual, SchedGrid, false, false, false>(lds, GemmDesc{1024, 2048u, 2048u, 0}, S, E);
            SEAM(pb + 3);
        }
        if (PHON(7) && IN(pb + 4)) {
            SchedGrid S{64, 4, 256, G, bid, (const char*)xb, (const char*)(ws + WS_WQK) + (size_t)l * 2 * 1024 * 2048, (size_t)256 * 2048, (size_t)256 * 2048, (size_t)1024 * 2048, DM};
            EpiSoftmax E{(bf16_t*)(ws + WS_PBUF), ssq, (LAS float*)(lds + LDS_EPI)};
            pg8::gemm_phase<EpiSoftmax, SchedGrid, true, false, false>(lds, GemmDesc{1024, 2048u, 2048u, 0}, S, E);
            SEAM(pb + 4);
        }
        if (PHON(8) && IN(pb + 5)) {
            SchedGrid S{64, 4, 256, G, bid, (const char*)(ws + WS_PBUF), (const char*)(ws + WS_WVO) + (size_t)l * 2 * 1024 * 2048, (size_t)256 * 2048, (size_t)256 * 2048, (size_t)1024 * 2048, DM};
            EpiResidual E{p.out, p.out, xb, (float*)(ws + WS_SSQ)};
            pg8::gemm_phase<EpiResidual, SchedGrid, false, false, false>(lds, GemmDesc{1024, 2048u, 2048u, 0}, S, E);
            SEAM(pb + 5);
        }
        if (PHON(9) && IN(pb + 6)) { phase_route(p, lds, l, bid, G); SEAM(pb + 6); }
        if (PHON(10) && IN(pb + 7)) {
            volatile LAS int* tab = (volatile LAS int*)(MISC + 16);
            moe_table(p, tab, l);
            SchedMoe S{G, bid, false, tab, (const int*)(ws + WS_TOKC), (const char*)xb, (const char*)(ws + WS_WGU) + (size_t)l * 16 * 512 * 2048};
            EpiMoeUp E{(bf16_t*)(ws + WS_HID), (const int*)(ws + WS_TOKC), ssq, (const f32x2*)(ws + WS_WTS)};
            pg8::gemm_phase<EpiMoeUp, SchedMoe, false, true, false>(lds, GemmDesc{1024, 2048u, 2048u, 0}, S, E);
            SEAM(pb + 7);
        }
        if (PHON(11) && IN(pb + 8)) {
            volatile LAS int* tab = (volatile LAS int*)(MISC + 16);
            moe_table(p, tab, l);
            SchedMoe S{G, bid, true, tab, (const int*)(ws + WS_TOKC), (const char*)(ws + WS_HID), (const char*)(ws + WS_WD) + (size_t)l * 16 * 1024 * 512};
            EpiMoeDown E{p.out, xb, (float*)(ws + WS_SSQ), (const int*)(ws + WS_TOKC)};
            pg8::gemm_phase<EpiMoeDown, SchedMoe, false, false, true>(lds, GemmDesc{512, 1024u, 512u, 4}, S, E);
            SEAM(pb + 8);
        }
    }
    if (IN(N_PHASES - 1)) phase_final(p, bid, G);
#undef IN
#undef SEAM
}

extern "C" void kernel_launch(void* const* d_in, const int* in_sizes, int n_in, void* d_out, int out_size, void* d_ws, size_t ws_size, hipStream_t stream) {
    static int grid = 0;
    if (grid == 0) {
        if (n_in != 27 || out_size != NTOK * DM || ws_size < WS_END) { fprintf(stderr, "kernel_launch: unexpected shapes (n_in %d out %d ws %zu)\n", n_in, out_size, ws_size); grid = -1; return; }
        int dev = 0, cus = 0, per_cu = 0;
        if (hipGetDevice(&dev) != hipSuccess || hipDeviceGetAttribute(&cus, hipDeviceAttributeMultiprocessorCount, dev) != hipSuccess) { grid = -1; return; }
        if (hipFuncSetAttribute((const void*)mk_fwd, hipFuncAttributeMaxDynamicSharedMemorySize, LDS_BYTES) != hipSuccess) { fprintf(stderr, "kernel_launch: hipFuncSetAttribute failed\n"); grid = -1; return; }
        if (hipOccupancyMaxActiveBlocksPerMultiprocessor(&per_cu, (const void*)mk_fwd, NTHR, LDS_BYTES) != hipSuccess || per_cu < 1) { fprintf(stderr, "kernel_launch: occupancy query reports %d\n", per_cu); }
        (void)hipGetLastError();
        grid = cus;
    }
    if (grid < 0) return;
    (void)hipMemsetAsync((char*)d_ws + WS_CTL, 0, CTL_ZERO_BYTES, stream);
    Params a{};
    for (int i = 0; i < 27; ++i) a.in[i] = (const float*)d_in[i];
    a.out = (float*)d_out; a.ws = (unsigned char*)d_ws;
#if ONE_LAUNCH
    a.ph_lo = 0; a.ph_hi = N_PHASES;
    hipLaunchKernelGGL(mk_fwd, dim3(grid), dim3(NTHR), LDS_BYTES, stream, a);
#else
    for (int k = 0; k < N_PHASES; ++k) { a.ph_lo = k; a.ph_hi = k + 1; const int kind = k < 3 ? k : (k == N_PHASES - 1 ? 12 : 3 + (k - 3) % 9);
        for (int rr = 0; rr < RUNS(kind); ++rr) hipLaunchKernelGGL(mk_fwd, dim3(grid), dim3(NTHR), LDS_BYTES, stream, a); }
#endif
}
```

```cpp
#include <hip/hip_runtime.h>
#include <cstdio>
#include <cstdint>

#ifndef USE_MFMA
#define USE_MFMA 1
#endif
#ifndef ONE_LAUNCH
#define ONE_LAUNCH 1
#endif
#ifndef DIS
#define DIS 0
#endif
#define PHON(k) (!(((DIS) >> (k)) & 1))
#ifndef REP
#define REP 0
#endif
#define RUNS(k) ((((REP) >> (k)) & 1) ? 2 : 1)
#ifndef SREP
#define SREP 0
#endif
#define SUBR(k) ((((SREP) >> (k)) & 1) ? 2 : 1)
#ifndef ATTN_MFMA
#define ATTN_MFMA 1
#endif
#ifndef PROBE_ID
#define PROBE_ID 0
#endif
#define PROBE_AMP 4
#if PROBE_ID
#define QB_(id) do { if (PROBE_ID == (id) && threadIdx.x == 0) ((volatile __attribute__((address_space(3))) unsigned long long*)(lds + 131072 + 8192 + 512))[1] = __builtin_amdgcn_s_memrealtime(); } while (0)
#define QE_(id) do { if (PROBE_ID == (id) && threadIdx.x == 0) { volatile __attribute__((address_space(3))) unsigned long long* tp_ = (volatile __attribute__((address_space(3))) unsigned long long*)(lds + 131072 + 8192 + 512); tp_[0] = tp_[0] + (__builtin_amdgcn_s_memrealtime() - tp_[1]); } } while (0)
#else
#define QB_(id) do {} while (0)
#define QE_(id) do {} while (0)
#endif
#ifndef FOX_PRUNE
#define FOX_PRUNE 1
#endif

#define LAS __attribute__((address_space(3)))
#define GAS __attribute__((address_space(1)))
typedef unsigned short bf16_t;
typedef short bf16x8 __attribute__((ext_vector_type(8)));
typedef float f32x4 __attribute__((ext_vector_type(4)));
typedef float f32x2 __attribute__((ext_vector_type(2)));
typedef unsigned u32x4 __attribute__((ext_vector_type(4)));
typedef unsigned u32x2 __attribute__((ext_vector_type(2)));

constexpr int NTOK = 16384, DM = 1024, SEQ = 8192, NLAYER = 4, NY = 3072;
constexpr float EPS = 1e-6f, LOG2E = 1.4426950408889634f;
constexpr float C2 = 0.125f * LOG2E;
constexpr int NWAVES = 8, NTHR = 512;

constexpr size_t MiB = 1u << 20;
constexpr size_t WS_CTL = 0, CTL_ZERO_BYTES = 64 * 1024;
constexpr size_t WS_WFFB = 1 * MiB + 640 * 1024;
constexpr size_t WS_WRH = 1 * MiB;
constexpr size_t WS_WRL = 1 * MiB + 256 * 1024;
constexpr size_t WS_LOGF = 2 * MiB;
constexpr size_t WS_CFOX = 2 * MiB + 512 * 1024;
constexpr size_t WS_SSQ = 3 * MiB;
constexpr size_t WS_HU = 4 * MiB;
constexpr size_t WS_HD = 8 * MiB;
constexpr size_t WS_TOKC = 9 * MiB;
constexpr size_t WS_WTS = 10 * MiB + 512 * 1024;
constexpr size_t WS_MEMN = 11 * MiB;
constexpr size_t WS_KV = 12 * MiB;
constexpr size_t WS_WIN = 20 * MiB;
constexpr size_t WS_WOUT = 44 * MiB;
constexpr size_t WS_WQK = 52 * MiB;
constexpr size_t WS_WVO = 68 * MiB;
constexpr size_t WS_WGU = 84 * MiB;
constexpr size_t WS_WD = 148 * MiB;
constexpr size_t WS_XB = 180 * MiB;
constexpr size_t WS_CAT = 212 * MiB;
constexpr size_t WS_R1 = 244 * MiB;
constexpr size_t WS_PBUF = WS_R1;
constexpr size_t WS_HID = WS_R1 + 32 * MiB;
constexpr size_t WS_WQS = WS_R1;
constexpr size_t WS_WKVT = WS_R1 + 8 * MiB;
constexpr size_t WS_WOT = WS_R1 + 24 * MiB;
constexpr size_t WS_END = 340 * MiB;

constexpr int CW_TMO = 0, CW_KQMAX = 256, CW_MOECNT = 512, CW_ATTQ = 640, CW_MOESYNC = 704, CW_BAR = 4096;

constexpr int LDS_STAGE = 0, LDS_STAGE_BYTES = 131072;
constexpr int LDS_EPI = 131072;
constexpr int LDS_MISC = 131072 + 8192;
constexpr int LDS_RSTD = 131072 + 8192 + 1024;
constexpr int LDS_BYTES = 131072 + 8192 + 1024 + 4096;

__device__ __forceinline__ float bf2f(unsigned b) { return __uint_as_float(b << 16); }
typedef __bf16 bf16x2_t __attribute__((ext_vector_type(2)));
__device__ __forceinline__ unsigned cvt_pk_bf16(float lo, float hi) { const f32x2 v = {lo, hi}; const bf16x2_t b = __builtin_convertvector(v, bf16x2_t); return __builtin_bit_cast(unsigned, b); }
__device__ __forceinline__ unsigned short f2bf1(float f) { return (unsigned short)(cvt_pk_bf16(f, 0.f) & 0xffffu); }
template <int K> __device__ __forceinline__ float swz_xor(float v) { return __int_as_float(__builtin_amdgcn_ds_swizzle(__float_as_int(v), (K << 10) | 0x1f)); }
__device__ __forceinline__ float x16_sum(float v) { auto r = __builtin_amdgcn_permlane16_swap(__float_as_uint(v), __float_as_uint(v), false, false); return __uint_as_float(r[0]) + __uint_as_float(r[1]); }
__device__ __forceinline__ float x16_max(float v) { auto r = __builtin_amdgcn_permlane16_swap(__float_as_uint(v), __float_as_uint(v), false, false); return fmaxf(__uint_as_float(r[0]), __uint_as_float(r[1])); }
__device__ __forceinline__ float x32_sum(float v) { auto r = __builtin_amdgcn_permlane32_swap(__float_as_uint(v), __float_as_uint(v), false, false); return __uint_as_float(r[0]) + __uint_as_float(r[1]); }
__device__ __forceinline__ float x32_max(float v) { auto r = __builtin_amdgcn_permlane32_swap(__float_as_uint(v), __float_as_uint(v), false, false); return fmaxf(__uint_as_float(r[0]), __uint_as_float(r[1])); }
template <int CTRL> __device__ __forceinline__ float dpp_f(float v) { return __int_as_float(__builtin_amdgcn_update_dpp(0, __float_as_int(v), CTRL, 0xf, 0xf, true)); }
__device__ __forceinline__ float wave_sum(float v) {
    v += dpp_f<0xB1>(v); v += dpp_f<0x4E>(v); v += dpp_f<0x141>(v); v += dpp_f<0x140>(v); v = x16_sum(v);
    return x32_sum(v);
}
__device__ __forceinline__ float sigmoidf_(float x) { return __builtin_amdgcn_rcpf(1.f + __expf(-x)); }
#define LDS_WAIT() asm volatile("s_waitcnt lgkmcnt(0)" ::: "memory")
#define LDS_BARRIER() asm volatile("s_waitcnt lgkmcnt(0)\n\ts_barrier" ::: "memory")
#define VM_WAIT() asm volatile("s_waitcnt vmcnt(0)" ::: "memory")

#define XB_TMO      128
#define XB_XCNT(j)  (256  + 64 * (j))
#define XB_XSUB(j)  (1280 + 64 * (j))
#define XB_XGEN(j)  (2304 + 64 * (j))
#define XB_TOP      3328
#define XB_TOPGEN   3392
#define XCD_BAR_WORDS 3456
#define XB_SPIN_CAP (1u << 22)
__device__ __forceinline__ unsigned xb_ld(unsigned* p)              { return __hip_atomic_load(p, __ATOMIC_RELAXED, __HIP_MEMORY_SCOPE_AGENT); }
__device__ __forceinline__ unsigned xb_add(unsigned* p, unsigned v) { return __hip_atomic_fetch_add(p, v, __ATOMIC_RELAXED, __HIP_MEMORY_SCOPE_AGENT); }
__device__ __forceinline__ unsigned xb_xcc_id() { return (unsigned)__builtin_amdgcn_s_getreg((3 << 11) | 20) & 0xFu; }
#define XB_SPIN(cond, bar) do { unsigned _sp = 0; while (cond) { __builtin_amdgcn_s_sleep(1); \
    if ((++_sp & 255u) == 0u) { if (xb_ld(&(bar)[XB_TMO])) break; if (_sp > XB_SPIN_CAP) { atomicAdd(&(bar)[XB_TMO], 1u); break; } } } } while (0)
struct XcdBarrier { unsigned* bar; unsigned x; volatile LAS unsigned* st; };
__device__ __forceinline__ XcdBarrier xcd_barrier_post(unsigned* bar, volatile LAS unsigned* st) {
    XcdBarrier b; b.bar = bar; b.x = xb_xcc_id(); b.st = st;
    if (threadIdx.x == 0) (void)xb_add(&bar[XB_XCNT(b.x)], 1u);
    return b;
}
__device__ __forceinline__ void xcd_barrier_complete(unsigned* bar, unsigned x, unsigned& nloc, unsigned& nx) {
    const unsigned G = gridDim.x * gridDim.y * gridDim.z;
    unsigned sum, cnt, mine, sp = 0u;
    for (;;) {
        sum = 0u; cnt = 0u; mine = 0u;
#pragma unroll
        for (unsigned j = 0; j < 16; ++j) { const unsigned c = xb_ld(&bar[XB_XCNT(j)]); sum += c; cnt += (c > 0u) ? 1u : 0u; mine = (j == x) ? c : mine; }
        if (sum == G) break;
        __builtin_amdgcn_s_sleep(1);
        if ((++sp & 255u) == 0u) { if (xb_ld(&bar[XB_TMO])) break; if (sp > XB_SPIN_CAP) { atomicAdd(&bar[XB_TMO], 1u); break; } }
    }
    nloc = mine > 0u ? mine : 1u; nx = cnt > 0u ? cnt : 1u;
}
__device__ __forceinline__ void xcd_barrier(const XcdBarrier& b) {
    asm volatile("s_waitcnt vmcnt(0)" ::: "memory");
    __syncthreads();
    if (threadIdx.x == 0) {
        unsigned* bar = b.bar;
        __builtin_amdgcn_s_waitcnt(0);
        unsigned nloc = b.st[0], nx = b.st[1];
        if (nloc == 0u) { xcd_barrier_complete(bar, b.x, nloc, nx); b.st[0] = nloc; b.st[1] = nx; }
        const unsigned old = xb_add(&bar[XB_XSUB(b.x)], 1u);
        const unsigned gen = old / nloc;
        if (old + 1u == (gen + 1u) * nloc) {
            __builtin_amdgcn_fence(__ATOMIC_RELEASE, "agent");
            asm volatile("s_waitcnt vmcnt(0)" ::: "memory");
            const unsigned og = xb_add(&bar[XB_TOP], 1u);
            const unsigned tg = og / nx;
            if (og + 1u == (tg + 1u) * nx) xb_add(&bar[XB_TOPGEN], 1u);
            else XB_SPIN(xb_ld(&bar[XB_TOPGEN]) == tg, bar);
            __builtin_amdgcn_fence(__ATOMIC_ACQUIRE, "agent");
            xb_add(&bar[XB_XGEN(b.x)], 1u);
            asm volatile("s_waitcnt vmcnt(0)" ::: "memory");
        } else {
            XB_SPIN(xb_ld(&bar[XB_XGEN(b.x)]) == gen, bar);
            __builtin_amdgcn_fence(__ATOMIC_ACQUIRE, "agent");
            asm volatile("s_waitcnt vmcnt(0)" ::: "memory");
        }
    }
    __syncthreads();
}

namespace pg8 {
constexpr int BM = 256, BK = 64, HALF = 128, HTB = HALF * BK * 2;
__host__ __device__ __forceinline__ int lds_byte(int r, int c) { const int st = (r >> 4) * 2 + (c >> 5), rr = r & 15, cc = c & 31, ob = rr * 64 + cc * 2; return st * 1024 + (ob ^ (((ob >> 9) & 1) << 5)); }
__host__ __device__ __forceinline__ void stage_rc(int b, int& R, int& C) { const int st = b / 1024, sb = b % 1024, swz = sb ^ (((sb >> 9) & 1) << 5); R = (st >> 1) * 16 + swz / 64; C = (st & 1) * 32 + (swz % 64) / 2; }
__host__ __device__ __forceinline__ int perm32(int rho) { const int n = rho >> 4, i = rho & 15; return 8 * (i >> 2) + 4 * n + (i & 3); }

struct Unit { int pm, pn, a0, a1, a2, a3, ord; };
struct GemmDesc { int K; unsigned lda, ldb; int ksplit; };


#if USE_MFMA
template <class Epi, class Sched, bool ALIGN_EPI, bool GATHER, bool BSPLIT>
__device__ __forceinline__ void gemm_phase(LAS unsigned char* lds, const GemmDesc g, const Sched& S, const Epi& E) {
    int tid = threadIdx.x; asm volatile("" : "+v"(tid));
    const int wid = __builtin_amdgcn_readfirstlane(tid >> 6), lane = tid & 63, wr = wid >> 2, wc = wid & 3, fr = lane & 15, fq = lane >> 4;
    const int nt = g.K / BK;
    int R0, C0; stage_rc(tid * 16, R0, C0);
    const unsigned voffB = (unsigned)((R0 & ~31) + perm32(R0 & 31)) * g.ldb + (unsigned)C0 * 2u, voffA = (unsigned)R0 * g.lda + (unsigned)C0 * 2u;
    const size_t qstepA = (size_t)64 * g.lda, qstepB = (size_t)64 * g.ldb;
    const size_t kstep = (size_t)(BK * 2);
    const size_t hstepB = (size_t)HALF * g.ldb, hstepA = GATHER ? (size_t)0 : (size_t)HALF * g.lda;
    const unsigned ldsw = (unsigned)wid * 1024u;
    const int aoff = lds_byte(wr * 64 + fr, fq * 8), boff = lds_byte(wc * 32 + fr, fq * 8);
#define PG8_SA(b, h) (((b) * 2 + (h)) * HTB)
#define PG8_SB(b, h) ((4 + (b) * 2 + (h)) * HTB)
#define PG8_STAGE(bufoff, gbase, voff) do { _Pragma("unroll") for (int _i = 0; _i < 2; ++_i) \
        __builtin_amdgcn_global_load_lds((const unsigned*)((const char*)(gbase) + (voff)[_i]), (LAS unsigned*)(lds + (bufoff) + ldsw + _i * 8192), 16, 0, 0); } while (0)
#define PG8_STAGE1(bufoff, gbase, voff, qstep) do { _Pragma("unroll") for (int _i = 0; _i < 2; ++_i) \
        __builtin_amdgcn_global_load_lds((const unsigned*)((const char*)(gbase) + _i * (qstep) + (voff)), (LAS unsigned*)(lds + (bufoff) + ldsw + _i * 8192), 16, 0, 0); } while (0)
#define PG8_STAGE_B(bufoff, gbase) PG8_STAGE1(bufoff, gbase, voffB, qstepB)
#define PG8_LDA(dst, b, h) do { _Pragma("unroll") for (int m = 0; m < 4; ++m) _Pragma("unroll") for (int k = 0; k < 2; ++k) dst[m][k] = *(const LAS bf16x8*)(lds + PG8_SA(b, h) + aoff + m * 2048 + k * 1024); } while (0)
#define PG8_LDB(dst, b, h) do { _Pragma("unroll") for (int n = 0; n < 2; ++n) _Pragma("unroll") for (int k = 0; k < 2; ++k) dst[n][k] = *(const LAS bf16x8*)(lds + PG8_SB(b, h) + boff + n * 2048 + k * 1024); } while (0)
#define PG8_MMA(ai, bj, At, Bt) do { __builtin_amdgcn_s_setprio(1); _Pragma("unroll") for (int m = 0; m < 4; ++m) _Pragma("unroll") for (int n = 0; n < 2; ++n) _Pragma("unroll") for (int k = 0; k < 2; ++k) \
        acc[ai][bj][m][n] = __builtin_amdgcn_mfma_f32_16x16x32_bf16(Bt[n][k], At[m][k], acc[ai][bj][m][n], 0, 0, 0); __builtin_amdgcn_s_setprio(0); } while (0)
#define PG8_WAIT_V(n) asm volatile("s_waitcnt vmcnt(" #n ")" ::: "memory")
#define PG8_WAIT_L(n) asm volatile("s_waitcnt lgkmcnt(" #n ")" ::: "memory")
#define PG8_BAR __builtin_amdgcn_s_barrier()
#define PG8_SCHED __builtin_amdgcn_sched_barrier(0)
#define PG8_OFFS(u, o) do { if constexpr (GATHER) { _Pragma("unroll") for (int _h = 0; _h < 2; ++_h) _Pragma("unroll") for (int _i = 0; _i < 2; ++_i) \
        o[_h][_i] = S.arow(u, _h * 128 + _i * 64 + R0) + (unsigned)C0 * 2u; } } while (0)
#define PG8_STAGE_A(bufoff, gbase, h, OFF) do { if constexpr (GATHER) { PG8_STAGE(bufoff, gbase, OFF[h]); } else { PG8_STAGE1(bufoff, (gbase) + (h) * hstepA, voffA, qstepA); } } while (0)
#define PG8_BP(base, base2, tt) ((base) + (size_t)(tt) * kstep)
    Unit cur, nxt; int ui = 0;
    if (!S.next(0, cur)) return;
    f32x4 acc[2][2][4][2];
#pragma unroll
    for (int a = 0; a < 2; ++a)
#pragma unroll
        for (int b = 0; b < 2; ++b)
#pragma unroll
            for (int m = 0; m < 4; ++m)
#pragma unroll
                for (int n = 0; n < 2; ++n) acc[a][b][m][n] = (f32x4){0.f, 0.f, 0.f, 0.f};
    bf16x8 At[4][2], B0[2][2], B1[2][2];
    unsigned coff[2][2], noff[2][2];
#pragma unroll
    for (int h = 0; h < 2; ++h)
#pragma unroll
        for (int i = 0; i < 2; ++i) { coff[h][i] = 0u; noff[h][i] = 0u; }
    PG8_OFFS(cur, coff);
    const char* cA = S.A(cur); const char* cB = S.B(cur); const char* cB2 = cB;
    PG8_STAGE_B(PG8_SB(0, 0), cB); PG8_STAGE_B(PG8_SB(0, 1), cB + hstepB); PG8_STAGE_A(PG8_SA(0, 0), cA, 0, coff); PG8_STAGE_A(PG8_SA(0, 1), cA, 1, coff);
    if (wr == 1) PG8_BAR;
    PG8_WAIT_V(2); PG8_BAR;
    PG8_STAGE_B(PG8_SB(1, 0), cB + kstep); PG8_STAGE_A(PG8_SA(1, 0), cA + kstep, 0, coff); PG8_STAGE_B(PG8_SB(1, 1), cB + hstepB + kstep);
    PG8_WAIT_V(6); PG8_BAR;
    for (;;) {
        const bool has_next = S.next(ui + 1, nxt);
        const char* nA = has_next ? S.A(nxt) : cA; const char* nB = has_next ? S.B(nxt) : cB; const char* nB2 = cB2;
        if constexpr (GATHER) { if (has_next) { PG8_OFFS(nxt, noff); } else {
#pragma unroll
            for (int h = 0; h < 2; ++h)
#pragma unroll
                for (int i = 0; i < 2; ++i) noff[h][i] = coff[h][i]; } }
        for (int t = 0; t < nt; t += 2) {
            const bool last = (t == nt - 2);
            const char* a1 = cA + (size_t)(t + 1) * kstep;
            const char* a2 = last ? nA : cA + (size_t)(t + 2) * kstep;
            const char* b2 = last ? nB : PG8_BP(cB, cB2, t + 2);
            const char* a3 = a2 + kstep;
            const char* b3 = last ? nB + kstep : PG8_BP(cB, cB2, t + 3);
            unsigned o2[2][2];
#pragma unroll
            for (int h = 0; h < 2; ++h)
#pragma unroll
                for (int i = 0; i < 2; ++i) o2[h][i] = GATHER ? (last ? noff[h][i] : coff[h][i]) : 0u;
            PG8_LDB(B0, 0, 0); PG8_LDB(B1, 0, 1); PG8_SCHED; PG8_LDA(At, 0, 0); PG8_STAGE_A(PG8_SA(1, 1), a1, 1, coff);
            PG8_WAIT_V(8); PG8_WAIT_L(0); PG8_BAR; PG8_MMA(0, 0, At, B0); PG8_MMA(0, 1, At, B1); PG8_BAR; PG8_SCHED;
            PG8_LDA(At, 0, 1); PG8_STAGE_B(PG8_SB(0, 0), b2); PG8_STAGE_B(PG8_SB(0, 1), b2 + hstepB); PG8_STAGE_A(PG8_SA(0, 0), a2, 0, o2);
            PG8_WAIT_V(8); PG8_WAIT_L(0); PG8_BAR; PG8_MMA(1, 0, At, B0); PG8_MMA(1, 1, At, B1); PG8_BAR; PG8_SCHED;
            PG8_LDB(B0, 1, 0); PG8_LDB(B1, 1, 1); PG8_SCHED; PG8_LDA(At, 1, 0); PG8_STAGE_A(PG8_SA(0, 1), a2, 1, o2);
            PG8_WAIT_V(8); PG8_WAIT_L(0); PG8_BAR; PG8_MMA(0, 0, At, B0); PG8_MMA(0, 1, At, B1); PG8_BAR; PG8_SCHED;
            PG8_LDA(At, 1, 1); PG8_STAGE_B(PG8_SB(1, 0), b3); PG8_STAGE_B(PG8_SB(1, 1), b3 + hstepB); PG8_STAGE_A(PG8_SA(1, 0), a3, 0, o2);
            PG8_WAIT_V(8); PG8_WAIT_L(0); PG8_BAR; PG8_MMA(1, 0, At, B0); PG8_MMA(1, 1, At, B1); PG8_BAR; PG8_SCHED;
        }
        const bool cont = BSPLIT && S.chain(cur);
        if (!cont) {
        if constexpr (ALIGN_EPI) { if (wr == 0) PG8_BAR; }
        { int t2 = threadIdx.x; asm volatile("" : "+v"(t2)); const int l2 = t2 & 63; E(acc, cur, wr, wc, l2 & 15, l2 >> 4); }
        }
        if (!has_next) break;
        if (!cont) {
#pragma unroll
        for (int a = 0; a < 2; ++a)
#pragma unroll
            for (int b = 0; b < 2; ++b)
#pragma unroll
                for (int m = 0; m < 4; ++m)
#pragma unroll
                    for (int n = 0; n < 2; ++n) acc[a][b][m][n] = (f32x4){0.f, 0.f, 0.f, 0.f};
        }
        cur = nxt; cA = nA; cB = nB; cB2 = nB2; ++ui;
#pragma unroll
        for (int h = 0; h < 2; ++h)
#pragma unroll
            for (int i = 0; i < 2; ++i) coff[h][i] = noff[h][i];
        if constexpr (ALIGN_EPI) { if (!cont && wr == 1) PG8_BAR; }
    }
    PG8_WAIT_V(0);
    if constexpr (!ALIGN_EPI) { if (wr == 0) PG8_BAR; }
    PG8_BAR;
#undef PG8_SA
#undef PG8_SB
#undef PG8_STAGE
#undef PG8_LDA
#undef PG8_LDB
#undef PG8_MMA
#undef PG8_WAIT_V
#undef PG8_WAIT_L
#undef PG8_BAR
#undef PG8_SCHED
#undef PG8_OFFS
#undef PG8_STAGE_A
#undef PG8_STAGE1
#undef PG8_STAGE_B
#undef PG8_BP
}
#else
template <class Epi, class Sched, bool ALIGN_EPI, bool GATHER, bool BSPLIT>
__device__ __forceinline__ void gemm_phase(LAS unsigned char* lds, const GemmDesc g, const Sched& S, const Epi& E) {
    const int tid = threadIdx.x, wid = __builtin_amdgcn_readfirstlane(tid >> 6), lane = tid & 63, wr = wid >> 2, wc = wid & 3, fr = lane & 15, fq = lane >> 4;
    Unit cur;
    for (int ui = 0; S.next(ui, cur); ++ui) {
        f32x4 acc[2][2][4][2];
#pragma unroll
        for (int a = 0; a < 2; ++a)
#pragma unroll
            for (int b = 0; b < 2; ++b)
#pragma unroll
                for (int m = 0; m < 4; ++m)
#pragma unroll
                    for (int n = 0; n < 2; ++n) acc[a][b][m][n] = (f32x4){0.f, 0.f, 0.f, 0.f};
        const char* cA = S.A(cur); const char* cB = S.B(cur); const char* cB2 = BSPLIT ? S.B2(cur) : cB;
        unsigned aro[2][4];
#pragma unroll
        for (int ai = 0; ai < 2; ++ai)
#pragma unroll
            for (int m = 0; m < 4; ++m) { const int r = ai * 128 + wr * 64 + m * 16 + fr; aro[ai][m] = GATHER ? S.arow(cur, r) : (unsigned)r * g.lda; }
        for (int k0 = 0; k0 < g.K; k0 += 4) {
            u32x2 av[2][4];
#pragma unroll
            for (int ai = 0; ai < 2; ++ai)
#pragma unroll
                for (int m = 0; m < 4; ++m) av[ai][m] = *(const u32x2*)(cA + aro[ai][m] + (size_t)k0 * 2);
            const char* bb = (BSPLIT && k0 >= g.ksplit * 64) ? cB2 : cB;
#pragma unroll
            for (int bj = 0; bj < 2; ++bj)
#pragma unroll
                for (int n = 0; n < 2; ++n)
#pragma unroll
                    for (int j = 0; j < 4; ++j) {
                        const int c = bj * 128 + wc * 32 + fq * 8 + n * 4 + j;
                        const u32x2 bv = *(const u32x2*)(bb + (size_t)c * g.ldb + (size_t)k0 * 2);
                        const float b0 = bf2f(bv.x & 0xffffu), b1 = bf2f(bv.x >> 16), b2 = bf2f(bv.y & 0xffffu), b3 = bf2f(bv.y >> 16);
#pragma unroll
                        for (int ai = 0; ai < 2; ++ai)
#pragma unroll
                            for (int m = 0; m < 4; ++m) {
                                const u32x2 a = av[ai][m];
                                acc[ai][bj][m][n][j] += bf2f(a.x & 0xffffu) * b0 + bf2f(a.x >> 16) * b1 + bf2f(a.y & 0xffffu) * b2 + bf2f(a.y >> 16) * b3;
                            }
                    }
        }
        E(acc, cur, wr, wc, fr, fq);
    }
    __syncthreads();
}
#endif
}
using pg8::Unit; using pg8::GemmDesc;

__device__ __forceinline__ float row_rstd(const float* ssq, int row) {
    const f32x4* p = (const f32x4*)(ssq + (size_t)row * 16);
    const f32x4 a = p[0], b = p[1], c = p[2], d = p[3];
    const float s = ((a.x + a.y) + (a.z + a.w)) + ((b.x + b.y) + (b.z + b.w)) + ((c.x + c.y) + (c.z + c.w)) + ((d.x + d.y) + (d.z + d.w));
    return rsqrtf(s * (1.f / 1024.f) + EPS);
}
__device__ __forceinline__ u32x4 pack8(f32x4 v0, f32x4 v1) { u32x4 w; w.x = cvt_pk_bf16(v0[0], v0[1]); w.y = cvt_pk_bf16(v0[2], v0[3]); w.z = cvt_pk_bf16(v1[0], v1[1]); w.w = cvt_pk_bf16(v1[2], v1[3]); return w; }

struct EpiBf16 {
    bf16_t* O; int ldc; const float* ssq; unsigned* kq; const LAS float* rt;
    __device__ __forceinline__ void operator()(const f32x4 (&acc)[2][2][4][2], const Unit& u, int wr, int wc, int fr, int fq) const {
        float nmax[2] = {0.f, 0.f};
        const bool donorm = kq != nullptr && u.pn < 4;
#pragma unroll
        for (int ai = 0; ai < 2; ++ai)
#pragma unroll
            for (int m = 0; m < 4; ++m) {
                const int r = ai * 128 + wr * 64 + m * 16 + fr;
                const float rs = (rt && u.a2 < 4) ? rt[u.a2 * 256 + r] : (ssq ? row_rstd(ssq, u.a1 + r) : 1.f);
                bf16_t* rowp = O + (size_t)u.a0 + (size_t)r * ldc + wc * 32 + fq * 8;
#pragma unroll
                for (int bj = 0; bj < 2; ++bj) { const u32x4 w = pack8(acc[ai][bj][m][0] * rs, acc[ai][bj][m][1] * rs); *(u32x4*)(rowp + bj * 128) = w;
                    if (donorm) { float s = 0.f;
#pragma unroll
                        for (int e = 0; e < 4; ++e) { const float a = bf2f(w[e] & 0xffffu), b2 = bf2f(w[e] >> 16); s += a * a + b2 * b2; }
                        s = x16_sum(s); s = x32_sum(s); nmax[bj] = fmaxf(nmax[bj], s); } }
                __builtin_amdgcn_sched_barrier(0);
            }
        if (donorm) {
#pragma unroll
            for (int bj = 0; bj < 2; ++bj) { float v = nmax[bj];
                v = fmaxf(v, dpp_f<0xB1>(v)); v = fmaxf(v, dpp_f<0x4E>(v)); v = fmaxf(v, dpp_f<0x141>(v)); v = fmaxf(v, dpp_f<0x140>(v));
                if (fr == 0 && fq == 0) { const int b = u.pm >> 5, isk = u.pn >> 1, head = (u.pn & 1) * 4 + bj * 2 + (wc >> 1);
                    atomicMax(&kq[((b * 8 + head) * 2 + isk) * 2 + (wc & 1)], __float_as_uint(v)); } }
        }
    }
};
struct EpiResidual {
    bf16_t* xb; float* ssq;
    __device__ __forceinline__ void operator()(const f32x4 (&acc)[2][2][4][2], const Unit& u, int wr, int wc, int fr, int fq) const {
#pragma unroll
        for (int ai = 0; ai < 2; ++ai) {
        u32x4 xi[2][4][2];
#pragma unroll
            for (int m = 0; m < 4; ++m)
#pragma unroll
                for (int bj = 0; bj < 2; ++bj) xi[ai][m][bj] = *(const u32x4*)(xb + (size_t)(u.pm * 256 + ai * 128 + wr * 64 + m * 16 + fr) * DM + u.pn * 256 + bj * 128 + wc * 32 + fq * 8);
        __builtin_amdgcn_sched_barrier(0);
#pragma unroll
            for (int m = 0; m < 4; ++m) {
                const int row = u.pm * 256 + ai * 128 + wr * 64 + m * 16 + fr;
                float ss = 0.f;
#pragma unroll
                for (int bj = 0; bj < 2; ++bj) {
                    const size_t o = (size_t)row * DM + u.pn * 256 + bj * 128 + wc * 32 + fq * 8;
                    const u32x4 x4 = xi[ai][m][bj];
                    f32x4 v0, v1;
                    v0[0] = acc[ai][bj][m][0][0] + bf2f(x4.x & 0xffffu); v0[1] = acc[ai][bj][m][0][1] + bf2f(x4.x >> 16); v0[2] = acc[ai][bj][m][0][2] + bf2f(x4.y & 0xffffu); v0[3] = acc[ai][bj][m][0][3] + bf2f(x4.y >> 16);
                    v1[0] = acc[ai][bj][m][1][0] + bf2f(x4.z & 0xffffu); v1[1] = acc[ai][bj][m][1][1] + bf2f(x4.z >> 16); v1[2] = acc[ai][bj][m][1][2] + bf2f(x4.w & 0xffffu); v1[3] = acc[ai][bj][m][1][3] + bf2f(x4.w >> 16);
                    *(u32x4*)(xb + o) = pack8(v0, v1);
                    ss += (v0[0] * v0[0] + v0[1] * v0[1]) + (v0[2] * v0[2] + v0[3] * v0[3]) + (v1[0] * v1[0] + v1[1] * v1[1]) + (v1[2] * v1[2] + v1[3] * v1[3]);
                }
                ss = x16_sum(ss); ss = x32_sum(ss);
                if (fq == 0) ssq[(size_t)row * 16 + u.pn * 4 + wc] = ss;
            }
        __builtin_amdgcn_sched_barrier(0);
        }
    }
};
struct EpiSoftmax {
    bf16_t* P; const float* ssq; LAS float* scr; const LAS float* rt;
    __device__ __forceinline__ void operator()(const f32x4 (&acc)[2][2][4][2], const Unit& u, int wr, int wc, int fr, int fq) const {
#pragma unroll
        for (int ai = 0; ai < 2; ++ai)
#pragma unroll
            for (int m = 0; m < 4; ++m) {
                const int rl = ai * 128 + wr * 64 + m * 16 + fr;
                const float rs = (u.a2 < 4 ? rt[u.a2 * 256 + rl] : row_rstd(ssq, u.pm * 256 + rl)) * (LOG2E / 16.f);
                float mm = -INFINITY;
#pragma unroll
                for (int bj = 0; bj < 2; ++bj)
#pragma unroll
                    for (int n = 0; n < 2; ++n)
#pragma unroll
                        for (int j = 0; j < 4; ++j) mm = fmaxf(mm, acc[ai][bj][m][n][j] * rs);
                mm = x16_max(mm); mm = x32_max(mm);
                if (fq == 0) scr[rl * 4 + wc] = mm;
            }
        LDS_WAIT(); __builtin_amdgcn_s_barrier();
#pragma unroll
        for (int ai = 0; ai < 2; ++ai)
#pragma unroll
            for (int m = 0; m < 4; ++m) {
                const int rl = ai * 128 + wr * 64 + m * 16 + fr;
                const float rs = (u.a2 < 4 ? rt[u.a2 * 256 + rl] : row_rstd(ssq, u.pm * 256 + rl)) * (LOG2E / 16.f);
                const f32x4 q = *(const LAS f32x4*)(scr + rl * 4);
                const float M = fmaxf(fmaxf(q.x, q.y), fmaxf(q.z, q.w));
                float s = 0.f;
#pragma unroll
                for (int bj = 0; bj < 2; ++bj)
#pragma unroll
                    for (int n = 0; n < 2; ++n)
#pragma unroll
                        for (int j = 0; j < 4; ++j) s += __builtin_amdgcn_exp2f(acc[ai][bj][m][n][j] * rs - M);
                s = x16_sum(s); s = x32_sum(s);
                if (fq == 0) scr[1024 + rl * 4 + wc] = s;
            }
        LDS_WAIT(); __builtin_amdgcn_s_barrier();
#pragma unroll
        for (int ai = 0; ai < 2; ++ai)
#pragma unroll
            for (int m = 0; m < 4; ++m) {
                const int rl = ai * 128 + wr * 64 + m * 16 + fr;
                const float r = (u.a2 < 4 ? rt[u.a2 * 256 + rl] : row_rstd(ssq, u.pm * 256 + rl)) * (LOG2E / 16.f);
                const f32x4 qm = *(const LAS f32x4*)(scr + rl * 4);
                const float M = fmaxf(fmaxf(qm.x, qm.y), fmaxf(qm.z, qm.w));
                const f32x4 q = *(const LAS f32x4*)(scr + 1024 + rl * 4);
                const float inv = 1.f / ((q.x + q.y) + (q.z + q.w));
                bf16_t* rowp = P + (size_t)(u.pm * 256 + rl) * DM + u.pn * 256 + wc * 32 + fq * 8;
#pragma unroll
                for (int bj = 0; bj < 2; ++bj) {
                    f32x4 v0, v1;
#pragma unroll
                    for (int j = 0; j < 4; ++j) { v0[j] = __builtin_amdgcn_exp2f(acc[ai][bj][m][0][j] * r - M) * inv; v1[j] = __builtin_amdgcn_exp2f(acc[ai][bj][m][1][j] * r - M) * inv; }
                    *(u32x4*)(rowp + bj * 128) = pack8(v0, v1);
                }
            }
        LDS_WAIT(); __builtin_amdgcn_s_barrier();
    }
};
struct EpiMoeUp {
    bf16_t* hid; const int* tokc; const float* ssq; const f32x2* wts; const LAS float* tb;
    __device__ __forceinline__ void operator()(const f32x4 (&acc)[2][2][4][2], const Unit& u, int wr, int wc, int fr, int fq) const {
#pragma unroll
        for (int ai = 0; ai < 2; ++ai)
#pragma unroll
            for (int m = 0; m < 4; ++m) {
                const int rl = ai * 128 + wr * 64 + m * 16 + fr;
                float rs, w;
                if (u.ord == 0) { rs = tb[rl]; w = tb[256 + rl]; }
                else { const bool valid = rl < u.a2; const int tok = valid ? tokc[u.a1 + rl] : 0; rs = row_rstd(ssq, tok); const f32x2 w2 = wts[tok]; w = valid ? (u.a3 ? w2.y : w2.x) : 0.f; }
                f32x4 h[2];
#pragma unroll
                for (int n = 0; n < 2; ++n)
#pragma unroll
                    for (int j = 0; j < 4; ++j) { const float gt = acc[ai][0][m][n][j] * rs, up = acc[ai][1][m][n][j] * rs; h[n][j] = gt * __builtin_amdgcn_rcpf(1.f + __expf(-gt)) * up * w; }
                *(u32x4*)(hid + (size_t)(u.a0 + rl) * 512 + u.a3 * 256 + u.pn * 128 + wc * 32 + fq * 8) = pack8(h[0], h[1]);
            }
    }
};
struct EpiMoeDown {
    bf16_t* xb; float* ssq; const int* tokc; const LAS int* tt;
    __device__ __forceinline__ void operator()(const f32x4 (&acc)[2][2][4][2], const Unit& u, int wr, int wc, int fr, int fq) const {
#pragma unroll
        for (int ai = 0; ai < 2; ++ai) {
            u32x4 xi[4][2]; int tokv[4];
#pragma unroll
            for (int m = 0; m < 4; ++m) {
                const int rl = ai * 128 + wr * 64 + m * 16 + fr;
                const bool valid = rl < u.a2;
                tokv[m] = valid ? (u.ord < 4 ? tt[u.ord * 256 + rl] : tokc[u.a1 + rl]) : 0;
#pragma unroll
                for (int bj = 0; bj < 2; ++bj) xi[m][bj] = *(const u32x4*)(xb + (size_t)tokv[m] * DM + u.pn * 256 + bj * 128 + wc * 32 + fq * 8);
            }
            __builtin_amdgcn_sched_barrier(0);
#pragma unroll
            for (int m = 0; m < 4; ++m) {
                const int rl = ai * 128 + wr * 64 + m * 16 + fr;
                const bool valid = rl < u.a2;
                const int tok = tokv[m];
                float ss = 0.f;
#pragma unroll
                for (int bj = 0; bj < 2; ++bj) {
                    const size_t o = (size_t)tok * DM + u.pn * 256 + bj * 128 + wc * 32 + fq * 8;
                    const u32x4 x4 = xi[m][bj];
                    f32x4 v0, v1;
                    v0[0] = acc[ai][bj][m][0][0] + bf2f(x4.x & 0xffffu); v0[1] = acc[ai][bj][m][0][1] + bf2f(x4.x >> 16); v0[2] = acc[ai][bj][m][0][2] + bf2f(x4.y & 0xffffu); v0[3] = acc[ai][bj][m][0][3] + bf2f(x4.y >> 16);
                    v1[0] = acc[ai][bj][m][1][0] + bf2f(x4.z & 0xffffu); v1[1] = acc[ai][bj][m][1][1] + bf2f(x4.z >> 16); v1[2] = acc[ai][bj][m][1][2] + bf2f(x4.w & 0xffffu); v1[3] = acc[ai][bj][m][1][3] + bf2f(x4.w >> 16);
                    if (valid) *(u32x4*)(xb + o) = pack8(v0, v1);
                    ss += (v0[0] * v0[0] + v0[1] * v0[1]) + (v0[2] * v0[2] + v0[3] * v0[3]) + (v1[0] * v1[0] + v1[1] * v1[1]) + (v1[2] * v1[2] + v1[3] * v1[3]);
                }
                ss = x16_sum(ss); ss = x32_sum(ss);
                if (valid && fq == 0) ssq[(size_t)tok * 16 + u.pn * 4 + wc] = ss;
            }
            __builtin_amdgcn_sched_barrier(0);
        }
    }
};

struct SchedGrid {
    int nM, nN, nwg, G, c; const char* Ab; const char* Bb; size_t astride, bstride, bbatch; int ldc;
    __device__ __forceinline__ bool next(int i, Unit& u) const {
        const long L = (long)i * G + c; if (L >= nwg) return false;
        int wgid = (int)L; { const int q = nwg / 8, r = nwg % 8, xcd = wgid % 8, off = wgid / 8; wgid = (xcd < r ? xcd * (q + 1) : r * (q + 1) + (xcd - r) * q) + off; }
        const int nig = 8 * nN, gid = wgid / nig, fm = gid * 8, gsz = (nM - fm) < 8 ? (nM - fm) : 8;
        u.pm = fm + ((wgid % nig) % gsz); u.pn = (wgid % nig) / gsz;
        u.a0 = u.pm * 256 * ldc + u.pn * 256; u.a1 = u.pm * 256; u.a2 = i; u.a3 = 0; u.ord = i; return true;
    }
    __device__ __forceinline__ const char* A(const Unit& u) const { return Ab + (size_t)u.pm * astride; }
    __device__ __forceinline__ const char* B(const Unit& u) const { return Bb + (size_t)u.pn * bstride + (u.pm >= 32 ? bbatch : 0); }
    __device__ __forceinline__ const char* B2(const Unit& u) const { return B(u); }
    __device__ __forceinline__ unsigned arow(const Unit&, int) const { return 0u; }
    __device__ __forceinline__ bool chain(const Unit&) const { return false; }
};
struct SchedKV {
    int G, c; const char* memn; const char* wkvt;
    __device__ __forceinline__ bool next(int i, Unit& u) const {
        const int L = i * G + c; if (L >= 64) return false;
        const int l = L >> 4; u.pm = (L >> 3) & 1; u.pn = L & 7; u.a2 = l; u.a3 = 0;
        u.a0 = l * 512 * 2048 + u.pm * 256 * 2048 + u.pn * 256; u.a1 = 0; u.ord = i; return true;
    }
    __device__ __forceinline__ const char* A(const Unit& u) const { return memn + (size_t)u.pm * 256 * 2048; }
    __device__ __forceinline__ const char* B(const Unit& u) const { return wkvt + ((size_t)u.a2 * 2048 + (size_t)u.pn * 256) * 2048; }
    __device__ __forceinline__ const char* B2(const Unit& u) const { return B(u); }
    __device__ __forceinline__ unsigned arow(const Unit&, int) const { return 0u; }
    __device__ __forceinline__ bool chain(const Unit&) const { return false; }
};
struct SchedQK {
    int G, c; const char* kv; const char* wqs;
    __device__ __forceinline__ bool next(int i, Unit& u) const {
        const int L = i * G + c; if (L >= 128) return false;
        const int l = L >> 5, b = (L >> 4) & 1, h = (L >> 2) & 3; u.pn = L & 3; u.pm = 0; u.a1 = l; u.a2 = b; u.a3 = h;
        u.a0 = ((l * 2 + b) * 1024 + h * 256) * 1024 + u.pn * 256; u.ord = i; return true;
    }
    __device__ __forceinline__ const char* A(const Unit& u) const { return kv + (((size_t)u.a1 * 512 + u.a2 * 256) * 2048 + u.a3 * 256) * 2; }
    __device__ __forceinline__ const char* B(const Unit& u) const { return wqs + (((size_t)u.a1 * 1024 + u.pn * 256) * 1024 + u.a3 * 256) * 2; }
    __device__ __forceinline__ const char* B2(const Unit& u) const { return B(u); }
    __device__ __forceinline__ unsigned arow(const Unit&, int) const { return 0u; }
    __device__ __forceinline__ bool chain(const Unit&) const { return false; }
};
struct SchedVO {
    int G, c; const char* kv; const char* wot;
    __device__ __forceinline__ bool next(int i, Unit& u) const {
        const int L = i * G + c; if (L >= 128) return false;
        const int l = L >> 5, b = (L >> 4) & 1, h = (L >> 2) & 3; u.pm = L & 3; u.pn = 0; u.a1 = l; u.a2 = b; u.a3 = h;
        u.a0 = ((l * 2 + b) * 1024 + u.pm * 256) * 1024 + h * 256; u.ord = i; return true;
    }
    __device__ __forceinline__ const char* A(const Unit& u) const { return wot + (((size_t)u.a1 * 1024 + u.pm * 256) * 1024 + u.a3 * 256) * 2; }
    __device__ __forceinline__ const char* B(const Unit& u) const { return kv + (((size_t)u.a1 * 512 + u.a2 * 256) * 2048 + 1024 + u.a3 * 256) * 2; }
    __device__ __forceinline__ const char* B2(const Unit& u) const { return B(u); }
    __device__ __forceinline__ unsigned arow(const Unit&, int) const { return 0u; }
    __device__ __forceinline__ bool chain(const Unit&) const { return false; }
};
struct SchedMoe {
    int base, stride, cnt; bool down; const volatile LAS int* tab; const int* tokc; const char* Ab; const char* Wb;
    __device__ __forceinline__ bool next(int i, Unit& u) const {
        const int half = down ? (i & 1) : 0, ii = down ? (i >> 1) : i;
        if (ii >= cnt) return false;
        const int L = base + ii * stride;
        const int q = L >> 2, sub = L & 3;
        int cc = 0;
        for (int k = 0; k < 24; ++k) if (q >= tab[k + 1]) cc = k + 1;
        const int j = q - tab[cc], n = tab[32 + cc];
        const int g = cc / 6, pi = cc % 6;
        const int e1 = pi < 3 ? 0 : (pi < 5 ? 1 : 2), e2 = pi < 3 ? pi + 1 : (pi < 5 ? pi - 1 : 3);
        u.a0 = q * 256; u.a1 = cc * 16384 + j * 256; u.a2 = (n - j * 256) < 256 ? (n - j * 256) : 256;
        if (!down) { const int s = sub >> 1; u.a3 = s; u.pn = sub & 1; u.pm = g * 4 + (s ? e2 : e1); }
        else { u.a3 = half; u.pn = sub; u.pm = g * 4 + (half ? e2 : e1); }
        u.pm = __builtin_amdgcn_readfirstlane(u.pm); u.pn = __builtin_amdgcn_readfirstlane(u.pn); u.a0 = __builtin_amdgcn_readfirstlane(u.a0);
        u.a1 = __builtin_amdgcn_readfirstlane(u.a1); u.a2 = __builtin_amdgcn_readfirstlane(u.a2); u.a3 = __builtin_amdgcn_readfirstlane(u.a3); u.ord = ii;
        return true;
    }
    __device__ __forceinline__ const char* A(const Unit& u) const { return down ? Ab + (size_t)u.a0 * 1024 + (size_t)u.a3 * 512 : Ab; }
    __device__ __forceinline__ const char* B(const Unit& u) const {
        return down ? Wb + (((size_t)u.pm * 1024 + u.pn * 256) * 256) * 2 : Wb + (((size_t)u.pm * 512 + u.pn * 256) * 1024) * 2; }
    __device__ __forceinline__ const char* B2(const Unit& u) const { return B(u); }
    __device__ __forceinline__ unsigned arow(const Unit& u, int r) const { const int tok = (r < u.a2) ? tokc[u.a1 + r] : 0; return (unsigned)tok * 2048u; }
    __device__ __forceinline__ bool chain(const Unit& u) const { return down && u.a3 == 0; }
};

struct Params { const float* in[27]; float* out; unsigned char* ws; int ph_lo, ph_hi; };
#define PIN(k) (p.in[(k)])
__device__ __forceinline__ const GAS float* ping_(const Params& p, int i) { asm volatile("" : "+s"(i)); return (const GAS float*)p.in[i]; }
#define PING(k) ping_(p, (k))

__device__ __forceinline__ void tr_item(const float* src, int ld, int c0, int K, int k0, const float* gain, float scale, bf16_t* dst, LAS float* scr, int lane) {
    float tv[32];
#pragma unroll
    for (int i = 0; i < 32; ++i) tv[i] = src[(size_t)(k0 + 2 * i + (lane >> 5)) * ld + c0 + (lane & 31)];
#pragma unroll
    for (int i = 0; i < 32; ++i) { const int kk = 2 * i + (lane >> 5); const float gsc = gain ? gain[k0 + kk] * scale : scale; scr[kk * 33 + (lane & 31)] = tv[i] * gsc; }
    LDS_WAIT(); asm volatile("" ::: "memory");
    const int c = lane & 7;
#pragma unroll
    for (int j = 0; j < 4; ++j) { const int n = (lane >> 3) + 8 * j; const LAS float* s = scr + (8 * c) * 33 + n;
        u32x4 o; o.x = cvt_pk_bf16(s[0 * 33], s[1 * 33]); o.y = cvt_pk_bf16(s[2 * 33], s[3 * 33]); o.z = cvt_pk_bf16(s[4 * 33], s[5 * 33]); o.w = cvt_pk_bf16(s[6 * 33], s[7 * 33]);
        *(u32x4*)(dst + (size_t)n * K + k0 + 8 * c) = o; }
    LDS_WAIT(); asm volatile("" ::: "memory");
}

__device__ __forceinline__ void phase_pro_a(const Params& p, LAS unsigned char* lds, int bid, int G) {
    int tid = threadIdx.x; asm volatile("" : "+v"(tid));
    const int lane = tid & 63, wave = tid >> 6;
    unsigned char* ws = p.ws;
    LAS float* scr = (LAS float*)(lds + wave * 16384);
    const int gw = bid * NWAVES + wave, NGW = G * NWAVES;
    constexpr int PER_L = 1536 + 512 + 1024 + 512 + 4096 + 2048;
    for (int it = gw; it < PER_L * NLAYER; it += NGW) {
        const int l = it / PER_L; int r = it % PER_L;
        if (r < 1536) {
            const int kb = r / 96, nb = r % 96, n0 = nb * 32, c0 = n0 < 1536 ? n0 : n0 + 8;
            tr_item(PIN(3) + (size_t)l * 1024 * 3080, 3080, c0, 1024, kb * 64, PIN(2) + l * 1024, n0 < 512 ? C2 : 1.f, (bf16_t*)(ws + WS_WIN) + ((size_t)l * 3072 + n0) * 1024, scr, lane); continue; }
        r -= 1536;
        if (r < 512) {
            const int kb = r / 32, nb = r % 32, k0 = kb * 64;
            const float* gain = k0 < 512 ? PIN(5) + l * 512 : (k0 < 768 ? PIN(7) + l * 256 - 512 : nullptr);
            tr_item(PIN(12) + (size_t)l * 1024 * 1024, 1024, nb * 32, 1024, k0, gain, 1.f, (bf16_t*)(ws + WS_WOUT) + ((size_t)l * 1024 + nb * 32) * 1024, scr, lane); continue; }
        r -= 512;
        if (r < 1024) {
            const int kb = r / 64, nb = r % 64;
            tr_item(PIN(16) + (size_t)l * 1024 * 2048, 2048, nb * 32, 1024, kb * 64, nullptr, 1.f, (bf16_t*)(ws + WS_WKVT) + ((size_t)l * 2048 + nb * 32) * 1024, scr, lane); continue; }
        r -= 1024;
        if (r < 512) {
            const int kb = r / 32, nb = r % 32;
            tr_item(PIN(17) + (size_t)l * 1024 * 1024, 1024, nb * 32, 1024, kb * 64, nullptr, 1.f, (bf16_t*)(ws + WS_WOT) + ((size_t)l * 1024 + nb * 32) * 1024, scr, lane); continue; }
        r -= 512;
        if (r < 4096) {
            const int e = r >> 8, rr = r & 255, kb = rr >> 4, nb = rr & 15;
            const int orow = nb * 32, t = orow >> 8, half = (orow >> 7) & 1, j = orow & 127;
            const float* src = (half ? PIN(24) : PIN(23)) + ((size_t)l * 16 + e) * 1024 * 256;
            tr_item(src, 256, t * 128 + j, 1024, kb * 64, PIN(18) + l * 1024, 1.f, (bf16_t*)(ws + WS_WGU) + (((size_t)l * 16 + e) * 512 + orow) * 1024, scr, lane); continue; }
        r -= 4096;
        {
            const int e = r >> 7, rr = r & 127, kb = rr >> 5, nb = rr & 31;
            tr_item(PIN(25) + ((size_t)l * 16 + e) * 256 * 1024, 1024, nb * 32, 256, kb * 64, nullptr, 1.f, (bf16_t*)(ws + WS_WD) + (((size_t)l * 16 + e) * 1024 + nb * 32) * 256, scr, lane); }
    }
    for (size_t i4 = (size_t)bid * NTHR + tid; i4 < (size_t)NLAYER * 1024 * 256; i4 += (size_t)G * NTHR * 4) {
        f32x4 v[4]; float gsc[4];
#pragma unroll
        for (int q = 0; q < 4; ++q) { const size_t i = i4 + (size_t)q * G * NTHR; if (i < (size_t)NLAYER * 1024 * 256) { const size_t e = i * 4; v[q] = *(const f32x4*)(PIN(15) + e); gsc[q] = PIN(13)[(int)(e >> 20) * 1024 + (int)((e >> 10) & 1023)]; } }
#pragma unroll
        for (int q = 0; q < 4; ++q) { const size_t i = i4 + (size_t)q * G * NTHR; if (i < (size_t)NLAYER * 1024 * 256) { const size_t e = i * 4;
            u32x2 o; o.x = cvt_pk_bf16(v[q].x * gsc[q], v[q].y * gsc[q]); o.y = cvt_pk_bf16(v[q].z * gsc[q], v[q].w * gsc[q]); *(u32x2*)((bf16_t*)(ws + WS_WQS) + e) = o; } }
    }
    for (int i = bid * NTHR + tid; i < NLAYER * 28 * 1024; i += G * NTHR) {
        const int l = i / (28 * 1024), r = i % (28 * 1024), j = r >> 10, k = r & 1023;
        if (j < 8) { const float wv = PIN(2)[l * 1024 + k] * PIN(3)[((size_t)l * 1024 + k) * 3080 + 1536 + j];
            ((bf16_t*)(ws + WS_WFFB))[(l * 16 + j) * 1024 + k] = f2bf1(wv); ((bf16_t*)(ws + WS_WFFB))[(l * 16 + 8 + j) * 1024 + k] = 0; }
        else { const int jj = j - 8; const float w = jj < 4 ? PIN(19)[(l * 1024 + k) * 4 + jj] : PIN(21)[(l * 1024 + k) * 16 + jj - 4];
            const float wv = PIN(18)[l * 1024 + k] * w; const unsigned short hb = f2bf1(wv);
            ((bf16_t*)(ws + WS_WRH))[(l * 32 + jj) * 1024 + k] = hb; ((bf16_t*)(ws + WS_WRL))[(l * 32 + jj) * 1024 + k] = f2bf1(wv - bf2f(hb));
            if (jj < 12) { ((bf16_t*)(ws + WS_WRH))[(l * 32 + 20 + jj) * 1024 + k] = 0; ((bf16_t*)(ws + WS_WRL))[(l * 32 + 20 + jj) * 1024 + k] = 0; } }
    }
    for (int row = gw; row < 512; row += NGW) {
        const f32x4* xr = (const f32x4*)(PIN(1) + (size_t)row * 1024) + lane; f32x4 v[4]; float s = 0.f;
#pragma unroll
        for (int j = 0; j < 4; ++j) { v[j] = xr[64 * j]; s += (v[j].x * v[j].x + v[j].y * v[j].y) + (v[j].z * v[j].z + v[j].w * v[j].w); }
        const float rstd = rsqrtf(wave_sum(s) * (1.f / 1024.f) + EPS);
#pragma unroll
        for (int j = 0; j < 4; ++j) { const f32x4 gg = ((const f32x4*)PIN(14))[64 * j + lane]; u32x2 o; o.x = cvt_pk_bf16(v[j].x * rstd * gg.x, v[j].y * rstd * gg.y); o.y = cvt_pk_bf16(v[j].z * rstd * gg.z, v[j].w * rstd * gg.w);
            ((u32x2*)((bf16_t*)(ws + WS_MEMN) + (size_t)row * 1024))[64 * j + lane] = o; }
    }
    for (int row0 = gw; row0 < NTOK; row0 += 4 * NGW) {
        f32x4 v[4][4];
#pragma unroll
        for (int q = 0; q < 4; ++q) { const int row = row0 + q * NGW; if (row < NTOK) { const f32x4* xr = (const f32x4*)(PIN(0) + (size_t)row * 1024) + lane;
#pragma unroll
            for (int j = 0; j < 4; ++j) v[q][j] = xr[64 * j]; } }
#pragma unroll
        for (int q = 0; q < 4; ++q) { const int row = row0 + q * NGW; if (row < NTOK) { float s = 0.f;
#pragma unroll
            for (int j = 0; j < 4; ++j) { const f32x4 w = v[q][j]; s += (w.x * w.x + w.y * w.y) + (w.z * w.z + w.w * w.w); u32x2 o; o.x = cvt_pk_bf16(w.x, w.y); o.y = cvt_pk_bf16(w.z, w.w);
                ((u32x2*)((bf16_t*)(ws + WS_XB) + (size_t)row * 1024))[64 * j + lane] = o; }
            s = wave_sum(s);
            if (lane < 16) ((float*)(ws + WS_SSQ))[(size_t)row * 16 + lane] = lane == 0 ? s : 0.f; } }
    }
}

__device__ __forceinline__ void phase_logf(const Params& p, LAS unsigned char* lds, int l, int bid, int G) {
    int tid = threadIdx.x; asm volatile("" : "+v"(tid));
    const int lane = tid & 63, wave = tid >> 6, sg = wave & 3, kh = wave >> 2;
    unsigned char* ws = p.ws;
    LAS f32x4* part = (LAS f32x4*)lds;
    const bf16_t* wb = (const bf16_t*)(ws + WS_WFFB) + (size_t)l * 16 * 1024 + (lane & 15) * 1024 + kh * 512 + (lane >> 4) * 8;
    for (int g0 = bid * 4; g0 < NTOK / 16; g0 += G * 4) {
        const int g16 = g0 + sg;
        const bf16_t* xa = (const bf16_t*)(ws + WS_XB) + (size_t)(g16 * 16 + (lane & 15)) * 1024 + kh * 512 + (lane >> 4) * 8;
        f32x4 acc = {0.f, 0.f, 0.f, 0.f};
#pragma unroll
        for (int ks = 0; ks < 16; ++ks) { const bf16x8 a = *(const bf16x8*)(xa + ks * 32), w = *(const bf16x8*)(wb + ks * 32); acc = __builtin_amdgcn_mfma_f32_16x16x32_bf16(a, w, acc, 0, 0, 0); }
        if (kh == 1) part[sg * 64 + lane] = acc;
        LDS_BARRIER();
        if (kh == 0) {
            acc += part[sg * 64 + lane];
            if ((lane & 15) < 8) { const float bias = PING(4)[l * 8 + (lane & 15)];
#pragma unroll
                for (int t = 0; t < 4; ++t) { const int row = g16 * 16 + (lane >> 4) * 4 + t; const float z = acc[t] * row_rstd((const float*)(ws + WS_SSQ), row) + bias;
                    ((float*)(ws + WS_LOGF))[(size_t)row * 8 + (lane & 15)] = fminf(z, 0.f) - __logf(1.f + __expf(-fabsf(z))); } }
        }
        LDS_BARRIER();
    }
}

constexpr int HP = 72;
template <bool FINAL>
__device__ __forceinline__ void hgrn_unit(const Params& p, LAS unsigned char* lds, int l, int unit) {
    int tid = threadIdx.x; asm volatile("" : "+v"(tid));
    const int lane = tid & 63, wave = __builtin_amdgcn_readfirstlane(tid >> 6), l15 = lane & 15, rq = lane >> 4;
    unsigned char* ws = p.ws;
    const int bh = unit >> 5, sc = unit & 31, b = bh >> 2, h = bh & 3;
    const bf16_t* y = (const bf16_t*)(ws + WS_R1);
    LAS bf16_t* QM = (LAS bf16_t*)lds; LAS bf16_t* KM = QM + 64 * HP; LAS bf16_t* QA = KM + 64 * HP; LAS bf16_t* KLT = QA + 64 * HP; LAS bf16_t* VT = KLT + 64 * HP; LAS bf16_t* ST = VT + 64 * HP;
    LAS float* DEC = (LAS float*)(ST + 4 * 64 * HP); LAS float* HG = DEC + 256; LAS float* lbv = HG + 4096; LAS float* SSX = lbv + 64;
    if (tid < 64) {
        const int k = h * 64 + tid; float e[4], mx = -INFINITY, den = 0.f, num = 0.f;
#pragma unroll
        for (int i = 0; i < 4; ++i) { e[i] = PING(6)[i * 256 + k]; mx = fmaxf(mx, e[i]); }
#pragma unroll
        for (int i = 0; i < 4; ++i) { e[i] = __expf(e[i] - mx); den += e[i]; if (i >= 1 && i <= l) num += e[i]; }
        lbv[tid] = num / den;
    }
    const int kt = wave >> 1, vt0 = 2 * (wave & 1);
    f32x4 S[2] = {{0.f, 0.f, 0.f, 0.f}, {0.f, 0.f, 0.f, 0.f}};
    if (FINAL) {
        const float* U = (const float*)(ws + WS_HU); const float* Dd = (const float*)(ws + WS_HD);
        int jj = 0;
        for (; jj + 4 <= sc; jj += 4) {
            float uu_[4][8], dd_[4][4];
#pragma unroll
            for (int q4 = 0; q4 < 4; ++q4) { const int uu = bh * 32 + jj + q4;
#pragma unroll
                for (int e = 0; e < 4; ++e) { dd_[q4][e] = Dd[uu * 64 + kt * 16 + rq * 4 + e];
                    uu_[q4][e] = U[(size_t)uu * 4096 + (kt * 16 + rq * 4 + e) * 64 + vt0 * 16 + l15]; uu_[q4][4 + e] = U[(size_t)uu * 4096 + (kt * 16 + rq * 4 + e) * 64 + vt0 * 16 + 16 + l15]; } }
#pragma unroll
            for (int q4 = 0; q4 < 4; ++q4)
#pragma unroll
                for (int e = 0; e < 4; ++e) { S[0][e] = dd_[q4][e] * S[0][e] + uu_[q4][e]; S[1][e] = dd_[q4][e] * S[1][e] + uu_[q4][4 + e]; }
        }
        for (; jj < sc; ++jj) { const int uu = bh * 32 + jj;
#pragma unroll
            for (int e = 0; e < 4; ++e) { const float d = Dd[uu * 64 + kt * 16 + rq * 4 + e];
                S[0][e] = d * S[0][e] + U[(size_t)uu * 4096 + (kt * 16 + rq * 4 + e) * 64 + vt0 * 16 + l15]; S[1][e] = d * S[1][e] + U[(size_t)uu * 4096 + (kt * 16 + rq * 4 + e) * 64 + vt0 * 16 + 16 + l15]; } }
    }
    float dtot = 1.f;
    const size_t row0 = (size_t)b * SEQ + sc * 256;
    const int cc_a = wave & 3, role = wave >> 2;
    unsigned short hf_[16], hq_[16]; u32x4 vraw, graw;
#define HG_LOAD(g_) do { _Pragma("unroll") for (int i = 0; i < 16; ++i) { const bf16_t* yr = y + (row0 + (g_) * 64 + cc_a * 16 + i) * NY; hf_[i] = yr[1792 + h * 64 + lane]; hq_[i] = FINAL ? yr[1536 + h * 64 + lane] : (unsigned short)0; } \
        { const bf16_t* yr = y + (row0 + (g_) * 64 + lane) * NY; vraw = *(const u32x4*)(yr + 2048 + h * 64 + wave * 8); if (FINAL) graw = *(const u32x4*)(yr + 2304 + h * 64 + wave * 8); } } while (0)
    HG_LOAD(0);
    LDS_BARRIER();
    for (int g = 0; g < 4; ++g) {
        {
            const float lb = lbv[lane];
            float bcum[16], k1[16]; float run = 0.f;
#pragma unroll
            for (int i = 0; i < 16; ++i) { const float f = lb + (1.f - lb) * sigmoidf_(bf2f(hf_[i])); k1[i] = 1.f - f; run += __logf(f); bcum[i] = run; }
            if (role == 0) {
                if (FINAL) { const float bm = bcum[8];
#pragma unroll
                    for (int i = 0; i < 16; ++i) { QM[(cc_a * 16 + i) * HP + lane] = f2bf1(bf2f(hq_[i]) * __expf(bcum[i] - bm)); KM[(cc_a * 16 + i) * HP + lane] = f2bf1(k1[i] * __expf(bm - bcum[i])); } }
            } else {
                const float bl = bcum[15];
                u32x4 w0, w1;
#pragma unroll
                for (int i = 0; i < 4; ++i) { w0[i] = cvt_pk_bf16(k1[2 * i] * __expf(bl - bcum[2 * i]), k1[2 * i + 1] * __expf(bl - bcum[2 * i + 1])); w1[i] = cvt_pk_bf16(k1[8 + 2 * i] * __expf(bl - bcum[8 + 2 * i]), k1[8 + 2 * i + 1] * __expf(bl - bcum[8 + 2 * i + 1])); }
                *(LAS u32x4*)(KLT + lane * HP + cc_a * 16) = w0; *(LAS u32x4*)(KLT + lane * HP + cc_a * 16 + 8) = w1;
                DEC[cc_a * 64 + lane] = __expf(bl);
                if (FINAL) {
#pragma unroll
                    for (int i = 0; i < 16; ++i) QA[(cc_a * 16 + i) * HP + lane] = f2bf1(bf2f(hq_[i]) * __expf(bcum[i]));
                }
            }
#pragma unroll
            for (int i = 0; i < 4; ++i) { VT[(wave * 8 + 2 * i) * HP + lane] = (bf16_t)(vraw[i] & 0xffffu); VT[(wave * 8 + 2 * i + 1) * HP + lane] = (bf16_t)(vraw[i] >> 16); }
            if (FINAL) { f32x4 g0, g1;
#pragma unroll
                for (int i = 0; i < 2; ++i) { g0[2 * i] = bf2f(graw[i] & 0xffffu); g0[2 * i + 1] = bf2f(graw[i] >> 16); g1[2 * i] = bf2f(graw[2 + i] & 0xffffu); g1[2 * i + 1] = bf2f(graw[2 + i] >> 16); }
                *(LAS f32x4*)(HG + lane * 64 + wave * 8) = g0; *(LAS f32x4*)(HG + lane * 64 + wave * 8 + 4) = g1; }
        }
        LDS_BARRIER();
        if (g < 3) HG_LOAD(g + 1);
        if (!FINAL && tid < 64) dtot *= (DEC[tid] * DEC[64 + tid]) * (DEC[128 + tid] * DEC[192 + tid]);
#pragma unroll
        for (int cc = 0; cc < 4; ++cc) {
            if (FINAL) {
#pragma unroll
                for (int j = 0; j < 2; ++j) { u32x2 w; w.x = cvt_pk_bf16(S[j][0], S[j][1]); w.y = cvt_pk_bf16(S[j][2], S[j][3]);
                    *(LAS u32x2*)(ST + (cc * 64 + (vt0 + j) * 16 + l15) * HP + kt * 16 + rq * 4) = w; }
            }
            const u32x2 ka = *(const LAS u32x2*)(KLT + (kt * 16 + l15) * HP + cc * 16 + rq * 4);
            const f32x4 dc = *(const LAS f32x4*)(DEC + cc * 64 + kt * 16 + rq * 4);
            const u32x4 kaw = {ka.x, ka.y, 0u, 0u};
#pragma unroll
            for (int j = 0; j < 2; ++j) {
                const u32x2 vb = *(const LAS u32x2*)(VT + ((vt0 + j) * 16 + l15) * HP + cc * 16 + rq * 4);
                const u32x4 vbw = {vb.x, vb.y, 0u, 0u};
                S[j] = __builtin_amdgcn_mfma_f32_16x16x32_bf16(__builtin_bit_cast(bf16x8, kaw), __builtin_bit_cast(bf16x8, vbw), S[j] * dc, 0, 0, 0);
            }
        }
        if (FINAL) {
            LDS_BARRIER();
            const int cc = wave & 3, vh = wave >> 2;
            f32x4 at = {0.f, 0.f, 0.f, 0.f};
#pragma unroll
            for (int ks = 0; ks < 2; ++ks) {
                const bf16x8 kmf = *(const LAS bf16x8*)(KM + (cc * 16 + l15) * HP + ks * 32 + rq * 8), qmf = *(const LAS bf16x8*)(QM + (cc * 16 + l15) * HP + ks * 32 + rq * 8);
                at = __builtin_amdgcn_mfma_f32_16x16x32_bf16(kmf, qmf, at, 0, 0, 0);
            }
#pragma unroll
            for (int e = 0; e < 4; ++e) if (rq * 4 + e > l15) at[e] = 0.f;
            const u32x4 atw = {cvt_pk_bf16(at[0], at[1]), cvt_pk_bf16(at[2], at[3]), 0u, 0u};
            const bf16x8 atf = __builtin_bit_cast(bf16x8, atw);
            const bf16x8 qa0 = *(const LAS bf16x8*)(QA + (cc * 16 + l15) * HP + rq * 8), qa1 = *(const LAS bf16x8*)(QA + (cc * 16 + l15) * HP + 32 + rq * 8);
            f32x4 o[2]; float ssp = 0.f;
#pragma unroll
            for (int j = 0; j < 2; ++j) { const int vt = vh * 2 + j;
                const u32x2 vb = *(const LAS u32x2*)(VT + (vt * 16 + l15) * HP + cc * 16 + rq * 4);
                const u32x4 vbw = {vb.x, vb.y, 0u, 0u};
                const bf16x8 s0 = *(const LAS bf16x8*)(ST + (cc * 64 + vt * 16 + l15) * HP + rq * 8), s1 = *(const LAS bf16x8*)(ST + (cc * 64 + vt * 16 + l15) * HP + 32 + rq * 8);
                f32x4 a = {0.f, 0.f, 0.f, 0.f};
                a = __builtin_amdgcn_mfma_f32_16x16x32_bf16(__builtin_bit_cast(bf16x8, vbw), atf, a, 0, 0, 0);
                a = __builtin_amdgcn_mfma_f32_16x16x32_bf16(s0, qa0, a, 0, 0, 0);
                a = __builtin_amdgcn_mfma_f32_16x16x32_bf16(s1, qa1, a, 0, 0, 0);
                o[j] = a; ssp += (a[0] * a[0] + a[1] * a[1]) + (a[2] * a[2] + a[3] * a[3]); }
            ssp = x16_sum(ssp); ssp = x32_sum(ssp);
            if (rq == 0) SSX[(cc * 2 + vh) * 16 + l15] = ssp;
            LDS_BARRIER();
            const float rstd = rsqrtf((SSX[(cc * 2) * 16 + l15] + SSX[(cc * 2 + 1) * 16 + l15]) * (1.f / 64.f) + EPS);
            const size_t row = row0 + g * 64 + cc * 16 + l15;
#pragma unroll
            for (int j = 0; j < 2; ++j) { const int vt = vh * 2 + j;
                const f32x4 hg = *(const LAS f32x4*)(HG + (cc * 16 + l15) * 64 + vt * 16 + rq * 4);
                u32x2 w; w.x = cvt_pk_bf16(o[j][0] * rstd * hg[0] * sigmoidf_(hg[0]), o[j][1] * rstd * hg[1] * sigmoidf_(hg[1])); w.y = cvt_pk_bf16(o[j][2] * rstd * hg[2] * sigmoidf_(hg[2]), o[j][3] * rstd * hg[3] * sigmoidf_(hg[3]));
                *(u32x2*)((bf16_t*)(ws + WS_CAT) + row * DM + 512 + h * 64 + vt * 16 + rq * 4) = w; }
        }
        LDS_BARRIER();
    }
#undef HG_LOAD
    if (!FINAL) {
        float* U = (float*)(ws + WS_HU); float* Dd = (float*)(ws + WS_HD);
#pragma unroll
        for (int j = 0; j < 2; ++j)
#pragma unroll
            for (int e = 0; e < 4; ++e) U[(size_t)unit * 4096 + (kt * 16 + rq * 4 + e) * 64 + (vt0 + j) * 16 + l15] = S[j][e];
        if (tid < 64) Dd[unit * 64 + tid] = dtot;
    }
}

template <bool FINAL>
__device__ __forceinline__ void hgrn_unit_old(const Params& p, LAS unsigned char* lds, int l, int unit) {
    int tid = threadIdx.x; asm volatile("" : "+v"(tid));
    const int lane = tid & 63, kg = tid >> 6;
    unsigned char* ws = p.ws;
    const int bh = unit >> 5, sc = unit & 31, b = bh >> 2, h = bh & 3;
    const bf16_t* y = (const bf16_t*)(ws + WS_R1);
    LAS float* F = (LAS float*)lds; LAS float* K1 = F + 4096; LAS float* Q = F + 8192; LAS float* V = F + 12288; LAS float* OP = F + 16384; LAS float* lbv = F + 16384 + 8192; LAS float* dpl = lbv + 64; LAS float* HG = dpl + 512;
    if (tid < 64) {
        const int k = h * 64 + tid; float e[4], mx = -INFINITY, den = 0.f, num = 0.f;
#pragma unroll
        for (int i = 0; i < 4; ++i) { e[i] = PING(6)[i * 256 + k]; mx = fmaxf(mx, e[i]); }
#pragma unroll
        for (int i = 0; i < 4; ++i) { e[i] = __expf(e[i] - mx); den += e[i]; if (i >= 1 && i <= l) num += e[i]; }
        lbv[tid] = num / den;
    }
    f32x2 s2[4];
#pragma unroll
    for (int j = 0; j < 4; ++j) s2[j] = (f32x2){0.f, 0.f};
    float dprod = 1.f;
    if (FINAL) {
        const float* U = (const float*)(ws + WS_HU); const float* Dd = (const float*)(ws + WS_HD);
        float s[8];
#pragma unroll
        for (int j = 0; j < 8; ++j) s[j] = 0.f;
        int jj = 0;
        for (; jj + 8 <= sc; jj += 8) {
            float uu_[8][8], dd_[8][8];
#pragma unroll
            for (int q4 = 0; q4 < 8; ++q4) { const int uu = bh * 32 + jj + q4;
#pragma unroll
                for (int j = 0; j < 8; ++j) { dd_[q4][j] = Dd[uu * 64 + kg * 8 + j]; uu_[q4][j] = U[(size_t)uu * 4096 + (kg * 8 + j) * 64 + lane]; } }
#pragma unroll
            for (int q4 = 0; q4 < 8; ++q4)
#pragma unroll
                for (int j = 0; j < 8; ++j) s[j] = dd_[q4][j] * s[j] + uu_[q4][j];
        }
        for (; jj < sc; ++jj) { const int uu = bh * 32 + jj;
#pragma unroll
            for (int j = 0; j < 8; ++j) s[j] = Dd[uu * 64 + kg * 8 + j] * s[j] + U[(size_t)uu * 4096 + (kg * 8 + j) * 64 + lane]; }
#pragma unroll
        for (int j = 0; j < 4; ++j) s2[j] = (f32x2){s[2 * j], s[2 * j + 1]};
    }
    LDS_BARRIER();
    const size_t row0 = (size_t)b * SEQ + sc * 256;
    unsigned short hf_[8], hq_[8], hv_[8], hg_[8];
#define HG_LOAD(ch_) do { _Pragma("unroll") for (int j = 0; j < 8; ++j) { const int tt = kg + 8 * j; const bf16_t* yr = y + (row0 + (ch_) * 64 + tt) * NY; hf_[j] = yr[1792 + h * 64 + lane]; hv_[j] = yr[2048 + h * 64 + lane]; \
        hq_[j] = FINAL ? yr[1536 + h * 64 + lane] : (unsigned short)0; hg_[j] = FINAL ? yr[2304 + h * 64 + lane] : (unsigned short)0; } } while (0)
    HG_LOAD(0);
    for (int ch = 0; ch < 4; ++ch) {
        { const float lb = lbv[lane];
#pragma unroll
          for (int j = 0; j < 8; ++j) { const int idx = (kg + 8 * j) * 64 + lane; const float f = lb + (1.f - lb) * sigmoidf_(bf2f(hf_[j]));
              F[idx] = f; K1[idx] = 1.f - f; V[idx] = bf2f(hv_[j]); if (FINAL) { Q[idx] = bf2f(hq_[j]); HG[idx] = bf2f(hg_[j]); } else dprod *= f; } }
        LDS_BARRIER();
        if (ch < 3) HG_LOAD(ch + 1);
        for (int sub = 0; sub < 4; ++sub) {
#pragma unroll 4
            for (int t16 = 0; t16 < 16; ++t16) {
                const int tt = sub * 16 + t16;
                const f32x4 fa = *(const LAS f32x4*)(F + tt * 64 + kg * 8), fb = *(const LAS f32x4*)(F + tt * 64 + kg * 8 + 4);
                const f32x4 ka = *(const LAS f32x4*)(K1 + tt * 64 + kg * 8), kb2 = *(const LAS f32x4*)(K1 + tt * 64 + kg * 8 + 4);
                const float vt = V[tt * 64 + lane];
                const f32x2 vt2 = {vt, vt};
                const f32x2 f2[4] = {{fa.x, fa.y}, {fa.z, fa.w}, {fb.x, fb.y}, {fb.z, fb.w}};
                const f32x2 k2[4] = {{ka.x, ka.y}, {ka.z, ka.w}, {kb2.x, kb2.y}, {kb2.z, kb2.w}};
#pragma unroll
                for (int j = 0; j < 4; ++j) s2[j] = f2[j] * s2[j] + k2[j] * vt2;
                if (FINAL) {
                    const f32x4 qa = *(const LAS f32x4*)(Q + tt * 64 + kg * 8), qb2 = *(const LAS f32x4*)(Q + tt * 64 + kg * 8 + 4);
                    const f32x2 q2[4] = {{qa.x, qa.y}, {qa.z, qa.w}, {qb2.x, qb2.y}, {qb2.z, qb2.w}};
                    f32x2 o2 = q2[0] * s2[0];
#pragma unroll
                    for (int j = 1; j < 4; ++j) o2 = q2[j] * s2[j] + o2;
                    OP[(t16 * 8 + kg) * 64 + lane] = o2.x + o2.y;
                }
            }
            if (FINAL) {
                LDS_BARRIER();
#pragma unroll
                for (int w2 = 0; w2 < 2; ++w2) { const int t16 = kg * 2 + w2; float o = 0.f;
#pragma unroll
                    for (int g8 = 0; g8 < 8; ++g8) o += OP[(t16 * 8 + g8) * 64 + lane];
                    const float ss = wave_sum(o * o), rstd = rsqrtf(ss * (1.f / 64.f) + EPS);
                    const size_t row = row0 + ch * 64 + sub * 16 + t16;
                    const float hg = HG[(sub * 16 + t16) * 64 + lane];
                    ((bf16_t*)(ws + WS_CAT))[row * DM + 512 + h * 64 + lane] = f2bf1(o * rstd * hg * sigmoidf_(hg)); }
                LDS_BARRIER();
            }
        }
        LDS_BARRIER();
    }
#undef HG_LOAD
    if (!FINAL) {
        float* U = (float*)(ws + WS_HU); float* Dd = (float*)(ws + WS_HD);
#pragma unroll
        for (int j = 0; j < 4; ++j) { U[(size_t)unit * 4096 + (kg * 8 + 2 * j) * 64 + lane] = s2[j].x; U[(size_t)unit * 4096 + (kg * 8 + 2 * j + 1) * 64 + lane] = s2[j].y; }
        dpl[kg * 64 + lane] = dprod;
        LDS_BARRIER();
        if (tid < 64) { float d = 1.f;
#pragma unroll
            for (int w = 0; w < 8; ++w) d *= dpl[w * 64 + tid];
            Dd[unit * 64 + tid] = d; }
    }
    LDS_BARRIER();
}

__device__ __forceinline__ void conv_unit(const Params& p, LAS unsigned char* lds, int l, int unit) {
    int tid = threadIdx.x; asm volatile("" : "+v"(tid));
    const int lane = tid & 63, wave = tid >> 6;
    unsigned char* ws = p.ws;
    const bf16_t* y = (const bf16_t*)(ws + WS_R1);
    LAS float* A = (LAS float*)lds; LAS float* Y = (LAS float*)(lds + 65536);
    const int row0 = unit * 32, b = row0 / SEQ, t0 = row0 % SEQ;
    float w[31], gam[4], bet[4];
    { const int c = tid & 255;
#pragma unroll
      for (int j = 0; j < 31; ++j) w[j] = PING(8)[(l * 31 + j) * 256 + c];
#pragma unroll
      for (int g4 = 0; g4 < 4; ++g4) { gam[g4] = PING(10)[l * 256 + g4 * 64 + lane]; bet[g4] = PING(11)[l * 256 + g4 * 64 + lane]; } }
    const float cbias = PING(9)[l * 256 + (tid & 255)];
    { u32x4 cu[4], cg[4];
#pragma unroll
        for (int q = 0; q < 4; ++q) { const int it = tid + NTHR * q, j = it >> 5, c8 = (it & 31) * 8, t = t0 - 30 + j;
            cu[q] = (u32x4){0u, 0u, 0u, 0u}; cg[q] = cu[q];
            if (it < 62 * 32 && t >= 0) { const bf16_t* yr = y + ((size_t)b * SEQ + t) * NY; cu[q] = *(const u32x4*)(yr + 2560 + c8); cg[q] = *(const u32x4*)(yr + 2816 + c8); } }
#pragma unroll
        for (int q = 0; q < 4; ++q) { const int it = tid + NTHR * q, j = it >> 5, c8 = (it & 31) * 8;
            if (it < 62 * 32) { f32x4 a0, a1;
#pragma unroll
                for (int e = 0; e < 4; ++e) { const float u0 = bf2f(cu[q][e] & 0xffffu), u1 = bf2f(cu[q][e] >> 16), g0 = bf2f(cg[q][e] & 0xffffu), g1 = bf2f(cg[q][e] >> 16);
                    const float r0 = u0 * sigmoidf_(g0), r1 = u1 * sigmoidf_(g1);
                    if (e < 2) { a0[2 * e] = r0; a0[2 * e + 1] = r1; } else { a1[2 * (e - 2)] = r0; a1[2 * (e - 2) + 1] = r1; } }
                *(LAS f32x4*)(A + j * 256 + c8) = a0; *(LAS f32x4*)(A + j * 256 + c8 + 4) = a1; } } }
    LDS_BARRIER();
    { const int c = tid & 255, th = tid >> 8;
        float av[46];
#pragma unroll
        for (int i = 0; i < 46; ++i) av[i] = A[(th * 16 + i) * 256 + c];
        float yv[16];
#pragma unroll
        for (int tl = 0; tl < 16; ++tl) { float a = cbias;
#pragma unroll
            for (int j = 0; j < 31; ++j) a += w[j] * av[tl + j];
            yv[tl] = a; }
#pragma unroll
        for (int tl = 0; tl < 16; ++tl) Y[(th * 16 + tl) * 256 + c] = yv[tl]; }
    LDS_BARRIER();
#pragma unroll 4
    for (int pr = wave * 16; pr < wave * 16 + 16; ++pr) { const int tl = pr >> 2, grp = pr & 3, c = grp * 64 + lane;
        const float v = Y[tl * 256 + c], mean = wave_sum(v) * (1.f / 64.f), ex2 = wave_sum(v * v) * (1.f / 64.f), var = fmaxf(ex2 - mean * mean, 0.f);
        const float gmm = grp == 0 ? gam[0] : (grp == 1 ? gam[1] : (grp == 2 ? gam[2] : gam[3])), btt = grp == 0 ? bet[0] : (grp == 1 ? bet[1] : (grp == 2 ? bet[2] : bet[3]));
        const float yn = (v - mean) * rsqrtf(var + EPS) * gmm + btt;
        ((bf16_t*)(ws + WS_CAT))[(size_t)(row0 + tl) * DM + 768 + c] = f2bf1(yn * sigmoidf_(yn)); }
    LDS_BARRIER();
}

__device__ __forceinline__ void phase_p2a(const Params& p, LAS unsigned char* lds, int l, int bid, int G) {
    int tid = threadIdx.x; asm volatile("" : "+v"(tid));
    const int lane = tid & 63, wave = tid >> 6;
    unsigned char* ws = p.ws;
    for (int sr = 0; sr < SUBR(1); ++sr)
    for (int bh = bid; bh < 16; bh += G) { const int b = bh >> 3, h = bh & 7;
        const float* lf = (const float*)(ws + WS_LOGF) + (size_t)b * SEQ * 8 + h;
        float v[16]; float run = 0.f;
#pragma unroll
        for (int i = 0; i < 16; ++i) { run += lf[(size_t)(tid * 16 + i) * 8]; v[i] = run; }
        float incl = run;
#pragma unroll
        for (int o = 1; o < 64; o <<= 1) { const float t = __int_as_float(__builtin_amdgcn_ds_bpermute(((lane - o) & 63) * 4, __float_as_int(incl))); if (lane >= o) incl += t; }
        LAS float* wt = (LAS float*)lds;
        if (lane == 63) wt[wave] = incl;
        LDS_BARRIER();
        float base = incl - run;
        for (int w = 0; w < wave; ++w) base += wt[w];
        float* c = (float*)(ws + WS_CFOX) + (size_t)bh * SEQ + tid * 16;
#pragma unroll
        for (int i = 0; i < 16; ++i) c[i] = base + v[i];
        LDS_BARRIER();
    }
    for (int sr = 0; sr < SUBR(2); ++sr) for (int u = bid; u < 512; u += G) conv_unit(p, lds, l, u);
    for (int sr = 0; sr < SUBR(3); ++sr) for (int u = bid; u < 256; u += G) if ((u & 31) != 31) hgrn_unit<false>(p, lds, l, u);
}

__device__ __forceinline__ void attn_unit_simple(const Params& p, int l, int unit) {
    int tid = threadIdx.x; asm volatile("" : "+v"(tid));
    const int lane = tid & 63, wave = tid >> 6;
    unsigned char* ws = p.ws;
    const int bh = unit >> 4, qb = unit & 15, b = bh >> 3, h = bh & 7;
    const bf16_t* y = (const bf16_t*)(ws + WS_R1);
    const float* cf = (const float*)(ws + WS_CFOX) + (size_t)bh * SEQ;
    const int t = qb * 512 + tid;
    const size_t rowb = (size_t)b * SEQ;
    float q[64], o[64];
    { const u32x4* qr = (const u32x4*)(y + (rowb + t) * NY + h * 64);
#pragma unroll
        for (int i = 0; i < 8; ++i) { const u32x4 a = qr[i];
#pragma unroll
            for (int j = 0; j < 4; ++j) { q[i * 8 + 2 * j] = bf2f(a[j] & 0xffffu); q[i * 8 + 2 * j + 1] = bf2f(a[j] >> 16); } } }
#pragma unroll
    for (int d = 0; d < 64; ++d) o[d] = 0.f;
    const float ct = cf[t] * LOG2E;
    float m = -INFINITY, lsum = 0.f;
    const int twmin = qb * 512 + wave * 64, smax = twmin + 63;
#if FOX_PRUNE
    const unsigned* ctl = (const unsigned*)(ws + WS_CTL);
    const unsigned* kqm = ctl + CW_KQMAX + l * 64 + (b * 8 + h) * 4;
    const float B2 = 1.01f * sqrtf((__uint_as_float(kqm[0]) + __uint_as_float(kqm[1])) * (__uint_as_float(kqm[2]) + __uint_as_float(kqm[3])));
    const float cmin = cf[twmin] * LOG2E;
#endif
    for (int s = smax; s >= 0; --s) {
        const float cs = cf[s] * LOG2E;
#if FOX_PRUNE
        if (cmin - cs + 2.f * B2 < -44.f) break;
#endif
        const u32x4* kr = (const u32x4*)(y + (rowb + s) * NY + 512 + h * 64);
        float dot = 0.f;
#pragma unroll
        for (int i = 0; i < 8; ++i) { const u32x4 a = kr[i];
#pragma unroll
            for (int j = 0; j < 4; ++j) dot += q[i * 8 + 2 * j] * bf2f(a[j] & 0xffffu) + q[i * 8 + 2 * j + 1] * bf2f(a[j] >> 16); }
        const float sc = dot + ct - cs;
        if (s <= t) {
            if (sc > m) { const float al = __builtin_amdgcn_exp2f(m - sc); lsum *= al;
#pragma unroll
                for (int d = 0; d < 64; ++d) o[d] *= al;
                m = sc; }
            const float pr = __builtin_amdgcn_exp2f(sc - m); lsum += pr;
            const u32x4* vr = (const u32x4*)(y + (rowb + s) * NY + 1024 + h * 64);
#pragma unroll
            for (int i = 0; i < 8; ++i) { const u32x4 a = vr[i];
#pragma unroll
                for (int j = 0; j < 4; ++j) { o[i * 8 + 2 * j] += pr * bf2f(a[j] & 0xffffu); o[i * 8 + 2 * j + 1] += pr * bf2f(a[j] >> 16); } }
        }
    }
    const float inv = 1.f / lsum; float ss = 0.f;
#pragma unroll
    for (int d = 0; d < 64; ++d) { o[d] *= inv; ss += o[d] * o[d]; }
    const float rstd = rsqrtf(ss * (1.f / 64.f) + EPS);
    u32x4* dst = (u32x4*)((bf16_t*)(ws + WS_CAT) + (rowb + t) * DM + h * 64);
#pragma unroll
    for (int i = 0; i < 8; ++i) { u32x4 w; w.x = cvt_pk_bf16(o[i * 8] * rstd, o[i * 8 + 1] * rstd); w.y = cvt_pk_bf16(o[i * 8 + 2] * rstd, o[i * 8 + 3] * rstd); w.z = cvt_pk_bf16(o[i * 8 + 4] * rstd, o[i * 8 + 5] * rstd); w.w = cvt_pk_bf16(o[i * 8 + 6] * rstd, o[i * 8 + 7] * rstd); dst[i] = w; }
}

typedef float f32x16 __attribute__((ext_vector_type(16)));
constexpr int AT_KP = 144, AT_VP = 136, AT_BUF = 18432;
__device__ __forceinline__ void attn_unit_mfma(const Params& p, LAS unsigned char* lds, int l, int unit) {
    int tid = threadIdx.x; asm volatile("" : "+v"(tid));
    const int lane = tid & 63, wave = __builtin_amdgcn_readfirstlane(tid >> 6), r32 = lane & 31, hi = lane >> 5;
    unsigned char* ws = p.ws;
    const int bh = unit >> 5, qb = unit & 31, b = bh >> 3, h = bh & 7, q0 = qb * 256, qw0 = q0 + wave * 32;
    const bf16_t* y = (const bf16_t*)(ws + WS_R1) + (size_t)b * SEQ * NY;
    const float* cf = (const float*)(ws + WS_CFOX) + (size_t)bh * SEQ;
    QB_(20);
    bf16x8 qr[4];
    { const bf16_t* qrow = y + (size_t)(qw0 + r32) * NY + h * 64;
#pragma unroll
      for (int d0 = 0; d0 < 4; ++d0) qr[d0] = *(const bf16x8*)(qrow + d0 * 16 + hi * 8); }
    float cq = cf[qw0 + r32] * LOG2E;
    const unsigned* ctl = (const unsigned*)(ws + WS_CTL);
    const unsigned* kqm = ctl + CW_KQMAX + l * 64 + (b * 8 + h) * 4;
    const float B2 = 1.01f * sqrtf((__uint_as_float(kqm[0]) + __uint_as_float(kqm[1])) * (__uint_as_float(kqm[2]) + __uint_as_float(kqm[3])));
    const float thr = -44.f - 2.f * B2;
    cq -= fminf(B2, 40.f);
    const float cblk = cf[q0] * LOG2E, cwv = cf[qw0] * LOG2E;
    const int jmax = (q0 + 255) >> 6;
    const int jhi = (qw0 + 31) >> 6;
    int jmin = 0, jlo = 0;
    { int base = jmax;
      for (;;) { const int t = base - lane; const bool nd = (t >= 0) && ((cblk - cf[t >= 0 ? 64 * t + 63 : 0] * LOG2E) >= thr);
          const unsigned long long mk = __ballot(nd); const int n = (mk == ~0ull) ? 64 : (int)__builtin_ctzll(~mk);
          if (n < 64 || base < 64) { jmin = base - n + 1; break; } base -= 64; }
      base = jhi;
      for (;;) { const int t = base - lane; const bool nd = (t >= 0) && ((cwv - cf[t >= 0 ? 64 * t + 63 : 0] * LOG2E) >= thr);
          const unsigned long long mk = __ballot(nd); const int n = (mk == ~0ull) ? 64 : (int)__builtin_ctzll(~mk);
          if (n < 64 || base < 64) { jlo = base - n + 1; break; } base -= 64; }
      jmin = __builtin_amdgcn_readfirstlane(jmin); jlo = __builtin_amdgcn_readfirstlane(jlo); }
    u32x4 kreg, vreg, kreg2, vreg2; float creg = 0.f, creg2 = 0.f;
#define AT_LOAD(j, KR, VR, CR) do { const int kb_ = (j) * 64; \
        KR = *(const u32x4*)(y + (size_t)(kb_ + (tid >> 3)) * NY + 512 + h * 64 + (tid & 7) * 8); \
        VR = *(const u32x4*)(y + (size_t)(kb_ + lane) * NY + 1024 + h * 64 + wave * 8); \
        if (tid < 64) CR = cf[kb_ + tid] * LOG2E; } while (0)
    AT_LOAD(jmax, kreg, vreg, creg);
    kreg2 = kreg; vreg2 = vreg;
    if (jmax - 1 >= jmin) AT_LOAD(jmax - 1, kreg2, vreg2, creg2);
    float lsum = 0.f;
    f32x16 o0, o1;
#pragma unroll
    for (int r = 0; r < 16; ++r) { o0[r] = 0.f; o1[r] = 0.f; }
    QE_(20); QB_(21);
    for (int j = jmax; j >= jmin; --j) {
        LAS unsigned char* Kb = lds + (j & 1) * AT_BUF; LAS unsigned char* Vb = Kb + 9216; LAS float* cb = (LAS float*)(Kb + 9216 + 8704);
        *(LAS u32x4*)(Kb + (tid >> 3) * AT_KP + (tid & 7) * 16) = kreg;
#pragma unroll
        for (int i = 0; i < 4; ++i) { *(LAS unsigned short*)(Vb + (wave * 8 + 2 * i) * AT_VP + lane * 2) = (unsigned short)(vreg[i] & 0xffffu); *(LAS unsigned short*)(Vb + (wave * 8 + 2 * i + 1) * AT_VP + lane * 2) = (unsigned short)(vreg[i] >> 16); }
        if (tid < 64) cb[tid] = creg;
        LDS_BARRIER();
        kreg = kreg2; vreg = vreg2; creg = creg2;
        if (j - 2 >= jmin) AT_LOAD(j - 2, kreg2, vreg2, creg2);
        const int kb = j * 64;
        if (j >= jlo && j <= jhi) {
            f32x16 p0, p1;
#pragma unroll
            for (int g4 = 0; g4 < 4; ++g4) {
                const f32x4 c0 = *(const LAS f32x4*)(cb + 8 * g4 + 4 * hi), c1 = *(const LAS f32x4*)(cb + 32 + 8 * g4 + 4 * hi);
#pragma unroll
                for (int i = 0; i < 4; ++i) { p0[4 * g4 + i] = cq - c0[i]; p1[4 * g4 + i] = cq - c1[i]; }
            }
            { bf16x8 kf[8];
#pragma unroll
              for (int d0 = 0; d0 < 4; ++d0) { kf[2 * d0] = *(const LAS bf16x8*)(Kb + r32 * AT_KP + d0 * 32 + hi * 16); kf[2 * d0 + 1] = *(const LAS bf16x8*)(Kb + (32 + r32) * AT_KP + d0 * 32 + hi * 16); }
              __builtin_amdgcn_sched_barrier(0);
#pragma unroll
              for (int d0 = 0; d0 < 4; ++d0) { p0 = __builtin_amdgcn_mfma_f32_32x32x16_bf16(kf[2 * d0], qr[d0], p0, 0, 0, 0); p1 = __builtin_amdgcn_mfma_f32_32x32x16_bf16(kf[2 * d0 + 1], qr[d0], p1, 0, 0, 0); }
              __builtin_amdgcn_sched_barrier(0); }
            if (kb + 63 > qw0) {
                const int qg = qw0 + r32;
#pragma unroll
                for (int r = 0; r < 16; ++r) { const int kg = kb + (r & 3) + 8 * (r >> 2) + 4 * hi; if (kg > qg) p0[r] = -INFINITY; if (kg + 32 > qg) p1[r] = -INFINITY; }
            }
            float rs = 0.f;
#pragma unroll
            for (int r = 0; r < 16; ++r) { p0[r] = __builtin_amdgcn_exp2f(p0[r]); p1[r] = __builtin_amdgcn_exp2f(p1[r]); rs += p0[r] + p1[r]; }
            lsum += rs;
#pragma unroll
            for (int mt = 0; mt < 2; ++mt) {
                u32x2 vfr[2][2][2];
#pragma unroll
                for (int ks = 0; ks < 2; ++ks)
#pragma unroll
                    for (int dt = 0; dt < 2; ++dt) { const LAS unsigned char* vp = Vb + (32 * dt + r32) * AT_VP + (32 * mt + 16 * ks + 4 * hi) * 2; vfr[ks][dt][0] = *(const LAS u32x2*)vp; vfr[ks][dt][1] = *(const LAS u32x2*)(vp + 16); }
                __builtin_amdgcn_sched_barrier(0);
#pragma unroll
                for (int ks = 0; ks < 2; ++ks) {
                    u32x4 pw;
#pragma unroll
                    for (int i = 0; i < 4; ++i) pw[i] = mt ? cvt_pk_bf16(p1[8 * ks + 2 * i], p1[8 * ks + 2 * i + 1]) : cvt_pk_bf16(p0[8 * ks + 2 * i], p0[8 * ks + 2 * i + 1]);
                    const bf16x8 pb = __builtin_bit_cast(bf16x8, pw);
#pragma unroll
                    for (int dt = 0; dt < 2; ++dt) {
                        const u32x4 vw = {vfr[ks][dt][0].x, vfr[ks][dt][0].y, vfr[ks][dt][1].x, vfr[ks][dt][1].y};
                        const bf16x8 vf = __builtin_bit_cast(bf16x8, vw);
                        if (dt == 0) o0 = __builtin_amdgcn_mfma_f32_32x32x16_bf16(vf, pb, o0, 0, 0, 0); else o1 = __builtin_amdgcn_mfma_f32_32x32x16_bf16(vf, pb, o1, 0, 0, 0);
                    }
                }
            }
        }
    }
#undef AT_LOAD
    QE_(21); QB_(22);
    lsum = x32_sum(lsum);
    const float inv = 1.f / lsum;
    float ss = 0.f;
#pragma unroll
    for (int r = 0; r < 16; ++r) { o0[r] *= inv; o1[r] *= inv; ss += o0[r] * o0[r] + o1[r] * o1[r]; }
    ss = x32_sum(ss);
    const float rstd = rsqrtf(ss * (1.f / 64.f) + EPS);
    bf16_t* orow = (bf16_t*)(ws + WS_CAT) + ((size_t)b * SEQ + qw0 + r32) * DM + h * 64;
#pragma unroll
    for (int g4 = 0; g4 < 4; ++g4) {
        u32x2 w0, w1;
        w0.x = cvt_pk_bf16(o0[4 * g4] * rstd, o0[4 * g4 + 1] * rstd); w0.y = cvt_pk_bf16(o0[4 * g4 + 2] * rstd, o0[4 * g4 + 3] * rstd);
        w1.x = cvt_pk_bf16(o1[4 * g4] * rstd, o1[4 * g4 + 1] * rstd); w1.y = cvt_pk_bf16(o1[4 * g4 + 2] * rstd, o1[4 * g4 + 3] * rstd);
        *(u32x2*)(orow + 8 * g4 + 4 * hi) = w0; *(u32x2*)(orow + 32 + 8 * g4 + 4 * hi) = w1;
    }
    LDS_BARRIER();
    QE_(22);
}

__device__ __forceinline__ void phase_route(const Params& p, LAS unsigned char* lds, int l, int bid, int G) {
    int tid = threadIdx.x; asm volatile("" : "+v"(tid));
    const int lane = tid & 63, wave = tid >> 6;
    unsigned char* ws = p.ws;
    LAS float* part = (LAS float*)lds;
    LAS float* ssp = part + 4096;
    LAS int* cls = (LAS int*)(ssp + 512);
    LAS int* basel = cls + 64;
    unsigned* ctl = (unsigned*)(ws + WS_CTL);
    const int r16 = lane & 15, kq = lane >> 4, grp = wave >> 1, kh = wave & 1;
    for (int u = bid; u < NTOK / 64; u += G) {
        float rb[20];
#pragma unroll
        for (int jj = 0; jj < 20; ++jj) rb[jj] = jj < 4 ? PING(20)[l * 4 + jj] : PING(22)[l * 16 + jj - 4];
        {
            const bf16_t* xr = (const bf16_t*)(ws + WS_XB) + (size_t)(u * 64 + grp * 16 + r16) * 1024 + kh * 512 + kq * 8;
            const bf16_t* wh = (const bf16_t*)(ws + WS_WRH) + ((size_t)l * 32 + r16) * 1024 + kh * 512 + kq * 8;
            const bf16_t* wl = (const bf16_t*)(ws + WS_WRL) + ((size_t)l * 32 + r16) * 1024 + kh * 512 + kq * 8;
            f32x4 acc0 = {0.f, 0.f, 0.f, 0.f}, acc1 = {0.f, 0.f, 0.f, 0.f}; float ssx = 0.f;
#pragma unroll 8
            for (int ks = 0; ks < 16; ++ks) {
                const u32x4 xw = *(const u32x4*)(xr + ks * 32);
                const bf16x8 wh0 = *(const bf16x8*)(wh + ks * 32), wh1 = *(const bf16x8*)(wh + 16 * 1024 + ks * 32), wl0 = *(const bf16x8*)(wl + ks * 32), wl1 = *(const bf16x8*)(wl + 16 * 1024 + ks * 32);
#pragma unroll
                for (int e = 0; e < 4; ++e) { const float a = bf2f(xw[e] & 0xffffu), b2 = bf2f(xw[e] >> 16); ssx += a * a + b2 * b2; }
                const bf16x8 xh = __builtin_bit_cast(bf16x8, xw);
                acc0 = __builtin_amdgcn_mfma_f32_16x16x32_bf16(xh, wh0, acc0, 0, 0, 0); acc0 = __builtin_amdgcn_mfma_f32_16x16x32_bf16(xh, wl0, acc0, 0, 0, 0);
                acc1 = __builtin_amdgcn_mfma_f32_16x16x32_bf16(xh, wh1, acc1, 0, 0, 0); acc1 = __builtin_amdgcn_mfma_f32_16x16x32_bf16(xh, wl1, acc1, 0, 0, 0);
            }
#pragma unroll
            for (int t = 0; t < 4; ++t) { part[((grp * 2 + kh) * 16 + kq * 4 + t) * 32 + r16] = acc0[t]; part[((grp * 2 + kh) * 16 + kq * 4 + t) * 32 + 16 + r16] = acc1[t]; }
            ssp[((grp * 2 + kh) * 4 + kq) * 16 + r16] = ssx;
        }
        LDS_BARRIER();
        if (tid < 64) {
            const int g4 = tid >> 4, r = tid & 15, row = u * 64 + tid;
            float ss = 0.f;
#pragma unroll
            for (int q = 0; q < 8; ++q) ss += ssp[(g4 * 8 + q) * 16 + r];
            const float rstd = rsqrtf(ss * (1.f / 1024.f) + EPS);
            float lg[20];
#pragma unroll
            for (int jj = 0; jj < 20; ++jj) lg[jj] = (part[((g4 * 2) * 16 + r) * 32 + jj] + part[((g4 * 2 + 1) * 16 + r) * 32 + jj]) * rstd + rb[jj];
            int gi = 0; float gm = lg[0];
#pragma unroll
            for (int j = 1; j < 4; ++j) if (lg[j] > gm) { gm = lg[j]; gi = j; }
            float den = 0.f;
#pragma unroll
            for (int j = 0; j < 4; ++j) den += __expf(lg[j] - gm);
            const float pg = 1.f / den;
            float e[4];
#pragma unroll
            for (int j = 0; j < 4; ++j) e[j] = gi == 0 ? lg[4 + j] : (gi == 1 ? lg[8 + j] : (gi == 2 ? lg[12 + j] : lg[16 + j]));
            int a = 0; float ea = e[0];
#pragma unroll
            for (int j = 1; j < 4; ++j) if (e[j] > ea) { ea = e[j]; a = j; }
            int bq = -1; float eb = -INFINITY;
#pragma unroll
            for (int j = 0; j < 4; ++j) if (j != a && e[j] > eb) { eb = e[j]; bq = j; }
            const float pb = __expf(eb - ea), wa = pg / (1.f + pb), wb = pg * pb / (1.f + pb);
            const int e1 = a < bq ? a : bq, e2 = a < bq ? bq : a;
            const int pi = e1 == 0 ? e2 - 1 : (e1 == 1 ? e2 + 1 : 5);
            cls[tid] = gi * 6 + pi; ((f32x2*)(ws + WS_WTS))[row] = (f32x2){a < bq ? wa : wb, a < bq ? wb : wa};
        }
        LDS_BARRIER();
        if (tid < 24) { int n = 0; for (int i = 0; i < 64; ++i) n += (cls[i] == tid); basel[tid] = n ? (int)atomicAdd(&ctl[CW_MOECNT + l * 32 + tid], (unsigned)n) : 0; }
        LDS_BARRIER();
        if (tid < 64) { const int c = cls[tid]; int rank = 0; for (int i = 0; i < tid; ++i) rank += (cls[i] == c); ((int*)(ws + WS_TOKC))[c * 16384 + basel[c] + rank] = u * 64 + tid; }
        LDS_BARRIER();
    }
}

__device__ __forceinline__ void moe_table(const Params& p, volatile LAS int* tab, int l) {
    int tid = threadIdx.x; asm volatile("" : "+v"(tid));
    if (tid < 24) { const unsigned voff = (unsigned)(CW_MOECNT + l * 32 + tid) * 4u; const unsigned* ctl = (const unsigned*)((const char*)p.ws + voff); tab[32 + tid] = (int)__hip_atomic_load(ctl, __ATOMIC_RELAXED, __HIP_MEMORY_SCOPE_AGENT); }
    LDS_BARRIER();
    if (tid == 0) { int pre = 0; for (int c = 0; c < 24; ++c) { tab[c] = pre; pre += (tab[32 + c] + 255) >> 8; } tab[24] = pre; }
    LDS_BARRIER();
}

__device__ __forceinline__ void phase_final(const Params& p, int bid, int G) {
    int tid = threadIdx.x; asm volatile("" : "+v"(tid));
    const int lane = tid & 63, wave = tid >> 6;
    const int gw = bid * NWAVES + wave, NGW = G * NWAVES;
    for (int row = gw; row < NTOK; row += NGW) {
        const u32x2* xr = (const u32x2*)((const bf16_t*)(p.ws + WS_XB) + (size_t)row * 1024) + lane; f32x4 v[4]; float s = 0.f;
#pragma unroll
        for (int j = 0; j < 4; ++j) { const u32x2 w = xr[64 * j]; v[j] = (f32x4){bf2f(w.x & 0xffffu), bf2f(w.x >> 16), bf2f(w.y & 0xffffu), bf2f(w.y >> 16)}; s += (v[j].x * v[j].x + v[j].y * v[j].y) + (v[j].z * v[j].z + v[j].w * v[j].w); }
        const float rstd = rsqrtf(wave_sum(s) * (1.f / 1024.f) + EPS);
        f32x4* orow = (f32x4*)(p.out + (size_t)row * 1024) + lane;
#pragma unroll
        for (int j = 0; j < 4; ++j) { const f32x4 gg = ((const f32x4*)PIN(26))[64 * j + lane]; orow[64 * j] = (f32x4){v[j].x * rstd * gg.x, v[j].y * rstd * gg.y, v[j].z * rstd * gg.z, v[j].w * rstd * gg.w}; }
    }
}

constexpr int N_PHASES = 3 + 9 * NLAYER + 1;
__global__ void __launch_bounds__(NTHR, 2) mk_fwd(Params p) {
    extern __shared__ __attribute__((aligned(16))) unsigned char lds_raw[];
    LAS unsigned char* lds = (LAS unsigned char*)lds_raw;
    volatile LAS unsigned* MISC = (volatile LAS unsigned*)(lds + LDS_MISC);
    const int tid = threadIdx.x;
    const int G = gridDim.x, bid = blockIdx.x;
    unsigned char* ws = p.ws;
    for (int u = tid; u < 256; u += NTHR) MISC[u] = 0u;
    __syncthreads();
    const int lo = p.ph_lo, hi = p.ph_hi;
    const bool use_bar = (hi - lo) > 1;
    XcdBarrier bar; bar.bar = (unsigned*)(ws + WS_CTL) + CW_BAR; bar.x = 0; bar.st = MISC + 8;
    if (use_bar) bar = xcd_barrier_post((unsigned*)(ws + WS_CTL) + CW_BAR, MISC + 8);
#if PROBE_ID
    volatile LAS unsigned long long* tprobe = (volatile LAS unsigned long long*)(MISC + 128);
#define PB(id) do { if (PROBE_ID == (id) && threadIdx.x == 0) tprobe[1] = __builtin_amdgcn_s_memrealtime(); } while (0)
#define PE(id) do { if (PROBE_ID == (id) && threadIdx.x == 0) tprobe[0] = tprobe[0] + (__builtin_amdgcn_s_memrealtime() - tprobe[1]); } while (0)
#else
#define PB(id) do {} while (0)
#define PE(id) do {} while (0)
#endif
#define IN(k) (lo <= (k) && (k) < hi)
#define SEAM(k) do { if ((k) + 1 < hi) { PB(1); xcd_barrier(bar); PE(1); } } while (0)
    const float* ssq = (const float*)(ws + WS_SSQ);
    bf16_t* xb = (bf16_t*)(ws + WS_XB);

    if (PHON(0) && IN(0)) { PB(9); phase_pro_a(p, lds, bid, G); PE(9); SEAM(0); }
    if (PHON(1) && IN(1)) { PB(10);
        SchedKV S{G, bid, (const char*)(ws + WS_MEMN), (const char*)(ws + WS_WKVT)};
        EpiBf16 E{(bf16_t*)(ws + WS_KV), 2048, nullptr, nullptr, nullptr};
        pg8::gemm_phase<EpiBf16, SchedKV, false, false, false>(lds, GemmDesc{1024, 2048u, 2048u, 0}, S, E);
        PE(10); SEAM(1);
    }
    if (PHON(2) && IN(2)) { PB(10);
        { SchedQK S{G, bid, (const char*)(ws + WS_KV), (const char*)(ws + WS_WQS)};
          EpiBf16 E{(bf16_t*)(ws + WS_WQK), 1024, nullptr, nullptr, nullptr};
          pg8::gemm_phase<EpiBf16, SchedQK, false, false, false>(lds, GemmDesc{256, 4096u, 2048u, 0}, S, E); }
        { SchedVO S{G, bid, (const char*)(ws + WS_KV), (const char*)(ws + WS_WOT)};
          EpiBf16 E{(bf16_t*)(ws + WS_WVO), 1024, nullptr, nullptr, nullptr};
          pg8::gemm_phase<EpiBf16, SchedVO, false, false, false>(lds, GemmDesc{256, 2048u, 4096u, 0}, S, E); }
        PE(10); SEAM(2);
    }
    for (int l = 0; l < NLAYER; ++l) {
        const int pb = 3 + 9 * l;
        if (!(lo < pb + 9 && pb < hi)) continue;
        if (PHON(3) && IN(pb + 0)) { PB(7);
            SchedGrid S{64, 12, 768, G, bid, (const char*)xb, (const char*)(ws + WS_WIN) + (size_t)l * 3072 * 2048, (size_t)256 * 2048, (size_t)256 * 2048, 0, NY};
            LAS float* rt = (LAS float*)(lds + LDS_RSTD);
            { int t_ = threadIdx.x; asm volatile("" : "+v"(t_)); Unit uu; int pmv[4]; int nu = 0;
#pragma unroll
              for (int i = 0; i < 4; ++i) { pmv[i] = 0; if (nu == i && S.next(i, uu)) { pmv[i] = uu.pm; nu = i + 1; } }
              float rv[4];
#pragma unroll
              for (int i = 0; i < 4; ++i) rv[i] = (i < nu && t_ < 256) ? row_rstd(ssq, pmv[i] * 256 + t_) : 0.f;
#pragma unroll
              for (int i = 0; i < 4; ++i) if (i < nu && t_ < 256) rt[i * 256 + t_] = rv[i];
              LDS_BARRIER(); }
            EpiBf16 E{(bf16_t*)(ws + WS_R1), NY, ssq, (unsigned*)(ws + WS_CTL) + CW_KQMAX + l * 64, rt};
            pg8::gemm_phase<EpiBf16, SchedGrid, true, false, false>(lds, GemmDesc{1024, 2048u, 2048u, 0}, S, E);
            for (int sr = 0; sr < SUBR(0); ++sr) phase_logf(p, lds, l, bid, G);
            PE(7); SEAM(pb + 0);
        }
        if (PHON(4) && IN(pb + 1)) { PB(12); phase_p2a(p, lds, l, bid, G); PE(12); SEAM(pb + 1); }
        if (PHON(5) && IN(pb + 2)) { PB(13);
            {
                volatile LAS int* qslot = (volatile LAS int*)(MISC + 96);
                unsigned* qctr = (unsigned*)(ws + WS_CTL) + CW_ATTQ + l;
                if (threadIdx.x == 0) qslot[0] = (int)atomicAdd(qctr, 1u);
                LDS_BARRIER();
                for (;;) {
                    const int qi = __builtin_amdgcn_readfirstlane(qslot[0]);
                    LDS_BARRIER();
                    if (qi >= 768) break;
                    int nxt = 0;
                    if (threadIdx.x == 0) nxt = (int)atomicAdd(qctr, 1u);
                    if (qi < 512) attn_unit_mfma(p, lds, l, qi); else hgrn_unit<true>(p, lds, l, qi - 512);
                    if (threadIdx.x == 0) qslot[0] = nxt;
                    LDS_BARRIER();
                }
            }
            PE(13); SEAM(pb + 2);
        }
        if (PHON(6) && IN(pb + 3)) { PB(2);
            SchedGrid S{64, 4, 256, G, bid, (const char*)(ws + WS_CAT), (const char*)(ws + WS_WOUT) + (size_t)l * 1024 * 2048, (size_t)256 * 2048, (size_t)256 * 2048, 0, DM};
            EpiResidual E{xb, (float*)(ws + WS_SSQ)};
            pg8::gemm_phase<EpiResidual, SchedGrid, false, false, false>(lds, GemmDesc{1024, 2048u, 2048u, 0}, S, E);
            PE(2); SEAM(pb + 3);
        }
        if (PHON(7) && IN(pb + 4)) { PB(8);
            SchedGrid S{64, 4, 256, G, bid, (const char*)xb, (const char*)(ws + WS_WQK) + (size_t)l * 2 * 1024 * 2048, (size_t)256 * 2048, (size_t)256 * 2048, (size_t)1024 * 2048, DM};
            LAS float* rt = (LAS float*)(lds + LDS_RSTD);
            { int t_ = threadIdx.x; asm volatile("" : "+v"(t_)); Unit uu; int pmv[4]; int nu = 0;
#pragma unroll
              for (int i = 0; i < 4; ++i) { pmv[i] = 0; if (nu == i && S.next(i, uu)) { pmv[i] = uu.pm; nu = i + 1; } }
              float rv[4];
#pragma unroll
              for (int i = 0; i < 4; ++i) rv[i] = (i < nu && t_ < 256) ? row_rstd(ssq, pmv[i] * 256 + t_) : 0.f;
#pragma unroll
              for (int i = 0; i < 4; ++i) if (i < nu && t_ < 256) rt[i * 256 + t_] = rv[i];
              LDS_BARRIER(); }
            EpiSoftmax E{(bf16_t*)(ws + WS_PBUF), ssq, (LAS float*)(lds + LDS_EPI), rt};
            pg8::gemm_phase<EpiSoftmax, SchedGrid, true, false, false>(lds, GemmDesc{1024, 2048u, 2048u, 0}, S, E);
            PE(8); SEAM(pb + 4);
        }
        if (PHON(8) && IN(pb + 5)) { PB(3);
            SchedGrid S{64, 4, 256, G, bid, (const char*)(ws + WS_PBUF), (const char*)(ws + WS_WVO) + (size_t)l * 2 * 1024 * 2048, (size_t)256 * 2048, (size_t)256 * 2048, (size_t)1024 * 2048, DM};
            EpiResidual E{xb, (float*)(ws + WS_SSQ)};
            pg8::gemm_phase<EpiResidual, SchedGrid, false, false, false>(lds, GemmDesc{1024, 2048u, 2048u, 0}, S, E);
            PE(3); SEAM(pb + 5);
        }
        if (PHON(9) && IN(pb + 6)) { PB(4); phase_route(p, lds, l, bid, G); PE(4); SEAM(pb + 6); }
        if (PHON(10) && IN(pb + 7)) { PB(5);
            volatile LAS int* tab = (volatile LAS int*)(MISC + 16);
            moe_table(p, tab, l);
            const int nun = __builtin_amdgcn_readfirstlane(tab[24]) * 4;
            const bool redeal = (G % 4 == 0) && nun > G && (nun - G) <= G;
            SchedMoe S{bid, G, redeal ? 1 : (bid < nun ? (nun - 1 - bid) / G + 1 : 0), false, tab, (const int*)(ws + WS_TOKC), (const char*)xb, (const char*)(ws + WS_WGU) + (size_t)l * 16 * 512 * 2048};
            { int t_ = threadIdx.x; asm volatile("" : "+v"(t_)); Unit uu; LAS float* tb_ = (LAS float*)(lds + LDS_RSTD);
                  if (S.next(0, uu) && t_ < 256) { const bool valid = t_ < uu.a2; const int tok = valid ? ((const int*)(ws + WS_TOKC))[uu.a1 + t_] : 0; const f32x2 w2 = ((const f32x2*)(ws + WS_WTS))[tok];
                      tb_[t_] = row_rstd(ssq, tok); tb_[256 + t_] = valid ? (uu.a3 ? w2.y : w2.x) : 0.f; }
                  LDS_BARRIER(); }
            EpiMoeUp E{(bf16_t*)(ws + WS_HID), (const int*)(ws + WS_TOKC), ssq, (const f32x2*)(ws + WS_WTS), (const LAS float*)(lds + LDS_RSTD)};
            pg8::gemm_phase<EpiMoeUp, SchedMoe, false, true, false>(lds, GemmDesc{1024, 2048u, 2048u, 0}, S, E);
            PE(5); SEAM(pb + 7);
        }
        if (PHON(11) && IN(pb + 8)) { PB(6);
            volatile LAS int* tab = (volatile LAS int*)(MISC + 16);
            moe_table(p, tab, l);
            const int nun = __builtin_amdgcn_readfirstlane(tab[24]) * 4;
            const bool redeal = (G % 4 == 0) && nun > G && (nun - G) <= G;
            const int nlate = redeal ? nun - G : 0;
            if (redeal) {
                { SchedMoe S{G + bid, G, bid < nlate ? 1 : 0, false, tab, (const int*)(ws + WS_TOKC), (const char*)xb, (const char*)(ws + WS_WGU) + (size_t)l * 16 * 512 * 2048};
                  { int t_ = threadIdx.x; asm volatile("" : "+v"(t_)); Unit uu; LAS float* tb_ = (LAS float*)(lds + LDS_RSTD);
                  if (S.next(0, uu) && t_ < 256) { const bool valid = t_ < uu.a2; const int tok = valid ? ((const int*)(ws + WS_TOKC))[uu.a1 + t_] : 0; const f32x2 w2 = ((const f32x2*)(ws + WS_WTS))[tok];
                      tb_[t_] = row_rstd(ssq, tok); tb_[256 + t_] = valid ? (uu.a3 ? w2.y : w2.x) : 0.f; }
                  LDS_BARRIER(); }
                  EpiMoeUp E{(bf16_t*)(ws + WS_HID), (const int*)(ws + WS_TOKC), ssq, (const f32x2*)(ws + WS_WTS), (const LAS float*)(lds + LDS_RSTD)};
                  pg8::gemm_phase<EpiMoeUp, SchedMoe, false, true, false>(lds, GemmDesc{1024, 2048u, 2048u, 0}, S, E); }
                if (bid < nlate) {
                    asm volatile("s_waitcnt vmcnt(0)" ::: "memory"); __syncthreads();
                    if (threadIdx.x == 0) {
                        __builtin_amdgcn_fence(__ATOMIC_RELEASE, "agent"); asm volatile("s_waitcnt vmcnt(0)" ::: "memory");
                        unsigned* cw = (unsigned*)(ws + WS_CTL) + CW_MOESYNC + l * 32 + (bid >> 2);
                        (void)xb_add(cw, 1u);
                        unsigned sp = 0u; while (xb_ld(cw) < 4u) { __builtin_amdgcn_s_sleep(1); if (++sp > XB_SPIN_CAP) break; }
                        __builtin_amdgcn_fence(__ATOMIC_ACQUIRE, "agent"); asm volatile("s_waitcnt vmcnt(0)" ::: "memory");
                    }
                    __syncthreads();
                }
            }
            const int bb = bid - nlate, Gb = G - nlate;
            SchedMoe S{redeal ? (bid < nlate ? G + bid : bb) : bid, redeal ? (bid < nlate ? G : Gb) : G,
                       redeal ? (bid < nlate ? 1 : (bb < G ? (G - 1 - bb) / Gb + 1 : 0)) : (bid < nun ? (nun - 1 - bid) / G + 1 : 0),
                       true, tab, (const int*)(ws + WS_TOKC), (const char*)(ws + WS_HID), (const char*)(ws + WS_WD) + (size_t)l * 16 * 1024 * 512};
            { int t_ = threadIdx.x; asm volatile("" : "+v"(t_)); Unit uu; LAS int* tt_ = (LAS int*)(lds + LDS_RSTD);
              for (int i = 0; i < 4 && S.next(2 * i, uu); ++i) if (t_ < 256) tt_[i * 256 + t_] = (t_ < uu.a2) ? ((const int*)(ws + WS_TOKC))[uu.a1 + t_] : 0;
              LDS_BARRIER(); }
            EpiMoeDown E{xb, (float*)(ws + WS_SSQ), (const int*)(ws + WS_TOKC), (const LAS int*)(lds + LDS_RSTD)};
            pg8::gemm_phase<EpiMoeDown, SchedMoe, false, false, true>(lds, GemmDesc{256, 1024u, 512u, 0}, S, E);
            PE(6); SEAM(pb + 8);
        }
    }
    if (IN(N_PHASES - 1)) { PB(11); phase_final(p, bid, G); PE(11); }
#if PROBE_ID
    if (threadIdx.x == 0) { const unsigned long long tgt = __builtin_amdgcn_s_memrealtime() + PROBE_AMP * tprobe[0]; while (__builtin_amdgcn_s_memrealtime() < tgt) __builtin_amdgcn_s_sleep(8); }
#endif
#undef IN
#undef SEAM
}

extern "C" void kernel_launch(void* const* d_in, const int* in_sizes, int n_in, void* d_out, int out_size, void* d_ws, size_t ws_size, hipStream_t stream) {
    static int grid = 0;
    if (grid == 0) {
        if (n_in != 27 || out_size != NTOK * DM || ws_size < WS_END) { fprintf(stderr, "kernel_launch: unexpected shapes (n_in %d out %d ws %zu)\n", n_in, out_size, ws_size); grid = -1; return; }
        int dev = 0, cus = 0, per_cu = 0;
        if (hipGetDevice(&dev) != hipSuccess || hipDeviceGetAttribute(&cus, hipDeviceAttributeMultiprocessorCount, dev) != hipSuccess) { grid = -1; return; }
        if (hipFuncSetAttribute((const void*)mk_fwd, hipFuncAttributeMaxDynamicSharedMemorySize, LDS_BYTES) != hipSuccess) { fprintf(stderr, "kernel_launch: hipFuncSetAttribute failed\n"); grid = -1; return; }
        if (hipOccupancyMaxActiveBlocksPerMultiprocessor(&per_cu, (const void*)mk_fwd, NTHR, LDS_BYTES) != hipSuccess || per_cu < 1) { fprintf(stderr, "kernel_launch: occupancy query reports %d\n", per_cu); }
        (void)hipGetLastError();
        grid = cus;
    }
    if (grid < 0) return;
    (void)hipMemsetAsync((char*)d_ws + WS_CTL, 0, CTL_ZERO_BYTES, stream);
    Params a{};
    for (int i = 0; i < 27; ++i) a.in[i] = (const float*)d_in[i];
    a.out = (float*)d_out; a.ws = (unsigned char*)d_ws;
#if ONE_LAUNCH
    a.ph_lo = 0; a.ph_hi = N_PHASES;
    hipLaunchKernelGGL(mk_fwd, dim3(grid), dim3(NTHR), LDS_BYTES, stream, a);
#else
    for (int k = 0; k < N_PHASES; ++k) { a.ph_lo = k; a.ph_hi = k + 1; const int kind = k < 3 ? k : (k == N_PHASES - 1 ? 12 : 3 + (k - 3) % 9);
        for (int rr = 0; rr < RUNS(kind); ++rr) hipLaunchKernelGGL(mk_fwd, dim3(grid), dim3(NTHR), LDS_BYTES, stream, a); }
#endif
}
```

```cpp
#include <hip/hip_runtime.h>
#include <cstdio>
#include <cstdint>

#ifndef USE_MFMA
#define USE_MFMA 1
#endif
#ifndef ONE_LAUNCH
#define ONE_LAUNCH 1
#endif
#ifndef DIS
#define DIS 0
#endif
#define PHON(k) (!(((DIS) >> (k)) & 1))
#ifndef REP
#define REP 0
#endif
#define RUNS(k) ((((REP) >> (k)) & 1) ? 2 : 1)
#ifndef SREP
#define SREP 0
#endif
#define SUBR(k) ((((SREP) >> (k)) & 1) ? 2 : 1)
#ifndef ATTN_MFMA
#define ATTN_MFMA 1
#endif
#ifndef PROBE_ID
#define PROBE_ID 0
#endif
#define PROBE_AMP 4
#if PROBE_ID
#define QB_(id) do { if (PROBE_ID == (id) && threadIdx.x == 0) ((volatile __attribute__((address_space(3))) unsigned long long*)(lds + 131072 + 8192 + 512))[1] = __builtin_amdgcn_s_memrealtime(); } while (0)
#define QE_(id) do { if (PROBE_ID == (id) && threadIdx.x == 0) { volatile __attribute__((address_space(3))) unsigned long long* tp_ = (volatile __attribute__((address_space(3))) unsigned long long*)(lds + 131072 + 8192 + 512); tp_[0] = tp_[0] + (__builtin_amdgcn_s_memrealtime() - tp_[1]); } } while (0)
#else
#define QB_(id) do {} while (0)
#define QE_(id) do {} while (0)
#endif
#ifndef FOX_PRUNE
#define FOX_PRUNE 1
#endif

#define LAS __attribute__((address_space(3)))
#define GAS __attribute__((address_space(1)))
typedef unsigned short bf16_t;
typedef short bf16x8 __attribute__((ext_vector_type(8)));
typedef float f32x4 __attribute__((ext_vector_type(4)));
typedef float f32x2 __attribute__((ext_vector_type(2)));
typedef unsigned u32x4 __attribute__((ext_vector_type(4)));
typedef unsigned u32x2 __attribute__((ext_vector_type(2)));

constexpr int NTOK = 16384, DM = 1024, SEQ = 8192, NLAYER = 4, NY = 3072;
constexpr float EPS = 1e-6f, LOG2E = 1.4426950408889634f;
constexpr float C2 = 0.125f * LOG2E;
constexpr int NWAVES = 8, NTHR = 512;

constexpr size_t MiB = 1u << 20;
constexpr size_t WS_CTL = 0, CTL_ZERO_BYTES = 64 * 1024;
constexpr size_t WS_WFFB = 1 * MiB + 640 * 1024;
constexpr size_t WS_WRH = 1 * MiB;
constexpr size_t WS_WRL = 1 * MiB + 256 * 1024;
constexpr size_t WS_LOGF = 2 * MiB;
constexpr size_t WS_CFOX = 2 * MiB + 512 * 1024;
constexpr size_t WS_SSQ = 3 * MiB;
constexpr size_t WS_HU = 4 * MiB;
constexpr size_t WS_HD = 8 * MiB;
constexpr size_t WS_TOKC = 9 * MiB;
constexpr size_t WS_WTS = 10 * MiB + 512 * 1024;
constexpr size_t WS_MEMN = 11 * MiB;
constexpr size_t WS_KV = 12 * MiB;
constexpr size_t WS_WIN = 20 * MiB;
constexpr size_t WS_WOUT = 44 * MiB;
constexpr size_t WS_WQK = 52 * MiB;
constexpr size_t WS_WVO = 68 * MiB;
constexpr size_t WS_WGU = 84 * MiB;
constexpr size_t WS_WD = 148 * MiB;
constexpr size_t WS_XB = 180 * MiB;
constexpr size_t WS_CAT = 212 * MiB;
constexpr size_t WS_R1 = 244 * MiB;
constexpr size_t WS_PBUF = WS_R1;
constexpr size_t WS_HID = WS_R1 + 32 * MiB;
constexpr size_t WS_WQS = 340 * MiB;
constexpr size_t WS_WKVT = 348 * MiB;
constexpr size_t WS_WOT = 364 * MiB;
constexpr size_t WS_END = 372 * MiB;

constexpr int CW_TMO = 0, CW_KQMAX = 256, CW_MOECNT = 512, CW_ATTQ = 640, CW_MOESYNC = 704, CW_CONVQ = 1536, CW_BAR = 4096;

constexpr int LDS_STAGE = 0, LDS_STAGE_BYTES = 131072;
constexpr int LDS_EPI = 131072;
constexpr int LDS_MISC = 131072 + 8192;
constexpr int LDS_RSTD = 131072 + 8192 + 1024;
constexpr int LDS_BYTES = 131072 + 8192 + 1024 + 4096;

__device__ __forceinline__ float bf2f(unsigned b) { return __uint_as_float(b << 16); }
typedef __bf16 bf16x2_t __attribute__((ext_vector_type(2)));
__device__ __forceinline__ unsigned cvt_pk_bf16(float lo, float hi) { const f32x2 v = {lo, hi}; const bf16x2_t b = __builtin_convertvector(v, bf16x2_t); return __builtin_bit_cast(unsigned, b); }
__device__ __forceinline__ unsigned short f2bf1(float f) { return (unsigned short)(cvt_pk_bf16(f, 0.f) & 0xffffu); }
template <int K> __device__ __forceinline__ float swz_xor(float v) { return __int_as_float(__builtin_amdgcn_ds_swizzle(__float_as_int(v), (K << 10) | 0x1f)); }
__device__ __forceinline__ float x16_sum(float v) { auto r = __builtin_amdgcn_permlane16_swap(__float_as_uint(v), __float_as_uint(v), false, false); return __uint_as_float(r[0]) + __uint_as_float(r[1]); }
__device__ __forceinline__ float x16_max(float v) { auto r = __builtin_amdgcn_permlane16_swap(__float_as_uint(v), __float_as_uint(v), false, false); return fmaxf(__uint_as_float(r[0]), __uint_as_float(r[1])); }
__device__ __forceinline__ float x32_sum(float v) { auto r = __builtin_amdgcn_permlane32_swap(__float_as_uint(v), __float_as_uint(v), false, false); return __uint_as_float(r[0]) + __uint_as_float(r[1]); }
__device__ __forceinline__ float x32_max(float v) { auto r = __builtin_amdgcn_permlane32_swap(__float_as_uint(v), __float_as_uint(v), false, false); return fmaxf(__uint_as_float(r[0]), __uint_as_float(r[1])); }
template <int CTRL> __device__ __forceinline__ float dpp_f(float v) { return __int_as_float(__builtin_amdgcn_update_dpp(0, __float_as_int(v), CTRL, 0xf, 0xf, true)); }
__device__ __forceinline__ float wave_sum(float v) {
    v += dpp_f<0xB1>(v); v += dpp_f<0x4E>(v); v += dpp_f<0x141>(v); v += dpp_f<0x140>(v); v = x16_sum(v);
    return x32_sum(v);
}
__device__ __forceinline__ float sigmoidf_(float x) { return __builtin_amdgcn_rcpf(1.f + __expf(-x)); }
#define LDS_WAIT() asm volatile("s_waitcnt lgkmcnt(0)" ::: "memory")
#define LDS_BARRIER() asm volatile("s_waitcnt lgkmcnt(0)\n\ts_barrier" ::: "memory")
#define VM_WAIT() asm volatile("s_waitcnt vmcnt(0)" ::: "memory")

#define XB_TMO      128
#define XB_XCNT(j)  (256  + 64 * (j))
#define XB_XSUB(j)  (1280 + 64 * (j))
#define XB_XGEN(j)  (2304 + 64 * (j))
#define XB_TOP      3328
#define XB_TOPGEN   3392
#define XCD_BAR_WORDS 3456
#define XB_SPIN_CAP (1u << 22)
__device__ __forceinline__ unsigned xb_ld(unsigned* p)              { return __hip_atomic_load(p, __ATOMIC_RELAXED, __HIP_MEMORY_SCOPE_AGENT); }
__device__ __forceinline__ unsigned xb_add(unsigned* p, unsigned v) { return __hip_atomic_fetch_add(p, v, __ATOMIC_RELAXED, __HIP_MEMORY_SCOPE_AGENT); }
__device__ __forceinline__ unsigned xb_xcc_id() { return (unsigned)__builtin_amdgcn_s_getreg((3 << 11) | 20) & 0xFu; }
#define XB_SPIN(cond, bar) do { unsigned _sp = 0; while (cond) { __builtin_amdgcn_s_sleep(1); \
    if ((++_sp & 255u) == 0u) { if (xb_ld(&(bar)[XB_TMO])) break; if (_sp > XB_SPIN_CAP) { atomicAdd(&(bar)[XB_TMO], 1u); break; } } } } while (0)
struct XcdBarrier { unsigned* bar; unsigned x; volatile LAS unsigned* st; };
__device__ __forceinline__ XcdBarrier xcd_barrier_post(unsigned* bar, volatile LAS unsigned* st) {
    XcdBarrier b; b.bar = bar; b.x = xb_xcc_id(); b.st = st;
    if (threadIdx.x == 0) (void)xb_add(&bar[XB_XCNT(b.x)], 1u);
    return b;
}
__device__ __forceinline__ void xcd_barrier_complete(unsigned* bar, unsigned x, unsigned& nloc, unsigned& nx) {
    const unsigned G = gridDim.x * gridDim.y * gridDim.z;
    unsigned sum, cnt, mine, sp = 0u;
    for (;;) {
        sum = 0u; cnt = 0u; mine = 0u;
#pragma unroll
        for (unsigned j = 0; j < 16; ++j) { const unsigned c = xb_ld(&bar[XB_XCNT(j)]); sum += c; cnt += (c > 0u) ? 1u : 0u; mine = (j == x) ? c : mine; }
        if (sum == G) break;
        __builtin_amdgcn_s_sleep(1);
        if ((++sp & 255u) == 0u) { if (xb_ld(&bar[XB_TMO])) break; if (sp > XB_SPIN_CAP) { atomicAdd(&bar[XB_TMO], 1u); break; } }
    }
    nloc = mine > 0u ? mine : 1u; nx = cnt > 0u ? cnt : 1u;
}
__device__ __forceinline__ void xcd_barrier(const XcdBarrier& b) {
    asm volatile("s_waitcnt vmcnt(0)" ::: "memory");
    __syncthreads();
    if (threadIdx.x == 0) {
        unsigned* bar = b.bar;
        __builtin_amdgcn_s_waitcnt(0);
        unsigned nloc = b.st[0], nx = b.st[1];
        if (nloc == 0u) { xcd_barrier_complete(bar, b.x, nloc, nx); b.st[0] = nloc; b.st[1] = nx; }
        const unsigned old = xb_add(&bar[XB_XSUB(b.x)], 1u);
        const unsigned gen = old / nloc;
        if (old + 1u == (gen + 1u) * nloc) {
            __builtin_amdgcn_fence(__ATOMIC_RELEASE, "agent");
            asm volatile("s_waitcnt vmcnt(0)" ::: "memory");
            const unsigned og = xb_add(&bar[XB_TOP], 1u);
            const unsigned tg = og / nx;
            if (og + 1u == (tg + 1u) * nx) xb_add(&bar[XB_TOPGEN], 1u);
            else XB_SPIN(xb_ld(&bar[XB_TOPGEN]) == tg, bar);
            __builtin_amdgcn_fence(__ATOMIC_ACQUIRE, "agent");
            xb_add(&bar[XB_XGEN(b.x)], 1u);
            asm volatile("s_waitcnt vmcnt(0)" ::: "memory");
        } else {
            XB_SPIN(xb_ld(&bar[XB_XGEN(b.x)]) == gen, bar);
            __builtin_amdgcn_fence(__ATOMIC_ACQUIRE, "agent");
            asm volatile("s_waitcnt vmcnt(0)" ::: "memory");
        }
    }
    __syncthreads();
}

namespace pg8 {
constexpr int BM = 256, BK = 64, HALF = 128, HTB = HALF * BK * 2;
__host__ __device__ __forceinline__ int lds_byte(int r, int c) { const int st = (r >> 4) * 2 + (c >> 5), rr = r & 15, cc = c & 31, ob = rr * 64 + cc * 2; return st * 1024 + (ob ^ (((ob >> 9) & 1) << 5)); }
__host__ __device__ __forceinline__ void stage_rc(int b, int& R, int& C) { const int st = b / 1024, sb = b % 1024, swz = sb ^ (((sb >> 9) & 1) << 5); R = (st >> 1) * 16 + swz / 64; C = (st & 1) * 32 + (swz % 64) / 2; }
__host__ __device__ __forceinline__ int perm32(int rho) { const int n = rho >> 4, i = rho & 15; return 8 * (i >> 2) + 4 * n + (i & 3); }

struct Unit { int pm, pn, a0, a1, a2, a3, ord; };
struct GemmDesc { int K; unsigned lda, ldb; int ksplit; };


#if USE_MFMA
template <class Epi, class Sched, bool ALIGN_EPI, bool GATHER, bool BSPLIT>
__device__ __forceinline__ void gemm_phase(LAS unsigned char* lds, const GemmDesc g, const Sched& S, const Epi& E) {
    int tid = threadIdx.x; asm volatile("" : "+v"(tid));
    const int wid = __builtin_amdgcn_readfirstlane(tid >> 6), lane = tid & 63, wr = wid >> 2, wc = wid & 3, fr = lane & 15, fq = lane >> 4;
    const int nt = g.K / BK;
    int R0, C0; stage_rc(tid * 16, R0, C0);
    const unsigned voffB = (unsigned)((R0 & ~31) + perm32(R0 & 31)) * g.ldb + (unsigned)C0 * 2u, voffA = (unsigned)R0 * g.lda + (unsigned)C0 * 2u;
    const size_t qstepA = (size_t)64 * g.lda, qstepB = (size_t)64 * g.ldb;
    const size_t kstep = (size_t)(BK * 2);
    const size_t hstepB = (size_t)HALF * g.ldb, hstepA = GATHER ? (size_t)0 : (size_t)HALF * g.lda;
    const unsigned ldsw = (unsigned)wid * 1024u;
    const int aoff = lds_byte(wr * 64 + fr, fq * 8), boff = lds_byte(wc * 32 + fr, fq * 8);
#define PG8_SA(b, h) (((b) * 2 + (h)) * HTB)
#define PG8_SB(b, h) ((4 + (b) * 2 + (h)) * HTB)
#define PG8_STAGE(bufoff, gbase, voff) do { _Pragma("unroll") for (int _i = 0; _i < 2; ++_i) \
        __builtin_amdgcn_global_load_lds((const unsigned*)((const char*)(gbase) + (voff)[_i]), (LAS unsigned*)(lds + (bufoff) + ldsw + _i * 8192), 16, 0, 0); } while (0)
#define PG8_STAGE1(bufoff, gbase, voff, qstep) do { _Pragma("unroll") for (int _i = 0; _i < 2; ++_i) \
        __builtin_amdgcn_global_load_lds((const unsigned*)((const char*)(gbase) + _i * (qstep) + (voff)), (LAS unsigned*)(lds + (bufoff) + ldsw + _i * 8192), 16, 0, 0); } while (0)
#define PG8_STAGE_B(bufoff, gbase) PG8_STAGE1(bufoff, gbase, voffB, qstepB)
#define PG8_LDA(dst, b, h) do { _Pragma("unroll") for (int m = 0; m < 4; ++m) _Pragma("unroll") for (int k = 0; k < 2; ++k) dst[m][k] = *(const LAS bf16x8*)(lds + PG8_SA(b, h) + aoff + m * 2048 + k * 1024); } while (0)
#define PG8_LDB(dst, b, h) do { _Pragma("unroll") for (int n = 0; n < 2; ++n) _Pragma("unroll") for (int k = 0; k < 2; ++k) dst[n][k] = *(const LAS bf16x8*)(lds + PG8_SB(b, h) + boff + n * 2048 + k * 1024); } while (0)
#define PG8_MMA(ai, bj, At, Bt) do { __builtin_amdgcn_s_setprio(1); _Pragma("unroll") for (int m = 0; m < 4; ++m) _Pragma("unroll") for (int n = 0; n < 2; ++n) _Pragma("unroll") for (int k = 0; k < 2; ++k) \
        acc[ai][bj][m][n] = __builtin_amdgcn_mfma_f32_16x16x32_bf16(Bt[n][k], At[m][k], acc[ai][bj][m][n], 0, 0, 0); __builtin_amdgcn_s_setprio(0); } while (0)
#define PG8_WAIT_V(n) asm volatile("s_waitcnt vmcnt(" #n ")" ::: "memory")
#define PG8_WAIT_L(n) asm volatile("s_waitcnt lgkmcnt(" #n ")" ::: "memory")
#define PG8_BAR __builtin_amdgcn_s_barrier()
#define PG8_SCHED __builtin_amdgcn_sched_barrier(0)
#define PG8_OFFS(u, o) do { if constexpr (GATHER) { _Pragma("unroll") for (int _h = 0; _h < 2; ++_h) _Pragma("unroll") for (int _i = 0; _i < 2; ++_i) \
        o[_h][_i] = S.arow(u, _h * 128 + _i * 64 + R0) + (unsigned)C0 * 2u; } } while (0)
#define PG8_STAGE_A(bufoff, gbase, h, OFF) do { if constexpr (GATHER) { PG8_STAGE(bufoff, gbase, OFF[h]); } else { PG8_STAGE1(bufoff, (gbase) + (h) * hstepA, voffA, qstepA); } } while (0)
#define PG8_BP(base, base2, tt) ((base) + (size_t)(tt) * kstep)
    Unit cur, nxt; int ui = 0;
    if (!S.next(0, cur)) return;
    f32x4 acc[2][2][4][2];
#pragma unroll
    for (int a = 0; a < 2; ++a)
#pragma unroll
        for (int b = 0; b < 2; ++b)
#pragma unroll
            for (int m = 0; m < 4; ++m)
#pragma unroll
                for (int n = 0; n < 2; ++n) acc[a][b][m][n] = (f32x4){0.f, 0.f, 0.f, 0.f};
    bf16x8 At[4][2], B0[2][2], B1[2][2];
    unsigned coff[2][2], noff[2][2];
#pragma unroll
    for (int h = 0; h < 2; ++h)
#pragma unroll
        for (int i = 0; i < 2; ++i) { coff[h][i] = 0u; noff[h][i] = 0u; }
    PG8_OFFS(cur, coff);
    const char* cA = S.A(cur); const char* cB = S.B(cur); const char* cB2 = cB;
    PG8_STAGE_B(PG8_SB(0, 0), cB); PG8_STAGE_B(PG8_SB(0, 1), cB + hstepB); PG8_STAGE_A(PG8_SA(0, 0), cA, 0, coff); PG8_STAGE_A(PG8_SA(0, 1), cA, 1, coff);
    if (wr == 1) PG8_BAR;
    PG8_WAIT_V(2); PG8_BAR;
    PG8_STAGE_B(PG8_SB(1, 0), cB + kstep); PG8_STAGE_A(PG8_SA(1, 0), cA + kstep, 0, coff); PG8_STAGE_B(PG8_SB(1, 1), cB + hstepB + kstep);
    PG8_WAIT_V(6); PG8_BAR;
    for (;;) {
        const bool has_next = S.next(ui + 1, nxt);
        const char* nA = has_next ? S.A(nxt) : cA; const char* nB = has_next ? S.B(nxt) : cB; const char* nB2 = cB2;
        if constexpr (GATHER) { if (has_next) { PG8_OFFS(nxt, noff); } else {
#pragma unroll
            for (int h = 0; h < 2; ++h)
#pragma unroll
                for (int i = 0; i < 2; ++i) noff[h][i] = coff[h][i]; } }
        for (int t = 0; t < nt; t += 2) {
            const bool last = (t == nt - 2);
            const char* a1 = cA + (size_t)(t + 1) * kstep;
            const char* a2 = last ? nA : cA + (size_t)(t + 2) * kstep;
            const char* b2 = last ? nB : PG8_BP(cB, cB2, t + 2);
            const char* a3 = a2 + kstep;
            const char* b3 = last ? nB + kstep : PG8_BP(cB, cB2, t + 3);
            unsigned o2[2][2];
#pragma unroll
            for (int h = 0; h < 2; ++h)
#pragma unroll
                for (int i = 0; i < 2; ++i) o2[h][i] = GATHER ? (last ? noff[h][i] : coff[h][i]) : 0u;
            PG8_LDB(B0, 0, 0); PG8_LDB(B1, 0, 1); PG8_SCHED; PG8_LDA(At, 0, 0); PG8_STAGE_A(PG8_SA(1, 1), a1, 1, coff);
            PG8_WAIT_V(8); PG8_WAIT_L(0); PG8_BAR; PG8_MMA(0, 0, At, B0); PG8_MMA(0, 1, At, B1); PG8_BAR; PG8_SCHED;
            PG8_LDA(At, 0, 1); PG8_STAGE_B(PG8_SB(0, 0), b2); PG8_STAGE_B(PG8_SB(0, 1), b2 + hstepB); PG8_STAGE_A(PG8_SA(0, 0), a2, 0, o2);
            PG8_WAIT_V(8); PG8_WAIT_L(0); PG8_BAR; PG8_MMA(1, 0, At, B0); PG8_MMA(1, 1, At, B1); PG8_BAR; PG8_SCHED;
            PG8_LDB(B0, 1, 0); PG8_LDB(B1, 1, 1); PG8_SCHED; PG8_LDA(At, 1, 0); PG8_STAGE_A(PG8_SA(0, 1), a2, 1, o2);
            PG8_WAIT_V(8); PG8_WAIT_L(0); PG8_BAR; PG8_MMA(0, 0, At, B0); PG8_MMA(0, 1, At, B1); PG8_BAR; PG8_SCHED;
            PG8_LDA(At, 1, 1); PG8_STAGE_B(PG8_SB(1, 0), b3); PG8_STAGE_B(PG8_SB(1, 1), b3 + hstepB); PG8_STAGE_A(PG8_SA(1, 0), a3, 0, o2);
            PG8_WAIT_V(8); PG8_WAIT_L(0); PG8_BAR; PG8_MMA(1, 0, At, B0); PG8_MMA(1, 1, At, B1); PG8_BAR; PG8_SCHED;
        }
        const bool cont = BSPLIT && S.chain(cur);
        if (!cont) {
        if constexpr (ALIGN_EPI) { if (wr == 0) PG8_BAR; }
        { int t2 = threadIdx.x; asm volatile("" : "+v"(t2)); const int l2 = t2 & 63; E(acc, cur, wr, wc, l2 & 15, l2 >> 4); }
        }
        if (!has_next) break;
        if (!cont) {
#pragma unroll
        for (int a = 0; a < 2; ++a)
#pragma unroll
            for (int b = 0; b < 2; ++b)
#pragma unroll
                for (int m = 0; m < 4; ++m)
#pragma unroll
                    for (int n = 0; n < 2; ++n) acc[a][b][m][n] = (f32x4){0.f, 0.f, 0.f, 0.f};
        }
        cur = nxt; cA = nA; cB = nB; cB2 = nB2; ++ui;
#pragma unroll
        for (int h = 0; h < 2; ++h)
#pragma unroll
            for (int i = 0; i < 2; ++i) coff[h][i] = noff[h][i];
        if constexpr (ALIGN_EPI) { if (!cont && wr == 1) PG8_BAR; }
    }
    PG8_WAIT_V(0);
    if constexpr (!ALIGN_EPI) { if (wr == 0) PG8_BAR; }
    PG8_BAR;
#undef PG8_SA
#undef PG8_SB
#undef PG8_STAGE
#undef PG8_LDA
#undef PG8_LDB
#undef PG8_MMA
#undef PG8_WAIT_V
#undef PG8_WAIT_L
#undef PG8_BAR
#undef PG8_SCHED
#undef PG8_OFFS
#undef PG8_STAGE_A
#undef PG8_STAGE1
#undef PG8_STAGE_B
#undef PG8_BP
}
#else
template <class Epi, class Sched, bool ALIGN_EPI, bool GATHER, bool BSPLIT>
__device__ __forceinline__ void gemm_phase(LAS unsigned char* lds, const GemmDesc g, const Sched& S, const Epi& E) {
    const int tid = threadIdx.x, wid = __builtin_amdgcn_readfirstlane(tid >> 6), lane = tid & 63, wr = wid >> 2, wc = wid & 3, fr = lane & 15, fq = lane >> 4;
    Unit cur;
    for (int ui = 0; S.next(ui, cur); ++ui) {
        f32x4 acc[2][2][4][2];
#pragma unroll
        for (int a = 0; a < 2; ++a)
#pragma unroll
            for (int b = 0; b < 2; ++b)
#pragma unroll
                for (int m = 0; m < 4; ++m)
#pragma unroll
                    for (int n = 0; n < 2; ++n) acc[a][b][m][n] = (f32x4){0.f, 0.f, 0.f, 0.f};
        const char* cA = S.A(cur); const char* cB = S.B(cur); const char* cB2 = BSPLIT ? S.B2(cur) : cB;
        unsigned aro[2][4];
#pragma unroll
        for (int ai = 0; ai < 2; ++ai)
#pragma unroll
            for (int m = 0; m < 4; ++m) { const int r = ai * 128 + wr * 64 + m * 16 + fr; aro[ai][m] = GATHER ? S.arow(cur, r) : (unsigned)r * g.lda; }
        for (int k0 = 0; k0 < g.K; k0 += 4) {
            u32x2 av[2][4];
#pragma unroll
            for (int ai = 0; ai < 2; ++ai)
#pragma unroll
                for (int m = 0; m < 4; ++m) av[ai][m] = *(const u32x2*)(cA + aro[ai][m] + (size_t)k0 * 2);
            const char* bb = (BSPLIT && k0 >= g.ksplit * 64) ? cB2 : cB;
#pragma unroll
            for (int bj = 0; bj < 2; ++bj)
#pragma unroll
                for (int n = 0; n < 2; ++n)
#pragma unroll
                    for (int j = 0; j < 4; ++j) {
                        const int c = bj * 128 + wc * 32 + fq * 8 + n * 4 + j;
                        const u32x2 bv = *(const u32x2*)(bb + (size_t)c * g.ldb + (size_t)k0 * 2);
                        const float b0 = bf2f(bv.x & 0xffffu), b1 = bf2f(bv.x >> 16), b2 = bf2f(bv.y & 0xffffu), b3 = bf2f(bv.y >> 16);
#pragma unroll
                        for (int ai = 0; ai < 2; ++ai)
#pragma unroll
                            for (int m = 0; m < 4; ++m) {
                                const u32x2 a = av[ai][m];
                                acc[ai][bj][m][n][j] += bf2f(a.x & 0xffffu) * b0 + bf2f(a.x >> 16) * b1 + bf2f(a.y & 0xffffu) * b2 + bf2f(a.y >> 16) * b3;
                            }
                    }
        }
        E(acc, cur, wr, wc, fr, fq);
    }
    __syncthreads();
}
#endif
}
using pg8::Unit; using pg8::GemmDesc;

__device__ __forceinline__ float row_rstd(const float* ssq, int row) {
    const f32x4* p = (const f32x4*)(ssq + (size_t)row * 16);
    const f32x4 a = p[0], b = p[1], c = p[2], d = p[3];
    const float s = ((a.x + a.y) + (a.z + a.w)) + ((b.x + b.y) + (b.z + b.w)) + ((c.x + c.y) + (c.z + c.w)) + ((d.x + d.y) + (d.z + d.w));
    return rsqrtf(s * (1.f / 1024.f) + EPS);
}
__device__ __forceinline__ u32x4 pack8(f32x4 v0, f32x4 v1) { u32x4 w; w.x = cvt_pk_bf16(v0[0], v0[1]); w.y = cvt_pk_bf16(v0[2], v0[3]); w.z = cvt_pk_bf16(v1[0], v1[1]); w.w = cvt_pk_bf16(v1[2], v1[3]); return w; }

struct EpiBf16 {
    bf16_t* O; int ldc; const float* ssq; unsigned* kq; const LAS float* rt;
    __device__ __forceinline__ void operator()(const f32x4 (&acc)[2][2][4][2], const Unit& u, int wr, int wc, int fr, int fq) const {
        float nmax[2] = {0.f, 0.f};
        const bool donorm = kq != nullptr && u.pn < 4;
#pragma unroll
        for (int ai = 0; ai < 2; ++ai)
#pragma unroll
            for (int m = 0; m < 4; ++m) {
                const int r = ai * 128 + wr * 64 + m * 16 + fr;
                const float rs = (rt && u.a2 < 4) ? rt[u.a2 * 256 + r] : (ssq ? row_rstd(ssq, u.a1 + r) : 1.f);
                bf16_t* rowp = O + (size_t)u.a0 + (size_t)r * ldc + wc * 32 + fq * 8;
#pragma unroll
                for (int bj = 0; bj < 2; ++bj) { const u32x4 w = pack8(acc[ai][bj][m][0] * rs, acc[ai][bj][m][1] * rs); *(u32x4*)(rowp + bj * 128) = w;
                    if (donorm) { float s = 0.f;
#pragma unroll
                        for (int e = 0; e < 4; ++e) { const float a = bf2f(w[e] & 0xffffu), b2 = bf2f(w[e] >> 16); s += a * a + b2 * b2; }
                        s = x16_sum(s); s = x32_sum(s); nmax[bj] = fmaxf(nmax[bj], s); } }
                __builtin_amdgcn_sched_barrier(0);
            }
        if (donorm) {
#pragma unroll
            for (int bj = 0; bj < 2; ++bj) { float v = nmax[bj];
                v = fmaxf(v, dpp_f<0xB1>(v)); v = fmaxf(v, dpp_f<0x4E>(v)); v = fmaxf(v, dpp_f<0x141>(v)); v = fmaxf(v, dpp_f<0x140>(v));
                if (fr == 0 && fq == 0) { const int b = u.pm >> 5, isk = u.pn >> 1, head = (u.pn & 1) * 4 + bj * 2 + (wc >> 1);
                    atomicMax(&kq[((b * 8 + head) * 2 + isk) * 2 + (wc & 1)], __float_as_uint(v)); } }
        }
    }
};
struct EpiResidual {
    bf16_t* xb; float* ssq;
    __device__ __forceinline__ void operator()(const f32x4 (&acc)[2][2][4][2], const Unit& u, int wr, int wc, int fr, int fq) const {
#pragma unroll
        for (int ai = 0; ai < 2; ++ai) {
        u32x4 xi[2][4][2];
#pragma unroll
            for (int m = 0; m < 4; ++m)
#pragma unroll
                for (int bj = 0; bj < 2; ++bj) xi[ai][m][bj] = *(const u32x4*)(xb + (size_t)(u.pm * 256 + ai * 128 + wr * 64 + m * 16 + fr) * DM + u.pn * 256 + bj * 128 + wc * 32 + fq * 8);
        __builtin_amdgcn_sched_barrier(0);
#pragma unroll
            for (int m = 0; m < 4; ++m) {
                const int row = u.pm * 256 + ai * 128 + wr * 64 + m * 16 + fr;
                float ss = 0.f;
#pragma unroll
                for (int bj = 0; bj < 2; ++bj) {
                    const size_t o = (size_t)row * DM + u.pn * 256 + bj * 128 + wc * 32 + fq * 8;
                    const u32x4 x4 = xi[ai][m][bj];
                    f32x4 v0, v1;
                    v0[0] = acc[ai][bj][m][0][0] + bf2f(x4.x & 0xffffu); v0[1] = acc[ai][bj][m][0][1] + bf2f(x4.x >> 16); v0[2] = acc[ai][bj][m][0][2] + bf2f(x4.y & 0xffffu); v0[3] = acc[ai][bj][m][0][3] + bf2f(x4.y >> 16);
                    v1[0] = acc[ai][bj][m][1][0] + bf2f(x4.z & 0xffffu); v1[1] = acc[ai][bj][m][1][1] + bf2f(x4.z >> 16); v1[2] = acc[ai][bj][m][1][2] + bf2f(x4.w & 0xffffu); v1[3] = acc[ai][bj][m][1][3] + bf2f(x4.w >> 16);
                    *(u32x4*)(xb + o) = pack8(v0, v1);
                    ss += (v0[0] * v0[0] + v0[1] * v0[1]) + (v0[2] * v0[2] + v0[3] * v0[3]) + (v1[0] * v1[0] + v1[1] * v1[1]) + (v1[2] * v1[2] + v1[3] * v1[3]);
                }
                ss = x16_sum(ss); ss = x32_sum(ss);
                if (fq == 0) ssq[(size_t)row * 16 + u.pn * 4 + wc] = ss;
            }
        __builtin_amdgcn_sched_barrier(0);
        }
    }
};
struct EpiSoftmax {
    bf16_t* P; const float* ssq; LAS float* scr; const LAS float* rt;
    __device__ __forceinline__ void operator()(const f32x4 (&acc)[2][2][4][2], const Unit& u, int wr, int wc, int fr, int fq) const {
#pragma unroll
        for (int ai = 0; ai < 2; ++ai)
#pragma unroll
            for (int m = 0; m < 4; ++m) {
                const int rl = ai * 128 + wr * 64 + m * 16 + fr;
                const float rs = (u.a2 < 4 ? rt[u.a2 * 256 + rl] : row_rstd(ssq, u.pm * 256 + rl)) * (LOG2E / 16.f);
                float mm = -INFINITY;
#pragma unroll
                for (int bj = 0; bj < 2; ++bj)
#pragma unroll
                    for (int n = 0; n < 2; ++n)
#pragma unroll
                        for (int j = 0; j < 4; ++j) mm = fmaxf(mm, acc[ai][bj][m][n][j] * rs);
                mm = x16_max(mm); mm = x32_max(mm);
                if (fq == 0) scr[rl * 4 + wc] = mm;
            }
        LDS_WAIT(); __builtin_amdgcn_s_barrier();
#pragma unroll
        for (int ai = 0; ai < 2; ++ai)
#pragma unroll
            for (int m = 0; m < 4; ++m) {
                const int rl = ai * 128 + wr * 64 + m * 16 + fr;
                const float rs = (u.a2 < 4 ? rt[u.a2 * 256 + rl] : row_rstd(ssq, u.pm * 256 + rl)) * (LOG2E / 16.f);
                const f32x4 q = *(const LAS f32x4*)(scr + rl * 4);
                const float M = fmaxf(fmaxf(q.x, q.y), fmaxf(q.z, q.w));
                float s = 0.f;
#pragma unroll
                for (int bj = 0; bj < 2; ++bj)
#pragma unroll
                    for (int n = 0; n < 2; ++n)
#pragma unroll
                        for (int j = 0; j < 4; ++j) s += __builtin_amdgcn_exp2f(acc[ai][bj][m][n][j] * rs - M);
                s = x16_sum(s); s = x32_sum(s);
                if (fq == 0) scr[1024 + rl * 4 + wc] = s;
            }
        LDS_WAIT(); __builtin_amdgcn_s_barrier();
#pragma unroll
        for (int ai = 0; ai < 2; ++ai)
#pragma unroll
            for (int m = 0; m < 4; ++m) {
                const int rl = ai * 128 + wr * 64 + m * 16 + fr;
                const float r = (u.a2 < 4 ? rt[u.a2 * 256 + rl] : row_rstd(ssq, u.pm * 256 + rl)) * (LOG2E / 16.f);
                const f32x4 qm = *(const LAS f32x4*)(scr + rl * 4);
                const float M = fmaxf(fmaxf(qm.x, qm.y), fmaxf(qm.z, qm.w));
                const f32x4 q = *(const LAS f32x4*)(scr + 1024 + rl * 4);
                const float inv = 1.f / ((q.x + q.y) + (q.z + q.w));
                bf16_t* rowp = P + (size_t)(u.pm * 256 + rl) * DM + u.pn * 256 + wc * 32 + fq * 8;
#pragma unroll
                for (int bj = 0; bj < 2; ++bj) {
                    f32x4 v0, v1;
#pragma unroll
                    for (int j = 0; j < 4; ++j) { v0[j] = __builtin_amdgcn_exp2f(acc[ai][bj][m][0][j] * r - M) * inv; v1[j] = __builtin_amdgcn_exp2f(acc[ai][bj][m][1][j] * r - M) * inv; }
                    *(u32x4*)(rowp + bj * 128) = pack8(v0, v1);
                }
            }
        LDS_WAIT(); __builtin_amdgcn_s_barrier();
    }
};
struct EpiMoeUp {
    bf16_t* hid; const int* tokc; const float* ssq; const f32x2* wts; const LAS float* tb;
    __device__ __forceinline__ void operator()(const f32x4 (&acc)[2][2][4][2], const Unit& u, int wr, int wc, int fr, int fq) const {
#pragma unroll
        for (int ai = 0; ai < 2; ++ai)
#pragma unroll
            for (int m = 0; m < 4; ++m) {
                const int rl = ai * 128 + wr * 64 + m * 16 + fr;
                float rs, w;
                if (u.ord == 0) { rs = tb[rl]; w = tb[256 + rl]; }
                else { const bool valid = rl < u.a2; const int tok = valid ? tokc[u.a1 + rl] : 0; rs = row_rstd(ssq, tok); const f32x2 w2 = wts[tok]; w = valid ? (u.a3 ? w2.y : w2.x) : 0.f; }
                f32x4 h[2];
#pragma unroll
                for (int n = 0; n < 2; ++n)
#pragma unroll
                    for (int j = 0; j < 4; ++j) { const float gt = acc[ai][0][m][n][j] * rs, up = acc[ai][1][m][n][j] * rs; h[n][j] = gt * __builtin_amdgcn_rcpf(1.f + __expf(-gt)) * up * w; }
                *(u32x4*)(hid + (size_t)(u.a0 + rl) * 512 + u.a3 * 256 + u.pn * 128 + wc * 32 + fq * 8) = pack8(h[0], h[1]);
            }
    }
};
struct EpiMoeDown {
    bf16_t* xb; float* ssq; const int* tokc; const LAS int* tt;
    __device__ __forceinline__ void operator()(const f32x4 (&acc)[2][2][4][2], const Unit& u, int wr, int wc, int fr, int fq) const {
#pragma unroll
        for (int ai = 0; ai < 2; ++ai) {
            u32x4 xi[4][2]; int tokv[4];
#pragma unroll
            for (int m = 0; m < 4; ++m) {
                const int rl = ai * 128 + wr * 64 + m * 16 + fr;
                const bool valid = rl < u.a2;
                tokv[m] = valid ? (u.ord < 4 ? tt[u.ord * 256 + rl] : tokc[u.a1 + rl]) : 0;
#pragma unroll
                for (int bj = 0; bj < 2; ++bj) xi[m][bj] = *(const u32x4*)(xb + (size_t)tokv[m] * DM + u.pn * 256 + bj * 128 + wc * 32 + fq * 8);
            }
            __builtin_amdgcn_sched_barrier(0);
#pragma unroll
            for (int m = 0; m < 4; ++m) {
                const int rl = ai * 128 + wr * 64 + m * 16 + fr;
                const bool valid = rl < u.a2;
                const int tok = tokv[m];
                float ss = 0.f;
#pragma unroll
                for (int bj = 0; bj < 2; ++bj) {
                    const size_t o = (size_t)tok * DM + u.pn * 256 + bj * 128 + wc * 32 + fq * 8;
                    const u32x4 x4 = xi[m][bj];
                    f32x4 v0, v1;
                    v0[0] = acc[ai][bj][m][0][0] + bf2f(x4.x & 0xffffu); v0[1] = acc[ai][bj][m][0][1] + bf2f(x4.x >> 16); v0[2] = acc[ai][bj][m][0][2] + bf2f(x4.y & 0xffffu); v0[3] = acc[ai][bj][m][0][3] + bf2f(x4.y >> 16);
                    v1[0] = acc[ai][bj][m][1][0] + bf2f(x4.z & 0xffffu); v1[1] = acc[ai][bj][m][1][1] + bf2f(x4.z >> 16); v1[2] = acc[ai][bj][m][1][2] + bf2f(x4.w & 0xffffu); v1[3] = acc[ai][bj][m][1][3] + bf2f(x4.w >> 16);
                    if (valid) *(u32x4*)(xb + o) = pack8(v0, v1);
                    ss += (v0[0] * v0[0] + v0[1] * v0[1]) + (v0[2] * v0[2] + v0[3] * v0[3]) + (v1[0] * v1[0] + v1[1] * v1[1]) + (v1[2] * v1[2] + v1[3] * v1[3]);
                }
                ss = x16_sum(ss); ss = x32_sum(ss);
                if (valid && fq == 0) ssq[(size_t)tok * 16 + u.pn * 4 + wc] = ss;
            }
            __builtin_amdgcn_sched_barrier(0);
        }
    }
};

struct SchedGrid {
    int nM, nN, nwg, G, c; const char* Ab; const char* Bb; size_t astride, bstride, bbatch; int ldc;
    __device__ __forceinline__ bool next(int i, Unit& u) const {
        const long L = (long)i * G + c; if (L >= nwg) return false;
        int wgid = (int)L; { const int q = nwg / 8, r = nwg % 8, xcd = wgid % 8, off = wgid / 8; wgid = (xcd < r ? xcd * (q + 1) : r * (q + 1) + (xcd - r) * q) + off; }
        const int nig = 8 * nN, gid = wgid / nig, fm = gid * 8, gsz = (nM - fm) < 8 ? (nM - fm) : 8;
        u.pm = fm + ((wgid % nig) % gsz); u.pn = (wgid % nig) / gsz;
        u.a0 = u.pm * 256 * ldc + u.pn * 256; u.a1 = u.pm * 256; u.a2 = i; u.a3 = 0; u.ord = i; return true;
    }
    __device__ __forceinline__ const char* A(const Unit& u) const { return Ab + (size_t)u.pm * astride; }
    __device__ __forceinline__ const char* B(const Unit& u) const { return Bb + (size_t)u.pn * bstride + (u.pm >= 32 ? bbatch : 0); }
    __device__ __forceinline__ const char* B2(const Unit& u) const { return B(u); }
    __device__ __forceinline__ unsigned arow(const Unit&, int) const { return 0u; }
    __device__ __forceinline__ bool chain(const Unit&) const { return false; }
};
struct SchedKV {
    int G, c; const char* memn; const char* wkvt;
    __device__ __forceinline__ bool next(int i, Unit& u) const {
        const int L = i * G + c; if (L >= 64) return false;
        const int l = L >> 4; u.pm = (L >> 3) & 1; u.pn = L & 7; u.a2 = l; u.a3 = 0;
        u.a0 = l * 512 * 2048 + u.pm * 256 * 2048 + u.pn * 256; u.a1 = 0; u.ord = i; return true;
    }
    __device__ __forceinline__ const char* A(const Unit& u) const { return memn + (size_t)u.pm * 256 * 2048; }
    __device__ __forceinline__ const char* B(const Unit& u) const { return wkvt + ((size_t)u.a2 * 2048 + (size_t)u.pn * 256) * 2048; }
    __device__ __forceinline__ const char* B2(const Unit& u) const { return B(u); }
    __device__ __forceinline__ unsigned arow(const Unit&, int) const { return 0u; }
    __device__ __forceinline__ bool chain(const Unit&) const { return false; }
};
struct SchedQK {
    int G, c; const char* kv; const char* wqs;
    __device__ __forceinline__ bool next(int i, Unit& u) const {
        const int L = i * G + c; if (L >= 128) return false;
        const int l = L >> 5, b = (L >> 4) & 1, h = (L >> 2) & 3; u.pn = L & 3; u.pm = 0; u.a1 = l; u.a2 = b; u.a3 = h;
        u.a0 = ((l * 2 + b) * 1024 + h * 256) * 1024 + u.pn * 256; u.ord = i; return true;
    }
    __device__ __forceinline__ const char* A(const Unit& u) const { return kv + (((size_t)u.a1 * 512 + u.a2 * 256) * 2048 + u.a3 * 256) * 2; }
    __device__ __forceinline__ const char* B(const Unit& u) const { return wqs + (((size_t)u.a1 * 1024 + u.pn * 256) * 1024 + u.a3 * 256) * 2; }
    __device__ __forceinline__ const char* B2(const Unit& u) const { return B(u); }
    __device__ __forceinline__ unsigned arow(const Unit&, int) const { return 0u; }
    __device__ __forceinline__ bool chain(const Unit&) const { return false; }
};
struct SchedVO {
    int G, c; const char* kv; const char* wot;
    __device__ __forceinline__ bool next(int i, Unit& u) const {
        const int L = i * G + c; if (L >= 128) return false;
        const int l = L >> 5, b = (L >> 4) & 1, h = (L >> 2) & 3; u.pm = L & 3; u.pn = 0; u.a1 = l; u.a2 = b; u.a3 = h;
        u.a0 = ((l * 2 + b) * 1024 + u.pm * 256) * 1024 + h * 256; u.ord = i; return true;
    }
    __device__ __forceinline__ const char* A(const Unit& u) const { return wot + (((size_t)u.a1 * 1024 + u.pm * 256) * 1024 + u.a3 * 256) * 2; }
    __device__ __forceinline__ const char* B(const Unit& u) const { return kv + (((size_t)u.a1 * 512 + u.a2 * 256) * 2048 + 1024 + u.a3 * 256) * 2; }
    __device__ __forceinline__ const char* B2(const Unit& u) const { return B(u); }
    __device__ __forceinline__ unsigned arow(const Unit&, int) const { return 0u; }
    __device__ __forceinline__ bool chain(const Unit&) const { return false; }
};
struct SchedMoe {
    int base, stride, cnt; bool down; const volatile LAS int* tab; const int* tokc; const char* Ab; const char* Wb;
    __device__ __forceinline__ bool next(int i, Unit& u) const {
        const int half = down ? (i & 1) : 0, ii = down ? (i >> 1) : i;
        if (ii >= cnt) return false;
        const int L = base + ii * stride;
        const int q = L >> 2, sub = L & 3;
        int cc = 0;
        for (int k = 0; k < 24; ++k) if (q >= tab[k + 1]) cc = k + 1;
        const int j = q - tab[cc], n = tab[32 + cc];
        const int g = cc / 6, pi = cc % 6;
        const int e1 = pi < 3 ? 0 : (pi < 5 ? 1 : 2), e2 = pi < 3 ? pi + 1 : (pi < 5 ? pi - 1 : 3);
        u.a0 = q * 256; u.a1 = cc * 16384 + j * 256; u.a2 = (n - j * 256) < 256 ? (n - j * 256) : 256;
        if (!down) { const int s = sub >> 1; u.a3 = s; u.pn = sub & 1; u.pm = g * 4 + (s ? e2 : e1); }
        else { u.a3 = half; u.pn = sub; u.pm = g * 4 + (half ? e2 : e1); }
        u.pm = __builtin_amdgcn_readfirstlane(u.pm); u.pn = __builtin_amdgcn_readfirstlane(u.pn); u.a0 = __builtin_amdgcn_readfirstlane(u.a0);
        u.a1 = __builtin_amdgcn_readfirstlane(u.a1); u.a2 = __builtin_amdgcn_readfirstlane(u.a2); u.a3 = __builtin_amdgcn_readfirstlane(u.a3); u.ord = ii;
        return true;
    }
    __device__ __forceinline__ const char* A(const Unit& u) const { return down ? Ab + (size_t)u.a0 * 1024 + (size_t)u.a3 * 512 : Ab; }
    __device__ __forceinline__ const char* B(const Unit& u) const {
        return down ? Wb + (((size_t)u.pm * 1024 + u.pn * 256) * 256) * 2 : Wb + (((size_t)u.pm * 512 + u.pn * 256) * 1024) * 2; }
    __device__ __forceinline__ const char* B2(const Unit& u) const { return B(u); }
    __device__ __forceinline__ unsigned arow(const Unit& u, int r) const { const int tok = (r < u.a2) ? tokc[u.a1 + r] : 0; return (unsigned)tok * 2048u; }
    __device__ __forceinline__ bool chain(const Unit& u) const { return down && u.a3 == 0; }
};

struct Params { const float* in[27]; float* out; unsigned char* ws; int ph_lo, ph_hi; };
#define PIN(k) (p.in[(k)])
__device__ __forceinline__ const GAS float* ping_(const Params& p, int i) { asm volatile("" : "+s"(i)); return (const GAS float*)p.in[i]; }
#define PING(k) ping_(p, (k))

__device__ __forceinline__ void tr_item(const float* src, int ld, int c0, int K, int k0, const float* gain, float scale, bf16_t* dst, LAS float* scr, int lane) {
    float tv[32];
#pragma unroll
    for (int i = 0; i < 32; ++i) tv[i] = src[(size_t)(k0 + 2 * i + (lane >> 5)) * ld + c0 + (lane & 31)];
#pragma unroll
    for (int i = 0; i < 32; ++i) { const int kk = 2 * i + (lane >> 5); const float gsc = gain ? gain[k0 + kk] * scale : scale; scr[kk * 33 + (lane & 31)] = tv[i] * gsc; }
    LDS_WAIT(); asm volatile("" ::: "memory");
    const int c = lane & 7;
#pragma unroll
    for (int j = 0; j < 4; ++j) { const int n = (lane >> 3) + 8 * j; const LAS float* s = scr + (8 * c) * 33 + n;
        u32x4 o; o.x = cvt_pk_bf16(s[0 * 33], s[1 * 33]); o.y = cvt_pk_bf16(s[2 * 33], s[3 * 33]); o.z = cvt_pk_bf16(s[4 * 33], s[5 * 33]); o.w = cvt_pk_bf16(s[6 * 33], s[7 * 33]);
        *(u32x4*)(dst + (size_t)n * K + k0 + 8 * c) = o; }
    LDS_WAIT(); asm volatile("" ::: "memory");
}

__device__ __forceinline__ void conv_item(const Params& p, int l, int r, LAS float* scr, int lane) {
    unsigned char* ws = p.ws;
    if (r < 1536) {
        const int kb = r / 96, nb = r % 96, n0 = nb * 32, c0 = n0 < 1536 ? n0 : n0 + 8;
        tr_item(PIN(3) + (size_t)l * 1024 * 3080, 3080, c0, 1024, kb * 64, PIN(2) + l * 1024, n0 < 512 ? C2 : 1.f, (bf16_t*)(ws + WS_WIN) + ((size_t)l * 3072 + n0) * 1024, scr, lane); return; }
    r -= 1536;
    if (r < 512) {
        const int kb = r / 32, nb = r % 32, k0 = kb * 64;
        const float* gain = k0 < 512 ? PIN(5) + l * 512 : (k0 < 768 ? PIN(7) + l * 256 - 512 : nullptr);
        tr_item(PIN(12) + (size_t)l * 1024 * 1024, 1024, nb * 32, 1024, k0, gain, 1.f, (bf16_t*)(ws + WS_WOUT) + ((size_t)l * 1024 + nb * 32) * 1024, scr, lane); return; }
    r -= 512;
    if (r < 1024) {
        const int kb = r / 64, nb = r % 64;
        tr_item(PIN(16) + (size_t)l * 1024 * 2048, 2048, nb * 32, 1024, kb * 64, nullptr, 1.f, (bf16_t*)(ws + WS_WKVT) + ((size_t)l * 2048 + nb * 32) * 1024, scr, lane); return; }
    r -= 1024;
    if (r < 512) {
        const int kb = r / 32, nb = r % 32;
        tr_item(PIN(17) + (size_t)l * 1024 * 1024, 1024, nb * 32, 1024, kb * 64, nullptr, 1.f, (bf16_t*)(ws + WS_WOT) + ((size_t)l * 1024 + nb * 32) * 1024, scr, lane); return; }
    r -= 512;
    if (r < 4096) {
        const int e = r >> 8, rr = r & 255, kb = rr >> 4, nb = rr & 15;
        const int orow = nb * 32, t = orow >> 8, half = (orow >> 7) & 1, j = orow & 127;
        const float* src = (half ? PIN(24) : PIN(23)) + ((size_t)l * 16 + e) * 1024 * 256;
        tr_item(src, 256, t * 128 + j, 1024, kb * 64, PIN(18) + l * 1024, 1.f, (bf16_t*)(ws + WS_WGU) + (((size_t)l * 16 + e) * 512 + orow) * 1024, scr, lane); return; }
    r -= 4096;
    {
        const int e = r >> 7, rr = r & 127, kb = rr >> 5, nb = rr & 31;
        tr_item(PIN(25) + ((size_t)l * 16 + e) * 256 * 1024, 1024, nb * 32, 256, kb * 64, nullptr, 1.f, (bf16_t*)(ws + WS_WD) + (((size_t)l * 16 + e) * 1024 + nb * 32) * 256, scr, lane); }
}
__device__ __forceinline__ int conv_deferred_r(int d) { return d < 2048 ? d : d + 1536; }

__device__ __forceinline__ void phase_pro_a(const Params& p, LAS unsigned char* lds, int bid, int G) {
    int tid = threadIdx.x; asm volatile("" : "+v"(tid));
    const int lane = tid & 63, wave = tid >> 6;
    unsigned char* ws = p.ws;
    LAS float* scr = (LAS float*)(lds + wave * 16384);
    const int gw = bid * NWAVES + wave, NGW = G * NWAVES;
    constexpr int N_EARLY = 2048 + 4 * 1536;
    for (int it = gw; it < N_EARLY; it += NGW) {
        if (it < 2048) conv_item(p, 0, it, scr, lane);
        else { const int q = it - 2048; conv_item(p, q / 1536, 2048 + q % 1536, scr, lane); }
    }
    { constexpr unsigned NV = (unsigned)NLAYER * 1024u * 256u; const unsigned stp = (unsigned)G * NTHR;
      for (unsigned i4 = (unsigned)bid * NTHR + (unsigned)tid; i4 < NV; i4 += stp * 4u) {
        f32x4 v[4]; float gsc[4];
#pragma unroll
        for (int q = 0; q < 4; ++q) { const unsigned i = i4 + (unsigned)q * stp; if (i < NV) { const size_t e = (size_t)i * 4; v[q] = *(const f32x4*)(PIN(15) + e); gsc[q] = PIN(13)[(int)(e >> 20) * 1024 + (int)((e >> 10) & 1023)]; } }
#pragma unroll
        for (int q = 0; q < 4; ++q) { const unsigned i = i4 + (unsigned)q * stp; if (i < NV) { const size_t e = (size_t)i * 4;
            u32x2 o; o.x = cvt_pk_bf16(v[q].x * gsc[q], v[q].y * gsc[q]); o.y = cvt_pk_bf16(v[q].z * gsc[q], v[q].w * gsc[q]); *(u32x2*)((bf16_t*)(ws + WS_WQS) + e) = o; } }
      } }
    for (int i = bid * NTHR + tid; i < NLAYER * 28 * 1024; i += G * NTHR) {
        const int l = i / (28 * 1024), r = i % (28 * 1024), j = r >> 10, k = r & 1023;
        if (j < 8) { const float wv = PIN(2)[l * 1024 + k] * PIN(3)[((size_t)l * 1024 + k) * 3080 + 1536 + j];
            ((bf16_t*)(ws + WS_WFFB))[(l * 16 + j) * 1024 + k] = f2bf1(wv); ((bf16_t*)(ws + WS_WFFB))[(l * 16 + 8 + j) * 1024 + k] = 0; }
        else { const int jj = j - 8; const float w = jj < 4 ? PIN(19)[(l * 1024 + k) * 4 + jj] : PIN(21)[(l * 1024 + k) * 16 + jj - 4];
            const float wv = PIN(18)[l * 1024 + k] * w; const unsigned short hb = f2bf1(wv);
            ((bf16_t*)(ws + WS_WRH))[(l * 32 + jj) * 1024 + k] = hb; ((bf16_t*)(ws + WS_WRL))[(l * 32 + jj) * 1024 + k] = f2bf1(wv - bf2f(hb));
            if (jj < 12) { ((bf16_t*)(ws + WS_WRH))[(l * 32 + 20 + jj) * 1024 + k] = 0; ((bf16_t*)(ws + WS_WRL))[(l * 32 + 20 + jj) * 1024 + k] = 0; } }
    }
    for (int row = gw; row < 512; row += NGW) {
        const f32x4* xr = (const f32x4*)(PIN(1) + (size_t)row * 1024) + lane; f32x4 v[4]; float s = 0.f;
#pragma unroll
        for (int j = 0; j < 4; ++j) { v[j] = xr[64 * j]; s += (v[j].x * v[j].x + v[j].y * v[j].y) + (v[j].z * v[j].z + v[j].w * v[j].w); }
        const float rstd = rsqrtf(wave_sum(s) * (1.f / 1024.f) + EPS);
#pragma unroll
        for (int j = 0; j < 4; ++j) { const f32x4 gg = ((const f32x4*)PIN(14))[64 * j + lane]; u32x2 o; o.x = cvt_pk_bf16(v[j].x * rstd * gg.x, v[j].y * rstd * gg.y); o.y = cvt_pk_bf16(v[j].z * rstd * gg.z, v[j].w * rstd * gg.w);
            ((u32x2*)((bf16_t*)(ws + WS_MEMN) + (size_t)row * 1024))[64 * j + lane] = o; }
    }
    for (int row0 = gw; row0 < NTOK; row0 += 4 * NGW) {
        f32x4 v[4][4];
#pragma unroll
        for (int q = 0; q < 4; ++q) { const int row = row0 + q * NGW; if (row < NTOK) { const f32x4* xr = (const f32x4*)(PIN(0) + (size_t)row * 1024) + lane;
#pragma unroll
            for (int j = 0; j < 4; ++j) v[q][j] = xr[64 * j]; } }
#pragma unroll
        for (int q = 0; q < 4; ++q) { const int row = row0 + q * NGW; if (row < NTOK) { float s = 0.f;
#pragma unroll
            for (int j = 0; j < 4; ++j) { const f32x4 w = v[q][j]; s += (w.x * w.x + w.y * w.y) + (w.z * w.z + w.w * w.w); u32x2 o; o.x = cvt_pk_bf16(w.x, w.y); o.y = cvt_pk_bf16(w.z, w.w);
                ((u32x2*)((bf16_t*)(ws + WS_XB) + (size_t)row * 1024))[64 * j + lane] = o; }
            s = wave_sum(s);
            if (lane < 16) ((float*)(ws + WS_SSQ))[(size_t)row * 16 + lane] = lane == 0 ? s : 0.f; } }
    }
}

__device__ __forceinline__ void phase_logf(const Params& p, LAS unsigned char* lds, int l, int bid, int G) {
    int tid = threadIdx.x; asm volatile("" : "+v"(tid));
    const int lane = tid & 63, wave = tid >> 6, sg = wave & 3, kh = wave >> 2;
    unsigned char* ws = p.ws;
    LAS f32x4* part = (LAS f32x4*)lds;
    const bf16_t* wb = (const bf16_t*)(ws + WS_WFFB) + (size_t)l * 16 * 1024 + (lane & 15) * 1024 + kh * 512 + (lane >> 4) * 8;
    for (int g0 = bid * 4; g0 < NTOK / 16; g0 += G * 4) {
        const int g16 = g0 + sg;
        const bf16_t* xa = (const bf16_t*)(ws + WS_XB) + (size_t)(g16 * 16 + (lane & 15)) * 1024 + kh * 512 + (lane >> 4) * 8;
        f32x4 acc = {0.f, 0.f, 0.f, 0.f};
#pragma unroll
        for (int ks = 0; ks < 16; ++ks) { const bf16x8 a = *(const bf16x8*)(xa + ks * 32), w = *(const bf16x8*)(wb + ks * 32); acc = __builtin_amdgcn_mfma_f32_16x16x32_bf16(a, w, acc, 0, 0, 0); }
        if (kh == 1) part[sg * 64 + lane] = acc;
        LDS_BARRIER();
        if (kh == 0) {
            acc += part[sg * 64 + lane];
            if ((lane & 15) < 8) { const float bias = PING(4)[l * 8 + (lane & 15)];
#pragma unroll
                for (int t = 0; t < 4; ++t) { const int row = g16 * 16 + (lane >> 4) * 4 + t; const float z = acc[t] * row_rstd((const float*)(ws + WS_SSQ), row) + bias;
                    ((float*)(ws + WS_LOGF))[(size_t)row * 8 + (lane & 15)] = fminf(z, 0.f) - __logf(1.f + __expf(-fabsf(z))); } }
        }
        LDS_BARRIER();
    }
}

constexpr int HP = 72;
template <bool FINAL>
__device__ __forceinline__ void hgrn_unit(const Params& p, LAS unsigned char* lds, int l, int unit) {
    int tid = threadIdx.x; asm volatile("" : "+v"(tid));
    const int lane = tid & 63, wave = __builtin_amdgcn_readfirstlane(tid >> 6), l15 = lane & 15, rq = lane >> 4;
    unsigned char* ws = p.ws;
    const int bh = unit >> 5, sc = unit & 31, b = bh >> 2, h = bh & 3;
    const bf16_t* y = (const bf16_t*)(ws + WS_R1);
    LAS bf16_t* QM = (LAS bf16_t*)lds; LAS bf16_t* KM = QM + 64 * HP; LAS bf16_t* QA = KM + 64 * HP; LAS bf16_t* KLT = QA + 64 * HP; LAS bf16_t* VT = KLT + 64 * HP; LAS bf16_t* ST = VT + 64 * HP;
    LAS float* DEC = (LAS float*)(ST + 4 * 64 * HP); LAS float* HG = DEC + 256; LAS float* lbv = HG + 4096; LAS float* SSX = lbv + 64;
    if (tid < 64) {
        const int k = h * 64 + tid; float e[4], mx = -INFINITY, den = 0.f, num = 0.f;
#pragma unroll
        for (int i = 0; i < 4; ++i) { e[i] = PING(6)[i * 256 + k]; mx = fmaxf(mx, e[i]); }
#pragma unroll
        for (int i = 0; i < 4; ++i) { e[i] = __expf(e[i] - mx); den += e[i]; if (i >= 1 && i <= l) num += e[i]; }
        lbv[tid] = num / den;
    }
    const int kt = wave >> 1, vt0 = 2 * (wave & 1);
    f32x4 S[2] = {{0.f, 0.f, 0.f, 0.f}, {0.f, 0.f, 0.f, 0.f}};
    if (FINAL) {
        const float* U = (const float*)(ws + WS_HU); const float* Dd = (const float*)(ws + WS_HD);
        int jj = 0;
        for (; jj + 4 <= sc; jj += 4) {
            float uu_[4][8], dd_[4][4];
#pragma unroll
            for (int q4 = 0; q4 < 4; ++q4) { const int uu = bh * 32 + jj + q4;
#pragma unroll
                for (int e = 0; e < 4; ++e) { dd_[q4][e] = Dd[uu * 64 + kt * 16 + rq * 4 + e];
                    uu_[q4][e] = U[(size_t)uu * 4096 + (kt * 16 + rq * 4 + e) * 64 + vt0 * 16 + l15]; uu_[q4][4 + e] = U[(size_t)uu * 4096 + (kt * 16 + rq * 4 + e) * 64 + vt0 * 16 + 16 + l15]; } }
#pragma unroll
            for (int q4 = 0; q4 < 4; ++q4)
#pragma unroll
                for (int e = 0; e < 4; ++e) { S[0][e] = dd_[q4][e] * S[0][e] + uu_[q4][e]; S[1][e] = dd_[q4][e] * S[1][e] + uu_[q4][4 + e]; }
        }
        for (; jj < sc; ++jj) { const int uu = bh * 32 + jj;
#pragma unroll
            for (int e = 0; e < 4; ++e) { const float d = Dd[uu * 64 + kt * 16 + rq * 4 + e];
                S[0][e] = d * S[0][e] + U[(size_t)uu * 4096 + (kt * 16 + rq * 4 + e) * 64 + vt0 * 16 + l15]; S[1][e] = d * S[1][e] + U[(size_t)uu * 4096 + (kt * 16 + rq * 4 + e) * 64 + vt0 * 16 + 16 + l15]; } }
    }
    float dtot = 1.f;
    const size_t row0 = (size_t)b * SEQ + sc * 256;
    const int cc_a = wave & 3, role = wave >> 2;
    unsigned short hf_[16], hq_[16]; u32x4 vraw, graw;
#define HG_LOAD(g_) do { _Pragma("unroll") for (int i = 0; i < 16; ++i) { const bf16_t* yr = y + (row0 + (g_) * 64 + cc_a * 16 + i) * NY; hf_[i] = yr[1792 + h * 64 + lane]; hq_[i] = FINAL ? yr[1536 + h * 64 + lane] : (unsigned short)0; } \
        { const bf16_t* yr = y + (row0 + (g_) * 64 + lane) * NY; vraw = *(const u32x4*)(yr + 2048 + h * 64 + wave * 8); if (FINAL) graw = *(const u32x4*)(yr + 2304 + h * 64 + wave * 8); } } while (0)
    HG_LOAD(0);
    LDS_BARRIER();
    for (int g = 0; g < 4; ++g) {
        {
            const float lb = lbv[lane];
            float bcum[16], k1[16]; float run = 0.f;
#pragma unroll
            for (int i = 0; i < 16; ++i) { const float f = lb + (1.f - lb) * sigmoidf_(bf2f(hf_[i])); k1[i] = 1.f - f; run += __logf(f); bcum[i] = run; }
            if (role == 0) {
                if (FINAL) { const float bm = bcum[8];
#pragma unroll
                    for (int i = 0; i < 16; ++i) { QM[(cc_a * 16 + i) * HP + lane] = f2bf1(bf2f(hq_[i]) * __expf(bcum[i] - bm)); KM[(cc_a * 16 + i) * HP + lane] = f2bf1(k1[i] * __expf(bm - bcum[i])); } }
            } else {
                const float bl = bcum[15];
                u32x4 w0, w1;
#pragma unroll
                for (int i = 0; i < 4; ++i) { w0[i] = cvt_pk_bf16(k1[2 * i] * __expf(bl - bcum[2 * i]), k1[2 * i + 1] * __expf(bl - bcum[2 * i + 1])); w1[i] = cvt_pk_bf16(k1[8 + 2 * i] * __expf(bl - bcum[8 + 2 * i]), k1[8 + 2 * i + 1] * __expf(bl - bcum[8 + 2 * i + 1])); }
                *(LAS u32x4*)(KLT + lane * HP + cc_a * 16) = w0; *(LAS u32x4*)(KLT + lane * HP + cc_a * 16 + 8) = w1;
                DEC[cc_a * 64 + lane] = __expf(bl);
                if (FINAL) {
#pragma unroll
                    for (int i = 0; i < 16; ++i) QA[(cc_a * 16 + i) * HP + lane] = f2bf1(bf2f(hq_[i]) * __expf(bcum[i]));
                }
            }
#pragma unroll
            for (int i = 0; i < 4; ++i) { VT[(wave * 8 + 2 * i) * HP + lane] = (bf16_t)(vraw[i] & 0xffffu); VT[(wave * 8 + 2 * i + 1) * HP + lane] = (bf16_t)(vraw[i] >> 16); }
            if (FINAL) { f32x4 g0, g1;
#pragma unroll
                for (int i = 0; i < 2; ++i) { g0[2 * i] = bf2f(graw[i] & 0xffffu); g0[2 * i + 1] = bf2f(graw[i] >> 16); g1[2 * i] = bf2f(graw[2 + i] & 0xffffu); g1[2 * i + 1] = bf2f(graw[2 + i] >> 16); }
                *(LAS f32x4*)(HG + lane * 64 + wave * 8) = g0; *(LAS f32x4*)(HG + lane * 64 + wave * 8 + 4) = g1; }
        }
        LDS_BARRIER();
        if (g < 3) HG_LOAD(g + 1);
        if (!FINAL && tid < 64) dtot *= (DEC[tid] * DEC[64 + tid]) * (DEC[128 + tid] * DEC[192 + tid]);
#pragma unroll
        for (int cc = 0; cc < 4; ++cc) {
            if (FINAL) {
#pragma unroll
                for (int j = 0; j < 2; ++j) { u32x2 w; w.x = cvt_pk_bf16(S[j][0], S[j][1]); w.y = cvt_pk_bf16(S[j][2], S[j][3]);
                    *(LAS u32x2*)(ST + (cc * 64 + (vt0 + j) * 16 + l15) * HP + kt * 16 + rq * 4) = w; }
            }
            const u32x2 ka = *(const LAS u32x2*)(KLT + (kt * 16 + l15) * HP + cc * 16 + rq * 4);
            const f32x4 dc = *(const LAS f32x4*)(DEC + cc * 64 + kt * 16 + rq * 4);
            const u32x4 kaw = {ka.x, ka.y, 0u, 0u};
#pragma unroll
            for (int j = 0; j < 2; ++j) {
                const u32x2 vb = *(const LAS u32x2*)(VT + ((vt0 + j) * 16 + l15) * HP + cc * 16 + rq * 4);
                const u32x4 vbw = {vb.x, vb.y, 0u, 0u};
                S[j] = __builtin_amdgcn_mfma_f32_16x16x32_bf16(__builtin_bit_cast(bf16x8, kaw), __builtin_bit_cast(bf16x8, vbw), S[j] * dc, 0, 0, 0);
            }
        }
        if (FINAL) {
            LDS_BARRIER();
            const int cc = wave & 3, vh = wave >> 2;
            f32x4 at = {0.f, 0.f, 0.f, 0.f};
#pragma unroll
            for (int ks = 0; ks < 2; ++ks) {
                const bf16x8 kmf = *(const LAS bf16x8*)(KM + (cc * 16 + l15) * HP + ks * 32 + rq * 8), qmf = *(const LAS bf16x8*)(QM + (cc * 16 + l15) * HP + ks * 32 + rq * 8);
                at = __builtin_amdgcn_mfma_f32_16x16x32_bf16(kmf, qmf, at, 0, 0, 0);
            }
#pragma unroll
            for (int e = 0; e < 4; ++e) if (rq * 4 + e > l15) at[e] = 0.f;
            const u32x4 atw = {cvt_pk_bf16(at[0], at[1]), cvt_pk_bf16(at[2], at[3]), 0u, 0u};
            const bf16x8 atf = __builtin_bit_cast(bf16x8, atw);
            const bf16x8 qa0 = *(const LAS bf16x8*)(QA + (cc * 16 + l15) * HP + rq * 8), qa1 = *(const LAS bf16x8*)(QA + (cc * 16 + l15) * HP + 32 + rq * 8);
            f32x4 o[2]; float ssp = 0.f;
#pragma unroll
            for (int j = 0; j < 2; ++j) { const int vt = vh * 2 + j;
                const u32x2 vb = *(const LAS u32x2*)(VT + (vt * 16 + l15) * HP + cc * 16 + rq * 4);
                const u32x4 vbw = {vb.x, vb.y, 0u, 0u};
                const bf16x8 s0 = *(const LAS bf16x8*)(ST + (cc * 64 + vt * 16 + l15) * HP + rq * 8), s1 = *(const LAS bf16x8*)(ST + (cc * 64 + vt * 16 + l15) * HP + 32 + rq * 8);
                f32x4 a = {0.f, 0.f, 0.f, 0.f};
                a = __builtin_amdgcn_mfma_f32_16x16x32_bf16(__builtin_bit_cast(bf16x8, vbw), atf, a, 0, 0, 0);
                a = __builtin_amdgcn_mfma_f32_16x16x32_bf16(s0, qa0, a, 0, 0, 0);
                a = __builtin_amdgcn_mfma_f32_16x16x32_bf16(s1, qa1, a, 0, 0, 0);
                o[j] = a; ssp += (a[0] * a[0] + a[1] * a[1]) + (a[2] * a[2] + a[3] * a[3]); }
            ssp = x16_sum(ssp); ssp = x32_sum(ssp);
            if (rq == 0) SSX[(cc * 2 + vh) * 16 + l15] = ssp;
            LDS_BARRIER();
            const float rstd = rsqrtf((SSX[(cc * 2) * 16 + l15] + SSX[(cc * 2 + 1) * 16 + l15]) * (1.f / 64.f) + EPS);
            const size_t row = row0 + g * 64 + cc * 16 + l15;
#pragma unroll
            for (int j = 0; j < 2; ++j) { const int vt = vh * 2 + j;
                const f32x4 hg = *(const LAS f32x4*)(HG + (cc * 16 + l15) * 64 + vt * 16 + rq * 4);
                u32x2 w; w.x = cvt_pk_bf16(o[j][0] * rstd * hg[0] * sigmoidf_(hg[0]), o[j][1] * rstd * hg[1] * sigmoidf_(hg[1])); w.y = cvt_pk_bf16(o[j][2] * rstd * hg[2] * sigmoidf_(hg[2]), o[j][3] * rstd * hg[3] * sigmoidf_(hg[3]));
                *(u32x2*)((bf16_t*)(ws + WS_CAT) + row * DM + 512 + h * 64 + vt * 16 + rq * 4) = w; }
        }
        LDS_BARRIER();
    }
#undef HG_LOAD
    if (!FINAL) {
        float* U = (float*)(ws + WS_HU); float* Dd = (float*)(ws + WS_HD);
#pragma unroll
        for (int j = 0; j < 2; ++j)
#pragma unroll
            for (int e = 0; e < 4; ++e) U[(size_t)unit * 4096 + (kt * 16 + rq * 4 + e) * 64 + (vt0 + j) * 16 + l15] = S[j][e];
        if (tid < 64) Dd[unit * 64 + tid] = dtot;
    }
}

template <bool FINAL>
__device__ __forceinline__ void hgrn_unit_old(const Params& p, LAS unsigned char* lds, int l, int unit) {
    int tid = threadIdx.x; asm volatile("" : "+v"(tid));
    const int lane = tid & 63, kg = tid >> 6;
    unsigned char* ws = p.ws;
    const int bh = unit >> 5, sc = unit & 31, b = bh >> 2, h = bh & 3;
    const bf16_t* y = (const bf16_t*)(ws + WS_R1);
    LAS float* F = (LAS float*)lds; LAS float* K1 = F + 4096; LAS float* Q = F + 8192; LAS float* V = F + 12288; LAS float* OP = F + 16384; LAS float* lbv = F + 16384 + 8192; LAS float* dpl = lbv + 64; LAS float* HG = dpl + 512;
    if (tid < 64) {
        const int k = h * 64 + tid; float e[4], mx = -INFINITY, den = 0.f, num = 0.f;
#pragma unroll
        for (int i = 0; i < 4; ++i) { e[i] = PING(6)[i * 256 + k]; mx = fmaxf(mx, e[i]); }
#pragma unroll
        for (int i = 0; i < 4; ++i) { e[i] = __expf(e[i] - mx); den += e[i]; if (i >= 1 && i <= l) num += e[i]; }
        lbv[tid] = num / den;
    }
    f32x2 s2[4];
#pragma unroll
    for (int j = 0; j < 4; ++j) s2[j] = (f32x2){0.f, 0.f};
    float dprod = 1.f;
    if (FINAL) {
        const float* U = (const float*)(ws + WS_HU); const float* Dd = (const float*)(ws + WS_HD);
        float s[8];
#pragma unroll
        for (int j = 0; j < 8; ++j) s[j] = 0.f;
        int jj = 0;
        for (; jj + 8 <= sc; jj += 8) {
            float uu_[8][8], dd_[8][8];
#pragma unroll
            for (int q4 = 0; q4 < 8; ++q4) { const int uu = bh * 32 + jj + q4;
#pragma unroll
                for (int j = 0; j < 8; ++j) { dd_[q4][j] = Dd[uu * 64 + kg * 8 + j]; uu_[q4][j] = U[(size_t)uu * 4096 + (kg * 8 + j) * 64 + lane]; } }
#pragma unroll
            for (int q4 = 0; q4 < 8; ++q4)
#pragma unroll
                for (int j = 0; j < 8; ++j) s[j] = dd_[q4][j] * s[j] + uu_[q4][j];
        }
        for (; jj < sc; ++jj) { const int uu = bh * 32 + jj;
#pragma unroll
            for (int j = 0; j < 8; ++j) s[j] = Dd[uu * 64 + kg * 8 + j] * s[j] + U[(size_t)uu * 4096 + (kg * 8 + j) * 64 + lane]; }
#pragma unroll
        for (int j = 0; j < 4; ++j) s2[j] = (f32x2){s[2 * j], s[2 * j + 1]};
    }
    LDS_BARRIER();
    const size_t row0 = (size_t)b * SEQ + sc * 256;
    unsigned short hf_[8], hq_[8], hv_[8], hg_[8];
#define HG_LOAD(ch_) do { _Pragma("unroll") for (int j = 0; j < 8; ++j) { const int tt = kg + 8 * j; const bf16_t* yr = y + (row0 + (ch_) * 64 + tt) * NY; hf_[j] = yr[1792 + h * 64 + lane]; hv_[j] = yr[2048 + h * 64 + lane]; \
        hq_[j] = FINAL ? yr[1536 + h * 64 + lane] : (unsigned short)0; hg_[j] = FINAL ? yr[2304 + h * 64 + lane] : (unsigned short)0; } } while (0)
    HG_LOAD(0);
    for (int ch = 0; ch < 4; ++ch) {
        { const float lb = lbv[lane];
#pragma unroll
          for (int j = 0; j < 8; ++j) { const int idx = (kg + 8 * j) * 64 + lane; const float f = lb + (1.f - lb) * sigmoidf_(bf2f(hf_[j]));
              F[idx] = f; K1[idx] = 1.f - f; V[idx] = bf2f(hv_[j]); if (FINAL) { Q[idx] = bf2f(hq_[j]); HG[idx] = bf2f(hg_[j]); } else dprod *= f; } }
        LDS_BARRIER();
        if (ch < 3) HG_LOAD(ch + 1);
        for (int sub = 0; sub < 4; ++sub) {
#pragma unroll 4
            for (int t16 = 0; t16 < 16; ++t16) {
                const int tt = sub * 16 + t16;
                const f32x4 fa = *(const LAS f32x4*)(F + tt * 64 + kg * 8), fb = *(const LAS f32x4*)(F + tt * 64 + kg * 8 + 4);
                const f32x4 ka = *(const LAS f32x4*)(K1 + tt * 64 + kg * 8), kb2 = *(const LAS f32x4*)(K1 + tt * 64 + kg * 8 + 4);
                const float vt = V[tt * 64 + lane];
                const f32x2 vt2 = {vt, vt};
                const f32x2 f2[4] = {{fa.x, fa.y}, {fa.z, fa.w}, {fb.x, fb.y}, {fb.z, fb.w}};
                const f32x2 k2[4] = {{ka.x, ka.y}, {ka.z, ka.w}, {kb2.x, kb2.y}, {kb2.z, kb2.w}};
#pragma unroll
                for (int j = 0; j < 4; ++j) s2[j] = f2[j] * s2[j] + k2[j] * vt2;
                if (FINAL) {
                    const f32x4 qa = *(const LAS f32x4*)(Q + tt * 64 + kg * 8), qb2 = *(const LAS f32x4*)(Q + tt * 64 + kg * 8 + 4);
                    const f32x2 q2[4] = {{qa.x, qa.y}, {qa.z, qa.w}, {qb2.x, qb2.y}, {qb2.z, qb2.w}};
                    f32x2 o2 = q2[0] * s2[0];
#pragma unroll
                    for (int j = 1; j < 4; ++j) o2 = q2[j] * s2[j] + o2;
                    OP[(t16 * 8 + kg) * 64 + lane] = o2.x + o2.y;
                }
            }
            if (FINAL) {
                LDS_BARRIER();
#pragma unroll
                for (int w2 = 0; w2 < 2; ++w2) { const int t16 = kg * 2 + w2; float o = 0.f;
#pragma unroll
                    for (int g8 = 0; g8 < 8; ++g8) o += OP[(t16 * 8 + g8) * 64 + lane];
                    const float ss = wave_sum(o * o), rstd = rsqrtf(ss * (1.f / 64.f) + EPS);
                    const size_t row = row0 + ch * 64 + sub * 16 + t16;
                    const float hg = HG[(sub * 16 + t16) * 64 + lane];
                    ((bf16_t*)(ws + WS_CAT))[row * DM + 512 + h * 64 + lane] = f2bf1(o * rstd * hg * sigmoidf_(hg)); }
                LDS_BARRIER();
            }
        }
        LDS_BARRIER();
    }
#undef HG_LOAD
    if (!FINAL) {
        float* U = (float*)(ws + WS_HU); float* Dd = (float*)(ws + WS_HD);
#pragma unroll
        for (int j = 0; j < 4; ++j) { U[(size_t)unit * 4096 + (kg * 8 + 2 * j) * 64 + lane] = s2[j].x; U[(size_t)unit * 4096 + (kg * 8 + 2 * j + 1) * 64 + lane] = s2[j].y; }
        dpl[kg * 64 + lane] = dprod;
        LDS_BARRIER();
        if (tid < 64) { float d = 1.f;
#pragma unroll
            for (int w = 0; w < 8; ++w) d *= dpl[w * 64 + tid];
            Dd[unit * 64 + tid] = d; }
    }
    LDS_BARRIER();
}

__device__ __forceinline__ void conv_unit(const Params& p, LAS unsigned char* lds, int l, int unit) {
    int tid = threadIdx.x; asm volatile("" : "+v"(tid));
    const int lane = tid & 63, wave = tid >> 6;
    unsigned char* ws = p.ws;
    const bf16_t* y = (const bf16_t*)(ws + WS_R1);
    LAS float* A = (LAS float*)lds; LAS float* Y = (LAS float*)(lds + 65536);
    const int row0 = unit * 32, b = row0 / SEQ, t0 = row0 % SEQ;
    float w[31], gam[4], bet[4];
    { const int c = tid & 255;
#pragma unroll
      for (int j = 0; j < 31; ++j) w[j] = PING(8)[(l * 31 + j) * 256 + c];
#pragma unroll
      for (int g4 = 0; g4 < 4; ++g4) { gam[g4] = PING(10)[l * 256 + g4 * 64 + lane]; bet[g4] = PING(11)[l * 256 + g4 * 64 + lane]; } }
    const float cbias = PING(9)[l * 256 + (tid & 255)];
    { u32x4 cu[4], cg[4];
#pragma unroll
        for (int q = 0; q < 4; ++q) { const int it = tid + NTHR * q, j = it >> 5, c8 = (it & 31) * 8, t = t0 - 30 + j;
            cu[q] = (u32x4){0u, 0u, 0u, 0u}; cg[q] = cu[q];
            if (it < 62 * 32 && t >= 0) { const bf16_t* yr = y + ((size_t)b * SEQ + t) * NY; cu[q] = *(const u32x4*)(yr + 2560 + c8); cg[q] = *(const u32x4*)(yr + 2816 + c8); } }
#pragma unroll
        for (int q = 0; q < 4; ++q) { const int it = tid + NTHR * q, j = it >> 5, c8 = (it & 31) * 8;
            if (it < 62 * 32) { f32x4 a0, a1;
#pragma unroll
                for (int e = 0; e < 4; ++e) { const float u0 = bf2f(cu[q][e] & 0xffffu), u1 = bf2f(cu[q][e] >> 16), g0 = bf2f(cg[q][e] & 0xffffu), g1 = bf2f(cg[q][e] >> 16);
                    const float r0 = u0 * sigmoidf_(g0), r1 = u1 * sigmoidf_(g1);
                    if (e < 2) { a0[2 * e] = r0; a0[2 * e + 1] = r1; } else { a1[2 * (e - 2)] = r0; a1[2 * (e - 2) + 1] = r1; } }
                *(LAS f32x4*)(A + j * 256 + c8) = a0; *(LAS f32x4*)(A + j * 256 + c8 + 4) = a1; } } }
    LDS_BARRIER();
    { const int c = tid & 255, th = tid >> 8;
        float av[46];
#pragma unroll
        for (int i = 0; i < 46; ++i) av[i] = A[(th * 16 + i) * 256 + c];
        float yv[16];
#pragma unroll
        for (int tl = 0; tl < 16; ++tl) { float a = cbias;
#pragma unroll
            for (int j = 0; j < 31; ++j) a += w[j] * av[tl + j];
            yv[tl] = a; }
#pragma unroll
        for (int tl = 0; tl < 16; ++tl) Y[(th * 16 + tl) * 256 + c] = yv[tl]; }
    LDS_BARRIER();
#pragma unroll 4
    for (int pr = wave * 16; pr < wave * 16 + 16; ++pr) { const int tl = pr >> 2, grp = pr & 3, c = grp * 64 + lane;
        const float v = Y[tl * 256 + c], mean = wave_sum(v) * (1.f / 64.f), ex2 = wave_sum(v * v) * (1.f / 64.f), var = fmaxf(ex2 - mean * mean, 0.f);
        const float gmm = grp == 0 ? gam[0] : (grp == 1 ? gam[1] : (grp == 2 ? gam[2] : gam[3])), btt = grp == 0 ? bet[0] : (grp == 1 ? bet[1] : (grp == 2 ? bet[2] : bet[3]));
        const float yn = (v - mean) * rsqrtf(var + EPS) * gmm + btt;
        ((bf16_t*)(ws + WS_CAT))[(size_t)(row0 + tl) * DM + 768 + c] = f2bf1(yn * sigmoidf_(yn)); }
    LDS_BARRIER();
}

__device__ __forceinline__ void phase_p2a(const Params& p, LAS unsigned char* lds, int l, int bid, int G) {
    int tid = threadIdx.x; asm volatile("" : "+v"(tid));
    const int lane = tid & 63, wave = tid >> 6;
    unsigned char* ws = p.ws;
    for (int sr = 0; sr < SUBR(1); ++sr)
    for (int bh = bid; bh < 16; bh += G) { const int b = bh >> 3, h = bh & 7;
        const float* lf = (const float*)(ws + WS_LOGF) + (size_t)b * SEQ * 8 + h;
        float v[16]; float run = 0.f;
#pragma unroll
        for (int i = 0; i < 16; ++i) { run += lf[(size_t)(tid * 16 + i) * 8]; v[i] = run; }
        float incl = run;
#pragma unroll
        for (int o = 1; o < 64; o <<= 1) { const float t = __int_as_float(__builtin_amdgcn_ds_bpermute(((lane - o) & 63) * 4, __float_as_int(incl))); if (lane >= o) incl += t; }
        LAS float* wt = (LAS float*)lds;
        if (lane == 63) wt[wave] = incl;
        LDS_BARRIER();
        float base = incl - run;
        for (int w = 0; w < wave; ++w) base += wt[w];
        float* c = (float*)(ws + WS_CFOX) + (size_t)bh * SEQ + tid * 16;
#pragma unroll
        for (int i = 0; i < 16; ++i) c[i] = base + v[i];
        LDS_BARRIER();
    }
    for (int sr = 0; sr < SUBR(3); ++sr) for (int u = bid; u < 256; u += G) if ((u & 31) != 31) hgrn_unit<false>(p, lds, l, u);
}

__device__ __forceinline__ void attn_unit_simple(const Params& p, int l, int unit) {
    int tid = threadIdx.x; asm volatile("" : "+v"(tid));
    const int lane = tid & 63, wave = tid >> 6;
    unsigned char* ws = p.ws;
    const int bh = unit >> 4, qb = unit & 15, b = bh >> 3, h = bh & 7;
    const bf16_t* y = (const bf16_t*)(ws + WS_R1);
    const float* cf = (const float*)(ws + WS_CFOX) + (size_t)bh * SEQ;
    const int t = qb * 512 + tid;
    const size_t rowb = (size_t)b * SEQ;
    float q[64], o[64];
    { const u32x4* qr = (const u32x4*)(y + (rowb + t) * NY + h * 64);
#pragma unroll
        for (int i = 0; i < 8; ++i) { const u32x4 a = qr[i];
#pragma unroll
            for (int j = 0; j < 4; ++j) { q[i * 8 + 2 * j] = bf2f(a[j] & 0xffffu); q[i * 8 + 2 * j + 1] = bf2f(a[j] >> 16); } } }
#pragma unroll
    for (int d = 0; d < 64; ++d) o[d] = 0.f;
    const float ct = cf[t] * LOG2E;
    float m = -INFINITY, lsum = 0.f;
    const int twmin = qb * 512 + wave * 64, smax = twmin + 63;
#if FOX_PRUNE
    const unsigned* ctl = (const unsigned*)(ws + WS_CTL);
    const unsigned* kqm = ctl + CW_KQMAX + l * 64 + (b * 8 + h) * 4;
    const float B2 = 1.01f * sqrtf((__uint_as_float(kqm[0]) + __uint_as_float(kqm[1])) * (__uint_as_float(kqm[2]) + __uint_as_float(kqm[3])));
    const float cmin = cf[twmin] * LOG2E;
#endif
    for (int s = smax; s >= 0; --s) {
        const float cs = cf[s] * LOG2E;
#if FOX_PRUNE
        if (cmin - cs + 2.f * B2 < -44.f) break;
#endif
        const u32x4* kr = (const u32x4*)(y + (rowb + s) * NY + 512 + h * 64);
        float dot = 0.f;
#pragma unroll
        for (int i = 0; i < 8; ++i) { const u32x4 a = kr[i];
#pragma unroll
            for (int j = 0; j < 4; ++j) dot += q[i * 8 + 2 * j] * bf2f(a[j] & 0xffffu) + q[i * 8 + 2 * j + 1] * bf2f(a[j] >> 16); }
        const float sc = dot + ct - cs;
        if (s <= t) {
            if (sc > m) { const float al = __builtin_amdgcn_exp2f(m - sc); lsum *= al;
#pragma unroll
                for (int d = 0; d < 64; ++d) o[d] *= al;
                m = sc; }
            const float pr = __builtin_amdgcn_exp2f(sc - m); lsum += pr;
            const u32x4* vr = (const u32x4*)(y + (rowb + s) * NY + 1024 + h * 64);
#pragma unroll
            for (int i = 0; i < 8; ++i) { const u32x4 a = vr[i];
#pragma unroll
                for (int j = 0; j < 4; ++j) { o[i * 8 + 2 * j] += pr * bf2f(a[j] & 0xffffu); o[i * 8 + 2 * j + 1] += pr * bf2f(a[j] >> 16); } }
        }
    }
    const float inv = 1.f / lsum; float ss = 0.f;
#pragma unroll
    for (int d = 0; d < 64; ++d) { o[d] *= inv; ss += o[d] * o[d]; }
    const float rstd = rsqrtf(ss * (1.f / 64.f) + EPS);
    u32x4* dst = (u32x4*)((bf16_t*)(ws + WS_CAT) + (rowb + t) * DM + h * 64);
#pragma unroll
    for (int i = 0; i < 8; ++i) { u32x4 w; w.x = cvt_pk_bf16(o[i * 8] * rstd, o[i * 8 + 1] * rstd); w.y = cvt_pk_bf16(o[i * 8 + 2] * rstd, o[i * 8 + 3] * rstd); w.z = cvt_pk_bf16(o[i * 8 + 4] * rstd, o[i * 8 + 5] * rstd); w.w = cvt_pk_bf16(o[i * 8 + 6] * rstd, o[i * 8 + 7] * rstd); dst[i] = w; }
}

typedef float f32x16 __attribute__((ext_vector_type(16)));
constexpr int AT_KP = 144, AT_VP = 136, AT_BUF = 18432;
__device__ __forceinline__ void attn_unit_mfma(const Params& p, LAS unsigned char* lds, int l, int unit) {
    int tid = threadIdx.x; asm volatile("" : "+v"(tid));
    const int lane = tid & 63, wave = __builtin_amdgcn_readfirstlane(tid >> 6), r32 = lane & 31, hi = lane >> 5;
    unsigned char* ws = p.ws;
    const int bh = unit >> 5, qb = unit & 31, b = bh >> 3, h = bh & 7, q0 = qb * 256, qw0 = q0 + wave * 32;
    const bf16_t* y = (const bf16_t*)(ws + WS_R1) + (size_t)b * SEQ * NY;
    const float* cf = (const float*)(ws + WS_CFOX) + (size_t)bh * SEQ;
    QB_(20);
    bf16x8 qr[4];
    { const bf16_t* qrow = y + (size_t)(qw0 + r32) * NY + h * 64;
#pragma unroll
      for (int d0 = 0; d0 < 4; ++d0) qr[d0] = *(const bf16x8*)(qrow + d0 * 16 + hi * 8); }
    float cq = cf[qw0 + r32] * LOG2E;
    const unsigned* ctl = (const unsigned*)(ws + WS_CTL);
    const unsigned* kqm = ctl + CW_KQMAX + l * 64 + (b * 8 + h) * 4;
    const float B2 = 1.01f * sqrtf((__uint_as_float(kqm[0]) + __uint_as_float(kqm[1])) * (__uint_as_float(kqm[2]) + __uint_as_float(kqm[3])));
    const float thr = -44.f - 2.f * B2;
    cq -= fminf(B2, 40.f);
    const float cblk = cf[q0] * LOG2E, cwv = cf[qw0] * LOG2E;
    const int jmax = (q0 + 255) >> 6;
    const int jhi = (qw0 + 31) >> 6;
    int jmin = 0, jlo = 0;
    { int base = jmax;
      for (;;) { const int t = base - lane; const bool nd = (t >= 0) && ((cblk - cf[t >= 0 ? 64 * t + 63 : 0] * LOG2E) >= thr);
          const unsigned long long mk = __ballot(nd); const int n = (mk == ~0ull) ? 64 : (int)__builtin_ctzll(~mk);
          if (n < 64 || base < 64) { jmin = base - n + 1; break; } base -= 64; }
      base = jhi;
      for (;;) { const int t = base - lane; const bool nd = (t >= 0) && ((cwv - cf[t >= 0 ? 64 * t + 63 : 0] * LOG2E) >= thr);
          const unsigned long long mk = __ballot(nd); const int n = (mk == ~0ull) ? 64 : (int)__builtin_ctzll(~mk);
          if (n < 64 || base < 64) { jlo = base - n + 1; break; } base -= 64; }
      jmin = __builtin_amdgcn_readfirstlane(jmin); jlo = __builtin_amdgcn_readfirstlane(jlo); }
    u32x4 kreg, vreg, kreg2, vreg2; float creg = 0.f, creg2 = 0.f;
#define AT_LOAD(j, KR, VR, CR) do { const int kb_ = (j) * 64; \
        KR = *(const u32x4*)(y + (size_t)(kb_ + (tid >> 3)) * NY + 512 + h * 64 + (tid & 7) * 8); \
        VR = *(const u32x4*)(y + (size_t)(kb_ + lane) * NY + 1024 + h * 64 + wave * 8); \
        if (tid < 64) CR = cf[kb_ + tid] * LOG2E; } while (0)
    AT_LOAD(jmax, kreg, vreg, creg);
    kreg2 = kreg; vreg2 = vreg;
    if (jmax - 1 >= jmin) AT_LOAD(jmax - 1, kreg2, vreg2, creg2);
    float lsum = 0.f;
    f32x16 o0, o1;
#pragma unroll
    for (int r = 0; r < 16; ++r) { o0[r] = 0.f; o1[r] = 0.f; }
    QE_(20); QB_(21);
    for (int j = jmax; j >= jmin; --j) {
        LAS unsigned char* Kb = lds + (j & 1) * AT_BUF; LAS unsigned char* Vb = Kb + 9216; LAS float* cb = (LAS float*)(Kb + 9216 + 8704);
        *(LAS u32x4*)(Kb + (tid >> 3) * AT_KP + (tid & 7) * 16) = kreg;
#pragma unroll
        for (int i = 0; i < 4; ++i) { *(LAS unsigned short*)(Vb + (wave * 8 + 2 * i) * AT_VP + lane * 2) = (unsigned short)(vreg[i] & 0xffffu); *(LAS unsigned short*)(Vb + (wave * 8 + 2 * i + 1) * AT_VP + lane * 2) = (unsigned short)(vreg[i] >> 16); }
        if (tid < 64) cb[tid] = creg;
        LDS_BARRIER();
        kreg = kreg2; vreg = vreg2; creg = creg2;
        if (j - 2 >= jmin) AT_LOAD(j - 2, kreg2, vreg2, creg2);
        const int kb = j * 64;
        if (j >= jlo && j <= jhi) {
            f32x16 p0, p1;
#pragma unroll
            for (int g4 = 0; g4 < 4; ++g4) {
                const f32x4 c0 = *(const LAS f32x4*)(cb + 8 * g4 + 4 * hi), c1 = *(const LAS f32x4*)(cb + 32 + 8 * g4 + 4 * hi);
#pragma unroll
                for (int i = 0; i < 4; ++i) { p0[4 * g4 + i] = cq - c0[i]; p1[4 * g4 + i] = cq - c1[i]; }
            }
            { bf16x8 kf[8];
#pragma unroll
              for (int d0 = 0; d0 < 4; ++d0) { kf[2 * d0] = *(const LAS bf16x8*)(Kb + r32 * AT_KP + d0 * 32 + hi * 16); kf[2 * d0 + 1] = *(const LAS bf16x8*)(Kb + (32 + r32) * AT_KP + d0 * 32 + hi * 16); }
              __builtin_amdgcn_sched_barrier(0);
#pragma unroll
              for (int d0 = 0; d0 < 4; ++d0) { p0 = __builtin_amdgcn_mfma_f32_32x32x16_bf16(kf[2 * d0], qr[d0], p0, 0, 0, 0); p1 = __builtin_amdgcn_mfma_f32_32x32x16_bf16(kf[2 * d0 + 1], qr[d0], p1, 0, 0, 0); }
              __builtin_amdgcn_sched_barrier(0); }
            if (kb + 63 > qw0) {
                const int qg = qw0 + r32;
#pragma unroll
                for (int r = 0; r < 16; ++r) { const int kg = kb + (r & 3) + 8 * (r >> 2) + 4 * hi; if (kg > qg) p0[r] = -INFINITY; if (kg + 32 > qg) p1[r] = -INFINITY; }
            }
            float rs = 0.f;
#pragma unroll
            for (int r = 0; r < 16; ++r) { p0[r] = __builtin_amdgcn_exp2f(p0[r]); p1[r] = __builtin_amdgcn_exp2f(p1[r]); rs += p0[r] + p1[r]; }
            lsum += rs;
#pragma unroll
            for (int mt = 0; mt < 2; ++mt) {
                u32x2 vfr[2][2][2];
#pragma unroll
                for (int ks = 0; ks < 2; ++ks)
#pragma unroll
                    for (int dt = 0; dt < 2; ++dt) { const LAS unsigned char* vp = Vb + (32 * dt + r32) * AT_VP + (32 * mt + 16 * ks + 4 * hi) * 2; vfr[ks][dt][0] = *(const LAS u32x2*)vp; vfr[ks][dt][1] = *(const LAS u32x2*)(vp + 16); }
                __builtin_amdgcn_sched_barrier(0);
#pragma unroll
                for (int ks = 0; ks < 2; ++ks) {
                    u32x4 pw;
#pragma unroll
                    for (int i = 0; i < 4; ++i) pw[i] = mt ? cvt_pk_bf16(p1[8 * ks + 2 * i], p1[8 * ks + 2 * i + 1]) : cvt_pk_bf16(p0[8 * ks + 2 * i], p0[8 * ks + 2 * i + 1]);
                    const bf16x8 pb = __builtin_bit_cast(bf16x8, pw);
#pragma unroll
                    for (int dt = 0; dt < 2; ++dt) {
                        const u32x4 vw = {vfr[ks][dt][0].x, vfr[ks][dt][0].y, vfr[ks][dt][1].x, vfr[ks][dt][1].y};
                        const bf16x8 vf = __builtin_bit_cast(bf16x8, vw);
                        if (dt == 0) o0 = __builtin_amdgcn_mfma_f32_32x32x16_bf16(vf, pb, o0, 0, 0, 0); else o1 = __builtin_amdgcn_mfma_f32_32x32x16_bf16(vf, pb, o1, 0, 0, 0);
                    }
                }
            }
        }
    }
#undef AT_LOAD
    QE_(21); QB_(22);
    lsum = x32_sum(lsum);
    const float inv = 1.f / lsum;
    float ss = 0.f;
#pragma unroll
    for (int r = 0; r < 16; ++r) { o0[r] *= inv; o1[r] *= inv; ss += o0[r] * o0[r] + o1[r] * o1[r]; }
    ss = x32_sum(ss);
    const float rstd = rsqrtf(ss * (1.f / 64.f) + EPS);
    bf16_t* orow = (bf16_t*)(ws + WS_CAT) + ((size_t)b * SEQ + qw0 + r32) * DM + h * 64;
#pragma unroll
    for (int g4 = 0; g4 < 4; ++g4) {
        u32x2 w0, w1;
        w0.x = cvt_pk_bf16(o0[4 * g4] * rstd, o0[4 * g4 + 1] * rstd); w0.y = cvt_pk_bf16(o0[4 * g4 + 2] * rstd, o0[4 * g4 + 3] * rstd);
        w1.x = cvt_pk_bf16(o1[4 * g4] * rstd, o1[4 * g4 + 1] * rstd); w1.y = cvt_pk_bf16(o1[4 * g4 + 2] * rstd, o1[4 * g4 + 3] * rstd);
        *(u32x2*)(orow + 8 * g4 + 4 * hi) = w0; *(u32x2*)(orow + 32 + 8 * g4 + 4 * hi) = w1;
    }
    LDS_BARRIER();
    QE_(22);
}

__device__ __forceinline__ void phase_route(const Params& p, LAS unsigned char* lds, int l, int bid, int G) {
    int tid = threadIdx.x; asm volatile("" : "+v"(tid));
    const int lane = tid & 63, wave = tid >> 6;
    unsigned char* ws = p.ws;
    LAS float* part = (LAS float*)lds;
    LAS float* ssp = part + 4096;
    LAS int* cls = (LAS int*)(ssp + 512);
    LAS int* basel = cls + 64;
    unsigned* ctl = (unsigned*)(ws + WS_CTL);
    const int r16 = lane & 15, kq = lane >> 4, grp = wave >> 1, kh = wave & 1;
    for (int u = bid; u < NTOK / 64; u += G) {
        float rb[20];
#pragma unroll
        for (int jj = 0; jj < 20; ++jj) rb[jj] = jj < 4 ? PING(20)[l * 4 + jj] : PING(22)[l * 16 + jj - 4];
        {
            const bf16_t* xr = (const bf16_t*)(ws + WS_XB) + (size_t)(u * 64 + grp * 16 + r16) * 1024 + kh * 512 + kq * 8;
            const bf16_t* wh = (const bf16_t*)(ws + WS_WRH) + ((size_t)l * 32 + r16) * 1024 + kh * 512 + kq * 8;
            const bf16_t* wl = (const bf16_t*)(ws + WS_WRL) + ((size_t)l * 32 + r16) * 1024 + kh * 512 + kq * 8;
            f32x4 acc0 = {0.f, 0.f, 0.f, 0.f}, acc1 = {0.f, 0.f, 0.f, 0.f}; float ssx = 0.f;
#pragma unroll 8
            for (int ks = 0; ks < 16; ++ks) {
                const u32x4 xw = *(const u32x4*)(xr + ks * 32);
                const bf16x8 wh0 = *(const bf16x8*)(wh + ks * 32), wh1 = *(const bf16x8*)(wh + 16 * 1024 + ks * 32), wl0 = *(const bf16x8*)(wl + ks * 32), wl1 = *(const bf16x8*)(wl + 16 * 1024 + ks * 32);
#pragma unroll
                for (int e = 0; e < 4; ++e) { const float a = bf2f(xw[e] & 0xffffu), b2 = bf2f(xw[e] >> 16); ssx += a * a + b2 * b2; }
                const bf16x8 xh = __builtin_bit_cast(bf16x8, xw);
                acc0 = __builtin_amdgcn_mfma_f32_16x16x32_bf16(xh, wh0, acc0, 0, 0, 0); acc0 = __builtin_amdgcn_mfma_f32_16x16x32_bf16(xh, wl0, acc0, 0, 0, 0);
                acc1 = __builtin_amdgcn_mfma_f32_16x16x32_bf16(xh, wh1, acc1, 0, 0, 0); acc1 = __builtin_amdgcn_mfma_f32_16x16x32_bf16(xh, wl1, acc1, 0, 0, 0);
            }
#pragma unroll
            for (int t = 0; t < 4; ++t) { part[((grp * 2 + kh) * 16 + kq * 4 + t) * 32 + r16] = acc0[t]; part[((grp * 2 + kh) * 16 + kq * 4 + t) * 32 + 16 + r16] = acc1[t]; }
            ssp[((grp * 2 + kh) * 4 + kq) * 16 + r16] = ssx;
        }
        LDS_BARRIER();
        if (tid < 64) {
            const int g4 = tid >> 4, r = tid & 15, row = u * 64 + tid;
            float ss = 0.f;
#pragma unroll
            for (int q = 0; q < 8; ++q) ss += ssp[(g4 * 8 + q) * 16 + r];
            const float rstd = rsqrtf(ss * (1.f / 1024.f) + EPS);
            float lg[20];
#pragma unroll
            for (int jj = 0; jj < 20; ++jj) lg[jj] = (part[((g4 * 2) * 16 + r) * 32 + jj] + part[((g4 * 2 + 1) * 16 + r) * 32 + jj]) * rstd + rb[jj];
            int gi = 0; float gm = lg[0];
#pragma unroll
            for (int j = 1; j < 4; ++j) if (lg[j] > gm) { gm = lg[j]; gi = j; }
            float den = 0.f;
#pragma unroll
            for (int j = 0; j < 4; ++j) den += __expf(lg[j] - gm);
            const float pg = 1.f / den;
            float e[4];
#pragma unroll
            for (int j = 0; j < 4; ++j) e[j] = gi == 0 ? lg[4 + j] : (gi == 1 ? lg[8 + j] : (gi == 2 ? lg[12 + j] : lg[16 + j]));
            int a = 0; float ea = e[0];
#pragma unroll
            for (int j = 1; j < 4; ++j) if (e[j] > ea) { ea = e[j]; a = j; }
            int bq = -1; float eb = -INFINITY;
#pragma unroll
            for (int j = 0; j < 4; ++j) if (j != a && e[j] > eb) { eb = e[j]; bq = j; }
            const float pb = __expf(eb - ea), wa = pg / (1.f + pb), wb = pg * pb / (1.f + pb);
            const int e1 = a < bq ? a : bq, e2 = a < bq ? bq : a;
            const int pi = e1 == 0 ? e2 - 1 : (e1 == 1 ? e2 + 1 : 5);
            cls[tid] = gi * 6 + pi; ((f32x2*)(ws + WS_WTS))[row] = (f32x2){a < bq ? wa : wb, a < bq ? wb : wa};
        }
        LDS_BARRIER();
        if (tid < 24) { int n = 0; for (int i = 0; i < 64; ++i) n += (cls[i] == tid); basel[tid] = n ? (int)atomicAdd(&ctl[CW_MOECNT + l * 32 + tid], (unsigned)n) : 0; }
        LDS_BARRIER();
        if (tid < 64) { const int c = cls[tid]; int rank = 0; for (int i = 0; i < tid; ++i) rank += (cls[i] == c); ((int*)(ws + WS_TOKC))[c * 16384 + basel[c] + rank] = u * 64 + tid; }
        LDS_BARRIER();
    }
}

__device__ __forceinline__ void moe_table(const Params& p, volatile LAS int* tab, int l) {
    int tid = threadIdx.x; asm volatile("" : "+v"(tid));
    if (tid < 24) { const unsigned voff = (unsigned)(CW_MOECNT + l * 32 + tid) * 4u; const unsigned* ctl = (const unsigned*)((const char*)p.ws + voff); tab[32 + tid] = (int)__hip_atomic_load(ctl, __ATOMIC_RELAXED, __HIP_MEMORY_SCOPE_AGENT); }
    LDS_BARRIER();
    if (tid == 0) { int pre = 0; for (int c = 0; c < 24; ++c) { tab[c] = pre; pre += (tab[32 + c] + 255) >> 8; } tab[24] = pre; }
    LDS_BARRIER();
}

__device__ __forceinline__ void phase_final(const Params& p, int bid, int G) {
    int tid = threadIdx.x; asm volatile("" : "+v"(tid));
    const int lane = tid & 63, wave = tid >> 6;
    const int gw = bid * NWAVES + wave, NGW = G * NWAVES;
    for (int row = gw; row < NTOK; row += NGW) {
        const u32x2* xr = (const u32x2*)((const bf16_t*)(p.ws + WS_XB) + (size_t)row * 1024) + lane; f32x4 v[4]; float s = 0.f;
#pragma unroll
        for (int j = 0; j < 4; ++j) { const u32x2 w = xr[64 * j]; v[j] = (f32x4){bf2f(w.x & 0xffffu), bf2f(w.x >> 16), bf2f(w.y & 0xffffu), bf2f(w.y >> 16)}; s += (v[j].x * v[j].x + v[j].y * v[j].y) + (v[j].z * v[j].z + v[j].w * v[j].w); }
        const float rstd = rsqrtf(wave_sum(s) * (1.f / 1024.f) + EPS);
        f32x4* orow = (f32x4*)(p.out + (size_t)row * 1024) + lane;
#pragma unroll
        for (int j = 0; j < 4; ++j) { const f32x4 gg = ((const f32x4*)PIN(26))[64 * j + lane]; orow[64 * j] = (f32x4){v[j].x * rstd * gg.x, v[j].y * rstd * gg.y, v[j].z * rstd * gg.z, v[j].w * rstd * gg.w}; }
    }
}

constexpr int N_PHASES = 3 + 9 * NLAYER + 1;
__global__ void __launch_bounds__(NTHR, 2) mk_fwd(Params p) {
    extern __shared__ __attribute__((aligned(16))) unsigned char lds_raw[];
    LAS unsigned char* lds = (LAS unsigned char*)lds_raw;
    volatile LAS unsigned* MISC = (volatile LAS unsigned*)(lds + LDS_MISC);
    const int tid = threadIdx.x;
    const int G = gridDim.x, bid = blockIdx.x;
    unsigned char* ws = p.ws;
    for (int u = tid; u < 256; u += NTHR) MISC[u] = 0u;
    __syncthreads();
    const int lo = p.ph_lo, hi = p.ph_hi;
    const bool use_bar = (hi - lo) > 1;
    XcdBarrier bar; bar.bar = (unsigned*)(ws + WS_CTL) + CW_BAR; bar.x = 0; bar.st = MISC + 8;
    if (use_bar) bar = xcd_barrier_post((unsigned*)(ws + WS_CTL) + CW_BAR, MISC + 8);
#if PROBE_ID
    volatile LAS unsigned long long* tprobe = (volatile LAS unsigned long long*)(MISC + 128);
#define PB(id) do { if (PROBE_ID == (id) && threadIdx.x == 0) tprobe[1] = __builtin_amdgcn_s_memrealtime(); } while (0)
#define PE(id) do { if (PROBE_ID == (id) && threadIdx.x == 0) tprobe[0] = tprobe[0] + (__builtin_amdgcn_s_memrealtime() - tprobe[1]); } while (0)
#else
#define PB(id) do {} while (0)
#define PE(id) do {} while (0)
#endif
#define IN(k) (lo <= (k) && (k) < hi)
#define SEAM(k) do { if ((k) + 1 < hi) { PB(1); xcd_barrier(bar); PE(1); } } while (0)
    const float* ssq = (const float*)(ws + WS_SSQ);
    bf16_t* xb = (bf16_t*)(ws + WS_XB);

    if (PHON(0) && IN(0)) { PB(9); phase_pro_a(p, lds, bid, G); PE(9); SEAM(0); }
    for (int l = 0; l < NLAYER; ++l) {
        const int pb = 3 + 9 * l;
        if (!(lo < pb + 9 && pb < hi)) continue;
        if (PHON(3) && IN(pb + 0)) { PB(7);
            int bidl = bid; asm volatile("" : "+s"(bidl));
            SchedGrid S{64, 12, 768, G, bidl, (const char*)xb, (const char*)(ws + WS_WIN) + (size_t)l * 3072 * 2048, (size_t)256 * 2048, (size_t)256 * 2048, 0, NY};
            LAS float* rt = (LAS float*)(lds + LDS_RSTD);
            { int t_ = threadIdx.x; asm volatile("" : "+v"(t_)); Unit uu; int pmv[4]; int nu = 0;
#pragma unroll
              for (int i = 0; i < 4; ++i) { pmv[i] = 0; if (nu == i && S.next(i, uu)) { pmv[i] = __builtin_amdgcn_readfirstlane(uu.pm); nu = i + 1; } }
              nu = __builtin_amdgcn_readfirstlane(nu);
              float rv[4];
#pragma unroll
              for (int i = 0; i < 4; ++i) rv[i] = (i < nu && t_ < 256) ? row_rstd(ssq, pmv[i] * 256 + t_) : 0.f;
#pragma unroll
              for (int i = 0; i < 4; ++i) if (i < nu && t_ < 256) rt[i * 256 + t_] = rv[i];
              LDS_BARRIER(); }
            EpiBf16 E{(bf16_t*)(ws + WS_R1), NY, ssq, (unsigned*)(ws + WS_CTL) + CW_KQMAX + l * 64, rt};
            pg8::gemm_phase<EpiBf16, SchedGrid, true, false, false>(lds, GemmDesc{1024, 2048u, 2048u, 0}, S, E);
            for (int sr = 0; sr < SUBR(0); ++sr) phase_logf(p, lds, l, bid, G);
            PE(7); SEAM(pb + 0);
        }
        if (PHON(4) && IN(pb + 1)) { PB(12); phase_p2a(p, lds, l, bid, G); PE(12); SEAM(pb + 1); }
        if (PHON(5) && IN(pb + 2)) { PB(13);
            {
                volatile LAS int* qslot = (volatile LAS int*)(MISC + 96);
                unsigned* qctr = (unsigned*)(ws + WS_CTL) + CW_ATTQ + l;
                if (threadIdx.x == 0) qslot[0] = (int)atomicAdd(qctr, 1u);
                LDS_BARRIER();
                for (;;) {
                    const int qi = __builtin_amdgcn_readfirstlane(qslot[0]);
                    LDS_BARRIER();
                    const int qoff = (l == 0) ? 64 : 0;
                    if (qi >= qoff + (l == 0 ? 1280 + 192 : 1280)) break;
                    int nxt = 0;
                    if (threadIdx.x == 0) nxt = (int)atomicAdd(qctr, 1u);
                    const int q2 = qi - qoff;
                    if (q2 < 0) { SchedKV SK{1 << 20, qi, (const char*)(ws + WS_MEMN), (const char*)(ws + WS_WKVT)};
                        EpiBf16 EK{(bf16_t*)(ws + WS_KV), 2048, nullptr, nullptr, nullptr};
                        pg8::gemm_phase<EpiBf16, SchedKV, false, false, false>(lds, GemmDesc{1024, 2048u, 2048u, 0}, SK, EK); }
                    else if (q2 < 512) attn_unit_mfma(p, lds, l, q2); else if (q2 < 768) hgrn_unit<true>(p, lds, l, q2 - 512); else if (q2 < 1280) conv_unit(p, lds, l, q2 - 768);
                    else { int t_ = threadIdx.x; asm volatile("" : "+v"(t_));
#pragma unroll 1
                        for (int k = 0; k < 4; ++k) conv_item(p, 0, conv_deferred_r(2048 + (q2 - 1280) * 32 + k * 8 + (t_ >> 6)), (LAS float*)(lds + (t_ >> 6) * 16384), t_ & 63); }
                    if (threadIdx.x == 0) qslot[0] = nxt;
                    LDS_BARRIER();
                }
            }
            PE(13); SEAM(pb + 2);
        }
        if (PHON(6) && IN(pb + 3)) { PB(2);
            if (l == 0) {
                { SchedQK SQ{G, bid, (const char*)(ws + WS_KV), (const char*)(ws + WS_WQS)};
                  EpiBf16 EQ{(bf16_t*)(ws + WS_WQK), 1024, nullptr, nullptr, nullptr};
                  pg8::gemm_phase<EpiBf16, SchedQK, false, false, false>(lds, GemmDesc{256, 4096u, 2048u, 0}, SQ, EQ); }
                { SchedVO SV{G, bid, (const char*)(ws + WS_KV), (const char*)(ws + WS_WOT)};
                  EpiBf16 EV{(bf16_t*)(ws + WS_WVO), 1024, nullptr, nullptr, nullptr};
                  pg8::gemm_phase<EpiBf16, SchedVO, false, false, false>(lds, GemmDesc{256, 2048u, 4096u, 0}, SV, EV); }
            }
            SchedGrid S{64, 4, 256, G, bid, (const char*)(ws + WS_CAT), (const char*)(ws + WS_WOUT) + (size_t)l * 1024 * 2048, (size_t)256 * 2048, (size_t)256 * 2048, 0, DM};
            EpiResidual E{xb, (float*)(ws + WS_SSQ)};
            pg8::gemm_phase<EpiResidual, SchedGrid, false, false, false>(lds, GemmDesc{1024, 2048u, 2048u, 0}, S, E);
            PE(2); SEAM(pb + 3);
        }
        if (PHON(7) && IN(pb + 4)) { PB(8);
            int bidl = bid; asm volatile("" : "+s"(bidl));
            SchedGrid S{64, 4, 256, G, bidl, (const char*)xb, (const char*)(ws + WS_WQK) + (size_t)l * 2 * 1024 * 2048, (size_t)256 * 2048, (size_t)256 * 2048, (size_t)1024 * 2048, DM};
            LAS float* rt = (LAS float*)(lds + LDS_RSTD);
            { int t_ = threadIdx.x; asm volatile("" : "+v"(t_)); Unit uu; int pmv[4]; int nu = 0;
#pragma unroll
              for (int i = 0; i < 4; ++i) { pmv[i] = 0; if (nu == i && S.next(i, uu)) { pmv[i] = __builtin_amdgcn_readfirstlane(uu.pm); nu = i + 1; } }
              nu = __builtin_amdgcn_readfirstlane(nu);
              float rv[4];
#pragma unroll
              for (int i = 0; i < 4; ++i) rv[i] = (i < nu && t_ < 256) ? row_rstd(ssq, pmv[i] * 256 + t_) : 0.f;
#pragma unroll
              for (int i = 0; i < 4; ++i) if (i < nu && t_ < 256) rt[i * 256 + t_] = rv[i];
              LDS_BARRIER(); }
            EpiSoftmax E{(bf16_t*)(ws + WS_PBUF), ssq, (LAS float*)(lds + LDS_EPI), rt};
            pg8::gemm_phase<EpiSoftmax, SchedGrid, true, false, false>(lds, GemmDesc{1024, 2048u, 2048u, 0}, S, E);
            PE(8); SEAM(pb + 4);
        }
        if (PHON(8) && IN(pb + 5)) { PB(3);
            SchedGrid S{64, 4, 256, G, bid, (const char*)(ws + WS_PBUF), (const char*)(ws + WS_WVO) + (size_t)l * 2 * 1024 * 2048, (size_t)256 * 2048, (size_t)256 * 2048, (size_t)1024 * 2048, DM};
            EpiResidual E{xb, (float*)(ws + WS_SSQ)};
            pg8::gemm_phase<EpiResidual, SchedGrid, false, false, false>(lds, GemmDesc{1024, 2048u, 2048u, 0}, S, E);
            PE(3); SEAM(pb + 5);
        }
        if (PHON(9) && IN(pb + 6)) { PB(4); phase_route(p, lds, l, bid, G); PE(4); SEAM(pb + 6); }
        if (PHON(10) && IN(pb + 7)) { PB(5);
            volatile LAS int* tab = (volatile LAS int*)(MISC + 16);
            moe_table(p, tab, l);
            const int nun = __builtin_amdgcn_readfirstlane(tab[24]) * 4;
            const bool redeal = (G % 4 == 0) && nun > G && (nun - G) <= G;
            SchedMoe S{bid, G, redeal ? 1 : (bid < nun ? (nun - 1 - bid) / G + 1 : 0), false, tab, (const int*)(ws + WS_TOKC), (const char*)xb, (const char*)(ws + WS_WGU) + (size_t)l * 16 * 512 * 2048};
            { int t_ = threadIdx.x; asm volatile("" : "+v"(t_)); Unit uu; LAS float* tb_ = (LAS float*)(lds + LDS_RSTD);
                  if (S.next(0, uu) && t_ < 256) { const bool valid = t_ < uu.a2; const int tok = valid ? ((const int*)(ws + WS_TOKC))[uu.a1 + t_] : 0; const f32x2 w2 = ((const f32x2*)(ws + WS_WTS))[tok];
                      tb_[t_] = row_rstd(ssq, tok); tb_[256 + t_] = valid ? (uu.a3 ? w2.y : w2.x) : 0.f; }
                  LDS_BARRIER(); }
            EpiMoeUp E{(bf16_t*)(ws + WS_HID), (const int*)(ws + WS_TOKC), ssq, (const f32x2*)(ws + WS_WTS), (const LAS float*)(lds + LDS_RSTD)};
            pg8::gemm_phase<EpiMoeUp, SchedMoe, false, true, false>(lds, GemmDesc{1024, 2048u, 2048u, 0}, S, E);
            PE(5); SEAM(pb + 7);
        }
        if (PHON(11) && IN(pb + 8)) { PB(6);
            volatile LAS int* tab = (volatile LAS int*)(MISC + 16);
            moe_table(p, tab, l);
            const int nun = __builtin_amdgcn_readfirstlane(tab[24]) * 4;
            const bool redeal = (G % 4 == 0) && nun > G && (nun - G) <= G;
            const int nlate = redeal ? nun - G : 0;
            if (redeal) {
                { SchedMoe S{G + bid, G, bid < nlate ? 1 : 0, false, tab, (const int*)(ws + WS_TOKC), (const char*)xb, (const char*)(ws + WS_WGU) + (size_t)l * 16 * 512 * 2048};
                  { int t_ = threadIdx.x; asm volatile("" : "+v"(t_)); Unit uu; LAS float* tb_ = (LAS float*)(lds + LDS_RSTD);
                  if (S.next(0, uu) && t_ < 256) { const bool valid = t_ < uu.a2; const int tok = valid ? ((const int*)(ws + WS_TOKC))[uu.a1 + t_] : 0; const f32x2 w2 = ((const f32x2*)(ws + WS_WTS))[tok];
                      tb_[t_] = row_rstd(ssq, tok); tb_[256 + t_] = valid ? (uu.a3 ? w2.y : w2.x) : 0.f; }
                  LDS_BARRIER(); }
                  EpiMoeUp E{(bf16_t*)(ws + WS_HID), (const int*)(ws + WS_TOKC), ssq, (const f32x2*)(ws + WS_WTS), (const LAS float*)(lds + LDS_RSTD)};
                  pg8::gemm_phase<EpiMoeUp, SchedMoe, false, true, false>(lds, GemmDesc{1024, 2048u, 2048u, 0}, S, E); }
                if (bid < nlate) {
                    asm volatile("s_waitcnt vmcnt(0)" ::: "memory"); __syncthreads();
                    if (threadIdx.x == 0) {
                        __builtin_amdgcn_fence(__ATOMIC_RELEASE, "agent"); asm volatile("s_waitcnt vmcnt(0)" ::: "memory");
                        unsigned* cw = (unsigned*)(ws + WS_CTL) + CW_MOESYNC + l * 32 + (bid >> 2);
                        (void)xb_add(cw, 1u);
                        unsigned sp = 0u; while (xb_ld(cw) < 4u) { __builtin_amdgcn_s_sleep(1); if (++sp > XB_SPIN_CAP) break; }
                        __builtin_amdgcn_fence(__ATOMIC_ACQUIRE, "agent"); asm volatile("s_waitcnt vmcnt(0)" ::: "memory");
                    }
                    __syncthreads();
                }
            }
            const int bb = bid - nlate, Gb = G - nlate;
            SchedMoe S{redeal ? (bid < nlate ? G + bid : bb) : bid, redeal ? (bid < nlate ? G : Gb) : G,
                       redeal ? (bid < nlate ? 1 : (bb < G ? (G - 1 - bb) / Gb + 1 : 0)) : (bid < nun ? (nun - 1 - bid) / G + 1 : 0),
                       true, tab, (const int*)(ws + WS_TOKC), (const char*)(ws + WS_HID), (const char*)(ws + WS_WD) + (size_t)l * 16 * 1024 * 512};
            { int t_ = threadIdx.x; asm volatile("" : "+v"(t_)); Unit uu; LAS int* tt_ = (LAS int*)(lds + LDS_RSTD);
              for (int i = 0; i < 4 && S.next(2 * i, uu); ++i) if (t_ < 256) tt_[i * 256 + t_] = (t_ < uu.a2) ? ((const int*)(ws + WS_TOKC))[uu.a1 + t_] : 0;
              LDS_BARRIER(); }
            EpiMoeDown E{xb, (float*)(ws + WS_SSQ), (const int*)(ws + WS_TOKC), (const LAS int*)(lds + LDS_RSTD)};
            pg8::gemm_phase<EpiMoeDown, SchedMoe, false, false, true>(lds, GemmDesc{256, 1024u, 512u, 0}, S, E);
            if (l + 1 < NLAYER) {
                volatile LAS int* fslot = (volatile LAS int*)(MISC + 100);
                unsigned* fq = (unsigned*)(ws + WS_CTL) + CW_CONVQ + l;
                int t_ = threadIdx.x; asm volatile("" : "+v"(t_));
                LAS float* scr = (LAS float*)(lds + (t_ >> 6) * 16384);
                for (;;) {
                    if (t_ == 0) fslot[0] = (int)atomicAdd(fq, 1u);
                    LDS_BARRIER();
                    const int cb = __builtin_amdgcn_readfirstlane(fslot[0]) * 32;
                    LDS_BARRIER();
                    if (cb >= 8192) break;
#pragma unroll 1
                    for (int k = 0; k < 4; ++k) conv_item(p, l + 1, conv_deferred_r(cb + k * 8 + (t_ >> 6)), scr, t_ & 63);
                }
            }
            PE(6); SEAM(pb + 8);
        }
    }
    if (IN(N_PHASES - 1)) { PB(11); phase_final(p, bid, G); PE(11); }
#if PROBE_ID
    if (threadIdx.x == 0) { const unsigned long long tgt = __builtin_amdgcn_s_memrealtime() + PROBE_AMP * tprobe[0]; while (__builtin_amdgcn_s_memrealtime() < tgt) __builtin_amdgcn_s_sleep(8); }
#endif
#undef IN
#undef SEAM
}

extern "C" void kernel_launch(void* const* d_in, const int* in_sizes, int n_in, void* d_out, int out_size, void* d_ws, size_t ws_size, hipStream_t stream) {
    static int grid = 0;
    if (grid == 0) {
        if (n_in != 27 || out_size != NTOK * DM || ws_size < WS_END) { fprintf(stderr, "kernel_launch: unexpected shapes (n_in %d out %d ws %zu)\n", n_in, out_size, ws_size); grid = -1; return; }
        int dev = 0, cus = 0, per_cu = 0;
        if (hipGetDevice(&dev) != hipSuccess || hipDeviceGetAttribute(&cus, hipDeviceAttributeMultiprocessorCount, dev) != hipSuccess) { grid = -1; return; }
        if (hipFuncSetAttribute((const void*)mk_fwd, hipFuncAttributeMaxDynamicSharedMemorySize, LDS_BYTES) != hipSuccess) { fprintf(stderr, "kernel_launch: hipFuncSetAttribute failed\n"); grid = -1; return; }
        if (hipOccupancyMaxActiveBlocksPerMultiprocessor(&per_cu, (const void*)mk_fwd, NTHR, LDS_BYTES) != hipSuccess || per_cu < 1) { fprintf(stderr, "kernel_launch: occupancy query reports %d\n", per_cu); }
        (void)hipGetLastError();
        grid = cus;
    }
    if (grid < 0) return;
    (void)hipMemsetAsync((char*)d_ws + WS_CTL, 0, CTL_ZERO_BYTES, stream);
    Params a{};
    for (int i = 0; i < 27; ++i) a.in[i] = (const float*)d_in[i];
    a.out = (float*)d_out; a.ws = (unsigned char*)d_ws;
#if ONE_LAUNCH
    a.ph_lo = 0; a.ph_hi = N_PHASES;
    hipLaunchKernelGGL(mk_fwd, dim3(grid), dim3(NTHR), LDS_BYTES, stream, a);
#else
    for (int k = 0; k < N_PHASES; ++k) { a.ph_lo = k; a.ph_hi = k + 1; const int kind = k < 3 ? k : (k == N_PHASES - 1 ? 12 : 3 + (k - 3) % 9);
        for (int rr = 0; rr < RUNS(kind); ++rr) hipLaunchKernelGGL(mk_fwd, dim3(grid), dim3(NTHR), LDS_BYTES, stream, a); }
#endif
}
```

```cpp
#include <hip/hip_runtime.h>
#include <cstdio>
#include <cstdint>

#ifndef USE_MFMA
#define USE_MFMA 1
#endif
#ifndef ONE_LAUNCH
#define ONE_LAUNCH 1
#endif
#ifndef DIS
#define DIS 0
#endif
#define PHON(k) (!(((DIS) >> (k)) & 1))
#ifndef REP
#define REP 0
#endif
#define RUNS(k) ((((REP) >> (k)) & 1) ? 2 : 1)
#ifndef SREP
#define SREP 0
#endif
#define SUBR(k) ((((SREP) >> (k)) & 1) ? 2 : 1)
#ifndef ATTN_MFMA
#define ATTN_MFMA 1
#endif
#ifndef PROBE_ID
#define PROBE_ID 0
#endif
#define PROBE_AMP 4
#if PROBE_ID
#define QB_(id) do { if (PROBE_ID == (id) && threadIdx.x == 0) ((volatile __attribute__((address_space(3))) unsigned long long*)(lds + 131072 + 8192 + 512))[1] = __builtin_amdgcn_s_memrealtime(); } while (0)
#define QE_(id) do { if (PROBE_ID == (id) && threadIdx.x == 0) { volatile __attribute__((address_space(3))) unsigned long long* tp_ = (volatile __attribute__((address_space(3))) unsigned long long*)(lds + 131072 + 8192 + 512); tp_[0] = tp_[0] + (__builtin_amdgcn_s_memrealtime() - tp_[1]); } } while (0)
#else
#define QB_(id) do {} while (0)
#define QE_(id) do {} while (0)
#endif
#ifndef FOX_PRUNE
#define FOX_PRUNE 1
#endif

#define LAS __attribute__((address_space(3)))
#define GAS __attribute__((address_space(1)))
typedef unsigned short bf16_t;
typedef short bf16x8 __attribute__((ext_vector_type(8)));
typedef float f32x4 __attribute__((ext_vector_type(4)));
typedef float f32x2 __attribute__((ext_vector_type(2)));
typedef unsigned u32x4 __attribute__((ext_vector_type(4)));
typedef unsigned u32x2 __attribute__((ext_vector_type(2)));

constexpr int NTOK = 16384, DM = 1024, SEQ = 8192, NLAYER = 4, NY = 3072;
constexpr float EPS = 1e-6f, LOG2E = 1.4426950408889634f;
constexpr float C2 = 0.125f * LOG2E;
constexpr int NWAVES = 8, NTHR = 512;

constexpr size_t MiB = 1u << 20;
constexpr size_t WS_CTL = 0, CTL_ZERO_BYTES = 64 * 1024;
constexpr size_t WS_KT = 128 * 1024;
constexpr size_t WS_LB = 512 * 1024;
constexpr size_t WS_WFFB = 1 * MiB + 640 * 1024;
constexpr size_t WS_WRH = 1 * MiB;
constexpr size_t WS_WRL = 1 * MiB + 256 * 1024;
constexpr size_t WS_LOGF = 2 * MiB;
constexpr size_t WS_CFOX = 2 * MiB + 512 * 1024;
constexpr size_t WS_SSQ = 3 * MiB;
constexpr size_t WS_HU = 4 * MiB;
constexpr size_t WS_HD = 8 * MiB;
constexpr size_t WS_TOKC = 9 * MiB;
constexpr size_t WS_WTS = 10 * MiB + 512 * 1024;
constexpr size_t WS_MEMN = 11 * MiB;
constexpr size_t WS_KV = 12 * MiB;
constexpr size_t WS_WIN = 20 * MiB;
constexpr size_t WS_WOUT = 44 * MiB;
constexpr size_t WS_WQK = 52 * MiB;
constexpr size_t WS_WVO = 68 * MiB;
constexpr size_t WS_WGU = 84 * MiB;
constexpr size_t WS_WD = 148 * MiB;
constexpr size_t WS_XB = 180 * MiB;
constexpr size_t WS_CAT = 212 * MiB;
constexpr size_t WS_R1 = 244 * MiB;
constexpr size_t WS_PBUF = WS_R1;
constexpr size_t WS_HID = WS_R1 + 32 * MiB;
constexpr size_t WS_WQS = 340 * MiB;
constexpr size_t WS_WKVT = 348 * MiB;
constexpr size_t WS_WOT = 364 * MiB;
constexpr size_t WS_END = 372 * MiB;

constexpr int CW_TMO = 0, CW_KQMAX = 13312  , CW_MOECNT = 8192  , CW_ATTQ = 640, CW_MOESYNC = 832  , CW_CONVQ = 1536, CW_SB = 1600, CW_CHK = 1760, CW_Q8 = 12288  , CW_LSUB = 2048  , CW_LGEN = 3072  , CW_BAR = 4096;

constexpr int LDS_STAGE = 0, LDS_STAGE_BYTES = 131072;
constexpr int LDS_EPI = 131072;
constexpr int LDS_MISC = 131072 + 8192;
constexpr int LDS_RSTD = 131072 + 8192 + 1024;
constexpr int LDS_BYTES = 131072 + 8192 + 1024 + 4096;

__device__ __forceinline__ float bf2f(unsigned b) { return __uint_as_float(b << 16); }
typedef __bf16 bf16x2_t __attribute__((ext_vector_type(2)));
__device__ __forceinline__ unsigned cvt_pk_bf16(float lo, float hi) { const f32x2 v = {lo, hi}; const bf16x2_t b = __builtin_convertvector(v, bf16x2_t); return __builtin_bit_cast(unsigned, b); }
__device__ __forceinline__ unsigned short f2bf1(float f) { return (unsigned short)(cvt_pk_bf16(f, 0.f) & 0xffffu); }
template <int K> __device__ __forceinline__ float swz_xor(float v) { return __int_as_float(__builtin_amdgcn_ds_swizzle(__float_as_int(v), (K << 10) | 0x1f)); }
__device__ __forceinline__ float x16_sum(float v) { auto r = __builtin_amdgcn_permlane16_swap(__float_as_uint(v), __float_as_uint(v), false, false); return __uint_as_float(r[0]) + __uint_as_float(r[1]); }
__device__ __forceinline__ float x16_max(float v) { auto r = __builtin_amdgcn_permlane16_swap(__float_as_uint(v), __float_as_uint(v), false, false); return fmaxf(__uint_as_float(r[0]), __uint_as_float(r[1])); }
__device__ __forceinline__ float x32_sum(float v) { auto r = __builtin_amdgcn_permlane32_swap(__float_as_uint(v), __float_as_uint(v), false, false); return __uint_as_float(r[0]) + __uint_as_float(r[1]); }
__device__ __forceinline__ float x32_max(float v) { auto r = __builtin_amdgcn_permlane32_swap(__float_as_uint(v), __float_as_uint(v), false, false); return fmaxf(__uint_as_float(r[0]), __uint_as_float(r[1])); }
template <int CTRL> __device__ __forceinline__ float dpp_f(float v) { return __int_as_float(__builtin_amdgcn_update_dpp(0, __float_as_int(v), CTRL, 0xf, 0xf, true)); }
__device__ __forceinline__ float wave_sum(float v) {
    v += dpp_f<0xB1>(v); v += dpp_f<0x4E>(v); v += dpp_f<0x141>(v); v += dpp_f<0x140>(v); v = x16_sum(v);
    return x32_sum(v);
}
__device__ __forceinline__ float sigmoidf_(float x) { return __builtin_amdgcn_rcpf(1.f + __expf(-x)); }
#define LDS_WAIT() asm volatile("s_waitcnt lgkmcnt(0)" ::: "memory")
#define LDS_BARRIER() asm volatile("s_waitcnt lgkmcnt(0)\n\ts_barrier" ::: "memory")
#define VM_WAIT() asm volatile("s_waitcnt vmcnt(0)" ::: "memory")

#define XB_TMO      128
#define XB_XCNT(j)  (256  + 64 * (j))
#define XB_XSUB(j)  (1280 + 64 * (j))
#define XB_XGEN(j)  (2304 + 64 * (j))
#define XB_TOP      3328
#define XB_TOPGEN   3392
#define XCD_BAR_WORDS 3456
#define XB_TOPREP(r) (3456 + 32 * (r))
#define XB_SPIN_CAP (1u << 22)
__device__ __forceinline__ unsigned xb_ld(unsigned* p)              { return __hip_atomic_load(p, __ATOMIC_RELAXED, __HIP_MEMORY_SCOPE_AGENT); }
__device__ __forceinline__ unsigned xb_add(unsigned* p, unsigned v) { return __hip_atomic_fetch_add(p, v, __ATOMIC_RELAXED, __HIP_MEMORY_SCOPE_AGENT); }
__device__ __forceinline__ unsigned xb_xcc_id() { return (unsigned)__builtin_amdgcn_s_getreg((3 << 11) | 20) & 0xFu; }
#define XB_SPIN(cond, bar) do { unsigned _sp = 0; while (cond) { __builtin_amdgcn_s_sleep(1); \
    if ((++_sp & 255u) == 0u) { if (xb_ld(&(bar)[XB_TMO])) break; if (_sp > XB_SPIN_CAP) { atomicAdd(&(bar)[XB_TMO], 1u); break; } } } } while (0)
struct XcdBarrier { unsigned* bar; unsigned x; volatile LAS unsigned* st; };
__device__ __forceinline__ XcdBarrier xcd_barrier_post(unsigned* bar, volatile LAS unsigned* st) {
    XcdBarrier b; b.bar = bar; b.x = xb_xcc_id(); b.st = st;
    if (threadIdx.x == 0) (void)xb_add(&bar[XB_XCNT(b.x)], 1u);
    return b;
}
__device__ __forceinline__ void xcd_barrier_complete(unsigned* bar, unsigned x, unsigned& nloc, unsigned& nx) {
    const unsigned G = gridDim.x * gridDim.y * gridDim.z;
    unsigned sum, cnt, mine, sp = 0u;
    for (;;) {
        sum = 0u; cnt = 0u; mine = 0u;
#pragma unroll
        for (unsigned j = 0; j < 16; ++j) { const unsigned c = xb_ld(&bar[XB_XCNT(j)]); sum += c; cnt += (c > 0u) ? 1u : 0u; mine = (j == x) ? c : mine; }
        if (sum == G) break;
        __builtin_amdgcn_s_sleep(1);
        if ((++sp & 255u) == 0u) { if (xb_ld(&bar[XB_TMO])) break; if (sp > XB_SPIN_CAP) { atomicAdd(&bar[XB_TMO], 1u); break; } }
    }
    nloc = mine > 0u ? mine : 1u; nx = cnt > 0u ? cnt : 1u;
}
__device__ __forceinline__ void xcd_barrier(const XcdBarrier& b) {
    asm volatile("s_waitcnt vmcnt(0)" ::: "memory");
    __syncthreads();
    if (threadIdx.x == 0) {
        unsigned* bar = b.bar;
        __builtin_amdgcn_s_waitcnt(0);
        unsigned nloc = b.st[0], nx = b.st[1];
        if (nloc == 0u) { xcd_barrier_complete(bar, b.x, nloc, nx); b.st[0] = nloc; b.st[1] = nx; }
        const unsigned old = xb_add(&bar[XB_XSUB(b.x)], 1u);
        const unsigned gen = old / nloc;
        if (old + 1u == (gen + 1u) * nloc) {
            __builtin_amdgcn_fence(__ATOMIC_RELEASE, "agent");
            asm volatile("s_waitcnt vmcnt(0)" ::: "memory");
#pragma unroll
            for (unsigned r = 0; r < 8u; ++r) (void)xb_add(&bar[XB_TOPREP(r)], 1u);
        }
        XB_SPIN(xb_ld(&bar[XB_TOPREP(b.x & 7u)]) < (gen + 1u) * nx, bar);
        __builtin_amdgcn_fence(__ATOMIC_ACQUIRE, "agent");
        asm volatile("s_waitcnt vmcnt(0)" ::: "memory");
    }
    __syncthreads();
}

__device__ __forceinline__ void xcd_split_arrive(const XcdBarrier& b, unsigned* sb) {
    asm volatile("s_waitcnt vmcnt(0)" ::: "memory");
    __syncthreads();
    if (threadIdx.x == 0) {
        __builtin_amdgcn_s_waitcnt(0);
        const unsigned nloc = b.st[0];
        const unsigned old = xb_add(&sb[b.x], 1u);
        if (old + 1u == nloc) { __builtin_amdgcn_fence(__ATOMIC_RELEASE, "agent"); asm volatile("s_waitcnt vmcnt(0)" ::: "memory"); (void)xb_add(&sb[16], 1u); }
    }
}
__device__ __forceinline__ void xcd_split_wait(const XcdBarrier& b, unsigned* sb) {
    if (threadIdx.x == 0) {
        const unsigned nx = b.st[1];
        XB_SPIN(xb_ld(&sb[16]) < nx, b.bar);
        __builtin_amdgcn_fence(__ATOMIC_ACQUIRE, "agent");
        asm volatile("s_waitcnt vmcnt(0)" ::: "memory");
    }
    __syncthreads();
}

__device__ __forceinline__ void xcd_local_barrier(const XcdBarrier& b, unsigned* lsub, unsigned* lgen) {
    asm volatile("s_waitcnt vmcnt(0)" ::: "memory");
    __syncthreads();
    if (threadIdx.x == 0) {
        __builtin_amdgcn_s_waitcnt(0);
        const unsigned nloc = b.st[0], n = b.st[2] + 1u;
        b.st[2] = n;
        (void)xb_add(&lsub[64 * b.x], 1u);
        XB_SPIN(xb_ld(&lsub[64 * b.x]) < n * nloc, b.bar);
        __builtin_amdgcn_fence(__ATOMIC_ACQUIRE, "agent");
        asm volatile("s_waitcnt vmcnt(0)" ::: "memory");
    }
    __syncthreads();
}

namespace pg8 {
constexpr int BM = 256, BK = 64, HALF = 128, HTB = HALF * BK * 2;
__host__ __device__ __forceinline__ int lds_byte(int r, int c) { const int st = (r >> 4) * 2 + (c >> 5), rr = r & 15, cc = c & 31, ob = rr * 64 + cc * 2; return st * 1024 + (ob ^ (((ob >> 9) & 1) << 5)); }
__host__ __device__ __forceinline__ void stage_rc(int b, int& R, int& C) { const int st = b / 1024, sb = b % 1024, swz = sb ^ (((sb >> 9) & 1) << 5); R = (st >> 1) * 16 + swz / 64; C = (st & 1) * 32 + (swz % 64) / 2; }
__host__ __device__ __forceinline__ int perm32(int rho) { const int n = rho >> 4, i = rho & 15; return 8 * (i >> 2) + 4 * n + (i & 3); }

struct Unit { int pm, pn, a0, a1, a2, a3, ord; };
struct GemmDesc { int K; unsigned lda, ldb; int ksplit; };


struct NoPre { static constexpr bool active = false; __device__ __forceinline__ void operator()() const {} };
#if USE_MFMA
template <class Epi, class Sched, bool ALIGN_EPI, bool GATHER, bool BSPLIT, class Pre = NoPre>
__device__ __forceinline__ void gemm_phase(LAS unsigned char* lds, const GemmDesc g, const Sched& S, const Epi& E, const Pre& pre = Pre{}) {
    int tid = threadIdx.x; asm volatile("" : "+v"(tid));
    const int wid = __builtin_amdgcn_readfirstlane(tid >> 6), lane = tid & 63, wr = wid >> 2, wc = wid & 3, fr = lane & 15, fq = lane >> 4;
    const int nt = g.K / BK;
    int R0, C0; stage_rc(tid * 16, R0, C0);
    const unsigned voffB = (unsigned)((R0 & ~31) + perm32(R0 & 31)) * g.ldb + (unsigned)C0 * 2u, voffA = (unsigned)R0 * g.lda + (unsigned)C0 * 2u;
    const size_t qstepA = (size_t)64 * g.lda, qstepB = (size_t)64 * g.ldb;
    const size_t kstep = (size_t)(BK * 2);
    const size_t hstepB = (size_t)HALF * g.ldb, hstepA = GATHER ? (size_t)0 : (size_t)HALF * g.lda;
    const unsigned ldsw = (unsigned)wid * 1024u;
    const int aoff = lds_byte(wr * 64 + fr, fq * 8), boff = lds_byte(wc * 32 + fr, fq * 8);
#define PG8_SA(b, h) (((b) * 2 + (h)) * HTB)
#define PG8_SB(b, h) ((4 + (b) * 2 + (h)) * HTB)
#define PG8_STAGE(bufoff, gbase, voff) do { _Pragma("unroll") for (int _i = 0; _i < 2; ++_i) \
        __builtin_amdgcn_global_load_lds((const unsigned*)((const char*)(gbase) + (voff)[_i]), (LAS unsigned*)(lds + (bufoff) + ldsw + _i * 8192), 16, 0, 0); } while (0)
#define PG8_STAGE1(bufoff, gbase, voff, qstep) do { _Pragma("unroll") for (int _i = 0; _i < 2; ++_i) \
        __builtin_amdgcn_global_load_lds((const unsigned*)((const char*)(gbase) + _i * (qstep) + (voff)), (LAS unsigned*)(lds + (bufoff) + ldsw + _i * 8192), 16, 0, 0); } while (0)
#define PG8_STAGE_B(bufoff, gbase) PG8_STAGE1(bufoff, gbase, voffB, qstepB)
#define PG8_LDA(dst, b, h) do { _Pragma("unroll") for (int m = 0; m < 4; ++m) _Pragma("unroll") for (int k = 0; k < 2; ++k) dst[m][k] = *(const LAS bf16x8*)(lds + PG8_SA(b, h) + aoff + m * 2048 + k * 1024); } while (0)
#define PG8_LDB(dst, b, h) do { _Pragma("unroll") for (int n = 0; n < 2; ++n) _Pragma("unroll") for (int k = 0; k < 2; ++k) dst[n][k] = *(const LAS bf16x8*)(lds + PG8_SB(b, h) + boff + n * 2048 + k * 1024); } while (0)
#define PG8_MMA(ai, bj, At, Bt) do { __builtin_amdgcn_s_setprio(1); _Pragma("unroll") for (int m = 0; m < 4; ++m) _Pragma("unroll") for (int n = 0; n < 2; ++n) _Pragma("unroll") for (int k = 0; k < 2; ++k) \
        acc[ai][bj][m][n] = __builtin_amdgcn_mfma_f32_16x16x32_bf16(Bt[n][k], At[m][k], acc[ai][bj][m][n], 0, 0, 0); __builtin_amdgcn_s_setprio(0); } while (0)
#define PG8_WAIT_V(n) asm volatile("s_waitcnt vmcnt(" #n ")" ::: "memory")
#define PG8_WAIT_L(n) asm volatile("s_waitcnt lgkmcnt(" #n ")" ::: "memory")
#define PG8_BAR __builtin_amdgcn_s_barrier()
#define PG8_SCHED __builtin_amdgcn_sched_barrier(0)
#define PG8_OFFS(u, o) do { if constexpr (GATHER) { _Pragma("unroll") for (int _h = 0; _h < 2; ++_h) _Pragma("unroll") for (int _i = 0; _i < 2; ++_i) \
        o[_h][_i] = S.arow(u, _h * 128 + _i * 64 + R0) + (unsigned)C0 * 2u; } } while (0)
#define PG8_STAGE_A(bufoff, gbase, h, OFF) do { if constexpr (GATHER) { PG8_STAGE(bufoff, gbase, OFF[h]); } else { PG8_STAGE1(bufoff, (gbase) + (h) * hstepA, voffA, qstepA); } } while (0)
#define PG8_BP(base, base2, tt) ((base) + (size_t)(tt) * kstep)
    Unit cur, nxt; int ui = 0;
    if (!S.next(0, cur)) return;
    f32x4 acc[2][2][4][2];
#pragma unroll
    for (int a = 0; a < 2; ++a)
#pragma unroll
        for (int b = 0; b < 2; ++b)
#pragma unroll
            for (int m = 0; m < 4; ++m)
#pragma unroll
                for (int n = 0; n < 2; ++n) acc[a][b][m][n] = (f32x4){0.f, 0.f, 0.f, 0.f};
    bf16x8 At[4][2], B0[2][2], B1[2][2];
    unsigned coff[2][2], noff[2][2];
#pragma unroll
    for (int h = 0; h < 2; ++h)
#pragma unroll
        for (int i = 0; i < 2; ++i) { coff[h][i] = 0u; noff[h][i] = 0u; }
    PG8_OFFS(cur, coff);
    const char* cA = S.A(cur); const char* cB = S.B(cur); const char* cB2 = cB;
    PG8_STAGE_B(PG8_SB(0, 0), cB); PG8_STAGE_B(PG8_SB(0, 1), cB + hstepB); PG8_STAGE_A(PG8_SA(0, 0), cA, 0, coff); PG8_STAGE_A(PG8_SA(0, 1), cA, 1, coff);
    if constexpr (Pre::active) { pre(); PG8_WAIT_V(0); PG8_SCHED; }
    if (wr == 1) PG8_BAR;
    PG8_WAIT_V(2); PG8_BAR;
    PG8_STAGE_B(PG8_SB(1, 0), cB + kstep); PG8_STAGE_A(PG8_SA(1, 0), cA + kstep, 0, coff); PG8_STAGE_B(PG8_SB(1, 1), cB + hstepB + kstep);
    PG8_WAIT_V(6); PG8_BAR;
    for (;;) {
        const bool has_next = S.next(ui + 1, nxt);
        const char* nA = has_next ? S.A(nxt) : cA; const char* nB = has_next ? S.B(nxt) : cB; const char* nB2 = cB2;
        if constexpr (GATHER) { if (has_next) { PG8_OFFS(nxt, noff); } else {
#pragma unroll
            for (int h = 0; h < 2; ++h)
#pragma unroll
                for (int i = 0; i < 2; ++i) noff[h][i] = coff[h][i]; } }
        for (int t = 0; t < nt; t += 2) {
            const bool last = (t == nt - 2);
            const char* a1 = cA + (size_t)(t + 1) * kstep;
            const char* a2 = last ? nA : cA + (size_t)(t + 2) * kstep;
            const char* b2 = last ? nB : PG8_BP(cB, cB2, t + 2);
            const char* a3 = a2 + kstep;
            const char* b3 = last ? nB + kstep : PG8_BP(cB, cB2, t + 3);
            unsigned o2[2][2];
#pragma unroll
            for (int h = 0; h < 2; ++h)
#pragma unroll
                for (int i = 0; i < 2; ++i) o2[h][i] = GATHER ? (last ? noff[h][i] : coff[h][i]) : 0u;
            PG8_LDB(B0, 0, 0); PG8_LDB(B1, 0, 1); PG8_SCHED; PG8_LDA(At, 0, 0); PG8_STAGE_A(PG8_SA(1, 1), a1, 1, coff);
            PG8_WAIT_V(8); PG8_WAIT_L(0); PG8_BAR; PG8_MMA(0, 0, At, B0); PG8_MMA(0, 1, At, B1); PG8_BAR; PG8_SCHED;
            PG8_LDA(At, 0, 1); PG8_STAGE_B(PG8_SB(0, 0), b2); PG8_STAGE_B(PG8_SB(0, 1), b2 + hstepB); PG8_STAGE_A(PG8_SA(0, 0), a2, 0, o2);
            PG8_WAIT_V(8); PG8_WAIT_L(0); PG8_BAR; PG8_MMA(1, 0, At, B0); PG8_MMA(1, 1, At, B1); PG8_BAR; PG8_SCHED;
            PG8_LDB(B0, 1, 0); PG8_LDB(B1, 1, 1); PG8_SCHED; PG8_LDA(At, 1, 0); PG8_STAGE_A(PG8_SA(0, 1), a2, 1, o2);
            PG8_WAIT_V(8); PG8_WAIT_L(0); PG8_BAR; PG8_MMA(0, 0, At, B0); PG8_MMA(0, 1, At, B1); PG8_BAR; PG8_SCHED;
            PG8_LDA(At, 1, 1); PG8_STAGE_B(PG8_SB(1, 0), b3); PG8_STAGE_B(PG8_SB(1, 1), b3 + hstepB); PG8_STAGE_A(PG8_SA(1, 0), a3, 0, o2);
            PG8_WAIT_V(8); PG8_WAIT_L(0); PG8_BAR; PG8_MMA(1, 0, At, B0); PG8_MMA(1, 1, At, B1); PG8_BAR; PG8_SCHED;
        }
        const bool cont = BSPLIT && S.chain(cur);
        if (!cont) {
        if constexpr (ALIGN_EPI) { if (wr == 0) PG8_BAR; }
        { int t2 = threadIdx.x; asm volatile("" : "+v"(t2)); const int l2 = t2 & 63; E(acc, cur, wr, wc, l2 & 15, l2 >> 4); }
        }
        if (!has_next) break;
        if (!cont) {
#pragma unroll
        for (int a = 0; a < 2; ++a)
#pragma unroll
            for (int b = 0; b < 2; ++b)
#pragma unroll
                for (int m = 0; m < 4; ++m)
#pragma unroll
                    for (int n = 0; n < 2; ++n) acc[a][b][m][n] = (f32x4){0.f, 0.f, 0.f, 0.f};
        }
        cur = nxt; cA = nA; cB = nB; cB2 = nB2; ++ui;
#pragma unroll
        for (int h = 0; h < 2; ++h)
#pragma unroll
            for (int i = 0; i < 2; ++i) coff[h][i] = noff[h][i];
        if constexpr (ALIGN_EPI) { if (!cont && wr == 1) PG8_BAR; }
    }
    PG8_WAIT_V(0);
    if constexpr (!ALIGN_EPI) { if (wr == 0) PG8_BAR; }
    PG8_BAR;
#undef PG8_SA
#undef PG8_SB
#undef PG8_STAGE
#undef PG8_LDA
#undef PG8_LDB
#undef PG8_MMA
#undef PG8_WAIT_V
#undef PG8_WAIT_L
#undef PG8_BAR
#undef PG8_SCHED
#undef PG8_OFFS
#undef PG8_STAGE_A
#undef PG8_STAGE1
#undef PG8_STAGE_B
#undef PG8_BP
}
#else
template <class Epi, class Sched, bool ALIGN_EPI, bool GATHER, bool BSPLIT>
__device__ __forceinline__ void gemm_phase(LAS unsigned char* lds, const GemmDesc g, const Sched& S, const Epi& E) {
    const int tid = threadIdx.x, wid = __builtin_amdgcn_readfirstlane(tid >> 6), lane = tid & 63, wr = wid >> 2, wc = wid & 3, fr = lane & 15, fq = lane >> 4;
    Unit cur;
    for (int ui = 0; S.next(ui, cur); ++ui) {
        f32x4 acc[2][2][4][2];
#pragma unroll
        for (int a = 0; a < 2; ++a)
#pragma unroll
            for (int b = 0; b < 2; ++b)
#pragma unroll
                for (int m = 0; m < 4; ++m)
#pragma unroll
                    for (int n = 0; n < 2; ++n) acc[a][b][m][n] = (f32x4){0.f, 0.f, 0.f, 0.f};
        const char* cA = S.A(cur); const char* cB = S.B(cur); const char* cB2 = BSPLIT ? S.B2(cur) : cB;
        unsigned aro[2][4];
#pragma unroll
        for (int ai = 0; ai < 2; ++ai)
#pragma unroll
            for (int m = 0; m < 4; ++m) { const int r = ai * 128 + wr * 64 + m * 16 + fr; aro[ai][m] = GATHER ? S.arow(cur, r) : (unsigned)r * g.lda; }
        for (int k0 = 0; k0 < g.K; k0 += 4) {
            u32x2 av[2][4];
#pragma unroll
            for (int ai = 0; ai < 2; ++ai)
#pragma unroll
                for (int m = 0; m < 4; ++m) av[ai][m] = *(const u32x2*)(cA + aro[ai][m] + (size_t)k0 * 2);
            const char* bb = (BSPLIT && k0 >= g.ksplit * 64) ? cB2 : cB;
#pragma unroll
            for (int bj = 0; bj < 2; ++bj)
#pragma unroll
                for (int n = 0; n < 2; ++n)
#pragma unroll
                    for (int j = 0; j < 4; ++j) {
                        const int c = bj * 128 + wc * 32 + fq * 8 + n * 4 + j;
                        const u32x2 bv = *(const u32x2*)(bb + (size_t)c * g.ldb + (size_t)k0 * 2);
                        const float b0 = bf2f(bv.x & 0xffffu), b1 = bf2f(bv.x >> 16), b2 = bf2f(bv.y & 0xffffu), b3 = bf2f(bv.y >> 16);
#pragma unroll
                        for (int ai = 0; ai < 2; ++ai)
#pragma unroll
                            for (int m = 0; m < 4; ++m) {
                                const u32x2 a = av[ai][m];
                                acc[ai][bj][m][n][j] += bf2f(a.x & 0xffffu) * b0 + bf2f(a.x >> 16) * b1 + bf2f(a.y & 0xffffu) * b2 + bf2f(a.y >> 16) * b3;
                            }
                    }
        }
        E(acc, cur, wr, wc, fr, fq);
    }
    __syncthreads();
}
#endif
}
using pg8::Unit; using pg8::GemmDesc;

__device__ __forceinline__ float row_rstd(const float* ssq, int row) {
    const f32x4* p = (const f32x4*)(ssq + (size_t)row * 16);
    const f32x4 a = p[0], b = p[1], c = p[2], d = p[3];
    const float s = ((a.x + a.y) + (a.z + a.w)) + ((b.x + b.y) + (b.z + b.w)) + ((c.x + c.y) + (c.z + c.w)) + ((d.x + d.y) + (d.z + d.w));
    return rsqrtf(s * (1.f / 1024.f) + EPS);
}
__device__ __forceinline__ u32x4 pack8(f32x4 v0, f32x4 v1) { u32x4 w; w.x = cvt_pk_bf16(v0[0], v0[1]); w.y = cvt_pk_bf16(v0[2], v0[3]); w.z = cvt_pk_bf16(v1[0], v1[1]); w.w = cvt_pk_bf16(v1[2], v1[3]); return w; }

struct EpiBf16 {
    bf16_t* O; int ldc; const float* ssq; unsigned* kq; const LAS float* rt;
    __device__ __forceinline__ void operator()(const f32x4 (&acc)[2][2][4][2], const Unit& u, int wr, int wc, int fr, int fq) const {
        float nmax[2][2] = {{0.f, 0.f}, {0.f, 0.f}};
        const bool donorm = kq != nullptr && u.pn >= 2 && u.pn < 4;
#pragma unroll
        for (int ai = 0; ai < 2; ++ai)
#pragma unroll
            for (int m = 0; m < 4; ++m) {
                const int r = ai * 128 + wr * 64 + m * 16 + fr;
                const float rs = (rt && u.a2 < 4) ? rt[u.a2 * 256 + r] : (ssq ? row_rstd(ssq, u.a1 + r) : 1.f);
                bf16_t* rowp = O + (size_t)u.a0 + (size_t)r * ldc + wc * 32 + fq * 8;
#pragma unroll
                for (int bj = 0; bj < 2; ++bj) { const u32x4 w = pack8(acc[ai][bj][m][0] * rs, acc[ai][bj][m][1] * rs); *(u32x4*)(rowp + bj * 128) = w;
                    if (donorm) { float s = 0.f;
#pragma unroll
                        for (int e = 0; e < 4; ++e) { const float a = bf2f(w[e] & 0xffffu), b2 = bf2f(w[e] >> 16); s += a * a + b2 * b2; }
                        s = x16_sum(s); s = x32_sum(s); nmax[ai][bj] = fmaxf(nmax[ai][bj], s); } }
                __builtin_amdgcn_sched_barrier(0);
            }
        if (donorm) {
#pragma unroll
            for (int ai = 0; ai < 2; ++ai)
#pragma unroll
            for (int bj = 0; bj < 2; ++bj) { float v = nmax[ai][bj];
                v = fmaxf(v, dpp_f<0xB1>(v)); v = fmaxf(v, dpp_f<0x4E>(v)); v = fmaxf(v, dpp_f<0x141>(v)); v = fmaxf(v, dpp_f<0x140>(v));
                if (fr == 0 && fq == 0) { const int b = u.pm >> 5, head = (u.pn & 1) * 4 + bj * 2 + (wc >> 1), tile = (u.pm & 31) * 4 + ai * 2 + wr;
                    ((float*)kq)[((b * 8 + head) * 128 + tile) * 2 + (wc & 1)] = v; } }
        }
    }
};
struct EpiResidual {
    bf16_t* xb; float* ssq;
    __device__ __forceinline__ void operator()(const f32x4 (&acc)[2][2][4][2], const Unit& u, int wr, int wc, int fr, int fq) const {
#pragma unroll
        for (int ai = 0; ai < 2; ++ai) {
        u32x4 xi[2][4][2];
#pragma unroll
            for (int m = 0; m < 4; ++m)
#pragma unroll
                for (int bj = 0; bj < 2; ++bj) xi[ai][m][bj] = *(const u32x4*)(xb + (size_t)(u.pm * 256 + ai * 128 + wr * 64 + m * 16 + fr) * DM + u.pn * 256 + bj * 128 + wc * 32 + fq * 8);
        __builtin_amdgcn_sched_barrier(0);
#pragma unroll
            for (int m = 0; m < 4; ++m) {
                const int row = u.pm * 256 + ai * 128 + wr * 64 + m * 16 + fr;
                float ss = 0.f;
#pragma unroll
                for (int bj = 0; bj < 2; ++bj) {
                    const size_t o = (size_t)row * DM + u.pn * 256 + bj * 128 + wc * 32 + fq * 8;
                    const u32x4 x4 = xi[ai][m][bj];
                    f32x4 v0, v1;
                    v0[0] = acc[ai][bj][m][0][0] + bf2f(x4.x & 0xffffu); v0[1] = acc[ai][bj][m][0][1] + bf2f(x4.x >> 16); v0[2] = acc[ai][bj][m][0][2] + bf2f(x4.y & 0xffffu); v0[3] = acc[ai][bj][m][0][3] + bf2f(x4.y >> 16);
                    v1[0] = acc[ai][bj][m][1][0] + bf2f(x4.z & 0xffffu); v1[1] = acc[ai][bj][m][1][1] + bf2f(x4.z >> 16); v1[2] = acc[ai][bj][m][1][2] + bf2f(x4.w & 0xffffu); v1[3] = acc[ai][bj][m][1][3] + bf2f(x4.w >> 16);
                    *(u32x4*)(xb + o) = pack8(v0, v1);
                    ss += (v0[0] * v0[0] + v0[1] * v0[1]) + (v0[2] * v0[2] + v0[3] * v0[3]) + (v1[0] * v1[0] + v1[1] * v1[1]) + (v1[2] * v1[2] + v1[3] * v1[3]);
                }
                ss = x16_sum(ss); ss = x32_sum(ss);
                if (fq == 0) ssq[(size_t)row * 16 + u.pn * 4 + wc] = ss;
            }
        __builtin_amdgcn_sched_barrier(0);
        }
    }
};
struct EpiSoftmax {
    bf16_t* P; const float* ssq; LAS float* scr; const LAS float* rt;
    __device__ __forceinline__ void operator()(const f32x4 (&acc)[2][2][4][2], const Unit& u, int wr, int wc, int fr, int fq) const {
#pragma unroll
        for (int ai = 0; ai < 2; ++ai)
#pragma unroll
            for (int m = 0; m < 4; ++m) {
                const int rl = ai * 128 + wr * 64 + m * 16 + fr;
                const float rs = (u.a2 < 4 ? rt[u.a2 * 256 + rl] : row_rstd(ssq, u.pm * 256 + rl)) * (LOG2E / 16.f);
                float mm = -INFINITY;
#pragma unroll
                for (int bj = 0; bj < 2; ++bj)
#pragma unroll
                    for (int n = 0; n < 2; ++n)
#pragma unroll
                        for (int j = 0; j < 4; ++j) mm = fmaxf(mm, acc[ai][bj][m][n][j] * rs);
                mm = x16_max(mm); mm = x32_max(mm);
                if (fq == 0) scr[rl * 4 + wc] = mm;
            }
        LDS_WAIT(); __builtin_amdgcn_s_barrier();
#pragma unroll
        for (int ai = 0; ai < 2; ++ai)
#pragma unroll
            for (int m = 0; m < 4; ++m) {
                const int rl = ai * 128 + wr * 64 + m * 16 + fr;
                const float rs = (u.a2 < 4 ? rt[u.a2 * 256 + rl] : row_rstd(ssq, u.pm * 256 + rl)) * (LOG2E / 16.f);
                const f32x4 q = *(const LAS f32x4*)(scr + rl * 4);
                const float M = fmaxf(fmaxf(q.x, q.y), fmaxf(q.z, q.w));
                float s = 0.f;
#pragma unroll
                for (int bj = 0; bj < 2; ++bj)
#pragma unroll
                    for (int n = 0; n < 2; ++n)
#pragma unroll
                        for (int j = 0; j < 4; ++j) s += __builtin_amdgcn_exp2f(acc[ai][bj][m][n][j] * rs - M);
                s = x16_sum(s); s = x32_sum(s);
                if (fq == 0) scr[1024 + rl * 4 + wc] = s;
            }
        LDS_WAIT(); __builtin_amdgcn_s_barrier();
#pragma unroll
        for (int ai = 0; ai < 2; ++ai)
#pragma unroll
            for (int m = 0; m < 4; ++m) {
                const int rl = ai * 128 + wr * 64 + m * 16 + fr;
                const float r = (u.a2 < 4 ? rt[u.a2 * 256 + rl] : row_rstd(ssq, u.pm * 256 + rl)) * (LOG2E / 16.f);
                const f32x4 qm = *(const LAS f32x4*)(scr + rl * 4);
                const float M = fmaxf(fmaxf(qm.x, qm.y), fmaxf(qm.z, qm.w));
                const f32x4 q = *(const LAS f32x4*)(scr + 1024 + rl * 4);
                const float inv = 1.f / ((q.x + q.y) + (q.z + q.w));
                bf16_t* rowp = P + (size_t)(u.pm * 256 + rl) * DM + u.pn * 256 + wc * 32 + fq * 8;
#pragma unroll
                for (int bj = 0; bj < 2; ++bj) {
                    f32x4 v0, v1;
#pragma unroll
                    for (int j = 0; j < 4; ++j) { v0[j] = __builtin_amdgcn_exp2f(acc[ai][bj][m][0][j] * r - M) * inv; v1[j] = __builtin_amdgcn_exp2f(acc[ai][bj][m][1][j] * r - M) * inv; }
                    *(u32x4*)(rowp + bj * 128) = pack8(v0, v1);
                }
            }
        LDS_WAIT(); __builtin_amdgcn_s_barrier();
    }
};
struct EpiMoeUp {
    bf16_t* hid; const int* tokc; const float* ssq; const f32x2* wts; const LAS float* tb;
    __device__ __forceinline__ void operator()(const f32x4 (&acc)[2][2][4][2], const Unit& u, int wr, int wc, int fr, int fq) const {
#pragma unroll
        for (int ai = 0; ai < 2; ++ai)
#pragma unroll
            for (int m = 0; m < 4; ++m) {
                const int rl = ai * 128 + wr * 64 + m * 16 + fr;
                float rs, w;
                if (u.ord == 0) { rs = tb[rl]; w = tb[256 + rl]; }
                else { const bool valid = rl < u.a2; const int tok = valid ? tokc[u.a1 + rl] : 0; rs = row_rstd(ssq, tok); const f32x2 w2 = wts[tok]; w = valid ? (u.a3 ? w2.y : w2.x) : 0.f; }
                f32x4 h[2];
#pragma unroll
                for (int n = 0; n < 2; ++n)
#pragma unroll
                    for (int j = 0; j < 4; ++j) { const float gt = acc[ai][0][m][n][j] * rs, up = acc[ai][1][m][n][j] * rs; h[n][j] = gt * __builtin_amdgcn_rcpf(1.f + __expf(-gt)) * up * w; }
                *(u32x4*)(hid + (size_t)(u.a0 + rl) * 512 + u.a3 * 256 + u.pn * 128 + wc * 32 + fq * 8) = pack8(h[0], h[1]);
            }
    }
};
struct EpiMoeDown {
    bf16_t* xb; float* ssq; const int* tokc; const LAS int* tt;
    __device__ __forceinline__ void operator()(const f32x4 (&acc)[2][2][4][2], const Unit& u, int wr, int wc, int fr, int fq) const {
#pragma unroll
        for (int ai = 0; ai < 2; ++ai) {
            u32x4 xi[4][2]; int tokv[4];
#pragma unroll
            for (int m = 0; m < 4; ++m) {
                const int rl = ai * 128 + wr * 64 + m * 16 + fr;
                const bool valid = rl < u.a2;
                tokv[m] = valid ? (u.ord < 4 ? tt[u.ord * 256 + rl] : tokc[u.a1 + rl]) : 0;
#pragma unroll
                for (int bj = 0; bj < 2; ++bj) xi[m][bj] = *(const u32x4*)(xb + (size_t)tokv[m] * DM + u.pn * 256 + bj * 128 + wc * 32 + fq * 8);
            }
            __builtin_amdgcn_sched_barrier(0);
#pragma unroll
            for (int m = 0; m < 4; ++m) {
                const int rl = ai * 128 + wr * 64 + m * 16 + fr;
                const bool valid = rl < u.a2;
                const int tok = tokv[m];
                float ss = 0.f;
#pragma unroll
                for (int bj = 0; bj < 2; ++bj) {
                    const size_t o = (size_t)tok * DM + u.pn * 256 + bj * 128 + wc * 32 + fq * 8;
                    const u32x4 x4 = xi[m][bj];
                    f32x4 v0, v1;
                    v0[0] = acc[ai][bj][m][0][0] + bf2f(x4.x & 0xffffu); v0[1] = acc[ai][bj][m][0][1] + bf2f(x4.x >> 16); v0[2] = acc[ai][bj][m][0][2] + bf2f(x4.y & 0xffffu); v0[3] = acc[ai][bj][m][0][3] + bf2f(x4.y >> 16);
                    v1[0] = acc[ai][bj][m][1][0] + bf2f(x4.z & 0xffffu); v1[1] = acc[ai][bj][m][1][1] + bf2f(x4.z >> 16); v1[2] = acc[ai][bj][m][1][2] + bf2f(x4.w & 0xffffu); v1[3] = acc[ai][bj][m][1][3] + bf2f(x4.w >> 16);
                    if (valid) *(u32x4*)(xb + o) = pack8(v0, v1);
                    ss += (v0[0] * v0[0] + v0[1] * v0[1]) + (v0[2] * v0[2] + v0[3] * v0[3]) + (v1[0] * v1[0] + v1[1] * v1[1]) + (v1[2] * v1[2] + v1[3] * v1[3]);
                }
                ss = x16_sum(ss); ss = x32_sum(ss);
                if (valid && fq == 0) ssq[(size_t)tok * 16 + u.pn * 4 + wc] = ss;
            }
            __builtin_amdgcn_sched_barrier(0);
        }
    }
};

struct SchedGrid {
    int nM, nN, nwg, G, c; const char* Ab; const char* Bb; size_t astride, bstride, bbatch; int ldc;
    __device__ __forceinline__ bool next(int i, Unit& u) const {
        const long L = (long)i * G + c; if (L >= nwg) return false;
        int wgid = (int)L; { const int q = nwg / 8, r = nwg % 8, xcd = wgid % 8, off = wgid / 8; wgid = (xcd < r ? xcd * (q + 1) : r * (q + 1) + (xcd - r) * q) + off; }
        const int nig = 8 * nN, gid = wgid / nig, fm = gid * 8, gsz = (nM - fm) < 8 ? (nM - fm) : 8;
        u.pm = fm + ((wgid % nig) % gsz); u.pn = (wgid % nig) / gsz;
        u.a0 = u.pm * 256 * ldc + u.pn * 256; u.a1 = u.pm * 256; u.a2 = i; u.a3 = 0; u.ord = i; return true;
    }
    __device__ __forceinline__ const char* A(const Unit& u) const { return Ab + (size_t)u.pm * astride; }
    __device__ __forceinline__ const char* B(const Unit& u) const { return Bb + (size_t)u.pn * bstride + (u.pm >= 32 ? bbatch : 0); }
    __device__ __forceinline__ const char* B2(const Unit& u) const { return B(u); }
    __device__ __forceinline__ unsigned arow(const Unit&, int) const { return 0u; }
    __device__ __forceinline__ bool chain(const Unit&) const { return false; }
};
struct SchedKV {
    int G, c; const char* memn; const char* wkvt;
    __device__ __forceinline__ bool next(int i, Unit& u) const {
        const int L = i * G + c; if (L >= 64) return false;
        const int l = L >> 4; u.pm = (L >> 3) & 1; u.pn = L & 7; u.a2 = l; u.a3 = 0;
        u.a0 = l * 512 * 2048 + u.pm * 256 * 2048 + u.pn * 256; u.a1 = 0; u.ord = i; return true;
    }
    __device__ __forceinline__ const char* A(const Unit& u) const { return memn + (size_t)u.pm * 256 * 2048; }
    __device__ __forceinline__ const char* B(const Unit& u) const { return wkvt + ((size_t)u.a2 * 2048 + (size_t)u.pn * 256) * 2048; }
    __device__ __forceinline__ const char* B2(const Unit& u) const { return B(u); }
    __device__ __forceinline__ unsigned arow(const Unit&, int) const { return 0u; }
    __device__ __forceinline__ bool chain(const Unit&) const { return false; }
};
struct SchedQK {
    int G, c; const char* kv; const char* wqs;
    __device__ __forceinline__ bool next(int i, Unit& u) const {
        const int L = i * G + c; if (L >= 128) return false;
        const int l = L >> 5, b = (L >> 4) & 1, h = (L >> 2) & 3; u.pn = L & 3; u.pm = 0; u.a1 = l; u.a2 = b; u.a3 = h;
        u.a0 = ((l * 2 + b) * 1024 + h * 256) * 1024 + u.pn * 256; u.ord = i; return true;
    }
    __device__ __forceinline__ const char* A(const Unit& u) const { return kv + (((size_t)u.a1 * 512 + u.a2 * 256) * 2048 + u.a3 * 256) * 2; }
    __device__ __forceinline__ const char* B(const Unit& u) const { return wqs + (((size_t)u.a1 * 1024 + u.pn * 256) * 1024 + u.a3 * 256) * 2; }
    __device__ __forceinline__ const char* B2(const Unit& u) const { return B(u); }
    __device__ __forceinline__ unsigned arow(const Unit&, int) const { return 0u; }
    __device__ __forceinline__ bool chain(const Unit&) const { return false; }
};
struct SchedVO {
    int G, c; const char* kv; const char* wot;
    __device__ __forceinline__ bool next(int i, Unit& u) const {
        const int L = i * G + c; if (L >= 128) return false;
        const int l = L >> 5, b = (L >> 4) & 1, h = (L >> 2) & 3; u.pm = L & 3; u.pn = 0; u.a1 = l; u.a2 = b; u.a3 = h;
        u.a0 = ((l * 2 + b) * 1024 + u.pm * 256) * 1024 + h * 256; u.ord = i; return true;
    }
    __device__ __forceinline__ const char* A(const Unit& u) const { return wot + (((size_t)u.a1 * 1024 + u.pm * 256) * 1024 + u.a3 * 256) * 2; }
    __device__ __forceinline__ const char* B(const Unit& u) const { return kv + (((size_t)u.a1 * 512 + u.a2 * 256) * 2048 + 1024 + u.a3 * 256) * 2; }
    __device__ __forceinline__ const char* B2(const Unit& u) const { return B(u); }
    __device__ __forceinline__ unsigned arow(const Unit&, int) const { return 0u; }
    __device__ __forceinline__ bool chain(const Unit&) const { return false; }
};
struct SchedMoe {
    int base, stride, cnt; bool down; const volatile LAS int* tab; const int* tokc; const char* Ab; const char* Wb;
    int rot = 0;
    __device__ __forceinline__ bool next(int i, Unit& u) const {
        const int half = down ? (i & 1) : 0, ii = down ? (i >> 1) : i;
        if (ii >= cnt) return false;
        const int L0 = base + ii * stride;
        const int L1 = (rot > 0 && L0 < 256) ? ((L0 + rot) & 255) : L0;
        const int L = (rot >= 0 && L1 < 256 && tab[24] >= 64) ? ((L1 & 7) * 32 + (L1 >> 3)) : L1;
        const int q = L >> 2, sub = L & 3;
        int cc = 0;
        for (int k = 0; k < 24; ++k) if (q >= tab[k + 1]) cc = k + 1;
        const int j = q - tab[cc], n = tab[32 + cc];
        const int g = cc / 6, pi = cc % 6;
        const int e1 = pi < 3 ? 0 : (pi < 5 ? 1 : 2), e2 = pi < 3 ? pi + 1 : (pi < 5 ? pi - 1 : 3);
        u.a0 = q * 256; u.a1 = cc * 16384 + j * 256; u.a2 = (n - j * 256) < 256 ? (n - j * 256) : 256;
        if (!down) { const int s = sub >> 1; u.a3 = s; u.pn = sub & 1; u.pm = g * 4 + (s ? e2 : e1); }
        else { u.a3 = half; u.pn = sub; u.pm = g * 4 + (half ? e2 : e1); }
        u.pm = __builtin_amdgcn_readfirstlane(u.pm); u.pn = __builtin_amdgcn_readfirstlane(u.pn); u.a0 = __builtin_amdgcn_readfirstlane(u.a0);
        u.a1 = __builtin_amdgcn_readfirstlane(u.a1); u.a2 = __builtin_amdgcn_readfirstlane(u.a2); u.a3 = __builtin_amdgcn_readfirstlane(u.a3); u.ord = ii;
        return true;
    }
    __device__ __forceinline__ const char* A(const Unit& u) const { return down ? Ab + (size_t)u.a0 * 1024 + (size_t)u.a3 * 512 : Ab; }
    __device__ __forceinline__ const char* B(const Unit& u) const {
        return down ? Wb + (((size_t)u.pm * 1024 + u.pn * 256) * 256) * 2 : Wb + (((size_t)u.pm * 512 + u.pn * 256) * 1024) * 2; }
    __device__ __forceinline__ const char* B2(const Unit& u) const { return B(u); }
    __device__ __forceinline__ unsigned arow(const Unit& u, int r) const { const int tok = (r < u.a2) ? tokc[u.a1 + r] : 0; return (unsigned)tok * 2048u; }
    __device__ __forceinline__ bool chain(const Unit& u) const { return down && u.a3 == 0; }
};

struct Params { const float* in[27]; float* out; unsigned char* ws; int ph_lo, ph_hi; };
#define PIN(k) (p.in[(k)])
__device__ __forceinline__ const GAS float* ping_(const Params& p, int i) { asm volatile("" : "+s"(i)); return (const GAS float*)p.in[i]; }
#define PING(k) ping_(p, (k))

__device__ __forceinline__ void tr_item(const float* src, int ld, int c0, int K, int k0, const float* gain, float scale, bf16_t* dst, LAS float* scr, int lane) {
    float tv[32];
#pragma unroll
    for (int i = 0; i < 32; ++i) tv[i] = src[(size_t)(k0 + 2 * i + (lane >> 5)) * ld + c0 + (lane & 31)];
#pragma unroll
    for (int i = 0; i < 32; ++i) { const int kk = 2 * i + (lane >> 5); const float gsc = gain ? gain[k0 + kk] * scale : scale; scr[kk * 33 + (lane & 31)] = tv[i] * gsc; }
    LDS_WAIT(); asm volatile("" ::: "memory");
    const int c = lane & 7;
#pragma unroll
    for (int j = 0; j < 4; ++j) { const int n = (lane >> 3) + 8 * j; const LAS float* s = scr + (8 * c) * 33 + n;
        u32x4 o; o.x = cvt_pk_bf16(s[0 * 33], s[1 * 33]); o.y = cvt_pk_bf16(s[2 * 33], s[3 * 33]); o.z = cvt_pk_bf16(s[4 * 33], s[5 * 33]); o.w = cvt_pk_bf16(s[6 * 33], s[7 * 33]);
        *(u32x4*)(dst + (size_t)n * K + k0 + 8 * c) = o; }
    LDS_WAIT(); asm volatile("" ::: "memory");
}

__device__ __forceinline__ void conv_item(const Params& p, int l, int r, LAS float* scr, int lane) {
    unsigned char* ws = p.ws;
    if (r < 1536) {
        const int kb = r / 96, nb = r % 96, n0 = nb * 32, c0 = n0 < 1536 ? n0 : n0 + 8;
        tr_item(PIN(3) + (size_t)l * 1024 * 3080, 3080, c0, 1024, kb * 64, PIN(2) + l * 1024, n0 < 512 ? C2 : 1.f, (bf16_t*)(ws + WS_WIN) + ((size_t)l * 3072 + n0) * 1024, scr, lane); return; }
    r -= 1536;
    if (r < 512) {
        const int kb = r / 32, nb = r % 32, k0 = kb * 64;
        const float* gain = k0 < 512 ? PIN(5) + l * 512 : (k0 < 768 ? PIN(7) + l * 256 - 512 : nullptr);
        tr_item(PIN(12) + (size_t)l * 1024 * 1024, 1024, nb * 32, 1024, k0, gain, 1.f, (bf16_t*)(ws + WS_WOUT) + ((size_t)l * 1024 + nb * 32) * 1024, scr, lane); return; }
    r -= 512;
    if (r < 1024) {
        const int kb = r / 64, nb = r % 64;
        tr_item(PIN(16) + (size_t)l * 1024 * 2048, 2048, nb * 32, 1024, kb * 64, nullptr, 1.f, (bf16_t*)(ws + WS_WKVT) + ((size_t)l * 2048 + nb * 32) * 1024, scr, lane); return; }
    r -= 1024;
    if (r < 512) {
        const int kb = r / 32, nb = r % 32;
        tr_item(PIN(17) + (size_t)l * 1024 * 1024, 1024, nb * 32, 1024, kb * 64, nullptr, 1.f, (bf16_t*)(ws + WS_WOT) + ((size_t)l * 1024 + nb * 32) * 1024, scr, lane); return; }
    r -= 512;
    if (r < 4096) {
        const int e = r >> 8, rr = r & 255, kb = rr >> 4, nb = rr & 15;
        const int orow = nb * 32, t = orow >> 8, half = (orow >> 7) & 1, j = orow & 127;
        const float* src = (half ? PIN(24) : PIN(23)) + ((size_t)l * 16 + e) * 1024 * 256;
        tr_item(src, 256, t * 128 + j, 1024, kb * 64, PIN(18) + l * 1024, 1.f, (bf16_t*)(ws + WS_WGU) + (((size_t)l * 16 + e) * 512 + orow) * 1024, scr, lane); return; }
    r -= 4096;
    {
        const int e = r >> 7, rr = r & 127, kb = rr >> 5, nb = rr & 31;
        tr_item(PIN(25) + ((size_t)l * 16 + e) * 256 * 1024, 1024, nb * 32, 256, kb * 64, nullptr, 1.f, (bf16_t*)(ws + WS_WD) + (((size_t)l * 16 + e) * 1024 + nb * 32) * 256, scr, lane); }
}
__device__ __forceinline__ int conv_deferred_r(int d) { return d < 2048 ? d : d + 1536; }

__device__ __forceinline__ void phase_pro_a(const Params& p, LAS unsigned char* lds, int bid, int G) {
    int tid = threadIdx.x; asm volatile("" : "+v"(tid));
    const int lane = tid & 63, wave = tid >> 6;
    unsigned char* ws = p.ws;
    LAS float* scr = (LAS float*)(lds + wave * 16384);
    const int gw = bid * NWAVES + wave, NGW = G * NWAVES;
    constexpr int N_EARLY = 2048 + 4 * 1536;
    for (int it = gw; it < N_EARLY; it += NGW) {
        if (it < 2048) conv_item(p, 0, it, scr, lane);
        else { const int q = it - 2048; conv_item(p, q / 1536, 2048 + q % 1536, scr, lane); }
    }
    { const int idx = bid * NTHR + tid;
      if (idx < NLAYER * 256) { const int ll = idx >> 8, k = idx & 255; float e[4], mx = -INFINITY, den = 0.f, num = 0.f;
#pragma unroll
        for (int i = 0; i < 4; ++i) { e[i] = PING(6)[i * 256 + k]; mx = fmaxf(mx, e[i]); }
#pragma unroll
        for (int i = 0; i < 4; ++i) { e[i] = __expf(e[i] - mx); den += e[i]; if (i >= 1 && i <= ll) num += e[i]; }
        ((float*)(ws + WS_LB))[idx] = num / den; } }
    { constexpr unsigned NV = (unsigned)NLAYER * 1024u * 256u; const unsigned stp = (unsigned)G * NTHR;
      for (unsigned i4 = (unsigned)bid * NTHR + (unsigned)tid; i4 < NV; i4 += stp * 4u) {
        f32x4 v[4]; float gsc[4];
#pragma unroll
        for (int q = 0; q < 4; ++q) { const unsigned i = i4 + (unsigned)q * stp; if (i < NV) { const size_t e = (size_t)i * 4; v[q] = *(const f32x4*)(PIN(15) + e); gsc[q] = PIN(13)[(int)(e >> 20) * 1024 + (int)((e >> 10) & 1023)]; } }
#pragma unroll
        for (int q = 0; q < 4; ++q) { const unsigned i = i4 + (unsigned)q * stp; if (i < NV) { const size_t e = (size_t)i * 4;
            u32x2 o; o.x = cvt_pk_bf16(v[q].x * gsc[q], v[q].y * gsc[q]); o.y = cvt_pk_bf16(v[q].z * gsc[q], v[q].w * gsc[q]); *(u32x2*)((bf16_t*)(ws + WS_WQS) + e) = o; } }
      } }
    for (int i = bid * NTHR + tid; i < NLAYER * 28 * 1024; i += G * NTHR) {
        const int l = i / (28 * 1024), r = i % (28 * 1024), j = r >> 10, k = r & 1023;
        if (j < 8) { const float wv = PIN(2)[l * 1024 + k] * PIN(3)[((size_t)l * 1024 + k) * 3080 + 1536 + j];
            ((bf16_t*)(ws + WS_WFFB))[(l * 16 + j) * 1024 + k] = f2bf1(wv); ((bf16_t*)(ws + WS_WFFB))[(l * 16 + 8 + j) * 1024 + k] = 0; }
        else { const int jj = j - 8; const float w = jj < 4 ? PIN(19)[(l * 1024 + k) * 4 + jj] : PIN(21)[(l * 1024 + k) * 16 + jj - 4];
            const float wv = PIN(18)[l * 1024 + k] * w; const unsigned short hb = f2bf1(wv);
            ((bf16_t*)(ws + WS_WRH))[(l * 32 + jj) * 1024 + k] = hb; ((bf16_t*)(ws + WS_WRL))[(l * 32 + jj) * 1024 + k] = f2bf1(wv - bf2f(hb));
            if (jj < 12) { ((bf16_t*)(ws + WS_WRH))[(l * 32 + 20 + jj) * 1024 + k] = 0; ((bf16_t*)(ws + WS_WRL))[(l * 32 + 20 + jj) * 1024 + k] = 0; } }
    }
    for (int row = gw; row < 512; row += NGW) {
        const f32x4* xr = (const f32x4*)(PIN(1) + (size_t)row * 1024) + lane; f32x4 v[4]; float s = 0.f;
#pragma unroll
        for (int j = 0; j < 4; ++j) { v[j] = xr[64 * j]; s += (v[j].x * v[j].x + v[j].y * v[j].y) + (v[j].z * v[j].z + v[j].w * v[j].w); }
        const float rstd = rsqrtf(wave_sum(s) * (1.f / 1024.f) + EPS);
#pragma unroll
        for (int j = 0; j < 4; ++j) { const f32x4 gg = ((const f32x4*)PIN(14))[64 * j + lane]; u32x2 o; o.x = cvt_pk_bf16(v[j].x * rstd * gg.x, v[j].y * rstd * gg.y); o.y = cvt_pk_bf16(v[j].z * rstd * gg.z, v[j].w * rstd * gg.w);
            ((u32x2*)((bf16_t*)(ws + WS_MEMN) + (size_t)row * 1024))[64 * j + lane] = o; }
    }
    for (int row0 = gw; row0 < NTOK; row0 += 4 * NGW) {
        f32x4 v[4][4];
#pragma unroll
        for (int q = 0; q < 4; ++q) { const int row = row0 + q * NGW; if (row < NTOK) { const f32x4* xr = (const f32x4*)(PIN(0) + (size_t)row * 1024) + lane;
#pragma unroll
            for (int j = 0; j < 4; ++j) v[q][j] = xr[64 * j]; } }
#pragma unroll
        for (int q = 0; q < 4; ++q) { const int row = row0 + q * NGW; if (row < NTOK) { float s = 0.f;
#pragma unroll
            for (int j = 0; j < 4; ++j) { const f32x4 w = v[q][j]; s += (w.x * w.x + w.y * w.y) + (w.z * w.z + w.w * w.w); u32x2 o; o.x = cvt_pk_bf16(w.x, w.y); o.y = cvt_pk_bf16(w.z, w.w);
                ((u32x2*)((bf16_t*)(ws + WS_XB) + (size_t)row * 1024))[64 * j + lane] = o; }
            s = wave_sum(s);
            if (lane < 16) ((float*)(ws + WS_SSQ))[(size_t)row * 16 + lane] = lane == 0 ? s : 0.f; } }
    }
}

__device__ __forceinline__ void phase_logf(const Params& p, LAS unsigned char* lds, int l, int bid, int G) {
    int tid = threadIdx.x; asm volatile("" : "+v"(tid));
    const int lane = tid & 63, wave = tid >> 6, sg = wave & 3, kh = wave >> 2;
    unsigned char* ws = p.ws;
    LAS f32x4* part = (LAS f32x4*)lds;
    const bf16_t* wb = (const bf16_t*)(ws + WS_WFFB) + (size_t)l * 16 * 1024 + (lane & 15) * 1024 + kh * 512 + (lane >> 4) * 8;
    for (int g0 = bid * 4; g0 < NTOK / 16; g0 += G * 4) {
        const int g16 = g0 + sg;
        const bf16_t* xa = (const bf16_t*)(ws + WS_XB) + (size_t)(g16 * 16 + (lane & 15)) * 1024 + kh * 512 + (lane >> 4) * 8;
        f32x4 acc = {0.f, 0.f, 0.f, 0.f};
#pragma unroll
        for (int ks = 0; ks < 16; ++ks) { const bf16x8 a = *(const bf16x8*)(xa + ks * 32), w = *(const bf16x8*)(wb + ks * 32); acc = __builtin_amdgcn_mfma_f32_16x16x32_bf16(a, w, acc, 0, 0, 0); }
        if (kh == 1) part[sg * 64 + lane] = acc;
        LDS_BARRIER();
        if (kh == 0) {
            acc += part[sg * 64 + lane];
            if ((lane & 15) < 8) { const float bias = PING(4)[l * 8 + (lane & 15)];
#pragma unroll
                for (int t = 0; t < 4; ++t) { const int row = g16 * 16 + (lane >> 4) * 4 + t; const float z = acc[t] * row_rstd((const float*)(ws + WS_SSQ), row) + bias;
                    ((float*)(ws + WS_LOGF))[(size_t)row * 8 + (lane & 15)] = fminf(z, 0.f) - __logf(1.f + __expf(-fabsf(z))); } }
        }
        LDS_BARRIER();
    }
}

constexpr int HP = 72;
template <bool FINAL>
__device__ __forceinline__ void hgrn_unit(const Params& p, LAS unsigned char* lds, int l, int unit) {
    int tid = threadIdx.x; asm volatile("" : "+v"(tid));
    const int lane = tid & 63, wave = __builtin_amdgcn_readfirstlane(tid >> 6), l15 = lane & 15, rq = lane >> 4;
    unsigned char* ws = p.ws;
    const int bh = unit >> 5, sc = unit & 31, b = bh >> 2, h = bh & 3;
    const bf16_t* y = (const bf16_t*)(ws + WS_R1);
    LAS bf16_t* QM = (LAS bf16_t*)lds; LAS bf16_t* KM = QM + 64 * HP; LAS bf16_t* QA = KM + 64 * HP; LAS bf16_t* KLT = QA + 64 * HP; LAS bf16_t* VT = KLT + 64 * HP; LAS bf16_t* ST = VT + 64 * HP;
    LAS float* DEC = (LAS float*)(ST + 4 * 64 * HP); LAS float* HG = DEC + 256; LAS float* lbv = HG + 4096; LAS float* SSX = lbv + 64;
    if (tid < 64) lbv[tid] = ((const float*)(ws + WS_LB))[l * 256 + h * 64 + tid];
    const int kt = wave >> 1, vt0 = 2 * (wave & 1);
    f32x4 S[2] = {{0.f, 0.f, 0.f, 0.f}, {0.f, 0.f, 0.f, 0.f}};
    if (FINAL) {
        const float* U = (const float*)(ws + WS_HU); const float* Dd = (const float*)(ws + WS_HD);
        int jj = 0;
        for (; jj + 4 <= sc; jj += 4) {
            float uu_[4][8], dd_[4][4];
#pragma unroll
            for (int q4 = 0; q4 < 4; ++q4) { const int uu = bh * 32 + jj + q4;
#pragma unroll
                for (int e = 0; e < 4; ++e) { dd_[q4][e] = Dd[uu * 64 + kt * 16 + rq * 4 + e];
                    uu_[q4][e] = U[(size_t)uu * 4096 + (kt * 16 + rq * 4 + e) * 64 + vt0 * 16 + l15]; uu_[q4][4 + e] = U[(size_t)uu * 4096 + (kt * 16 + rq * 4 + e) * 64 + vt0 * 16 + 16 + l15]; } }
#pragma unroll
            for (int q4 = 0; q4 < 4; ++q4)
#pragma unroll
                for (int e = 0; e < 4; ++e) { S[0][e] = dd_[q4][e] * S[0][e] + uu_[q4][e]; S[1][e] = dd_[q4][e] * S[1][e] + uu_[q4][4 + e]; }
        }
        for (; jj < sc; ++jj) { const int uu = bh * 32 + jj;
#pragma unroll
            for (int e = 0; e < 4; ++e) { const float d = Dd[uu * 64 + kt * 16 + rq * 4 + e];
                S[0][e] = d * S[0][e] + U[(size_t)uu * 4096 + (kt * 16 + rq * 4 + e) * 64 + vt0 * 16 + l15]; S[1][e] = d * S[1][e] + U[(size_t)uu * 4096 + (kt * 16 + rq * 4 + e) * 64 + vt0 * 16 + 16 + l15]; } }
    }
    float dtot = 1.f;
    const size_t row0 = (size_t)b * SEQ + sc * 256;
    const int cc_a = wave & 3, role = wave >> 2;
    unsigned short hf_[16], hq_[16]; u32x4 vraw, graw;
#define HG_LOAD(g_) do { _Pragma("unroll") for (int i = 0; i < 16; ++i) { const bf16_t* yr = y + (row0 + (g_) * 64 + cc_a * 16 + i) * NY; hf_[i] = yr[1792 + h * 64 + lane]; hq_[i] = FINAL ? yr[1536 + h * 64 + lane] : (unsigned short)0; } \
        { const bf16_t* yr = y + (row0 + (g_) * 64 + lane) * NY; vraw = *(const u32x4*)(yr + 2048 + h * 64 + wave * 8); if (FINAL) graw = *(const u32x4*)(yr + 2304 + h * 64 + wave * 8); } } while (0)
    HG_LOAD(0);
    LDS_BARRIER();
    for (int g = 0; g < 4; ++g) {
        {
            const float lb = lbv[lane];
            float bcum[16], k1[16]; float run = 0.f;
#pragma unroll
            for (int i = 0; i < 16; ++i) { const float f = lb + (1.f - lb) * sigmoidf_(bf2f(hf_[i])); k1[i] = 1.f - f; run += __builtin_amdgcn_logf(f); bcum[i] = run; }
            if (role == 0) {
                if (FINAL) { const float bm = bcum[8];
#pragma unroll
                    for (int i = 0; i < 16; ++i) { QM[(cc_a * 16 + i) * HP + lane] = f2bf1(bf2f(hq_[i]) * __builtin_amdgcn_exp2f(bcum[i] - bm)); KM[(cc_a * 16 + i) * HP + lane] = f2bf1(k1[i] * __builtin_amdgcn_exp2f(bm - bcum[i])); } }
            } else {
                const float bl = bcum[15];
                u32x4 w0, w1;
#pragma unroll
                for (int i = 0; i < 4; ++i) { w0[i] = cvt_pk_bf16(k1[2 * i] * __builtin_amdgcn_exp2f(bl - bcum[2 * i]), k1[2 * i + 1] * __builtin_amdgcn_exp2f(bl - bcum[2 * i + 1])); w1[i] = cvt_pk_bf16(k1[8 + 2 * i] * __builtin_amdgcn_exp2f(bl - bcum[8 + 2 * i]), k1[8 + 2 * i + 1] * __builtin_amdgcn_exp2f(bl - bcum[8 + 2 * i + 1])); }
                *(LAS u32x4*)(KLT + lane * HP + cc_a * 16) = w0; *(LAS u32x4*)(KLT + lane * HP + cc_a * 16 + 8) = w1;
                DEC[cc_a * 64 + lane] = __builtin_amdgcn_exp2f(bl);
                if (FINAL) {
#pragma unroll
                    for (int i = 0; i < 16; ++i) QA[(cc_a * 16 + i) * HP + lane] = f2bf1(bf2f(hq_[i]) * __builtin_amdgcn_exp2f(bcum[i]));
                }
            }
#pragma unroll
            for (int i = 0; i < 4; ++i) { VT[(wave * 8 + 2 * i) * HP + lane] = (bf16_t)(vraw[i] & 0xffffu); VT[(wave * 8 + 2 * i + 1) * HP + lane] = (bf16_t)(vraw[i] >> 16); }
            if (FINAL) { f32x4 g0, g1;
#pragma unroll
                for (int i = 0; i < 2; ++i) { g0[2 * i] = bf2f(graw[i] & 0xffffu); g0[2 * i + 1] = bf2f(graw[i] >> 16); g1[2 * i] = bf2f(graw[2 + i] & 0xffffu); g1[2 * i + 1] = bf2f(graw[2 + i] >> 16); }
                *(LAS f32x4*)(HG + lane * 64 + wave * 8) = g0; *(LAS f32x4*)(HG + lane * 64 + wave * 8 + 4) = g1; }
        }
        LDS_BARRIER();
        if (g < 3) HG_LOAD(g + 1);
        if (!FINAL && tid < 64) dtot *= (DEC[tid] * DEC[64 + tid]) * (DEC[128 + tid] * DEC[192 + tid]);
#pragma unroll
        for (int cc = 0; cc < 4; ++cc) {
            if (FINAL) {
#pragma unroll
                for (int j = 0; j < 2; ++j) { u32x2 w; w.x = cvt_pk_bf16(S[j][0], S[j][1]); w.y = cvt_pk_bf16(S[j][2], S[j][3]);
                    *(LAS u32x2*)(ST + (cc * 64 + (vt0 + j) * 16 + l15) * HP + kt * 16 + rq * 4) = w; }
            }
            const u32x2 ka = *(const LAS u32x2*)(KLT + (kt * 16 + l15) * HP + cc * 16 + rq * 4);
            const f32x4 dc = *(const LAS f32x4*)(DEC + cc * 64 + kt * 16 + rq * 4);
            const u32x4 kaw = {ka.x, ka.y, 0u, 0u};
#pragma unroll
            for (int j = 0; j < 2; ++j) {
                const u32x2 vb = *(const LAS u32x2*)(VT + ((vt0 + j) * 16 + l15) * HP + cc * 16 + rq * 4);
                const u32x4 vbw = {vb.x, vb.y, 0u, 0u};
                S[j] = __builtin_amdgcn_mfma_f32_16x16x32_bf16(__builtin_bit_cast(bf16x8, kaw), __builtin_bit_cast(bf16x8, vbw), S[j] * dc, 0, 0, 0);
            }
        }
        if (FINAL) {
            LDS_BARRIER();
            const int cc = wave & 3, vh = wave >> 2;
            f32x4 at = {0.f, 0.f, 0.f, 0.f};
#pragma unroll
            for (int ks = 0; ks < 2; ++ks) {
                const bf16x8 kmf = *(const LAS bf16x8*)(KM + (cc * 16 + l15) * HP + ks * 32 + rq * 8), qmf = *(const LAS bf16x8*)(QM + (cc * 16 + l15) * HP + ks * 32 + rq * 8);
                at = __builtin_amdgcn_mfma_f32_16x16x32_bf16(kmf, qmf, at, 0, 0, 0);
            }
#pragma unroll
            for (int e = 0; e < 4; ++e) if (rq * 4 + e > l15) at[e] = 0.f;
            const u32x4 atw = {cvt_pk_bf16(at[0], at[1]), cvt_pk_bf16(at[2], at[3]), 0u, 0u};
            const bf16x8 atf = __builtin_bit_cast(bf16x8, atw);
            const bf16x8 qa0 = *(const LAS bf16x8*)(QA + (cc * 16 + l15) * HP + rq * 8), qa1 = *(const LAS bf16x8*)(QA + (cc * 16 + l15) * HP + 32 + rq * 8);
            f32x4 o[2]; float ssp = 0.f;
#pragma unroll
            for (int j = 0; j < 2; ++j) { const int vt = vh * 2 + j;
                const u32x2 vb = *(const LAS u32x2*)(VT + (vt * 16 + l15) * HP + cc * 16 + rq * 4);
                const u32x4 vbw = {vb.x, vb.y, 0u, 0u};
                const bf16x8 s0 = *(const LAS bf16x8*)(ST + (cc * 64 + vt * 16 + l15) * HP + rq * 8), s1 = *(const LAS bf16x8*)(ST + (cc * 64 + vt * 16 + l15) * HP + 32 + rq * 8);
                f32x4 a = {0.f, 0.f, 0.f, 0.f};
                a = __builtin_amdgcn_mfma_f32_16x16x32_bf16(__builtin_bit_cast(bf16x8, vbw), atf, a, 0, 0, 0);
                a = __builtin_amdgcn_mfma_f32_16x16x32_bf16(s0, qa0, a, 0, 0, 0);
                a = __builtin_amdgcn_mfma_f32_16x16x32_bf16(s1, qa1, a, 0, 0, 0);
                o[j] = a; ssp += (a[0] * a[0] + a[1] * a[1]) + (a[2] * a[2] + a[3] * a[3]); }
            ssp = x16_sum(ssp); ssp = x32_sum(ssp);
            if (rq == 0) SSX[(cc * 2 + vh) * 16 + l15] = ssp;
            LDS_BARRIER();
            const float rstd = rsqrtf((SSX[(cc * 2) * 16 + l15] + SSX[(cc * 2 + 1) * 16 + l15]) * (1.f / 64.f) + EPS);
            const size_t row = row0 + g * 64 + cc * 16 + l15;
#pragma unroll
            for (int j = 0; j < 2; ++j) { const int vt = vh * 2 + j;
                const f32x4 hg = *(const LAS f32x4*)(HG + (cc * 16 + l15) * 64 + vt * 16 + rq * 4);
                u32x2 w; w.x = cvt_pk_bf16(o[j][0] * rstd * hg[0] * sigmoidf_(hg[0]), o[j][1] * rstd * hg[1] * sigmoidf_(hg[1])); w.y = cvt_pk_bf16(o[j][2] * rstd * hg[2] * sigmoidf_(hg[2]), o[j][3] * rstd * hg[3] * sigmoidf_(hg[3]));
                *(u32x2*)((bf16_t*)(ws + WS_CAT) + row * DM + 512 + h * 64 + vt * 16 + rq * 4) = w; }
        }
        LDS_BARRIER();
    }
#undef HG_LOAD
    if (!FINAL) {
        float* U = (float*)(ws + WS_HU); float* Dd = (float*)(ws + WS_HD);
#pragma unroll
        for (int j = 0; j < 2; ++j)
#pragma unroll
            for (int e = 0; e < 4; ++e) U[(size_t)unit * 4096 + (kt * 16 + rq * 4 + e) * 64 + (vt0 + j) * 16 + l15] = S[j][e];
        if (tid < 64) Dd[unit * 64 + tid] = dtot;
    }
}

template <bool FINAL>
__device__ __forceinline__ void hgrn_unit_old(const Params& p, LAS unsigned char* lds, int l, int unit) {
    int tid = threadIdx.x; asm volatile("" : "+v"(tid));
    const int lane = tid & 63, kg = tid >> 6;
    unsigned char* ws = p.ws;
    const int bh = unit >> 5, sc = unit & 31, b = bh >> 2, h = bh & 3;
    const bf16_t* y = (const bf16_t*)(ws + WS_R1);
    LAS float* F = (LAS float*)lds; LAS float* K1 = F + 4096; LAS float* Q = F + 8192; LAS float* V = F + 12288; LAS float* OP = F + 16384; LAS float* lbv = F + 16384 + 8192; LAS float* dpl = lbv + 64; LAS float* HG = dpl + 512;
    if (tid < 64) {
        const int k = h * 64 + tid; float e[4], mx = -INFINITY, den = 0.f, num = 0.f;
#pragma unroll
        for (int i = 0; i < 4; ++i) { e[i] = PING(6)[i * 256 + k]; mx = fmaxf(mx, e[i]); }
#pragma unroll
        for (int i = 0; i < 4; ++i) { e[i] = __expf(e[i] - mx); den += e[i]; if (i >= 1 && i <= l) num += e[i]; }
        lbv[tid] = num / den;
    }
    f32x2 s2[4];
#pragma unroll
    for (int j = 0; j < 4; ++j) s2[j] = (f32x2){0.f, 0.f};
    float dprod = 1.f;
    if (FINAL) {
        const float* U = (const float*)(ws + WS_HU); const float* Dd = (const float*)(ws + WS_HD);
        float s[8];
#pragma unroll
        for (int j = 0; j < 8; ++j) s[j] = 0.f;
        int jj = 0;
        for (; jj + 8 <= sc; jj += 8) {
            float uu_[8][8], dd_[8][8];
#pragma unroll
            for (int q4 = 0; q4 < 8; ++q4) { const int uu = bh * 32 + jj + q4;
#pragma unroll
                for (int j = 0; j < 8; ++j) { dd_[q4][j] = Dd[uu * 64 + kg * 8 + j]; uu_[q4][j] = U[(size_t)uu * 4096 + (kg * 8 + j) * 64 + lane]; } }
#pragma unroll
            for (int q4 = 0; q4 < 8; ++q4)
#pragma unroll
                for (int j = 0; j < 8; ++j) s[j] = dd_[q4][j] * s[j] + uu_[q4][j];
        }
        for (; jj < sc; ++jj) { const int uu = bh * 32 + jj;
#pragma unroll
            for (int j = 0; j < 8; ++j) s[j] = Dd[uu * 64 + kg * 8 + j] * s[j] + U[(size_t)uu * 4096 + (kg * 8 + j) * 64 + lane]; }
#pragma unroll
        for (int j = 0; j < 4; ++j) s2[j] = (f32x2){s[2 * j], s[2 * j + 1]};
    }
    LDS_BARRIER();
    const size_t row0 = (size_t)b * SEQ + sc * 256;
    unsigned short hf_[8], hq_[8], hv_[8], hg_[8];
#define HG_LOAD(ch_) do { _Pragma("unroll") for (int j = 0; j < 8; ++j) { const int tt = kg + 8 * j; const bf16_t* yr = y + (row0 + (ch_) * 64 + tt) * NY; hf_[j] = yr[1792 + h * 64 + lane]; hv_[j] = yr[2048 + h * 64 + lane]; \
        hq_[j] = FINAL ? yr[1536 + h * 64 + lane] : (unsigned short)0; hg_[j] = FINAL ? yr[2304 + h * 64 + lane] : (unsigned short)0; } } while (0)
    HG_LOAD(0);
    for (int ch = 0; ch < 4; ++ch) {
        { const float lb = lbv[lane];
#pragma unroll
          for (int j = 0; j < 8; ++j) { const int idx = (kg + 8 * j) * 64 + lane; const float f = lb + (1.f - lb) * sigmoidf_(bf2f(hf_[j]));
              F[idx] = f; K1[idx] = 1.f - f; V[idx] = bf2f(hv_[j]); if (FINAL) { Q[idx] = bf2f(hq_[j]); HG[idx] = bf2f(hg_[j]); } else dprod *= f; } }
        LDS_BARRIER();
        if (ch < 3) HG_LOAD(ch + 1);
        for (int sub = 0; sub < 4; ++sub) {
#pragma unroll 4
            for (int t16 = 0; t16 < 16; ++t16) {
                const int tt = sub * 16 + t16;
                const f32x4 fa = *(const LAS f32x4*)(F + tt * 64 + kg * 8), fb = *(const LAS f32x4*)(F + tt * 64 + kg * 8 + 4);
                const f32x4 ka = *(const LAS f32x4*)(K1 + tt * 64 + kg * 8), kb2 = *(const LAS f32x4*)(K1 + tt * 64 + kg * 8 + 4);
                const float vt = V[tt * 64 + lane];
                const f32x2 vt2 = {vt, vt};
                const f32x2 f2[4] = {{fa.x, fa.y}, {fa.z, fa.w}, {fb.x, fb.y}, {fb.z, fb.w}};
                const f32x2 k2[4] = {{ka.x, ka.y}, {ka.z, ka.w}, {kb2.x, kb2.y}, {kb2.z, kb2.w}};
#pragma unroll
                for (int j = 0; j < 4; ++j) s2[j] = f2[j] * s2[j] + k2[j] * vt2;
                if (FINAL) {
                    const f32x4 qa = *(const LAS f32x4*)(Q + tt * 64 + kg * 8), qb2 = *(const LAS f32x4*)(Q + tt * 64 + kg * 8 + 4);
                    const f32x2 q2[4] = {{qa.x, qa.y}, {qa.z, qa.w}, {qb2.x, qb2.y}, {qb2.z, qb2.w}};
                    f32x2 o2 = q2[0] * s2[0];
#pragma unroll
                    for (int j = 1; j < 4; ++j) o2 = q2[j] * s2[j] + o2;
                    OP[(t16 * 8 + kg) * 64 + lane] = o2.x + o2.y;
                }
            }
            if (FINAL) {
                LDS_BARRIER();
#pragma unroll
                for (int w2 = 0; w2 < 2; ++w2) { const int t16 = kg * 2 + w2; float o = 0.f;
#pragma unroll
                    for (int g8 = 0; g8 < 8; ++g8) o += OP[(t16 * 8 + g8) * 64 + lane];
                    const float ss = wave_sum(o * o), rstd = rsqrtf(ss * (1.f / 64.f) + EPS);
                    const size_t row = row0 + ch * 64 + sub * 16 + t16;
                    const float hg = HG[(sub * 16 + t16) * 64 + lane];
                    ((bf16_t*)(ws + WS_CAT))[row * DM + 512 + h * 64 + lane] = f2bf1(o * rstd * hg * sigmoidf_(hg)); }
                LDS_BARRIER();
            }
        }
        LDS_BARRIER();
    }
#undef HG_LOAD
    if (!FINAL) {
        float* U = (float*)(ws + WS_HU); float* Dd = (float*)(ws + WS_HD);
#pragma unroll
        for (int j = 0; j < 4; ++j) { U[(size_t)unit * 4096 + (kg * 8 + 2 * j) * 64 + lane] = s2[j].x; U[(size_t)unit * 4096 + (kg * 8 + 2 * j + 1) * 64 + lane] = s2[j].y; }
        dpl[kg * 64 + lane] = dprod;
        LDS_BARRIER();
        if (tid < 64) { float d = 1.f;
#pragma unroll
            for (int w = 0; w < 8; ++w) d *= dpl[w * 64 + tid];
            Dd[unit * 64 + tid] = d; }
    }
    LDS_BARRIER();
}

__device__ __forceinline__ void conv_unit(const Params& p, LAS unsigned char* lds, int l, int unit) {
    int tid = threadIdx.x; asm volatile("" : "+v"(tid));
    unsigned char* ws = p.ws;
    const bf16_t* y = (const bf16_t*)(ws + WS_R1);
    LAS float* A = (LAS float*)lds; LAS float* Y = (LAS float*)(lds + 65536); LAS float* GB = (LAS float*)(lds + 65536 + 40960);
    const int row0 = unit * 32, b = row0 / SEQ, t0 = row0 % SEQ;
    QB_(33);
    float w[31];
    { u32x4 cu[4], cg[4];
#pragma unroll
        for (int q = 0; q < 4; ++q) { const int it = tid + NTHR * q, j = it >> 5, c8 = (it & 31) * 8, t = t0 - 30 + j;
            cu[q] = (u32x4){0u, 0u, 0u, 0u}; cg[q] = cu[q];
            if (it < 62 * 32 && t >= 0) { const bf16_t* yr = y + ((size_t)b * SEQ + t) * NY; cu[q] = *(const u32x4*)(yr + 2560 + c8); cg[q] = *(const u32x4*)(yr + 2816 + c8); } }
        { const int c = tid & 255;
#pragma unroll
          for (int j = 0; j < 31; ++j) w[j] = PING(8)[(l * 31 + j) * 256 + c]; }
        if (tid < 256) GB[tid] = PING(10)[l * 256 + tid]; else GB[tid] = PING(11)[l * 256 + tid - 256];
#pragma unroll
        for (int q = 0; q < 4; ++q) { const int it = tid + NTHR * q, j = it >> 5, c8 = (it & 31) * 8;
            if (it < 62 * 32) { f32x4 a0, a1;
#pragma unroll
                for (int e = 0; e < 4; ++e) { const float u0 = bf2f(cu[q][e] & 0xffffu), u1 = bf2f(cu[q][e] >> 16), g0 = bf2f(cg[q][e] & 0xffffu), g1 = bf2f(cg[q][e] >> 16);
                    const float r0 = u0 * sigmoidf_(g0), r1 = u1 * sigmoidf_(g1);
                    if (e < 2) { a0[2 * e] = r0; a0[2 * e + 1] = r1; } else { a1[2 * (e - 2)] = r0; a1[2 * (e - 2) + 1] = r1; } }
                *(LAS f32x4*)(A + j * 256 + c8) = a0; *(LAS f32x4*)(A + j * 256 + c8 + 4) = a1; } } }
    const float cbias = PING(9)[l * 256 + (tid & 255)];
    LDS_BARRIER();
    QE_(33); QB_(34);
    { const int c = tid & 255, th = tid >> 8;
        float av[46];
#pragma unroll
        for (int i = 0; i < 46; ++i) av[i] = A[(th * 16 + i) * 256 + c];
        float yv[16];
#pragma unroll
        for (int tl = 0; tl < 16; ++tl) { float a = cbias;
#pragma unroll
            for (int j = 0; j < 31; ++j) a += w[j] * av[tl + j];
            yv[tl] = a; }
#pragma unroll
        for (int tl = 0; tl < 16; ++tl) Y[((th * 16 + tl) * 16 + (c >> 4)) * 20 + (c & 15)] = yv[tl]; }
    LDS_BARRIER();
    QE_(34); QB_(35);
    { const int pr = tid >> 2, tl = pr >> 2, ch = (pr & 3) * 4 + (tid & 3);
        const LAS float* yp = Y + (tl * 16 + ch) * 20;
        f32x4 v[4]; float s = 0.f, ss = 0.f;
#pragma unroll
        for (int k = 0; k < 4; ++k) v[k] = *(const LAS f32x4*)(yp + 4 * k);
#pragma unroll
        for (int k = 0; k < 4; ++k) { s += (v[k][0] + v[k][1]) + (v[k][2] + v[k][3]); ss += (v[k][0] * v[k][0] + v[k][1] * v[k][1]) + (v[k][2] * v[k][2] + v[k][3] * v[k][3]); }
        s += dpp_f<0xB1>(s); s += dpp_f<0x4E>(s); ss += dpp_f<0xB1>(ss); ss += dpp_f<0x4E>(ss);
        const float mean = s * (1.f / 64.f), var = fmaxf(ss * (1.f / 64.f) - mean * mean, 0.f), rstd = rsqrtf(var + EPS);
        u32x4 o[2];
#pragma unroll
        for (int k = 0; k < 4; ++k) { const f32x4 gm = *(const LAS f32x4*)(GB + ch * 16 + 4 * k), bt = *(const LAS f32x4*)(GB + 256 + ch * 16 + 4 * k); float r[4];
#pragma unroll
            for (int e = 0; e < 4; ++e) { const float yn = (v[k][e] - mean) * rstd * gm[e] + bt[e]; r[e] = yn * sigmoidf_(yn); }
            o[k >> 1][(k & 1) * 2] = cvt_pk_bf16(r[0], r[1]); o[k >> 1][(k & 1) * 2 + 1] = cvt_pk_bf16(r[2], r[3]); }
        u32x4* dst = (u32x4*)((bf16_t*)(ws + WS_CAT) + (size_t)(row0 + tl) * DM + 768 + ch * 16);
        dst[0] = o[0]; dst[1] = o[1]; }
    LDS_BARRIER();
    QE_(35);
}

__device__ __forceinline__ void phase_p2a(const Params& p, LAS unsigned char* lds, int l, int bid, int G) {
    int tid = threadIdx.x; asm volatile("" : "+v"(tid));
    const int lane = tid & 63, wave = tid >> 6;
    unsigned char* ws = p.ws;
    const bool csx = (G == 256);
    for (int bh = csx ? (((bid & 31) == 31) ? (bid >> 5) * 2 : 16) : bid; bh < (csx ? (((bid & 31) == 31) ? (bid >> 5) * 2 + 2 : 0) : 16); bh += csx ? 1 : G) { const int b = bh >> 3, h = bh & 7;
        const float* lf = (const float*)(ws + WS_LOGF) + (size_t)b * SEQ * 8 + h;
        float v[16]; float run = 0.f;
#pragma unroll
        for (int i = 0; i < 16; ++i) { run += lf[(size_t)(tid * 16 + i) * 8]; v[i] = run; }
        float incl = run;
#pragma unroll
        for (int o = 1; o < 64; o <<= 1) { const float t = __int_as_float(__builtin_amdgcn_ds_bpermute(((lane - o) & 63) * 4, __float_as_int(incl))); if (lane >= o) incl += t; }
        LAS float* wt = (LAS float*)lds;
        if (lane == 63) wt[wave] = incl;
        LDS_BARRIER();
        float base = incl - run;
        for (int w = 0; w < wave; ++w) base += wt[w];
        float* c = (float*)(ws + WS_CFOX) + (size_t)bh * SEQ + tid * 16;
#pragma unroll
        for (int i = 0; i < 16; ++i) c[i] = base + v[i];
        LDS_BARRIER();
    }
    for (int sr = 0; sr < SUBR(3); ++sr) for (int u = bid; u < 256; u += G) if ((u & 31) != 31) hgrn_unit<false>(p, lds, l, u);
}

__device__ __forceinline__ void attn_unit_simple(const Params& p, int l, int unit) {
    int tid = threadIdx.x; asm volatile("" : "+v"(tid));
    const int lane = tid & 63, wave = tid >> 6;
    unsigned char* ws = p.ws;
    const int bh = unit >> 4, qb = unit & 15, b = bh >> 3, h = bh & 7;
    const bf16_t* y = (const bf16_t*)(ws + WS_R1);
    const float* cf = (const float*)(ws + WS_CFOX) + (size_t)bh * SEQ;
    const int t = qb * 512 + tid;
    const size_t rowb = (size_t)b * SEQ;
    float q[64], o[64];
    { const u32x4* qr = (const u32x4*)(y + (rowb + t) * NY + h * 64);
#pragma unroll
        for (int i = 0; i < 8; ++i) { const u32x4 a = qr[i];
#pragma unroll
            for (int j = 0; j < 4; ++j) { q[i * 8 + 2 * j] = bf2f(a[j] & 0xffffu); q[i * 8 + 2 * j + 1] = bf2f(a[j] >> 16); } } }
#pragma unroll
    for (int d = 0; d < 64; ++d) o[d] = 0.f;
    const float ct = cf[t] * LOG2E;
    float m = -INFINITY, lsum = 0.f;
    const int twmin = qb * 512 + wave * 64, smax = twmin + 63;
#if FOX_PRUNE
    const unsigned* ctl = (const unsigned*)(ws + WS_CTL);
    u32x4 kqm = *(const u32x4*)(ctl + CW_KQMAX + l * 512 + (b * 8 + h) * 4);
#pragma unroll
    for (int cp = 1; cp < 8; ++cp) { const u32x4 t = *(const u32x4*)(ctl + CW_KQMAX + l * 512 + cp * 64 + (b * 8 + h) * 4);
        kqm.x = kqm.x > t.x ? kqm.x : t.x; kqm.y = kqm.y > t.y ? kqm.y : t.y; kqm.z = kqm.z > t.z ? kqm.z : t.z; kqm.w = kqm.w > t.w ? kqm.w : t.w; }
    const float B2 = 1.01f * sqrtf((__uint_as_float(kqm.x) + __uint_as_float(kqm.y)) * (__uint_as_float(kqm.z) + __uint_as_float(kqm.w)));
    const float cmin = cf[twmin] * LOG2E;
#endif
    for (int s = smax; s >= 0; --s) {
        const float cs = cf[s] * LOG2E;
#if FOX_PRUNE
        if (cmin - cs + 2.f * B2 < -44.f) break;
#endif
        const u32x4* kr = (const u32x4*)(y + (rowb + s) * NY + 512 + h * 64);
        float dot = 0.f;
#pragma unroll
        for (int i = 0; i < 8; ++i) { const u32x4 a = kr[i];
#pragma unroll
            for (int j = 0; j < 4; ++j) dot += q[i * 8 + 2 * j] * bf2f(a[j] & 0xffffu) + q[i * 8 + 2 * j + 1] * bf2f(a[j] >> 16); }
        const float sc = dot + ct - cs;
        if (s <= t) {
            if (sc > m) { const float al = __builtin_amdgcn_exp2f(m - sc); lsum *= al;
#pragma unroll
                for (int d = 0; d < 64; ++d) o[d] *= al;
                m = sc; }
            const float pr = __builtin_amdgcn_exp2f(sc - m); lsum += pr;
            const u32x4* vr = (const u32x4*)(y + (rowb + s) * NY + 1024 + h * 64);
#pragma unroll
            for (int i = 0; i < 8; ++i) { const u32x4 a = vr[i];
#pragma unroll
                for (int j = 0; j < 4; ++j) { o[i * 8 + 2 * j] += pr * bf2f(a[j] & 0xffffu); o[i * 8 + 2 * j + 1] += pr * bf2f(a[j] >> 16); } }
        }
    }
    const float inv = 1.f / lsum; float ss = 0.f;
#pragma unroll
    for (int d = 0; d < 64; ++d) { o[d] *= inv; ss += o[d] * o[d]; }
    const float rstd = rsqrtf(ss * (1.f / 64.f) + EPS);
    u32x4* dst = (u32x4*)((bf16_t*)(ws + WS_CAT) + (rowb + t) * DM + h * 64);
#pragma unroll
    for (int i = 0; i < 8; ++i) { u32x4 w; w.x = cvt_pk_bf16(o[i * 8] * rstd, o[i * 8 + 1] * rstd); w.y = cvt_pk_bf16(o[i * 8 + 2] * rstd, o[i * 8 + 3] * rstd); w.z = cvt_pk_bf16(o[i * 8 + 4] * rstd, o[i * 8 + 5] * rstd); w.w = cvt_pk_bf16(o[i * 8 + 6] * rstd, o[i * 8 + 7] * rstd); dst[i] = w; }
}

typedef float f32x16 __attribute__((ext_vector_type(16)));
typedef short v4i16_t __attribute__((ext_vector_type(4)));
constexpr int AT_KP = 144, AT_VP = 192, AT_BUF = 21760;
__device__ __forceinline__ void attn_unit_mfma(const Params& p, LAS unsigned char* lds, int l, int unit) {
    int tid = threadIdx.x; asm volatile("" : "+v"(tid));
    const int lane = tid & 63, wave = __builtin_amdgcn_readfirstlane(tid >> 6), r32 = lane & 31, hi = lane >> 5;
    unsigned char* ws = p.ws;
    const int bh = unit >> 5, qb = unit & 31, b = bh >> 3, h = bh & 7, q0 = qb * 256, qw0 = q0 + wave * 32;
    const bf16_t* y = (const bf16_t*)(ws + WS_R1) + (size_t)b * SEQ * NY;
    const float* cf = (const float*)(ws + WS_CFOX) + (size_t)bh * SEQ;
    QB_(20);
    bf16x8 qr[4];
    { const bf16_t* qrow = y + (size_t)(qw0 + r32) * NY + h * 64;
#pragma unroll
      for (int d0 = 0; d0 < 4; ++d0) qr[d0] = *(const bf16x8*)(qrow + d0 * 16 + hi * 8); }
    float cq = cf[qw0 + r32] * LOG2E;
    const unsigned* ctl = (const unsigned*)(ws + WS_CTL);
    u32x4 kqm = *(const u32x4*)(ctl + CW_KQMAX + l * 512 + (b * 8 + h) * 4);
#pragma unroll
    for (int cp = 1; cp < 8; ++cp) { const u32x4 t = *(const u32x4*)(ctl + CW_KQMAX + l * 512 + cp * 64 + (b * 8 + h) * 4);
        kqm.x = kqm.x > t.x ? kqm.x : t.x; kqm.y = kqm.y > t.y ? kqm.y : t.y; kqm.z = kqm.z > t.z ? kqm.z : t.z; kqm.w = kqm.w > t.w ? kqm.w : t.w; }
    float qmax;
    { float qs = 0.f;
#pragma unroll
      for (int d0 = 0; d0 < 4; ++d0) { const u32x4 qw = __builtin_bit_cast(u32x4, qr[d0]);
#pragma unroll
          for (int e = 0; e < 4; ++e) { const float a = bf2f(qw[e] & 0xffffu), b2 = bf2f(qw[e] >> 16); qs += a * a + b2 * b2; } }
      qs = x32_sum(qs);
      float qm = qs; qm = fmaxf(qm, dpp_f<0xB1>(qm)); qm = fmaxf(qm, dpp_f<0x4E>(qm)); qm = fmaxf(qm, dpp_f<0x141>(qm)); qm = fmaxf(qm, dpp_f<0x140>(qm)); qm = x16_max(qm);
      LAS float* qms = (LAS float*)(lds + 2 * AT_BUF);
      if (lane == 0) qms[wave] = qm;
      LDS_BARRIER();
      qmax = fmaxf(fmaxf(fmaxf(qms[0], qms[1]), fmaxf(qms[2], qms[3])), fmaxf(fmaxf(qms[4], qms[5]), fmaxf(qms[6], qms[7]))); }
    float kmax;
    { const int jt = (q0 + 255) >> 6; const f32x2* kt = (const f32x2*)(ws + WS_KT) + ((size_t)l * 16 + b * 8 + h) * 128;
      const int t0 = jt - lane, t1 = jt - 64 - lane;
      const f32x2 k0 = kt[t0 >= 0 ? t0 : 0], k1 = kt[t1 >= 0 ? t1 : 0];
      float km = fmaxf(t0 >= 0 ? k0.x + k0.y : 0.f, t1 >= 0 ? k1.x + k1.y : 0.f);
      km = fmaxf(km, dpp_f<0xB1>(km)); km = fmaxf(km, dpp_f<0x4E>(km)); km = fmaxf(km, dpp_f<0x141>(km)); km = fmaxf(km, dpp_f<0x140>(km)); km = x16_max(km); kmax = x32_max(km); }
    const float B2 = 1.01f * sqrtf(qmax * kmax);
    const float thr = -44.f - 2.f * B2;
    cq -= fminf(B2, 40.f);
    const float cblk = cf[q0] * LOG2E, cwv = cf[qw0] * LOG2E;
    const int jmax = (q0 + 255) >> 6;
    u32x4 kreg, vreg, kreg2, vreg2; float creg = 0.f, creg2 = 0.f;
#define AT_LOAD(j, KR, VR, CR) do { const int kb_ = (j) * 64; \
        KR = *(const u32x4*)(y + (size_t)(kb_ + (tid >> 3)) * NY + 512 + h * 64 + (tid & 7) * 8); \
        VR = *(const u32x4*)(y + (size_t)(kb_ + (tid >> 3)) * NY + 1024 + h * 64 + (tid & 7) * 8); \
        if (tid < 64) CR = cf[kb_ + tid] * LOG2E; } while (0)
    AT_LOAD(jmax, kreg, vreg, creg);
    const int jhi = (qw0 + 31) >> 6;
    int jmin = 0, jlo = 0;
    { int base = jmax; bool gotw = false;
      for (;;) { const int t = base - lane; const float v = cf[t >= 0 ? 64 * t + 63 : 0] * LOG2E;
          if (!gotw) { const bool ndw = (t >= 0) && (t > jhi || (cwv - v) >= thr);
              const unsigned long long mw = __ballot(ndw); const int nw = (mw == ~0ull) ? 64 : (int)__builtin_ctzll(~mw);
              if (nw < 64 || base < 64) { jlo = base - nw + 1; gotw = true; } }
          const bool nd = (t >= 0) && ((cblk - v) >= thr);
          const unsigned long long mk = __ballot(nd); const int n = (mk == ~0ull) ? 64 : (int)__builtin_ctzll(~mk);
          if (n < 64 || base < 64) { jmin = base - n + 1; break; } base -= 64; }
      jmin = __builtin_amdgcn_readfirstlane(jmin); jlo = __builtin_amdgcn_readfirstlane(jlo); }
    kreg2 = kreg; vreg2 = vreg;
    if (jmax - 1 >= jmin) AT_LOAD(jmax - 1, kreg2, vreg2, creg2);
    float lsum = 0.f;
    f32x16 o0, o1;
#pragma unroll
    for (int r = 0; r < 16; ++r) { o0[r] = 0.f; o1[r] = 0.f; }
    QE_(20); QB_(21);
    for (int j = jmax; j >= jmin; --j) {
        LAS unsigned char* Kb = lds + (j & 1) * AT_BUF; LAS unsigned char* Vb = Kb + 9216; LAS float* cb = (LAS float*)(Kb + 9216 + 12288);
        *(LAS u32x4*)(Kb + (tid >> 3) * AT_KP + (tid & 7) * 16) = kreg;
        *(LAS u32x4*)(Vb + (tid >> 3) * AT_VP + (tid & 7) * 16) = vreg;
        if (tid < 64) {
            const float base = __int_as_float(__builtin_amdgcn_readlane(__float_as_int(creg), 63)), d = creg - base;
            const unsigned d1 = cvt_pk_bf16(d, 0.f) & 0xffffu; const float r1 = d - bf2f(d1);
            const unsigned d2 = cvt_pk_bf16(r1, 0.f) & 0xffffu; const float r2 = r1 - bf2f(d2);
            const unsigned d3 = cvt_pk_bf16(r2, 0.f) & 0xffffu;
            *(LAS u32x4*)(Kb + tid * AT_KP + 128) = (u32x4){0x3F803F80u, 0x3F80u | ((d1 ^ 0x8000u) << 16), (d2 ^ 0x8000u) | ((d3 ^ 0x8000u) << 16), 0u};
            if (tid == 0) cb[0] = base;
        }
        LDS_BARRIER();
        kreg = kreg2; vreg = vreg2; creg = creg2;
        if (j - 2 >= jmin) AT_LOAD(j - 2, kreg2, vreg2, creg2);
        const int kb = j * 64;
        if (j >= jlo && j <= jhi) {
            f32x16 p0, p1;
            { bf16x8 kf[8];
              const bf16x8 kx0 = *(const LAS bf16x8*)(Kb + r32 * AT_KP + 128), kx1 = *(const LAS bf16x8*)(Kb + (32 + r32) * AT_KP + 128);
              const float rq = cq - cb[0];
              const unsigned q1 = cvt_pk_bf16(rq, 0.f) & 0xffffu; const float s1 = rq - bf2f(q1);
              const unsigned q2 = cvt_pk_bf16(s1, 0.f) & 0xffffu; const float s2 = s1 - bf2f(q2);
              const unsigned q3 = cvt_pk_bf16(s2, 0.f) & 0xffffu;
              const u32x4 qxw = hi ? (u32x4){0u, 0u, 0u, 0u} : (u32x4){q1 | (q2 << 16), q3 | 0x3F800000u, 0x3F803F80u, 0u};
              const bf16x8 qx = __builtin_bit_cast(bf16x8, qxw);
#pragma unroll
              for (int d0 = 0; d0 < 4; ++d0) { kf[2 * d0] = *(const LAS bf16x8*)(Kb + r32 * AT_KP + d0 * 32 + hi * 16); kf[2 * d0 + 1] = *(const LAS bf16x8*)(Kb + (32 + r32) * AT_KP + d0 * 32 + hi * 16); }
              __builtin_amdgcn_sched_barrier(0);
              { const f32x16 z = {0.f, 0.f, 0.f, 0.f, 0.f, 0.f, 0.f, 0.f, 0.f, 0.f, 0.f, 0.f, 0.f, 0.f, 0.f, 0.f};
                p0 = __builtin_amdgcn_mfma_f32_32x32x16_bf16(kx0, qx, z, 0, 0, 0); p1 = __builtin_amdgcn_mfma_f32_32x32x16_bf16(kx1, qx, z, 0, 0, 0); }
#pragma unroll
              for (int d0 = 0; d0 < 4; ++d0) { p0 = __builtin_amdgcn_mfma_f32_32x32x16_bf16(kf[2 * d0], qr[d0], p0, 0, 0, 0); p1 = __builtin_amdgcn_mfma_f32_32x32x16_bf16(kf[2 * d0 + 1], qr[d0], p1, 0, 0, 0); }
              __builtin_amdgcn_sched_barrier(0); }
            if (kb + 63 > qw0) {
                const int qg = qw0 + r32;
#pragma unroll
                for (int r = 0; r < 16; ++r) { const int kg = kb + (r & 3) + 8 * (r >> 2) + 4 * hi; if (kg > qg) p0[r] = -INFINITY; if (kg + 32 > qg) p1[r] = -INFINITY; }
            }
            float rs = 0.f;
#pragma unroll
            for (int r = 0; r < 16; ++r) { p0[r] = __builtin_amdgcn_exp2f(p0[r]); p1[r] = __builtin_amdgcn_exp2f(p1[r]); rs += p0[r] + p1[r]; }
            lsum += rs;
            const LAS unsigned char* vtb = Vb + (4 * hi + ((lane & 15) >> 2)) * AT_VP + (16 * ((lane >> 4) & 1) + 4 * (lane & 3)) * 2;
#pragma unroll
            for (int mt = 0; mt < 2; ++mt) {
                u32x2 vfr[2][2][2];
#pragma unroll
                for (int ks = 0; ks < 2; ++ks)
#pragma unroll
                    for (int dt = 0; dt < 2; ++dt)
#pragma unroll
                        for (int hf = 0; hf < 2; ++hf)
                            vfr[ks][dt][hf] = __builtin_bit_cast(u32x2, __builtin_amdgcn_ds_read_tr16_b64_v4i16((LAS v4i16_t*)(vtb + (32 * mt + 16 * ks + 8 * hf) * AT_VP + 64 * dt)));
                __builtin_amdgcn_sched_barrier(0);
#pragma unroll
                for (int ks = 0; ks < 2; ++ks) {
                    u32x4 pw;
#pragma unroll
                    for (int i = 0; i < 4; ++i) pw[i] = mt ? cvt_pk_bf16(p1[8 * ks + 2 * i], p1[8 * ks + 2 * i + 1]) : cvt_pk_bf16(p0[8 * ks + 2 * i], p0[8 * ks + 2 * i + 1]);
                    const bf16x8 pb = __builtin_bit_cast(bf16x8, pw);
#pragma unroll
                    for (int dt = 0; dt < 2; ++dt) {
                        const u32x4 vw = {vfr[ks][dt][0].x, vfr[ks][dt][0].y, vfr[ks][dt][1].x, vfr[ks][dt][1].y};
                        const bf16x8 vf = __builtin_bit_cast(bf16x8, vw);
                        if (dt == 0) o0 = __builtin_amdgcn_mfma_f32_32x32x16_bf16(vf, pb, o0, 0, 0, 0); else o1 = __builtin_amdgcn_mfma_f32_32x32x16_bf16(vf, pb, o1, 0, 0, 0);
                    }
                }
            }
        }
    }
#undef AT_LOAD
    QE_(21); QB_(22);
    lsum = x32_sum(lsum);
    const float inv = 1.f / lsum;
    float ss = 0.f;
#pragma unroll
    for (int r = 0; r < 16; ++r) { o0[r] *= inv; o1[r] *= inv; ss += o0[r] * o0[r] + o1[r] * o1[r]; }
    ss = x32_sum(ss);
    const float rstd = rsqrtf(ss * (1.f / 64.f) + EPS);
    bf16_t* orow = (bf16_t*)(ws + WS_CAT) + ((size_t)b * SEQ + qw0 + r32) * DM + h * 64;
#pragma unroll
    for (int g4 = 0; g4 < 4; ++g4) {
        u32x2 w0, w1;
        w0.x = cvt_pk_bf16(o0[4 * g4] * rstd, o0[4 * g4 + 1] * rstd); w0.y = cvt_pk_bf16(o0[4 * g4 + 2] * rstd, o0[4 * g4 + 3] * rstd);
        w1.x = cvt_pk_bf16(o1[4 * g4] * rstd, o1[4 * g4 + 1] * rstd); w1.y = cvt_pk_bf16(o1[4 * g4 + 2] * rstd, o1[4 * g4 + 3] * rstd);
        *(u32x2*)(orow + 8 * g4 + 4 * hi) = w0; *(u32x2*)(orow + 32 + 8 * g4 + 4 * hi) = w1;
    }
    LDS_BARRIER();
    QE_(22);
}

__device__ __forceinline__ void phase_route(const Params& p, LAS unsigned char* lds, int l, int bid, int G) {
    int tid = threadIdx.x; asm volatile("" : "+v"(tid));
    const int lane = tid & 63, wave = tid >> 6;
    unsigned char* ws = p.ws;
    LAS float* part = (LAS float*)lds;
    LAS float* ssp = part + 16384;
    LAS float* red = ssp + 2048;
    LAS int* cls = (LAS int*)(ssp + 512);
    LAS int* basel = cls + 64;
    unsigned* ctl = (unsigned*)(ws + WS_CTL);
    const int r16 = lane & 15, kq = lane >> 4, grp = wave >> 1, kh = wave & 1;
    for (int u = bid; u < NTOK / 64; u += G) {
        float rb[20];
#pragma unroll
        for (int jj = 0; jj < 20; ++jj) rb[jj] = jj < 4 ? PING(20)[l * 4 + jj] : PING(22)[l * 16 + jj - 4];
        {
            const int w = tid >> 6;
            const bf16_t* xr = (const bf16_t*)(ws + WS_XB) + (size_t)(u * 64 + r16) * 1024 + w * 128 + kq * 8;
            const bf16_t* wh = (const bf16_t*)(ws + WS_WRH) + ((size_t)l * 32 + r16) * 1024 + w * 128 + kq * 8;
            const bf16_t* wl = (const bf16_t*)(ws + WS_WRL) + ((size_t)l * 32 + r16) * 1024 + w * 128 + kq * 8;
            u32x4 xw[4][4]; bf16x8 wh0[4], wh1[4], wl0[4], wl1[4];
#pragma unroll
            for (int tt = 0; tt < 4; ++tt)
#pragma unroll
                for (int ks = 0; ks < 4; ++ks) xw[tt][ks] = *(const u32x4*)(xr + (size_t)tt * 16 * 1024 + ks * 32);
#pragma unroll
            for (int ks = 0; ks < 4; ++ks) { wh0[ks] = *(const bf16x8*)(wh + ks * 32); wh1[ks] = *(const bf16x8*)(wh + 16 * 1024 + ks * 32); wl0[ks] = *(const bf16x8*)(wl + ks * 32); wl1[ks] = *(const bf16x8*)(wl + 16 * 1024 + ks * 32); }
#pragma unroll
            for (int tt = 0; tt < 4; ++tt) {
                f32x4 acc0 = {0.f, 0.f, 0.f, 0.f}, acc1 = {0.f, 0.f, 0.f, 0.f}; float ssx = 0.f;
#pragma unroll
                for (int ks = 0; ks < 4; ++ks) {
#pragma unroll
                    for (int e = 0; e < 4; ++e) { const float a = bf2f(xw[tt][ks][e] & 0xffffu), b2 = bf2f(xw[tt][ks][e] >> 16); ssx += a * a + b2 * b2; }
                    const bf16x8 xh = __builtin_bit_cast(bf16x8, xw[tt][ks]);
                    acc0 = __builtin_amdgcn_mfma_f32_16x16x32_bf16(xh, wh0[ks], acc0, 0, 0, 0); acc0 = __builtin_amdgcn_mfma_f32_16x16x32_bf16(xh, wl0[ks], acc0, 0, 0, 0);
                    acc1 = __builtin_amdgcn_mfma_f32_16x16x32_bf16(xh, wh1[ks], acc1, 0, 0, 0); acc1 = __builtin_amdgcn_mfma_f32_16x16x32_bf16(xh, wl1[ks], acc1, 0, 0, 0);
                }
#pragma unroll
                for (int t = 0; t < 4; ++t) { part[(w * 64 + tt * 16 + kq * 4 + t) * 32 + r16] = acc0[t]; part[(w * 64 + tt * 16 + kq * 4 + t) * 32 + 16 + r16] = acc1[t]; }
                ssp[((w * 4 + tt) * 4 + kq) * 16 + r16] = ssx;
            }
        }
        LDS_BARRIER();
        { const int tok = tid >> 3, c4 = (tid & 7) * 4; f32x4 sum = {0.f, 0.f, 0.f, 0.f};
#pragma unroll
          for (int w8 = 0; w8 < 8; ++w8) sum += *(const LAS f32x4*)(part + (w8 * 64 + tok) * 32 + c4);
          *(LAS f32x4*)(red + tok * 32 + c4) = sum; }
        LDS_BARRIER();
        if (tid < 64) {
            const int g4 = tid >> 4, r = tid & 15, row = u * 64 + tid;
            float ss = 0.f;
#pragma unroll
            for (int q = 0; q < 32; ++q) ss += ssp[(((q >> 2) * 4 + g4) * 4 + (q & 3)) * 16 + r];
            const float rstd = rsqrtf(ss * (1.f / 1024.f) + EPS);
            float lg[20];
#pragma unroll
            for (int jj = 0; jj < 20; ++jj) lg[jj] = red[tid * 32 + jj] * rstd + rb[jj];
            int gi = 0; float gm = lg[0];
#pragma unroll
            for (int j = 1; j < 4; ++j) if (lg[j] > gm) { gm = lg[j]; gi = j; }
            float den = 0.f;
#pragma unroll
            for (int j = 0; j < 4; ++j) den += __expf(lg[j] - gm);
            const float pg = 1.f / den;
            float e[4];
#pragma unroll
            for (int j = 0; j < 4; ++j) e[j] = gi == 0 ? lg[4 + j] : (gi == 1 ? lg[8 + j] : (gi == 2 ? lg[12 + j] : lg[16 + j]));
            int a = 0; float ea = e[0];
#pragma unroll
            for (int j = 1; j < 4; ++j) if (e[j] > ea) { ea = e[j]; a = j; }
            int bq = -1; float eb = -INFINITY;
#pragma unroll
            for (int j = 0; j < 4; ++j) if (j != a && e[j] > eb) { eb = e[j]; bq = j; }
            const float pb = __expf(eb - ea), wa = pg / (1.f + pb), wb = pg * pb / (1.f + pb);
            const int e1 = a < bq ? a : bq, e2 = a < bq ? bq : a;
            const int pi = e1 == 0 ? e2 - 1 : (e1 == 1 ? e2 + 1 : 5);
            ((f32x2*)(ws + WS_WTS))[row] = (f32x2){a < bq ? wa : wb, a < bq ? wb : wa};
            const int c = gi * 6 + pi; int rank = 0, cnt = 0;
#pragma unroll
            for (int k = 0; k < 24; ++k) { const unsigned long long mk = __ballot(c == k);
                const int below = (int)__builtin_amdgcn_mbcnt_hi((unsigned)(mk >> 32), __builtin_amdgcn_mbcnt_lo((unsigned)mk, 0u));
                if (c == k) rank = below;
                if (tid == k) cnt = __builtin_popcountll(mk); }
            int basec = 0;
            if (tid < 24 && cnt) basec = (int)atomicAdd(&ctl[CW_MOECNT + l * 1024 + tid * 32], (unsigned)cnt);
            basec = __builtin_amdgcn_ds_bpermute(c * 4, basec);
            ((int*)(ws + WS_TOKC))[c * 16384 + basec + rank] = row;
        }
        LDS_BARRIER();
    }
}

__device__ __forceinline__ void moe_table(const Params& p, volatile LAS int* tab, int l) {
    int tid = threadIdx.x; asm volatile("" : "+v"(tid));
    if (tid < 64) {
        int cnt = 0;
        if (tid < 24) { const unsigned voff = (unsigned)(CW_MOECNT + l * 1024 + tid * 32) * 4u; const unsigned* ctl = (const unsigned*)((const char*)p.ws + voff); cnt = (int)__hip_atomic_load(ctl, __ATOMIC_RELAXED, __HIP_MEMORY_SCOPE_AGENT); }
        const int ch = (cnt + 255) >> 8; int pre = 0;
#pragma unroll
        for (int k = 0; k < 24; ++k) { const int v = __builtin_amdgcn_readlane(ch, k); if (tid > k) pre += v; }
        if (tid < 25) tab[tid] = pre;
        if (tid < 24) tab[32 + tid] = cnt;
    }
    LDS_BARRIER();
}

__device__ __forceinline__ void phase_final(const Params& p, int bid, int G) {
    int tid = threadIdx.x; asm volatile("" : "+v"(tid));
    const int lane = tid & 63, wave = tid >> 6;
    const int gw = bid * NWAVES + wave, NGW = G * NWAVES;
    for (int row = gw; row < NTOK; row += NGW) {
        const u32x2* xr = (const u32x2*)((const bf16_t*)(p.ws + WS_XB) + (size_t)row * 1024) + lane; f32x4 v[4]; float s = 0.f;
#pragma unroll
        for (int j = 0; j < 4; ++j) { const u32x2 w = xr[64 * j]; v[j] = (f32x4){bf2f(w.x & 0xffffu), bf2f(w.x >> 16), bf2f(w.y & 0xffffu), bf2f(w.y >> 16)}; s += (v[j].x * v[j].x + v[j].y * v[j].y) + (v[j].z * v[j].z + v[j].w * v[j].w); }
        const float rstd = rsqrtf(wave_sum(s) * (1.f / 1024.f) + EPS);
        f32x4* orow = (f32x4*)(p.out + (size_t)row * 1024) + lane;
#pragma unroll
        for (int j = 0; j < 4; ++j) { const f32x4 gg = ((const f32x4*)PIN(26))[64 * j + lane]; orow[64 * j] = (f32x4){v[j].x * rstd * gg.x, v[j].y * rstd * gg.y, v[j].z * rstd * gg.z, v[j].w * rstd * gg.w}; }
    }
}

#define MOE_DEAL(bid_, nlate_, late_, lu_, lc_, db_, ds_, dc_) do { const int r_ = (bid_) & 7, rk_ = (bid_) >> 3, nr_ = ((((nlate_) >> 2) - r_ + 7) >> 3), m_ = 32 - 4 * nr_, k_ = rk_ - 4 * nr_; \
        late_ = rk_ < 4 * nr_; lc_ = r_ + 8 * (rk_ >> 2); lu_ = 256 + 4 * lc_ + (rk_ & 3); db_ = r_ * 32 + k_; ds_ = m_; dc_ = (!late_ && m_ > 0) ? (31 - k_) / m_ + 1 : 0; } while (0)
template <class Sched>
struct RstdTablePre {
    static constexpr bool active = true;
    const Sched& S; const float* ssq; LAS float* rt;
    __device__ __forceinline__ void operator()() const {
        int t_ = threadIdx.x; asm volatile("" : "+v"(t_)); Unit uu; int pmv[4]; int nu = 0;
#pragma unroll
        for (int i = 0; i < 4; ++i) { pmv[i] = 0; if (nu == i && S.next(i, uu)) { pmv[i] = __builtin_amdgcn_readfirstlane(uu.pm); nu = i + 1; } }
        nu = __builtin_amdgcn_readfirstlane(nu);
        float rv[4];
#pragma unroll
        for (int i = 0; i < 4; ++i) rv[i] = (i < nu && t_ < 256) ? row_rstd(ssq, pmv[i] * 256 + t_) : 0.f;
#pragma unroll
        for (int i = 0; i < 4; ++i) if (i < nu && t_ < 256) rt[i * 256 + t_] = rv[i];
    }
};

struct MoeUpTablePre {
    static constexpr bool active = true;
    const SchedMoe& S; const unsigned char* ws; const float* ssq; LAS float* tb;
    __device__ __forceinline__ void operator()() const {
        int t_ = threadIdx.x; asm volatile("" : "+v"(t_)); Unit uu;
        if (S.next(0, uu) && t_ < 256) { const bool valid = t_ < uu.a2; const int tok = valid ? ((const int*)(ws + WS_TOKC))[uu.a1 + t_] : 0; const f32x2 w2 = ((const f32x2*)(ws + WS_WTS))[tok];
            tb[t_] = row_rstd(ssq, tok); tb[256 + t_] = valid ? (uu.a3 ? w2.y : w2.x) : 0.f; }
    }
};

struct MoeDownTablePre {
    static constexpr bool active = true;
    const SchedMoe& S; const unsigned char* ws; LAS int* tt; int lim;
    __device__ __forceinline__ void operator()() const {
        int t_ = threadIdx.x; asm volatile("" : "+v"(t_)); Unit uu;
        for (int i = 0; i < lim && S.next(2 * i, uu); ++i) if (t_ < 256) tt[i * 256 + t_] = (t_ < uu.a2) ? ((const int*)(ws + WS_TOKC))[uu.a1 + t_] : 0;
    }
};

constexpr int N_PHASES = 3 + 9 * NLAYER + 1;
__global__ void __launch_bounds__(NTHR, 2) mk_fwd(Params p) {
    extern __shared__ __attribute__((aligned(16))) unsigned char lds_raw[];
    LAS unsigned char* lds = (LAS unsigned char*)lds_raw;
    volatile LAS unsigned* MISC = (volatile LAS unsigned*)(lds + LDS_MISC);
    const int tid = threadIdx.x;
    const int G = gridDim.x, bid = blockIdx.x;
    unsigned char* ws = p.ws;
    for (int u = tid; u < 256; u += NTHR) MISC[u] = 0u;
    __syncthreads();
    const int lo = p.ph_lo, hi = p.ph_hi;
    const bool use_bar = (hi - lo) > 1;
    XcdBarrier bar; bar.bar = (unsigned*)(ws + WS_CTL) + CW_BAR; bar.x = 0; bar.st = MISC + 8;
    if (use_bar) { bar = xcd_barrier_post((unsigned*)(ws + WS_CTL) + CW_BAR, MISC + 8);
        if (tid == 0) atomicOr((unsigned*)(ws + WS_CTL) + CW_CHK + (bid & 7), 1u << bar.x); }
#if PROBE_ID
    volatile LAS unsigned long long* tprobe = (volatile LAS unsigned long long*)(MISC + 128);
#define PB(id) do { if (PROBE_ID == (id) && threadIdx.x == 0) tprobe[1] = __builtin_amdgcn_s_memrealtime(); } while (0)
#define PE(id) do { if (PROBE_ID == (id) && threadIdx.x == 0) { tprobe[0] = tprobe[0] + (__builtin_amdgcn_s_memrealtime() - tprobe[1]); tprobe[2] = tprobe[2] + 1ull; } } while (0)
#else
#define PB(id) do {} while (0)
#define PE(id) do {} while (0)
#endif
#define IN(k) (lo <= (k) && (k) < hi)
#define SEAM(k) do { if ((k) + 1 < hi) { PB(1); xcd_barrier(bar); PE(1); } } while (0)
    const float* ssq = (const float*)(ws + WS_SSQ);
    bf16_t* xb = (bf16_t*)(ws + WS_XB);

    if (PHON(0) && IN(0)) { PB(9); phase_pro_a(p, lds, bid, G); PE(9); SEAM(0); }
    if (use_bar && lo == 0 && hi == N_PHASES && G == 256 && !PROBE_ID) {
        if (tid == 0) { unsigned ok = 1u;
            for (int r = 0; r < 8; ++r) { const unsigned m = xb_ld((unsigned*)(ws + WS_CTL) + CW_CHK + r); ok &= (m != 0u && (m & (m - 1u)) == 0u) ? 1u : 0u; }
            SchedGrid S0{64, 4, 256, G, bid, nullptr, nullptr, 0, 0, 0, DM}; Unit uu; unsigned pq = 0u; if (S0.next(0, uu)) pq = (unsigned)(uu.pm * 4 + uu.pn);
            MISC[12] = ok; MISC[13] = pq; }
        __syncthreads();
    }
#define xok (__builtin_amdgcn_readfirstlane(MISC[12]) != 0u)
#define SEAMX(k) do { if (xok) { if ((k) + 1 < hi) xcd_local_barrier(bar, (unsigned*)(ws + WS_CTL) + CW_LSUB, (unsigned*)(ws + WS_CTL) + CW_LGEN); } else SEAM(k); } while (0)
    for (int l = 0; l < NLAYER; ++l) {
        const int pb = 3 + 9 * l;
        if (!(lo < pb + 9 && pb < hi)) continue;
        int bidv_ = bid, Gv_ = G; asm volatile("" : "+s"(bidv_), "+s"(Gv_));
        const int bid = bidv_, G = Gv_;
        if (PHON(3) && IN(pb + 0)) { PB(7);
            int bidl = bid; asm volatile("" : "+s"(bidl));
            SchedGrid S{64, 12, 768, G, bidl, (const char*)xb, (const char*)(ws + WS_WIN) + (size_t)l * 3072 * 2048, (size_t)256 * 2048, (size_t)256 * 2048, 0, NY};
            LAS float* rt = (LAS float*)(lds + LDS_RSTD);
            RstdTablePre<SchedGrid> PRE{S, ssq, rt};
            EpiBf16 E{(bf16_t*)(ws + WS_R1), NY, ssq, (unsigned*)(ws + WS_KT) + (size_t)l * 4096, rt};
            const bool lf_first = ((bidl >> 3) & 1) != 0;
#pragma unroll 1
            for (int st = 0; st < 2; ++st) {
                if ((st == 0) == lf_first) phase_logf(p, lds, l, bid, G);
                else pg8::gemm_phase<EpiBf16, SchedGrid, true, false, false, RstdTablePre<SchedGrid>>(lds, GemmDesc{1024, 2048u, 2048u, 0}, S, E, PRE);
            }
            PE(7); SEAM(pb + 0);
        }
        const bool split = use_bar && IN(pb + 1) && IN(pb + 2) && lo < pb && !PROBE_ID;
        unsigned* sbw = (unsigned*)(ws + WS_CTL) + CW_SB + l * 32;
        if (PHON(4) && IN(pb + 1)) { PB(12); phase_p2a(p, lds, l, bid, G); PE(12); if (split) xcd_split_arrive(bar, sbw); else SEAM(pb + 1); }
        if (PHON(5) && IN(pb + 2)) { PB(13);
            {
                volatile LAS int* qslot = (volatile LAS int*)(MISC + 96);
                int Gq = G, bq = bid; asm volatile("" : "+s"(Gq), "+s"(bq));
                const int NS = (Gq >= 8 && (Gq & 7) == 0) ? 8 : 1, xs = bq & (NS - 1);
                const int hEi = CW_Q8 + (l * 8 + xs) * 32, hTi = CW_ATTQ + l;
#define QPULL(wi_) ([&]() { int hi_ = (wi_); asm volatile("" : "+s"(hi_)); return (int)atomicAdd((unsigned*)(p.ws + WS_CTL) + hi_, 1u); }())
                const int KV8 = (l == 0) ? 8 : 0, SZE = KV8 + 96, SZET = SZE * (8 / NS), SZT = 512 + (l == 0 ? 192 : 0);
                if (threadIdx.x == 0) qslot[0] = QPULL(hEi);
                LDS_BARRIER();
                bool ready = !split, tail = false;
                for (;;) {
                    int qi = __builtin_amdgcn_readfirstlane(qslot[0]);
                    LDS_BARRIER();
                    if (!tail && qi >= SZET) {
                        tail = true;
                        if (threadIdx.x == 0) qslot[0] = QPULL(hTi);
                        LDS_BARRIER();
                        qi = __builtin_amdgcn_readfirstlane(qslot[0]);
                        LDS_BARRIER();
                    }
                    if (tail && qi >= SZT) break;
                    int nxt = 0;
                    if (!tail && threadIdx.x == 0) nxt = QPULL(hEi);
                    int kind, id;
                    if (!tail) { const int v = xs + NS * (qi / SZE), e = qi % SZE - KV8;
                        if (e < 0) { kind = 0; id = v * 8 + e + KV8; }
                        else if (e < 32) { kind = 1; id = v * 64 + e; }
                        else { const int a = e - 32; kind = 2; id = (v + 8 * (a & 1)) * 32 + (a >> 1); } }
                    else { if (qi < 256) { kind = 3; id = qi; } else if (qi < 512) { kind = 1; id = ((qi - 256) >> 5) * 64 + 32 + ((qi - 256) & 31); } else { kind = 4; id = qi - 512; } }
                    if (kind == 0) { SchedKV SK{1 << 20, id, (const char*)(ws + WS_MEMN), (const char*)(ws + WS_WKVT)};
                        EpiBf16 EK{(bf16_t*)(ws + WS_KV), 2048, nullptr, nullptr, nullptr};
                        pg8::gemm_phase<EpiBf16, SchedKV, false, false, false>(lds, GemmDesc{1024, 2048u, 2048u, 0}, SK, EK); }
                    else if (kind == 1) conv_unit(p, lds, l, id);
                    else if (kind == 4) { int t_ = threadIdx.x; asm volatile("" : "+v"(t_));
#pragma unroll 1
                        for (int k = 0; k < 4; ++k) conv_item(p, 0, conv_deferred_r(2048 + id * 32 + k * 8 + (t_ >> 6)), (LAS float*)(lds + (t_ >> 6) * 16384), t_ & 63); }
                    else {
                        if (!ready) { xcd_split_wait(bar, sbw); ready = true; }
                        if (kind == 2) attn_unit_mfma(p, lds, l, id); else hgrn_unit<true>(p, lds, l, id); }
                    if (threadIdx.x == 0) qslot[0] = tail ? QPULL(hTi) : nxt;
                    LDS_BARRIER();
                }
#undef QPULL
            }
            PE(13); SEAM(pb + 2);
        }
        if (PHON(6) && IN(pb + 3)) { PB(2);
            if (l == 0) {
                { SchedQK SQ{G, bid, (const char*)(ws + WS_KV), (const char*)(ws + WS_WQS)};
                  EpiBf16 EQ{(bf16_t*)(ws + WS_WQK), 1024, nullptr, nullptr, nullptr};
                  pg8::gemm_phase<EpiBf16, SchedQK, false, false, false>(lds, GemmDesc{256, 4096u, 2048u, 0}, SQ, EQ); }
                { SchedVO SV{G, (bid + G / 2) % G, (const char*)(ws + WS_KV), (const char*)(ws + WS_WOT)};
                  EpiBf16 EV{(bf16_t*)(ws + WS_WVO), 1024, nullptr, nullptr, nullptr};
                  pg8::gemm_phase<EpiBf16, SchedVO, false, false, false>(lds, GemmDesc{256, 2048u, 4096u, 0}, SV, EV); }
            }
            SchedGrid S{64, 4, 256, G, bid, (const char*)(ws + WS_CAT), (const char*)(ws + WS_WOUT) + (size_t)l * 1024 * 2048, (size_t)256 * 2048, (size_t)256 * 2048, 0, DM};
            EpiResidual E{xb, (float*)(ws + WS_SSQ)};
            pg8::gemm_phase<EpiResidual, SchedGrid, false, false, false>(lds, GemmDesc{1024, 2048u, 2048u, 0}, S, E);
            PE(2); if (l > 0) SEAMX(pb + 3); else SEAM(pb + 3);
        }
        if (PHON(7) && IN(pb + 4)) { PB(8);
            int bidl = bid; asm volatile("" : "+s"(bidl));
            SchedGrid S{64, 4, 256, G, bidl, (const char*)xb, (const char*)(ws + WS_WQK) + (size_t)l * 2 * 1024 * 2048, (size_t)256 * 2048, (size_t)256 * 2048, (size_t)1024 * 2048, DM};
            LAS float* rt = (LAS float*)(lds + LDS_RSTD);
            RstdTablePre<SchedGrid> PRE{S, ssq, rt};
            EpiSoftmax E{(bf16_t*)(ws + WS_PBUF), ssq, (LAS float*)(lds + LDS_EPI), rt};
            pg8::gemm_phase<EpiSoftmax, SchedGrid, true, false, false, RstdTablePre<SchedGrid>>(lds, GemmDesc{1024, 2048u, 2048u, 0}, S, E, PRE);
            PE(8); SEAMX(pb + 4);
        }
        if (PHON(8) && IN(pb + 5)) { PB(3);
            SchedGrid S{64, 4, 256, G, bid, (const char*)(ws + WS_PBUF), (const char*)(ws + WS_WVO) + (size_t)l * 2 * 1024 * 2048, (size_t)256 * 2048, (size_t)256 * 2048, (size_t)1024 * 2048, DM};
            EpiResidual E{xb, (float*)(ws + WS_SSQ)};
            pg8::gemm_phase<EpiResidual, SchedGrid, false, false, false>(lds, GemmDesc{1024, 2048u, 2048u, 0}, S, E);
            PE(3); SEAMX(pb + 5);
        }
        if (PHON(9) && IN(pb + 6)) { PB(4); phase_route(p, lds, l, xok ? (int)__builtin_amdgcn_readfirstlane(MISC[13]) : bid, G); PE(4);   SEAM(pb + 6); }
        if (PHON(10) && IN(pb + 7)) { PB(5);
            volatile LAS int* tab = (volatile LAS int*)(MISC + 16);
            moe_table(p, tab, l);
            const int nun = __builtin_amdgcn_readfirstlane(tab[24]) * 4;
            const bool redeal = (G == 256) && nun > G && (nun - G) <= 224;
            SchedMoe S{bid, G, redeal ? 1 : (bid < nun ? (nun - 1 - bid) / G + 1 : 0), false, tab, (const int*)(ws + WS_TOKC), (const char*)xb, (const char*)(ws + WS_WGU) + (size_t)l * 16 * 512 * 2048};
            MoeUpTablePre PRE{S, ws, ssq, (LAS float*)(lds + LDS_RSTD)};
            EpiMoeUp E{(bf16_t*)(ws + WS_HID), (const int*)(ws + WS_TOKC), ssq, (const f32x2*)(ws + WS_WTS), (const LAS float*)(lds + LDS_RSTD)};
            pg8::gemm_phase<EpiMoeUp, SchedMoe, false, true, false, MoeUpTablePre>(lds, GemmDesc{1024, 2048u, 2048u, 0}, S, E, PRE);
            PE(5);
            if (xok && redeal) { if ((pb + 7) + 1 < hi) xcd_local_barrier(bar, (unsigned*)(ws + WS_CTL) + CW_LSUB, (unsigned*)(ws + WS_CTL) + CW_LGEN); } else SEAM(pb + 7);
        }
        if (PHON(11) && IN(pb + 8)) { PB(6);
            volatile LAS int* tab = (volatile LAS int*)(MISC + 16);
            const bool pre = IN(pb + 7);
            if (!pre) moe_table(p, tab, l);
            const int nun = __builtin_amdgcn_readfirstlane(tab[24]) * 4;
            const bool redeal = (G == 256) && nun > G && (nun - G) <= 224;
            const int nlate = redeal ? nun - G : 0;
            bool late_ = false; int lu_ = 0, lc_ = 0, db_ = 0, ds_ = 1, dc_ = 0; if (redeal) MOE_DEAL(bid, nlate, late_, lu_, lc_, db_, ds_, dc_);
            if (redeal) {
                { SchedMoe S{lu_, G, late_ ? 1 : 0, false, tab, (const int*)(ws + WS_TOKC), (const char*)xb, (const char*)(ws + WS_WGU) + (size_t)l * 16 * 512 * 2048, -1};
                  MoeUpTablePre PRE{S, ws, ssq, (LAS float*)(lds + LDS_RSTD) + 512};
                  EpiMoeUp E{(bf16_t*)(ws + WS_HID), (const int*)(ws + WS_TOKC), ssq, (const f32x2*)(ws + WS_WTS), (const LAS float*)(lds + LDS_RSTD) + 512};
                  pg8::gemm_phase<EpiMoeUp, SchedMoe, false, true, false, MoeUpTablePre>(lds, GemmDesc{1024, 2048u, 2048u, 0}, S, E, PRE); }
                if (late_) {
                    asm volatile("s_waitcnt vmcnt(0)" ::: "memory"); __syncthreads();
                    if (threadIdx.x == 0) {
                        if (!xok) { __builtin_amdgcn_fence(__ATOMIC_RELEASE, "agent"); asm volatile("s_waitcnt vmcnt(0)" ::: "memory"); }
                        unsigned* cw = (unsigned*)(ws + WS_CTL) + CW_MOESYNC + l * 64 + lc_;
                        (void)xb_add(cw, 1u);
                        unsigned sp = 0u; while (xb_ld(cw) < 4u) { __builtin_amdgcn_s_sleep(1); if (++sp > XB_SPIN_CAP) break; }
                        __builtin_amdgcn_fence(__ATOMIC_ACQUIRE, "agent"); asm volatile("s_waitcnt vmcnt(0)" ::: "memory");
                    }
                    __syncthreads();
                }
            }
            SchedMoe S{redeal ? (late_ ? lu_ : db_) : bid, redeal ? (late_ ? G : ds_) : G,
                       redeal ? (late_ ? 1 : dc_) : (bid < nun ? (nun - 1 - bid) / G + 1 : 0),
                       true, tab, (const int*)(ws + WS_TOKC), (const char*)(ws + WS_HID), (const char*)(ws + WS_WD) + (size_t)l * 16 * 1024 * 512, redeal ? -1 : 0};
            MoeDownTablePre PRED{S, ws, (LAS int*)(lds + LDS_RSTD), late_ ? 1 : 4};
            EpiMoeDown E{xb, (float*)(ws + WS_SSQ), (const int*)(ws + WS_TOKC), (const LAS int*)(lds + LDS_RSTD)};
            pg8::gemm_phase<EpiMoeDown, SchedMoe, false, false, true, MoeDownTablePre>(lds, GemmDesc{256, 1024u, 512u, 0}, S, E, PRED);
            if (l + 1 < NLAYER) {
                volatile LAS int* fslot = (volatile LAS int*)(MISC + 100);
                unsigned* fq = (unsigned*)(ws + WS_CTL) + CW_CONVQ + l;
                int t_ = threadIdx.x; asm volatile("" : "+v"(t_));
                LAS float* scr = (LAS float*)(lds + (t_ >> 6) * 16384);
                for (;;) {
                    if (t_ == 0) fslot[0] = (int)atomicAdd(fq, 1u);
                    LDS_BARRIER();
                    const int cb = __builtin_amdgcn_readfirstlane(fslot[0]) * 32;
                    LDS_BARRIER();
                    if (cb >= 8192) break;
#pragma unroll 1
                    for (int k = 0; k < 4; ++k) conv_item(p, l + 1, conv_deferred_r(cb + k * 8 + (t_ >> 6)), scr, t_ & 63);
                }
            }
            PE(6); SEAM(pb + 8);
        }
    }
    if (IN(N_PHASES - 1)) { PB(11); phase_final(p, bid, G); PE(11); }
#if PROBE_ID
    if (threadIdx.x == 0) { const unsigned long long cnt_ = tprobe[2] ? tprobe[2] : 1ull; const unsigned long long tgt = __builtin_amdgcn_s_memrealtime() + (PROBE_ID >= 40 ? 256ull * tprobe[0] / cnt_ : PROBE_AMP * tprobe[0]); while (__builtin_amdgcn_s_memrealtime() < tgt) __builtin_amdgcn_s_sleep(8); }
#endif
#undef IN
#undef SEAM
#undef SEAMX
#undef xok
}

extern "C" void kernel_launch(void* const* d_in, const int* in_sizes, int n_in, void* d_out, int out_size, void* d_ws, size_t ws_size, hipStream_t stream) {
    static int grid = 0;
    if (grid == 0) {
        if (n_in != 27 || out_size != NTOK * DM || ws_size < WS_END) { fprintf(stderr, "kernel_launch: unexpected shapes (n_in %d out %d ws %zu)\n", n_in, out_size, ws_size); grid = -1; return; }
        int dev = 0, cus = 0, per_cu = 0;
        if (hipGetDevice(&dev) != hipSuccess || hipDeviceGetAttribute(&cus, hipDeviceAttributeMultiprocessorCount, dev) != hipSuccess) { grid = -1; return; }
        if (hipFuncSetAttribute((const void*)mk_fwd, hipFuncAttributeMaxDynamicSharedMemorySize, LDS_BYTES) != hipSuccess) { fprintf(stderr, "kernel_launch: hipFuncSetAttribute failed\n"); grid = -1; return; }
        if (hipOccupancyMaxActiveBlocksPerMultiprocessor(&per_cu, (const void*)mk_fwd, NTHR, LDS_BYTES) != hipSuccess || per_cu < 1) { fprintf(stderr, "kernel_launch: occupancy query reports %d\n", per_cu); }
        (void)hipGetLastError();
        grid = cus;
    }
    if (grid < 0) return;
    (void)hipMemsetAsync((char*)d_ws + WS_CTL, 0, CTL_ZERO_BYTES, stream);
    Params a{};
    for (int i = 0; i < 27; ++i) a.in[i] = (const float*)d_in[i];
    a.out = (float*)d_out; a.ws = (unsigned char*)d_ws;
#if ONE_LAUNCH
    a.ph_lo = 0; a.ph_hi = N_PHASES;
    hipLaunchKernelGGL(mk_fwd, dim3(grid), dim3(NTHR), LDS_BYTES, stream, a);
#else
    for (int k = 0; k < N_PHASES; ++k) { a.ph_lo = k; a.ph_hi = k + 1; const int kind = k < 3 ? k : (k == N_PHASES - 1 ? 12 : 3 + (k - 3) % 9);
        for (int rr = 0; rr < RUNS(kind); ++rr) hipLaunchKernelGGL(mk_fwd, dim3(grid), dim3(NTHR), LDS_BYTES, stream, a); }
#endif
}
```
